# Optimizing an MI355X kernel written in HIP

```python
import jax, jax.numpy as jnp
from jax import lax
import numpy as np

D_MODEL = 1024
BATCH = 2
SEQ = 8192
DEPTH = 1

CHUNK = 64
Q_BLOCK = 2 * CHUNK
CONV_CH = D_MODEL // 2
CONV_WIDTH = 31
FOX_HEADS = 8
FOX_HEAD_DIM = 64
FOX_WIDTH = FOX_HEADS * FOX_HEAD_DIM
N_EXPERTS = 256
TOP_K = 8
N_GROUPS = 8
TOPK_GROUPS = 4
EXPERT_HIDDEN = 256
SHARED_HIDDEN = 256
ROUTED_SCALE = 2.5
EXPERT_BLOCK = 128
LN_EPS = 1e-5
DEEPNORM_ALPHA = (2.0 * DEPTH) ** 0.25
DEEPNORM_BETA = (8.0 * DEPTH) ** -0.25
IN_COLS = 2 * CONV_CH + 3 * FOX_WIDTH + FOX_HEADS + 2 * D_MODEL

kernel_name = 'hybrid_conformer_fox_moe_deepnorm_adaln'


def layer_norm(x, g=None, b=None):
    xf = x.astype(jnp.float32)
    mu = jnp.mean(xf, axis=-1, keepdims=True)
    xc = xf - mu
    var = jnp.mean(xc * xc, axis=-1, keepdims=True)
    y = xc * lax.rsqrt(var + LN_EPS)
    if g is not None:
        y = y * g.astype(jnp.float32) + b.astype(jnp.float32)
    return y.astype(x.dtype)


def causal_depthwise_conv(u, w, b):
    k = w.shape[0]
    out = lax.conv_general_dilated(
        u, w[:, None, :].astype(u.dtype), window_strides=(1,), padding=[(k - 1, 0)],
        dimension_numbers=('NWC', 'WIO', 'NWC'), feature_group_count=u.shape[-1])
    return out + b


def forgetting_attention(q, k, v, log_f):
    bsz, seq, nh, dh = q.shape
    nb = seq // Q_BLOCK
    scale = dh ** -0.5
    cum = jnp.cumsum(log_f, axis=1)
    qb = q.reshape(bsz, nb, Q_BLOCK, nh, dh).transpose(1, 0, 3, 2, 4)
    cq = cum.reshape(bsz, nb, Q_BLOCK, nh).transpose(1, 0, 3, 2)
    kh = k.transpose(0, 2, 1, 3)
    vh = v.transpose(0, 2, 1, 3)
    ck = cum.transpose(0, 2, 1)
    key_pos = jnp.arange(seq)

    def block(args):
        q_blk, cq_blk, i = args
        s = jnp.einsum('bhqd,bhkd->bhqk', q_blk, kh,
                       preferred_element_type=jnp.float32) * scale
        s = s + (cq_blk[..., :, None] - ck[:, :, None, :])
        q_pos = i * Q_BLOCK + jnp.arange(Q_BLOCK)
        s = jnp.where(key_pos[None, :] <= q_pos[:, None], s, -1e30)
        p = jax.nn.softmax(s, axis=-1)
        return jnp.einsum('bhqk,bhkd->bhqd', p.astype(vh.dtype), vh)

    o = lax.map(block, (qb, cq, jnp.arange(nb)))
    return o.transpose(1, 0, 3, 2, 4).reshape(bsz, seq, nh * dh)


def token_mixers(h, w_in, b_forget, conv_w, conv_b, conv_ln_g, conv_ln_b,
                 w_conv_out, w_fox_out, w_mix_out):
    bsz, seq, _ = h.shape
    proj = h @ w_in
    o1 = 2 * CONV_CH
    o2 = o1 + FOX_WIDTH
    o3 = o2 + FOX_WIDTH
    o4 = o3 + FOX_WIDTH
    o5 = o4 + FOX_HEADS
    o6 = o5 + D_MODEL
    conv_in, q, k, v, f_logit, gate_a, gate_b = jnp.split(
        proj, [o1, o2, o3, o4, o5, o6], axis=-1)
    ua, ub = jnp.split(conv_in, 2, axis=-1)
    u = ua * jax.nn.sigmoid(ub)
    u = causal_depthwise_conv(u, conv_w, conv_b)
    u = jax.nn.silu(layer_norm(u, conv_ln_g, conv_ln_b))
    y_a = u @ w_conv_out
    log_f = jax.nn.log_sigmoid(f_logit.astype(jnp.float32) + b_forget.astype(jnp.float32))
    heads = lambda t: t.reshape(bsz, seq, FOX_HEADS, FOX_HEAD_DIM)
    y_b = forgetting_attention(heads(q), heads(k), heads(v), log_f) @ w_fox_out
    merged = jax.nn.sigmoid(gate_a) * y_a + jax.nn.sigmoid(gate_b) * y_b
    return merged @ w_mix_out


def moe_ffn(h, w_router, router_bias, w_exp_gate, w_exp_up, w_exp_down,
            w_sh_gate, w_sh_up, w_sh_down):
    t = h.shape[0]
    scores = jax.nn.sigmoid(h.astype(jnp.float32) @ w_router.astype(jnp.float32))
    sel = scores + router_bias.astype(jnp.float32)
    gsel = sel.reshape(t, N_GROUPS, N_EXPERTS // N_GROUPS)
    group_score = lax.top_k(gsel, 2)[0].sum(-1)
    _, top_groups = lax.top_k(group_score, TOPK_GROUPS)
    group_mask = jax.nn.one_hot(top_groups, N_GROUPS).sum(1) > 0
    masked = jnp.where(group_mask[:, :, None], gsel, -jnp.inf).reshape(t, N_EXPERTS)
    _, top_idx = lax.top_k(masked, TOP_K)
    wts = jnp.take_along_axis(scores, top_idx, axis=-1)
    wts = wts / jnp.sum(wts, axis=-1, keepdims=True) * ROUTED_SCALE

    n_assign = t * TOP_K
    n_pad = -(-(n_assign + N_EXPERTS * (EXPERT_BLOCK - 1)) // EXPERT_BLOCK) * EXPERT_BLOCK
    n_blocks = n_pad // EXPERT_BLOCK
    flat_e = top_idx.reshape(n_assign)
    flat_tok = jnp.arange(n_assign, dtype=jnp.int32) // TOP_K
    flat_w = wts.reshape(n_assign)
    order = jnp.argsort(flat_e)
    e_sorted = flat_e[order]
    tok_sorted = flat_tok[order]
    w_sorted = flat_w[order]
    counts = jnp.bincount(flat_e, length=N_EXPERTS)
    start = jnp.cumsum(counts) - counts
    padded = (counts + EXPERT_BLOCK - 1) // EXPERT_BLOCK * EXPERT_BLOCK
    pend = jnp.cumsum(padded)
    pstart = pend - padded
    dest = pstart[e_sorted] + (jnp.arange(n_assign) - start[e_sorted])
    row_tok = jnp.zeros((n_pad,), jnp.int32).at[dest].set(tok_sorted)
    row_w = jnp.zeros((n_pad,), jnp.float32).at[dest].set(w_sorted)
    block_expert = jnp.clip(
        jnp.searchsorted(pend, jnp.arange(n_blocks) * EXPERT_BLOCK, side='right'),
        0, N_EXPERTS - 1)

    def expert_block(args):
        rows, rw, e = args
        xb = h[rows]
        y = (jax.nn.silu(xb @ w_exp_gate[e]) * (xb @ w_exp_up[e])) @ w_exp_down[e]
        return y * rw[:, None].astype(y.dtype)

    y_pad = lax.map(expert_block, (row_tok.reshape(n_blocks, EXPERT_BLOCK),
                                   row_w.reshape(n_blocks, EXPERT_BLOCK), block_expert))
    routed = jax.ops.segment_sum(y_pad.reshape(n_pad, -1), row_tok, num_segments=t)
    shared = (jax.nn.silu(h @ w_sh_gate) * (h @ w_sh_up)) @ w_sh_down
    return routed.astype(h.dtype) + shared


def setup_inputs(seed: int = 0) -> dict:
    key = jax.random.key(seed)
    ks = jax.random.split(key, 25)
    nrm = lambda k, shape, s: jax.random.normal(k, shape, jnp.float32) * s
    L, D, E, F = DEPTH, D_MODEL, N_EXPERTS, EXPERT_HIDDEN
    beta = DEEPNORM_BETA
    return {
        'x': nrm(ks[0], (BATCH, SEQ, D), 1.0),
        'c': nrm(ks[1], (BATCH, D), 1.0),
        'w_ada': nrm(ks[2], (L, D, 6 * D), 0.1 * D ** -0.5),
        'b_ada': nrm(ks[3], (L, 6 * D), 0.01),
        'w_in': nrm(ks[4], (L, D, IN_COLS), D ** -0.5),
        'b_forget': jnp.linspace(1.0, 6.0, FOX_HEADS)[None, :] + nrm(ks[5], (L, FOX_HEADS), 0.1),
        'conv_w': nrm(ks[6], (L, CONV_WIDTH, CONV_CH), CONV_WIDTH ** -0.5),
        'conv_b': nrm(ks[7], (L, CONV_CH), 0.01),
        'conv_ln_g': 1.0 + nrm(ks[8], (L, CONV_CH), 0.01),
        'conv_ln_b': nrm(ks[9], (L, CONV_CH), 0.01),
        'w_conv_out': nrm(ks[10], (L, CONV_CH, D), CONV_CH ** -0.5 * beta),
        'w_fox_out': nrm(ks[11], (L, FOX_WIDTH, D), FOX_WIDTH ** -0.5 * beta),
        'w_mix_out': nrm(ks[12], (L, D, D), D ** -0.5 * beta),
        'ln1_g': 1.0 + nrm(ks[13], (L, D), 0.01),
        'ln1_b': nrm(ks[14], (L, D), 0.01),
        'w_router': nrm(ks[15], (L, D, E), D ** -0.5),
        'router_bias': nrm(ks[16], (L, E), 0.01),
        'w_exp_gate': nrm(ks[17], (L, E, D, F), D ** -0.5),
        'w_exp_up': nrm(ks[18], (L, E, D, F), D ** -0.5),
        'w_exp_down': nrm(ks[19], (L, E, F, D), F ** -0.5 * beta),
        'w_sh_gate': nrm(ks[20], (L, D, SHARED_HIDDEN), D ** -0.5),
        'w_sh_up': nrm(ks[21], (L, D, SHARED_HIDDEN), D ** -0.5),
        'w_sh_down': nrm(ks[22], (L, SHARED_HIDDEN, D), SHARED_HIDDEN ** -0.5 * beta),
        'ln2_g': 1.0 + nrm(ks[23], (L, D), 0.01),
        'ln2_b': nrm(ks[24], (L, D), 0.01),
    }


def reference(x, c, w_ada, b_ada, w_in, b_forget, conv_w, conv_b, conv_ln_g, conv_ln_b,
              w_conv_out, w_fox_out, w_mix_out, ln1_g, ln1_b, w_router, router_bias,
              w_exp_gate, w_exp_up, w_exp_down, w_sh_gate, w_sh_up, w_sh_down,
              ln2_g, ln2_b):
    bsz, seq, d = x.shape
    cond = jax.nn.silu(c)
    for l in range(DEPTH):
        ada = (cond @ w_ada[l] + b_ada[l])[:, None, :]
        shift1, scale1, gate1, shift2, scale2, gate2 = jnp.split(ada, 6, axis=-1)
        h = layer_norm(x) * (1 + scale1) + shift1
        y = token_mixers(h, w_in[l], b_forget[l], conv_w[l], conv_b[l], conv_ln_g[l],
                         conv_ln_b[l], w_conv_out[l], w_fox_out[l], w_mix_out[l])
        x = layer_norm(DEEPNORM_ALPHA * x + (1 + gate1) * y, ln1_g[l], ln1_b[l])
        h = layer_norm(x) * (1 + scale2) + shift2
        y = moe_ffn(h.reshape(bsz * seq, d), w_router[l], router_bias[l], w_exp_gate[l],
                    w_exp_up[l], w_exp_down[l], w_sh_gate[l], w_sh_up[l],
                    w_sh_down[l]).reshape(bsz, seq, d)
        x = layer_norm(DEEPNORM_ALPHA * x + (1 + gate2) * y, ln2_g[l], ln2_b[l])
    return x
```

```cpp
#include <hip/hip_runtime.h>
#include <cstdio>
#include <cstdint>

#define LAS __attribute__((address_space(3)))
typedef unsigned short bf16_t;
typedef float f32x4 __attribute__((ext_vector_type(4)));
typedef unsigned u32x4 __attribute__((ext_vector_type(4)));
typedef unsigned u32x2 __attribute__((ext_vector_type(2)));

constexpr int NB = 2, S = 8192, D = 1024, T = NB * S;
constexpr int CC = 512, CW = 31, NH = 8, HD = 64, FW = 512;
constexpr int NE = 256, TOPK = 8, NG = 8, EH = 256, SHH = 256;
constexpr int INC = 4616;
constexpr int O_Q = 1024, O_K = 1536, O_V = 2048, O_F = 2560, O_GA = 2568, O_GB = 3592;
constexpr float LN_EPS = 1e-5f;
constexpr float ALPHA = 1.189207115002721f;
constexpr float LOG2E = 1.4426950408889634f;
constexpr float QSCALE = 0.125f * LOG2E;
constexpr float ROUTED_SCALE = 2.5f;
constexpr int NWAVES = 8, NTHR = 512;
constexpr int LCAP = 16384;
constexpr int NSLOT = 9;

constexpr size_t MiB = 1u << 20;
constexpr size_t WS_CTL = 0, CTL_BYTES = 1 * MiB;
constexpr size_t WS_ADA = 1 * MiB;
constexpr size_t WS_ADAP = 1 * MiB + 64 * 1024;
constexpr size_t WS_CUM = 2 * MiB;
constexpr size_t WS_LOGF = 2 * MiB + 512 * 1024;
constexpr size_t WS_H = 20 * MiB;
constexpr size_t WS_U = 52 * MiB, WS_Q = 68 * MiB, WS_K = 84 * MiB, WS_V = 100 * MiB, WS_AC = 116 * MiB, WS_O = 132 * MiB;
constexpr size_t WS_GA = 148 * MiB, WS_GB = 180 * MiB, WS_YA = 212 * MiB, WS_MG = 244 * MiB;
constexpr size_t WS_YAS = 20 * MiB;
constexpr size_t WS_X1 = 308 * MiB;
constexpr size_t WS_H2 = 372 * MiB, WS_H2LO = 404 * MiB;
constexpr size_t WS_RL = 436 * MiB;
constexpr size_t WS_SHID = 484 * MiB;
constexpr size_t WS_LIST = 492 * MiB, WS_LISTW = 508 * MiB;
constexpr size_t WS_HID = 524 * MiB;
constexpr size_t WS_PROJ = 640 * MiB;
constexpr size_t WS_END = 1024 * MiB;
constexpr int CW_CNT = 1024;

__device__ __forceinline__ float bf2f(bf16_t v) { return __uint_as_float((unsigned)v << 16); }
__device__ __forceinline__ unsigned f2bf(float f) { unsigned u = __float_as_uint(f); return (u + 0x7fffu + ((u >> 16) & 1u)) >> 16; }
__device__ __forceinline__ unsigned pk2(float lo, float hi) { return f2bf(lo) | (f2bf(hi) << 16); }
__device__ __forceinline__ float wave_sum(float v) {
#pragma unroll
    for (int o = 1; o < 64; o <<= 1) v += __shfl_xor(v, o);
    return v;
}
__device__ __forceinline__ float wave_max(float v) {
#pragma unroll
    for (int o = 1; o < 64; o <<= 1) v = fmaxf(v, __shfl_xor(v, o));
    return v;
}
__device__ __forceinline__ float sigmoidf_(float x) { return 1.0f / (1.0f + expf(-x)); }
__device__ __forceinline__ float siluf_(float x) { return x / (1.0f + expf(-x)); }


constexpr int CW_BAR = 4096;
#define XB_TMO      128
#define XB_XCNT(j)  (256  + 64 * (j))
#define XB_XSUB(j)  (1280 + 64 * (j))
#define XB_XGEN(j)  (2304 + 64 * (j))
#define XB_TOP      3328
#define XB_TOPGEN   3392
#define XCD_BAR_WORDS 3456
#define XB_SPIN_CAP (1u << 20)
__device__ __forceinline__ unsigned xb_ld(unsigned* p)              { return __hip_atomic_load(p, __ATOMIC_RELAXED, __HIP_MEMORY_SCOPE_AGENT); }
__device__ __forceinline__ unsigned xb_add(unsigned* p, unsigned v) { return __hip_atomic_fetch_add(p, v, __ATOMIC_RELAXED, __HIP_MEMORY_SCOPE_AGENT); }
__device__ __forceinline__ unsigned xb_xcc_id() { return (unsigned)__builtin_amdgcn_s_getreg((3 << 11) | 20) & 0xFu; }
#define XB_SPIN(cond, bar) do { unsigned _sp = 0; while (cond) { __builtin_amdgcn_s_sleep(1); \
    if ((++_sp & 255u) == 0u) { if (xb_ld(&(bar)[XB_TMO])) break; if (_sp > XB_SPIN_CAP) { atomicAdd(&(bar)[XB_TMO], 1u); break; } } } } while (0)
struct XcdBarrier { unsigned* bar; unsigned x; volatile LAS unsigned* st; };
__device__ __forceinline__ XcdBarrier xcd_barrier_post(unsigned* bar, volatile LAS unsigned* st) {
    XcdBarrier b; b.bar = bar; b.x = xb_xcc_id(); b.st = st;
    if (threadIdx.x == 0) (void)xb_add(&bar[XB_XCNT(b.x)], 1u);
    return b;
}
__device__ __forceinline__ void xcd_barrier_complete(unsigned* bar, unsigned x, unsigned& nloc, unsigned& nx) {
    const unsigned G = gridDim.x * gridDim.y * gridDim.z;
    unsigned sum, cnt, mine, sp = 0u;
    for (;;) {
        sum = 0u; cnt = 0u; mine = 0u;
#pragma unroll
        for (unsigned j = 0; j < 16; ++j) { const unsigned c = xb_ld(&bar[XB_XCNT(j)]); sum += c; cnt += (c > 0u) ? 1u : 0u; mine = (j == x) ? c : mine; }
        if (sum == G) break;
        __builtin_amdgcn_s_sleep(1);
        if ((++sp & 255u) == 0u) { if (xb_ld(&bar[XB_TMO])) break; if (sp > XB_SPIN_CAP) { atomicAdd(&bar[XB_TMO], 1u); break; } }
    }
    nloc = mine > 0u ? mine : 1u; nx = cnt > 0u ? cnt : 1u;
}
__device__ __forceinline__ void xcd_barrier(const XcdBarrier& b) {
    asm volatile("s_waitcnt vmcnt(0)" ::: "memory");
    __syncthreads();
    if (threadIdx.x == 0) {
        unsigned* bar = b.bar;
        __builtin_amdgcn_s_waitcnt(0);
        unsigned nloc = b.st[0], nx = b.st[1];
        if (nloc == 0u) { xcd_barrier_complete(bar, b.x, nloc, nx); b.st[0] = nloc; b.st[1] = nx; }
        const unsigned old = xb_add(&bar[XB_XSUB(b.x)], 1u);
        const unsigned gen = old / nloc;
        if (old + 1u == (gen + 1u) * nloc) {
            __builtin_amdgcn_fence(__ATOMIC_RELEASE, "agent");
            asm volatile("s_waitcnt vmcnt(0)" ::: "memory");
            const unsigned og = xb_add(&bar[XB_TOP], 1u);
            const unsigned tg = og / nx;
            if (og + 1u == (tg + 1u) * nx) xb_add(&bar[XB_TOPGEN], 1u);
            else XB_SPIN(xb_ld(&bar[XB_TOPGEN]) == tg, bar);
            __builtin_amdgcn_fence(__ATOMIC_ACQUIRE, "agent");
            xb_add(&bar[XB_XGEN(b.x)], 1u);
            asm volatile("s_waitcnt vmcnt(0)" ::: "memory");
        } else {
            XB_SPIN(xb_ld(&bar[XB_XGEN(b.x)]) == gen, bar);
            __builtin_amdgcn_fence(__ATOMIC_ACQUIRE, "agent");
            asm volatile("s_waitcnt vmcnt(0)" ::: "memory");
        }
    }
    __syncthreads();
}

struct Args { const float* in[25]; float* out; unsigned char* ws; int ph_lo, ph_hi; };

struct Frame {
    LAS unsigned char* lds;
    int tid, lane, wave, gw, NGW;
    const float *x, *c, *w_ada, *b_ada, *w_in, *b_forget, *conv_w, *conv_b, *conv_ln_g, *conv_ln_b, *w_conv_out, *w_fox_out, *w_mix_out, *ln1_g, *ln1_b,
        *w_router, *router_bias, *w_exp_gate, *w_exp_up, *w_exp_down, *w_sh_gate, *w_sh_up, *w_sh_down, *ln2_g, *ln2_b;
    float* out; unsigned char* ws;
    unsigned* ctl;
    float *ADA, *ADAP, *CUM, *LOGF, *X1, *RL, *LISTW, *PROJ;
    bf16_t *H, *U, *Q, *K, *V, *AC, *O, *GA, *GB, *YA, *MG, *YAS, *H2, *H2LO, *SHID, *HID;
    int* LIST;
};

template <bool DUAL, class FA, class FB, class FB2, class FE>
__device__ __forceinline__ void ngemm_tile(LAS float* sm, int K, FA fa, FB fb, FB2 fb2, FE fe) {
    LAS float* As = sm; LAS float* Bs = sm + 1088; LAS float* Bs2 = Bs + 2048;
    const int tid = threadIdx.x, ty = tid >> 5, tx = tid & 31;
    float acc[4][4], acc2[4][4];
#pragma unroll
    for (int i = 0; i < 4; ++i)
#pragma unroll
        for (int j = 0; j < 4; ++j) { acc[i][j] = 0.f; acc2[i][j] = 0.f; }
    for (int k0 = 0; k0 < K; k0 += 16) {
#pragma unroll
        for (int i = 0; i < 2; ++i) { const int idx = tid + i * 512, r = idx >> 4, kk = idx & 15; As[kk * 68 + r] = fa(r, k0 + kk); }
#pragma unroll
        for (int i = 0; i < 4; ++i) { const int idx = tid + i * 512, kk = idx >> 7, n = idx & 127; Bs[kk * 128 + n] = fb(k0 + kk, n); if (DUAL) Bs2[kk * 128 + n] = fb2(k0 + kk, n); }
        __syncthreads();
#pragma unroll
        for (int kk = 0; kk < 16; ++kk) {
            const f32x4 a = *(const LAS f32x4*)(As + kk * 68 + ty * 4), b = *(const LAS f32x4*)(Bs + kk * 128 + tx * 4);
#pragma unroll
            for (int i = 0; i < 4; ++i)
#pragma unroll
                for (int j = 0; j < 4; ++j) acc[i][j] += a[i] * b[j];
            if (DUAL) { const f32x4 b2 = *(const LAS f32x4*)(Bs2 + kk * 128 + tx * 4);
#pragma unroll
                for (int i = 0; i < 4; ++i)
#pragma unroll
                    for (int j = 0; j < 4; ++j) acc2[i][j] += a[i] * b2[j]; }
        }
        __syncthreads();
    }
#pragma unroll
    for (int i = 0; i < 4; ++i)
#pragma unroll
        for (int j = 0; j < 4; ++j) fe(ty * 4 + i, tx * 4 + j, acc[i][j], acc2[i][j]);
}
#define NOFB2 [=](int, int) -> float { return 0.f; }

__device__ __forceinline__ void ph_ada(Frame& F) {
    const float* c = F.c; const float* w = F.w_ada; float* P = F.ADAP;
    for (int it = F.gw; it < 24 * 8; it += F.NGW) {
        const int jg = it % 24, kc = it / 24, j0 = jg * 256 + F.lane * 4;
        f32x4 a0 = {0.f, 0.f, 0.f, 0.f}, a1 = {0.f, 0.f, 0.f, 0.f};
        for (int k = kc * 128; k < kc * 128 + 128; ++k) {
            const f32x4 wv = *(const f32x4*)(w + (size_t)k * 6144 + j0);
            const float c0 = siluf_(c[k]), c1 = siluf_(c[D + k]);
            a0 += wv * c0; a1 += wv * c1;
        }
        *(f32x4*)(P + (size_t)(kc * 2 + 0) * 6144 + j0) = a0;
        *(f32x4*)(P + (size_t)(kc * 2 + 1) * 6144 + j0) = a1;
    }
}

__device__ __forceinline__ void ph_lnmod(Frame& F) {
    LAS float* ada1 = (LAS float*)F.lds;
    LAS float* wf = ada1 + 4096;
    const float* ADAP = F.ADAP; const float* b_ada = F.b_ada;
    for (int i = F.tid; i < 4096; i += NTHR) { const int b = i >> 11, j = i & 2047; float s = b_ada[j];
        for (int p = 0; p < 8; ++p) s += ADAP[(size_t)(p * 2 + b) * 6144 + j];
        ada1[i] = s; }
    for (int i = F.tid; i < 8192; i += NTHR) { const int k = i >> 3, hh = i & 7; wf[hh * 1024 + k] = F.w_in[(size_t)k * INC + O_F + hh]; }
    if (blockIdx.x == 0) for (int i = F.tid; i < 2 * 6144; i += NTHR) { const int b = i / 6144, j = i % 6144; float s = b_ada[j];
        for (int p = 0; p < 8; ++p) s += ADAP[(size_t)(p * 2 + b) * 6144 + j];
        F.ADA[i] = s; }
    __syncthreads();
    const int lane = F.lane;
    for (int m = F.gw; m < T; m += F.NGW) {
        const int b = m >> 13;
        const f32x4* xr = (const f32x4*)(F.x + (size_t)m * D) + lane;
        f32x4 v[4]; float s = 0.f;
#pragma unroll
        for (int j = 0; j < 4; ++j) { v[j] = xr[64 * j]; s += (v[j].x + v[j].y) + (v[j].z + v[j].w); }
        const float mean = wave_sum(s) * (1.f / D); float s2 = 0.f;
#pragma unroll
        for (int j = 0; j < 4; ++j) { v[j] = v[j] - mean; s2 += (v[j].x * v[j].x + v[j].y * v[j].y) + (v[j].z * v[j].z + v[j].w * v[j].w); }
        const float rstd = 1.f / sqrtf(wave_sum(s2) * (1.f / D) + LN_EPS);
        float fl[8];
#pragma unroll
        for (int hh = 0; hh < 8; ++hh) fl[hh] = 0.f;
        u32x2* hrow = (u32x2*)(F.H + (size_t)m * D) + lane;
#pragma unroll
        for (int j = 0; j < 4; ++j) { const int col = 4 * lane + 256 * j;
            const f32x4 sh = *(const LAS f32x4*)(ada1 + b * 2048 + col), sc = *(const LAS f32x4*)(ada1 + b * 2048 + 1024 + col);
            const f32x4 h = v[j] * rstd * (sc + 1.0f) + sh;
            u32x2 o; o.x = pk2(h.x, h.y); o.y = pk2(h.z, h.w); hrow[64 * j] = o;
#pragma unroll
            for (int hh = 0; hh < 8; ++hh) { const f32x4 w = *(const LAS f32x4*)(wf + hh * 1024 + col); fl[hh] += (h.x * w.x + h.y * w.y) + (h.z * w.z + h.w * w.w); } }
#pragma unroll
        for (int hh = 0; hh < 8; ++hh) fl[hh] = wave_sum(fl[hh]);
        float f = fl[0];
#pragma unroll
        for (int hh = 1; hh < 8; ++hh) f = (lane == hh) ? fl[hh] : f;
        if (lane < 8) { const float z = f + F.b_forget[lane]; F.LOGF[(size_t)m * 8 + lane] = fminf(z, 0.f) - log1pf(expf(-fabsf(z))); }
    }
}

__device__ __forceinline__ void ph_scan(Frame& F) {
    if (blockIdx.x >= 16) return;
    LAS double* sc = (LAS double*)F.lds;
    const int bh = blockIdx.x, b = bh >> 3, hh = bh & 7, s0 = F.tid * 16;
    double loc[16]; double run = 0.0;
#pragma unroll
    for (int i = 0; i < 16; ++i) { run += (double)F.LOGF[(size_t)(b * S + s0 + i) * 8 + hh]; loc[i] = run; }
    sc[F.tid] = run;
    __syncthreads();
    double off = 0.0;
    for (int i = 0; i < F.tid; ++i) off += sc[i];
#pragma unroll
    for (int i = 0; i < 16; ++i) F.CUM[(size_t)bh * S + s0 + i] = (float)(off + loc[i]);
    __syncthreads();
}

__device__ __forceinline__ void ph_inproj_simple(Frame& F) {
    LAS float* sm = (LAS float*)F.lds;
    const bf16_t* H = F.H; const float* w_in = F.w_in; float* PROJ = F.PROJ;
    constexpr int NTN = (INC + 127) / 128;
    for (int u = blockIdx.x; u < (T / 64) * NTN; u += gridDim.x) {
        const int m0 = (u / NTN) * 64, n0 = (u % NTN) * 128;
        ngemm_tile<false>(sm, D,
            [=](int r, int k) -> float { return bf2f(H[(size_t)(m0 + r) * D + k]); },
            [=](int k, int n) -> float { return (n0 + n < INC) ? w_in[(size_t)k * INC + n0 + n] : 0.f; },
            NOFB2,
            [=](int r, int n, float a, float) { if (n0 + n < INC) PROJ[(size_t)(m0 + r) * INC + n0 + n] = a; });
    }
}
__device__ __forceinline__ void ph_split_simple(Frame& F) {
    const float* PROJ = F.PROJ;
    const size_t total = (size_t)T * INC;
    for (size_t i = (size_t)blockIdx.x * NTHR + F.tid; i < total; i += (size_t)gridDim.x * NTHR) {
        const int m = (int)(i / INC), col = (int)(i % INC); const float v = PROJ[i];
        if (col < 512) F.U[(size_t)m * 512 + col] = (bf16_t)f2bf(v * sigmoidf_(PROJ[i + 512]));
        else if (col < O_Q) {}
        else if (col < O_K) F.Q[(size_t)m * 512 + col - O_Q] = (bf16_t)f2bf(v * QSCALE);
        else if (col < O_V) F.K[(size_t)m * 512 + col - O_K] = (bf16_t)f2bf(v);
        else if (col < O_F) F.V[(size_t)m * 512 + col - O_V] = (bf16_t)f2bf(v);
        else if (col < O_GA) {}
        else if (col < O_GB) F.GA[(size_t)m * D + col - O_GA] = (bf16_t)f2bf(sigmoidf_(v));
        else F.GB[(size_t)m * D + col - O_GB] = (bf16_t)f2bf(sigmoidf_(v));
    }
}

__device__ __forceinline__ void ph_conv(Frame& F) {
    LAS float* cw = (LAS float*)F.lds;
    LAS float* cb = cw + CW * CC;
    for (int i = F.tid; i < CW * CC; i += NTHR) cw[i] = F.conv_w[i];
    for (int i = F.tid; i < CC; i += NTHR) { cb[i] = F.conv_b[i]; cb[CC + i] = F.conv_ln_g[i]; cb[2 * CC + i] = F.conv_ln_b[i]; }
    __syncthreads();
    const int lane = F.lane, c0 = lane * 8;
    for (int m = F.gw; m < T; m += F.NGW) {
        const int t = m & (S - 1);
        float a[8];
#pragma unroll
        for (int i = 0; i < 8; ++i) a[i] = cb[c0 + i];
        for (int j = 0; j < CW; ++j) {
            const int tt = t - (CW - 1) + j;
            if (tt >= 0) {
                const u32x4 uv = *(const u32x4*)(F.U + (size_t)(m - (CW - 1) + j) * CC + c0);
                const f32x4 w0 = *(const LAS f32x4*)(cw + j * CC + c0), w1 = *(const LAS f32x4*)(cw + j * CC + c0 + 4);
                a[0] += __uint_as_float(uv.x << 16) * w0.x; a[1] += __uint_as_float(uv.x & 0xffff0000u) * w0.y;
                a[2] += __uint_as_float(uv.y << 16) * w0.z; a[3] += __uint_as_float(uv.y & 0xffff0000u) * w0.w;
                a[4] += __uint_as_float(uv.z << 16) * w1.x; a[5] += __uint_as_float(uv.z & 0xffff0000u) * w1.y;
                a[6] += __uint_as_float(uv.w << 16) * w1.z; a[7] += __uint_as_float(uv.w & 0xffff0000u) * w1.w;
            }
        }
        float s = 0.f;
#pragma unroll
        for (int i = 0; i < 8; ++i) s += a[i];
        const float mean = wave_sum(s) * (1.f / CC); float s2 = 0.f;
#pragma unroll
        for (int i = 0; i < 8; ++i) { a[i] -= mean; s2 += a[i] * a[i]; }
        const float rstd = 1.f / sqrtf(wave_sum(s2) * (1.f / CC) + LN_EPS);
        float y[8];
#pragma unroll
        for (int i = 0; i < 8; ++i) y[i] = siluf_(a[i] * rstd * cb[CC + c0 + i] + cb[2 * CC + c0 + i]);
        u32x4 o; o.x = pk2(y[0], y[1]); o.y = pk2(y[2], y[3]); o.z = pk2(y[4], y[5]); o.w = pk2(y[6], y[7]);
        *(u32x4*)(F.AC + (size_t)m * CC + c0) = o;
    }
}

__device__ __forceinline__ void ph_attn_simple(Frame& F) {
    const int lane = F.lane;
    for (int idx = F.gw; idx < 16 * S; idx += F.NGW) {
        const int bh = idx & 15, q = idx >> 4, b = bh >> 3, hh = bh & 7;
        const size_t m = (size_t)b * S + q;
        float qv[64];
        { const u32x4* qp = (const u32x4*)(F.Q + m * FW + hh * HD);
#pragma unroll
          for (int c = 0; c < 8; ++c) { const u32x4 w = qp[c];
              qv[8 * c + 0] = __uint_as_float(w.x << 16); qv[8 * c + 1] = __uint_as_float(w.x & 0xffff0000u); qv[8 * c + 2] = __uint_as_float(w.y << 16); qv[8 * c + 3] = __uint_as_float(w.y & 0xffff0000u);
              qv[8 * c + 4] = __uint_as_float(w.z << 16); qv[8 * c + 5] = __uint_as_float(w.z & 0xffff0000u); qv[8 * c + 6] = __uint_as_float(w.w << 16); qv[8 * c + 7] = __uint_as_float(w.w & 0xffff0000u); } }
        const float* cum = F.CUM + (size_t)bh * S;
        const float Fq = cum[q];
        const bf16_t* Kb = F.K + (size_t)b * S * FW + hh * HD; const bf16_t* Vb = F.V + (size_t)b * S * FW + hh * HD;
        float mx = -3.0e38f;
        for (int s0 = 0; s0 <= q; s0 += 64) {
            const int s = s0 + lane, sc = s <= q ? s : q;
            const u32x4* kp = (const u32x4*)(Kb + (size_t)sc * FW);
            float dot = 0.f;
#pragma unroll
            for (int c = 0; c < 8; ++c) { const u32x4 w = kp[c];
                dot += qv[8 * c + 0] * __uint_as_float(w.x << 16) + qv[8 * c + 1] * __uint_as_float(w.x & 0xffff0000u) + qv[8 * c + 2] * __uint_as_float(w.y << 16) + qv[8 * c + 3] * __uint_as_float(w.y & 0xffff0000u)
                     + qv[8 * c + 4] * __uint_as_float(w.z << 16) + qv[8 * c + 5] * __uint_as_float(w.z & 0xffff0000u) + qv[8 * c + 6] * __uint_as_float(w.w << 16) + qv[8 * c + 7] * __uint_as_float(w.w & 0xffff0000u); }
            const float s2 = dot + (Fq - cum[sc]) * LOG2E;
            if (s <= q) mx = fmaxf(mx, s2);
        }
        mx = wave_max(mx);
        float l = 0.f; float o[64];
#pragma unroll
        for (int d = 0; d < 64; ++d) o[d] = 0.f;
        for (int s0 = 0; s0 <= q; s0 += 64) {
            const int s = s0 + lane, sc = s <= q ? s : q;
            const u32x4* kp = (const u32x4*)(Kb + (size_t)sc * FW);
            float dot = 0.f;
#pragma unroll
            for (int c = 0; c < 8; ++c) { const u32x4 w = kp[c];
                dot += qv[8 * c + 0] * __uint_as_float(w.x << 16) + qv[8 * c + 1] * __uint_as_float(w.x & 0xffff0000u) + qv[8 * c + 2] * __uint_as_float(w.y << 16) + qv[8 * c + 3] * __uint_as_float(w.y & 0xffff0000u)
                     + qv[8 * c + 4] * __uint_as_float(w.z << 16) + qv[8 * c + 5] * __uint_as_float(w.z & 0xffff0000u) + qv[8 * c + 6] * __uint_as_float(w.w << 16) + qv[8 * c + 7] * __uint_as_float(w.w & 0xffff0000u); }
            const float s2 = dot + (Fq - cum[sc]) * LOG2E;
            const float p = (s <= q) ? exp2f(s2 - mx) : 0.f;
            l += p;
            const u32x4* vp = (const u32x4*)(Vb + (size_t)sc * FW);
#pragma unroll
            for (int c = 0; c < 8; ++c) { const u32x4 w = vp[c];
                o[8 * c + 0] += p * __uint_as_float(w.x << 16); o[8 * c + 1] += p * __uint_as_float(w.x & 0xffff0000u); o[8 * c + 2] += p * __uint_as_float(w.y << 16); o[8 * c + 3] += p * __uint_as_float(w.y & 0xffff0000u);
                o[8 * c + 4] += p * __uint_as_float(w.z << 16); o[8 * c + 5] += p * __uint_as_float(w.z & 0xffff0000u); o[8 * c + 6] += p * __uint_as_float(w.w << 16); o[8 * c + 7] += p * __uint_as_float(w.w & 0xffff0000u); }
        }
        l = wave_sum(l);
        float res = 0.f;
#pragma unroll
        for (int d = 0; d < 64; ++d) { const float od = wave_sum(o[d]); res = (lane == d) ? od : res; }
        F.O[m * FW + hh * HD + lane] = (bf16_t)f2bf(res / l);
    }
}

__device__ __forceinline__ void ph_merge_simple(Frame& F) {
    LAS float* sm = (LAS float*)F.lds;
    const bf16_t *AC = F.AC, *O = F.O, *GA = F.GA, *GB = F.GB; bf16_t *YA = F.YA, *MG = F.MG; const float *wc = F.w_conv_out, *wf = F.w_fox_out;
    for (int u = blockIdx.x; u < (T / 64) * 8; u += gridDim.x) {
        const int m0 = (u >> 3) * 64, n0 = (u & 7) * 128;
        ngemm_tile<false>(sm, CC,
            [=](int r, int k) -> float { return bf2f(AC[(size_t)(m0 + r) * CC + k]); },
            [=](int k, int n) -> float { return wc[(size_t)k * D + n0 + n]; }, NOFB2,
            [=](int r, int n, float a, float) { const size_t i = (size_t)(m0 + r) * D + n0 + n; YA[i] = (bf16_t)f2bf(bf2f(GA[i]) * a); });
        ngemm_tile<false>(sm, FW,
            [=](int r, int k) -> float { return bf2f(O[(size_t)(m0 + r) * FW + k]); },
            [=](int k, int n) -> float { return wf[(size_t)k * D + n0 + n]; }, NOFB2,
            [=](int r, int n, float a, float) { const size_t i = (size_t)(m0 + r) * D + n0 + n; MG[i] = (bf16_t)f2bf(bf2f(YA[i]) + bf2f(GB[i]) * a); });
    }
}
__device__ __forceinline__ void ph_mix_simple(Frame& F) {
    LAS float* sm = (LAS float*)F.lds;
    const bf16_t* MG = F.MG; const float *wm = F.w_mix_out, *x = F.x, *ADA = F.ADA; float* Z = F.X1;
    for (int u = blockIdx.x; u < (T / 64) * 8; u += gridDim.x) {
        const int m0 = (u >> 3) * 64, n0 = (u & 7) * 128, b = m0 >> 13;
        ngemm_tile<false>(sm, D,
            [=](int r, int k) -> float { return bf2f(MG[(size_t)(m0 + r) * D + k]); },
            [=](int k, int n) -> float { return wm[(size_t)k * D + n0 + n]; }, NOFB2,
            [=](int r, int n, float a, float) { const size_t i = (size_t)(m0 + r) * D + n0 + n; Z[i] = ALPHA * x[i] + (1.0f + ADA[b * 6144 + 2048 + n0 + n]) * a; });
    }
}

__device__ __forceinline__ void ph_ln2(Frame& F) {
    const int lane = F.lane;
    for (int m = F.gw; m < T; m += F.NGW) {
        const int b = m >> 13;
        f32x4* zr = (f32x4*)(F.X1 + (size_t)m * D) + lane;
        f32x4 v[4]; float s = 0.f;
#pragma unroll
        for (int j = 0; j < 4; ++j) { v[j] = zr[64 * j]; s += (v[j].x + v[j].y) + (v[j].z + v[j].w); }
        float mean = wave_sum(s) * (1.f / D); float s2 = 0.f;
#pragma unroll
        for (int j = 0; j < 4; ++j) { v[j] = v[j] - mean; s2 += (v[j].x * v[j].x + v[j].y * v[j].y) + (v[j].z * v[j].z + v[j].w * v[j].w); }
        float rstd = 1.f / sqrtf(wave_sum(s2) * (1.f / D) + LN_EPS);
        s = 0.f;
#pragma unroll
        for (int j = 0; j < 4; ++j) { const int col = 4 * lane + 256 * j;
            v[j] = v[j] * rstd * *(const f32x4*)(F.ln1_g + col) + *(const f32x4*)(F.ln1_b + col);
            zr[64 * j] = v[j]; s += (v[j].x + v[j].y) + (v[j].z + v[j].w); }
        mean = wave_sum(s) * (1.f / D); s2 = 0.f;
#pragma unroll
        for (int j = 0; j < 4; ++j) { v[j] = v[j] - mean; s2 += (v[j].x * v[j].x + v[j].y * v[j].y) + (v[j].z * v[j].z + v[j].w * v[j].w); }
        rstd = 1.f / sqrtf(wave_sum(s2) * (1.f / D) + LN_EPS);
        u32x2* hr = (u32x2*)(F.H2 + (size_t)m * D) + lane; u32x2* lr = (u32x2*)(F.H2LO + (size_t)m * D) + lane;
#pragma unroll
        for (int j = 0; j < 4; ++j) { const int col = 4 * lane + 256 * j;
            const f32x4 sh = *(const f32x4*)(F.ADA + b * 6144 + 3072 + col), sc = *(const f32x4*)(F.ADA + b * 6144 + 4096 + col);
            const f32x4 h = v[j] * rstd * (sc + 1.0f) + sh;
            const unsigned h0 = f2bf(h.x), h1 = f2bf(h.y), h2 = f2bf(h.z), h3 = f2bf(h.w);
            u32x2 o; o.x = h0 | (h1 << 16); o.y = h2 | (h3 << 16); hr[64 * j] = o;
            u32x2 l; l.x = pk2(h.x - __uint_as_float(h0 << 16), h.y - __uint_as_float(h1 << 16)); l.y = pk2(h.z - __uint_as_float(h2 << 16), h.w - __uint_as_float(h3 << 16)); lr[64 * j] = l; }
    }
}

__device__ __forceinline__ void ph_router_simple(Frame& F) {
    LAS float* sm = (LAS float*)F.lds;
    const bf16_t *H2 = F.H2, *H2LO = F.H2LO; const float *wr = F.w_router, *wg = F.w_sh_gate, *wu = F.w_sh_up; float* RL = F.RL; bf16_t* SHID = F.SHID;
    for (int u = blockIdx.x; u < (T / 64) * 4; u += gridDim.x) {
        const int m0 = (u >> 2) * 64, which = (u & 3) >> 1, n0 = (u & 1) * 128;
        if (which == 0)
            ngemm_tile<false>(sm, D,
                [=](int r, int k) -> float { const size_t i = (size_t)(m0 + r) * D + k; return bf2f(H2[i]) + bf2f(H2LO[i]); },
                [=](int k, int n) -> float { return wr[(size_t)k * NE + n0 + n]; }, NOFB2,
                [=](int r, int n, float a, float) { RL[(size_t)(m0 + r) * NE + n0 + n] = a; });
        else
            ngemm_tile<true>(sm, D,
                [=](int r, int k) -> float { return bf2f(H2[(size_t)(m0 + r) * D + k]); },
                [=](int k, int n) -> float { return wg[(size_t)k * SHH + n0 + n]; },
                [=](int k, int n) -> float { return wu[(size_t)k * SHH + n0 + n]; },
                [=](int r, int n, float g, float up) { SHID[(size_t)(m0 + r) * SHH + n0 + n] = (bf16_t)f2bf(siluf_(g) * up); });
    }
}

__device__ __forceinline__ void ph_route(Frame& F, int nparts) {
    const int lane = F.lane;
    for (int t = F.gw; t < T; t += F.NGW) {
        f32x4 lg = *(const f32x4*)(F.RL + (size_t)t * NE + lane * 4);
        for (int p = 1; p < nparts; ++p) lg += *(const f32x4*)(F.RL + (size_t)p * T * NE + (size_t)t * NE + lane * 4);
        const f32x4 bias = *(const f32x4*)(F.router_bias + lane * 4);
        float sc[4], sel[4];
#pragma unroll
        for (int i = 0; i < 4; ++i) { sc[i] = sigmoidf_(lg[i]); sel[i] = sc[i] + bias[i]; }
        float a1 = fmaxf(sel[0], sel[1]), a2 = fminf(sel[0], sel[1]);
        { const float b1 = fmaxf(sel[2], sel[3]), b2 = fminf(sel[2], sel[3]); const float n1 = fmaxf(a1, b1), n2 = fmaxf(fminf(a1, b1), fmaxf(a2, b2)); a1 = n1; a2 = n2; }
#pragma unroll
        for (int o = 1; o < 8; o <<= 1) { const float b1 = __shfl_xor(a1, o), b2 = __shfl_xor(a2, o); const float n1 = fmaxf(a1, b1), n2 = fmaxf(fminf(a1, b1), fmaxf(a2, b2)); a1 = n1; a2 = n2; }
        const float gs = a1 + a2; const int g = lane >> 3;
        int rank = 0;
#pragma unroll
        for (int gg = 0; gg < NG; ++gg) { const float og = __shfl(gs, gg * 8); rank += (og > gs || (og == gs && gg < g)) ? 1 : 0; }
        const bool gsel = rank < 4;
        float mv[4];
#pragma unroll
        for (int i = 0; i < 4; ++i) mv[i] = gsel ? sel[i] : -INFINITY;
        float myw = 0.f; int mye = 0; float wsum = 0.f;
#pragma unroll
        for (int k = 0; k < TOPK; ++k) {
            float bv = mv[0]; int bi = 0;
#pragma unroll
            for (int i = 1; i < 4; ++i) if (mv[i] > bv) { bv = mv[i]; bi = i; }
            int be = lane * 4 + bi; float bs = sc[0];
#pragma unroll
            for (int i = 1; i < 4; ++i) bs = (bi == i) ? sc[i] : bs;
            float v = bv; int e = be; float s = bs;
#pragma unroll
            for (int o = 1; o < 64; o <<= 1) { const float ov = __shfl_xor(v, o); const int oe = __shfl_xor(e, o); const float os = __shfl_xor(s, o);
                if (ov > v || (ov == v && oe < e)) { v = ov; e = oe; s = os; } }
            if ((e >> 2) == lane) {
#pragma unroll
                for (int i = 0; i < 4; ++i) if ((e & 3) == i) mv[i] = -INFINITY; }
            wsum += s;
            if (lane == k) { myw = s; mye = e; }
        }
        if (lane < TOPK) {
            const float w = myw / wsum * ROUTED_SCALE;
            const unsigned p = atomicAdd(F.ctl + CW_CNT + mye, 1u);
            F.LIST[(size_t)mye * LCAP + p] = t * TOPK + lane;
            F.LISTW[(size_t)mye * LCAP + p] = w;
        }
    }
}

__device__ __forceinline__ void build_expert_map(Frame& F, LAS int* pref, LAS int* base, int rows_per_chunk) {
    __syncthreads();
    if (F.tid == 0) { int p = 0, bsum = 0;
        for (int e = 0; e < NE; ++e) { const int n = (int)F.ctl[CW_CNT + e]; pref[e] = p; base[e] = bsum; p += (n + rows_per_chunk - 1) / rows_per_chunk; bsum += n; }
        pref[NE] = p; base[NE] = bsum; }
    __syncthreads();
}
__device__ __forceinline__ int find_expert(const LAS int* pref, int u) { int lo = 0, hi = NE - 1;
    while (lo < hi) { const int mid = (lo + hi + 1) >> 1; if (pref[mid] <= u) lo = mid; else hi = mid - 1; }
    return lo; }

__device__ __forceinline__ void ph_moe1_simple(Frame& F) {
    LAS float* sm = (LAS float*)F.lds; LAS int* pref = (LAS int*)(sm + 1088 + 4096); LAS int* base = pref + 260;
    build_expert_map(F, pref, base, 64);
    const bf16_t* H2 = F.H2; const int* LIST = F.LIST; bf16_t* HID = F.HID; const float *weg = F.w_exp_gate, *weu = F.w_exp_up;
    const int nchunks = pref[NE];
    for (int u = blockIdx.x; u < nchunks * 2; u += gridDim.x) {
        const int ch = u >> 1, n0 = (u & 1) * 128, e = find_expert(pref, ch), p0 = (ch - pref[e]) * 64, ne = base[e + 1] - base[e], bs = base[e];
        const float* wg = weg + (size_t)e * D * EH; const float* wu = weu + (size_t)e * D * EH; const int* le = LIST + (size_t)e * LCAP;
        ngemm_tile<true>(sm, D,
            [=](int r, int k) -> float { const int p = p0 + r; return p < ne ? bf2f(H2[(size_t)(le[p] >> 3) * D + k]) : 0.f; },
            [=](int k, int n) -> float { return wg[(size_t)k * EH + n0 + n]; },
            [=](int k, int n) -> float { return wu[(size_t)k * EH + n0 + n]; },
            [=](int r, int n, float g, float up) { const int p = p0 + r; if (p < ne) HID[(size_t)(bs + p) * EH + n0 + n] = (bf16_t)f2bf(siluf_(g) * up); });
    }
    const bf16_t* SHID = F.SHID; const float* wd = F.w_sh_down; bf16_t* YAS = F.YAS;
    for (int u = blockIdx.x; u < (T / 64) * 8; u += gridDim.x) {
        const int m0 = (u >> 3) * 64, n0 = (u & 7) * 128;
        ngemm_tile<false>(sm, SHH,
            [=](int r, int k) -> float { return bf2f(SHID[(size_t)(m0 + r) * SHH + k]); },
            [=](int k, int n) -> float { return wd[(size_t)k * D + n0 + n]; }, NOFB2,
            [=](int r, int n, float a, float) { YAS[((size_t)(m0 + r) * NSLOT + 8) * D + n0 + n] = (bf16_t)f2bf(a); });
    }
}
__device__ __forceinline__ void ph_moe2_simple(Frame& F) {
    LAS float* sm = (LAS float*)F.lds; LAS int* pref = (LAS int*)(sm + 1088 + 4096); LAS int* base = pref + 260;
    build_expert_map(F, pref, base, 64);
    const int* LIST = F.LIST; const float* LISTW = F.LISTW; const bf16_t* HID = F.HID; bf16_t* YAS = F.YAS; const float* wed = F.w_exp_down;
    const int nchunks = pref[NE];
    for (int u = blockIdx.x; u < nchunks * 8; u += gridDim.x) {
        const int ch = u >> 3, n0 = (u & 7) * 128, e = find_expert(pref, ch), p0 = (ch - pref[e]) * 64, ne = base[e + 1] - base[e], bs = base[e];
        const float* wd = wed + (size_t)e * EH * D; const int* le = LIST + (size_t)e * LCAP; const float* lw = LISTW + (size_t)e * LCAP;
        ngemm_tile<false>(sm, EH,
            [=](int r, int k) -> float { const int p = p0 + r; return p < ne ? bf2f(HID[(size_t)(bs + p) * EH + k]) : 0.f; },
            [=](int k, int n) -> float { return wd[(size_t)k * D + n0 + n]; }, NOFB2,
            [=](int r, int n, float a, float) { const int p = p0 + r; if (p < ne) { const int as = le[p]; YAS[((size_t)(as >> 3) * NSLOT + (as & 7)) * D + n0 + n] = (bf16_t)f2bf(lw[p] * a); } });
    }
}

__device__ __forceinline__ void ph_combine(Frame& F) {
    const int lane = F.lane;
    for (int m = F.gw; m < T; m += F.NGW) {
        const int b = m >> 13;
        f32x4 y[4];
#pragma unroll
        for (int j = 0; j < 4; ++j) y[j] = (f32x4){0.f, 0.f, 0.f, 0.f};
        for (int k = 0; k < NSLOT; ++k) { const u32x2* yr = (const u32x2*)(F.YAS + ((size_t)m * NSLOT + k) * D) + lane;
#pragma unroll
            for (int j = 0; j < 4; ++j) { const u32x2 w = yr[64 * j];
                y[j].x += __uint_as_float(w.x << 16); y[j].y += __uint_as_float(w.x & 0xffff0000u); y[j].z += __uint_as_float(w.y << 16); y[j].w += __uint_as_float(w.y & 0xffff0000u); } }
        const f32x4* xr = (const f32x4*)(F.X1 + (size_t)m * D) + lane;
        f32x4 v[4]; float s = 0.f;
#pragma unroll
        for (int j = 0; j < 4; ++j) { const int col = 4 * lane + 256 * j; const f32x4 g2 = *(const f32x4*)(F.ADA + b * 6144 + 5120 + col);
            v[j] = xr[64 * j] * ALPHA + (g2 + 1.0f) * y[j]; s += (v[j].x + v[j].y) + (v[j].z + v[j].w); }
        const float mean = wave_sum(s) * (1.f / D); float s2 = 0.f;
#pragma unroll
        for (int j = 0; j < 4; ++j) { v[j] = v[j] - mean; s2 += (v[j].x * v[j].x + v[j].y * v[j].y) + (v[j].z * v[j].z + v[j].w * v[j].w); }
        const float rstd = 1.f / sqrtf(wave_sum(s2) * (1.f / D) + LN_EPS);
        f32x4* orow = (f32x4*)(F.out + (size_t)m * D) + lane;
#pragma unroll
        for (int j = 0; j < 4; ++j) { const int col = 4 * lane + 256 * j; orow[64 * j] = v[j] * rstd * *(const f32x4*)(F.ln2_g + col) + *(const f32x4*)(F.ln2_b + col); }
    }
}

constexpr int NPHASE = 13;
constexpr int LDS_BYTES = 147456, MISC_OFF = 131072 + 320;
constexpr int N_LAUNCHES = 1;
__global__ void __launch_bounds__(NTHR, 2) fwd_kernel(Args args) {
    extern __shared__ __attribute__((aligned(16))) unsigned char lds_raw[];
    Frame F;
    F.lds = (LAS unsigned char*)lds_raw;
    F.tid = threadIdx.x; F.lane = F.tid & 63; F.wave = __builtin_amdgcn_readfirstlane(F.tid >> 6);
    F.gw = blockIdx.x * NWAVES + F.wave; F.NGW = gridDim.x * NWAVES;
    F.x = args.in[0]; F.c = args.in[1]; F.w_ada = args.in[2]; F.b_ada = args.in[3]; F.w_in = args.in[4]; F.b_forget = args.in[5]; F.conv_w = args.in[6]; F.conv_b = args.in[7];
    F.conv_ln_g = args.in[8]; F.conv_ln_b = args.in[9]; F.w_conv_out = args.in[10]; F.w_fox_out = args.in[11]; F.w_mix_out = args.in[12]; F.ln1_g = args.in[13]; F.ln1_b = args.in[14];
    F.w_router = args.in[15]; F.router_bias = args.in[16]; F.w_exp_gate = args.in[17]; F.w_exp_up = args.in[18]; F.w_exp_down = args.in[19]; F.w_sh_gate = args.in[20]; F.w_sh_up = args.in[21];
    F.w_sh_down = args.in[22]; F.ln2_g = args.in[23]; F.ln2_b = args.in[24];
    F.out = args.out; F.ws = args.ws; unsigned char* ws = args.ws;
    F.ctl = (unsigned*)(ws + WS_CTL);
    F.ADA = (float*)(ws + WS_ADA); F.ADAP = (float*)(ws + WS_ADAP); F.CUM = (float*)(ws + WS_CUM); F.LOGF = (float*)(ws + WS_LOGF); F.X1 = (float*)(ws + WS_X1); F.RL = (float*)(ws + WS_RL);
    F.LISTW = (float*)(ws + WS_LISTW); F.PROJ = (float*)(ws + WS_PROJ); F.LIST = (int*)(ws + WS_LIST);
    F.H = (bf16_t*)(ws + WS_H); F.U = (bf16_t*)(ws + WS_U); F.Q = (bf16_t*)(ws + WS_Q); F.K = (bf16_t*)(ws + WS_K); F.V = (bf16_t*)(ws + WS_V); F.AC = (bf16_t*)(ws + WS_AC); F.O = (bf16_t*)(ws + WS_O);
    F.GA = (bf16_t*)(ws + WS_GA); F.GB = (bf16_t*)(ws + WS_GB); F.YA = (bf16_t*)(ws + WS_YA); F.MG = (bf16_t*)(ws + WS_MG); F.YAS = (bf16_t*)(ws + WS_YAS); F.H2 = (bf16_t*)(ws + WS_H2);
    F.H2LO = (bf16_t*)(ws + WS_H2LO); F.SHID = (bf16_t*)(ws + WS_SHID); F.HID = (bf16_t*)(ws + WS_HID);
    const int lo = args.ph_lo, hi = args.ph_hi;
    volatile LAS unsigned* MISC = (volatile LAS unsigned*)(F.lds + MISC_OFF);
    for (int u = F.tid; u < 32; u += NTHR) MISC[u] = 0u;
    __syncthreads();
    XcdBarrier bar; bar.bar = F.ctl + CW_BAR; bar.x = 0; bar.st = MISC + 8;
    if (hi - lo > 1) bar = xcd_barrier_post(F.ctl + CW_BAR, MISC + 8);
#define IN(k) (lo <= (k) && (k) < hi)
#define SEAM(k) do { if (IN(k) && IN((k) + 1)) xcd_barrier(bar); } while (0)
    if (IN(0)) ph_ada(F);
    SEAM(0);
    if (IN(1)) ph_lnmod(F);
    SEAM(1);
    if (IN(2)) { ph_scan(F); ph_inproj_simple(F); }
    SEAM(2);
    if (IN(3)) ph_split_simple(F);
    SEAM(3);
    if (IN(4)) { ph_conv(F); ph_attn_simple(F); }
    SEAM(4);
    if (IN(5)) ph_merge_simple(F);
    SEAM(5);
    if (IN(6)) ph_mix_simple(F);
    SEAM(6);
    if (IN(7)) ph_ln2(F);
    SEAM(7);
    if (IN(8)) ph_router_simple(F);
    SEAM(8);
    if (IN(9)) ph_route(F, 1);
    SEAM(9);
    if (IN(10)) ph_moe1_simple(F);
    SEAM(10);
    if (IN(11)) ph_moe2_simple(F);
    SEAM(11);
    if (IN(12)) ph_combine(F);
#undef IN
#undef SEAM
}

extern "C" void kernel_launch(void* const* d_in, const int* in_sizes, int n_in, void* d_out, int out_size, void* d_ws, size_t ws_size, hipStream_t stream) {
    static int grid = 0;
    if (grid == 0) {
        if (n_in != 25 || out_size != T * D || ws_size < WS_END) { fprintf(stderr, "kernel_launch: unexpected sizes: n_in %d out %d ws %zu (need %zu)\n", n_in, out_size, ws_size, (size_t)WS_END); grid = -1; return; }
        int dev = 0, cus = 0, per_cu = 0;
        (void)hipGetDevice(&dev); (void)hipDeviceGetAttribute(&cus, hipDeviceAttributeMultiprocessorCount, dev);
        (void)hipFuncSetAttribute((const void*)fwd_kernel, hipFuncAttributeMaxDynamicSharedMemorySize, LDS_BYTES);
        (void)hipOccupancyMaxActiveBlocksPerMultiprocessor(&per_cu, (const void*)fwd_kernel, NTHR, LDS_BYTES);
        (void)hipGetLastError();
        if (per_cu < 1) { fprintf(stderr, "kernel_launch: occupancy query says %d blocks/CU\n", per_cu); }
        grid = cus > 0 ? cus : 256;
    }
    if (grid < 0) return;
    (void)hipMemsetAsync((char*)d_ws + WS_CTL, 0, CTL_BYTES, stream);
    Args a{};
    for (int i = 0; i < 25; ++i) a.in[i] = (const float*)d_in[i];
    a.out = (float*)d_out; a.ws = (unsigned char*)d_ws;
    if (N_LAUNCHES == 1) {
        a.ph_lo = 0; a.ph_hi = NPHASE;
        void* kargs[] = {(void*)&a};
        const hipError_t e = hipLaunchCooperativeKernel((const void*)fwd_kernel, dim3(grid), dim3(NTHR), kargs, LDS_BYTES, stream);
        if (e != hipSuccess) fprintf(stderr, "kernel_launch: cooperative launch failed: %s (grid %d)\n", hipGetErrorString(e), grid);
    } else {
        for (int p = 0; p < NPHASE; ++p) { a.ph_lo = p; a.ph_hi = p + 1; hipLaunchKernelGGL(fwd_kernel, dim3(grid), dim3(NTHR), LDS_BYTES, stream, a); }
    }
}
```

```cpp
#include <hip/hip_runtime.h>
#include <cstdio>
#include <cstdint>
#include <hip/hip_bf16.h>

#define LAS __attribute__((address_space(3)))
typedef unsigned short bf16_t;
typedef float f32x4 __attribute__((ext_vector_type(4)));
typedef unsigned u32x4 __attribute__((ext_vector_type(4)));
typedef unsigned u32x2 __attribute__((ext_vector_type(2)));

constexpr int NB = 2, S = 8192, D = 1024, T = NB * S;
constexpr int CC = 512, CW = 31, NH = 8, HD = 64, FW = 512;
constexpr int NE = 256, TOPK = 8, NG = 8, EH = 256, SHH = 256;
constexpr int INC = 4616;
constexpr int O_Q = 1024, O_K = 1536, O_V = 2048, O_F = 2560, O_GA = 2568, O_GB = 3592;
constexpr float LN_EPS = 1e-5f;
constexpr float ALPHA = 1.189207115002721f;
constexpr float LOG2E = 1.4426950408889634f;
constexpr float QSCALE = 0.125f * LOG2E;
constexpr float ROUTED_SCALE = 2.5f;
constexpr int NWAVES = 8, NTHR = 512;
constexpr int LCAP = 16384;
constexpr int NSLOT = 9;

constexpr size_t MiB = 1u << 20;
constexpr size_t WS_CTL = 0, CTL_BYTES = 1 * MiB;
constexpr size_t WS_ADA = 1 * MiB;
constexpr size_t WS_ADAP = 1 * MiB + 64 * 1024;
constexpr size_t WS_CUM = 2 * MiB;
constexpr size_t WS_LOGF = 2 * MiB + 512 * 1024;
constexpr size_t WS_H = 20 * MiB;
constexpr size_t WS_U = 52 * MiB, WS_Q = 68 * MiB, WS_K = 84 * MiB, WS_V = 100 * MiB, WS_AC = 116 * MiB, WS_O = 132 * MiB;
constexpr size_t WS_GA = 148 * MiB, WS_GB = 180 * MiB, WS_YA = 212 * MiB, WS_MG = 244 * MiB;
constexpr size_t WS_YAS = 20 * MiB;
constexpr size_t WS_X1 = 308 * MiB;
constexpr size_t WS_H2 = 372 * MiB, WS_H2LO = 404 * MiB;
constexpr size_t WS_RL = 436 * MiB;
constexpr size_t WS_SHID = 484 * MiB;
constexpr size_t WS_LIST = 492 * MiB, WS_LISTW = 508 * MiB;
constexpr size_t WS_HID = 524 * MiB;
constexpr size_t WS_PROJ = 640 * MiB;
constexpr size_t WS_END = 1024 * MiB;
constexpr int CW_CNT = 1024;

__device__ __forceinline__ float bf2f(bf16_t v) { return __uint_as_float((unsigned)v << 16); }
__device__ __forceinline__ unsigned f2bf(float f) { unsigned u = __float_as_uint(f); return (u + 0x7fffu + ((u >> 16) & 1u)) >> 16; }
__device__ __forceinline__ unsigned pk2(float lo, float hi) { return f2bf(lo) | (f2bf(hi) << 16); }
__device__ __forceinline__ float wave_sum(float v) {
#pragma unroll
    for (int o = 1; o < 64; o <<= 1) v += __shfl_xor(v, o);
    return v;
}
__device__ __forceinline__ float wave_max(float v) {
#pragma unroll
    for (int o = 1; o < 64; o <<= 1) v = fmaxf(v, __shfl_xor(v, o));
    return v;
}
__device__ __forceinline__ int ltid() { int t = (int)__builtin_amdgcn_mbcnt_hi(~0u, __builtin_amdgcn_mbcnt_lo(~0u, 0u)); asm volatile("" : "+v"(t)); return t; }
__device__ __forceinline__ float sigmoidf_(float x) { return 1.0f / (1.0f + expf(-x)); }
__device__ __forceinline__ float siluf_(float x) { return x / (1.0f + expf(-x)); }


constexpr int CW_BAR = 4096;
#define XB_TMO      128
#define XB_XCNT(j)  (256  + 64 * (j))
#define XB_XSUB(j)  (1280 + 64 * (j))
#define XB_XGEN(j)  (2304 + 64 * (j))
#define XB_TOP      3328
#define XB_TOPGEN   3392
#define XCD_BAR_WORDS 3456
#define XB_SPIN_CAP (1u << 20)
__device__ __forceinline__ unsigned xb_ld(unsigned* p)              { return __hip_atomic_load(p, __ATOMIC_RELAXED, __HIP_MEMORY_SCOPE_AGENT); }
__device__ __forceinline__ unsigned xb_add(unsigned* p, unsigned v) { return __hip_atomic_fetch_add(p, v, __ATOMIC_RELAXED, __HIP_MEMORY_SCOPE_AGENT); }
__device__ __forceinline__ unsigned xb_xcc_id() { return (unsigned)__builtin_amdgcn_s_getreg((3 << 11) | 20) & 0xFu; }
#define XB_SPIN(cond, bar) do { unsigned _sp = 0; while (cond) { __builtin_amdgcn_s_sleep(1); \
    if ((++_sp & 255u) == 0u) { if (xb_ld(&(bar)[XB_TMO])) break; if (_sp > XB_SPIN_CAP) { atomicAdd(&(bar)[XB_TMO], 1u); break; } } } } while (0)
struct XcdBarrier { unsigned* bar; unsigned x; volatile LAS unsigned* st; };
__device__ __forceinline__ XcdBarrier xcd_barrier_post(unsigned* bar, volatile LAS unsigned* st) {
    XcdBarrier b; b.bar = bar; b.x = xb_xcc_id(); b.st = st;
    if (threadIdx.x == 0) (void)xb_add(&bar[XB_XCNT(b.x)], 1u);
    return b;
}
__device__ __forceinline__ void xcd_barrier_complete(unsigned* bar, unsigned x, unsigned& nloc, unsigned& nx) {
    const unsigned G = gridDim.x * gridDim.y * gridDim.z;
    unsigned sum, cnt, mine, sp = 0u;
    for (;;) {
        sum = 0u; cnt = 0u; mine = 0u;
#pragma unroll
        for (unsigned j = 0; j < 16; ++j) { const unsigned c = xb_ld(&bar[XB_XCNT(j)]); sum += c; cnt += (c > 0u) ? 1u : 0u; mine = (j == x) ? c : mine; }
        if (sum == G) break;
        __builtin_amdgcn_s_sleep(1);
        if ((++sp & 255u) == 0u) { if (xb_ld(&bar[XB_TMO])) break; if (sp > XB_SPIN_CAP) { atomicAdd(&bar[XB_TMO], 1u); break; } }
    }
    nloc = mine > 0u ? mine : 1u; nx = cnt > 0u ? cnt : 1u;
}
__device__ __forceinline__ void xcd_barrier(const XcdBarrier& b) {
    asm volatile("s_waitcnt vmcnt(0)" ::: "memory");
    __syncthreads();
    if (threadIdx.x == 0) {
        unsigned* bar = b.bar;
        __builtin_amdgcn_s_waitcnt(0);
        unsigned nloc = b.st[0], nx = b.st[1];
        if (nloc == 0u) { xcd_barrier_complete(bar, b.x, nloc, nx); b.st[0] = nloc; b.st[1] = nx; }
        const unsigned old = xb_add(&bar[XB_XSUB(b.x)], 1u);
        const unsigned gen = old / nloc;
        if (old + 1u == (gen + 1u) * nloc) {
            __builtin_amdgcn_fence(__ATOMIC_RELEASE, "agent");
            asm volatile("s_waitcnt vmcnt(0)" ::: "memory");
            const unsigned og = xb_add(&bar[XB_TOP], 1u);
            const unsigned tg = og / nx;
            if (og + 1u == (tg + 1u) * nx) xb_add(&bar[XB_TOPGEN], 1u);
            else XB_SPIN(xb_ld(&bar[XB_TOPGEN]) == tg, bar);
            __builtin_amdgcn_fence(__ATOMIC_ACQUIRE, "agent");
            xb_add(&bar[XB_XGEN(b.x)], 1u);
            asm volatile("s_waitcnt vmcnt(0)" ::: "memory");
        } else {
            XB_SPIN(xb_ld(&bar[XB_XGEN(b.x)]) == gen, bar);
            __builtin_amdgcn_fence(__ATOMIC_ACQUIRE, "agent");
            asm volatile("s_waitcnt vmcnt(0)" ::: "memory");
        }
    }
    __syncthreads();
}

struct Args { const float* in[25]; float* out; unsigned char* ws; int ph_lo, ph_hi; };

struct Frame {
    LAS unsigned char* lds; unsigned char* lds_generic;
    int tid, lane, wave, gw, NGW;
    const float *x, *c, *w_ada, *b_ada, *w_in, *b_forget, *conv_w, *conv_b, *conv_ln_g, *conv_ln_b, *w_conv_out, *w_fox_out, *w_mix_out, *ln1_g, *ln1_b,
        *w_router, *router_bias, *w_exp_gate, *w_exp_up, *w_exp_down, *w_sh_gate, *w_sh_up, *w_sh_down, *ln2_g, *ln2_b;
    float* out; unsigned char* ws;
    unsigned* ctl;
    float *ADA, *ADAP, *CUM, *LOGF, *X1, *RL, *LISTW, *PROJ;
    bf16_t *H, *U, *Q, *K, *V, *AC, *O, *GA, *GB, *YA, *MG, *YAS, *H2, *H2LO, *SHID, *HID;
    int* LIST;
};

template <bool DUAL, class FA, class FB, class FB2, class FE>
__device__ __forceinline__ void ngemm_tile(LAS float* sm, int K, FA fa, FB fb, FB2 fb2, FE fe) {
    LAS float* As = sm; LAS float* Bs = sm + 1088; LAS float* Bs2 = Bs + 2048;
    const int tid = __builtin_amdgcn_readfirstlane((int)threadIdx.x >> 6) * 64 + ltid(), ty = tid >> 5, tx = tid & 31;
    float acc[4][4], acc2[4][4];
#pragma unroll
    for (int i = 0; i < 4; ++i)
#pragma unroll
        for (int j = 0; j < 4; ++j) { acc[i][j] = 0.f; acc2[i][j] = 0.f; }
    for (int k0 = 0; k0 < K; k0 += 16) {
#pragma unroll
        for (int i = 0; i < 2; ++i) { const int idx = tid + i * 512, r = idx >> 4, kk = idx & 15; As[kk * 68 + r] = fa(r, k0 + kk); }
#pragma unroll
        for (int i = 0; i < 4; ++i) { const int idx = tid + i * 512, kk = idx >> 7, n = idx & 127; Bs[kk * 128 + n] = fb(k0 + kk, n); if (DUAL) Bs2[kk * 128 + n] = fb2(k0 + kk, n); }
        __syncthreads();
#pragma unroll
        for (int kk = 0; kk < 16; ++kk) {
            const f32x4 a = *(const LAS f32x4*)(As + kk * 68 + ty * 4), b = *(const LAS f32x4*)(Bs + kk * 128 + tx * 4);
#pragma unroll
            for (int i = 0; i < 4; ++i)
#pragma unroll
                for (int j = 0; j < 4; ++j) acc[i][j] += a[i] * b[j];
            if (DUAL) { const f32x4 b2 = *(const LAS f32x4*)(Bs2 + kk * 128 + tx * 4);
#pragma unroll
                for (int i = 0; i < 4; ++i)
#pragma unroll
                    for (int j = 0; j < 4; ++j) acc2[i][j] += a[i] * b2[j]; }
        }
        __syncthreads();
    }
#pragma unroll
    for (int i = 0; i < 4; ++i)
#pragma unroll
        for (int j = 0; j < 4; ++j) fe(ty * 4 + i, tx * 4 + j, acc[i][j], acc2[i][j]);
}
#define NOFB2 [=](int, int) -> float { return 0.f; }

__device__ __forceinline__ void ph_ada(Frame& F) {
    F.lane = ltid(); F.tid = F.wave * 64 + F.lane;
    const float* c = F.c; const float* w = F.w_ada; float* P = F.ADAP;
    for (int it = F.gw; it < 24 * 8; it += F.NGW) {
        const int jg = it % 24, kc = it / 24, j0 = jg * 256 + F.lane * 4;
        f32x4 a0 = {0.f, 0.f, 0.f, 0.f}, a1 = {0.f, 0.f, 0.f, 0.f};
        for (int k = kc * 128; k < kc * 128 + 128; ++k) {
            const f32x4 wv = *(const f32x4*)(w + (size_t)k * 6144 + j0);
            const float c0 = siluf_(c[k]), c1 = siluf_(c[D + k]);
            a0 += wv * c0; a1 += wv * c1;
        }
        *(f32x4*)(P + (size_t)(kc * 2 + 0) * 6144 + j0) = a0;
        *(f32x4*)(P + (size_t)(kc * 2 + 1) * 6144 + j0) = a1;
    }
}

__device__ __forceinline__ void ph_lnmod(Frame& F) {
    F.lane = ltid(); F.tid = F.wave * 64 + F.lane;
    LAS float* ada1 = (LAS float*)F.lds;
    LAS float* wf = ada1 + 4096;
    const float* ADAP = F.ADAP; const float* b_ada = F.b_ada;
    for (int i = F.tid; i < 4096; i += NTHR) { const int b = i >> 11, j = i & 2047; float s = b_ada[j];
        for (int p = 0; p < 8; ++p) s += ADAP[(size_t)(p * 2 + b) * 6144 + j];
        ada1[i] = s; }
    for (int i = F.tid; i < 8192; i += NTHR) { const int k = i >> 3, hh = i & 7; wf[hh * 1024 + k] = F.w_in[(size_t)k * INC + O_F + hh]; }
    if (blockIdx.x == 0) for (int i = F.tid; i < 2 * 6144; i += NTHR) { const int b = i / 6144, j = i % 6144; float s = b_ada[j];
        for (int p = 0; p < 8; ++p) s += ADAP[(size_t)(p * 2 + b) * 6144 + j];
        F.ADA[i] = s; }
    __syncthreads();
    const int lane = F.lane;
    for (int m = F.gw; m < T; m += F.NGW) {
        const int b = m >> 13;
        const f32x4* xr = (const f32x4*)(F.x + (size_t)m * D) + lane;
        f32x4 v[4]; float s = 0.f;
#pragma unroll
        for (int j = 0; j < 4; ++j) { v[j] = xr[64 * j]; s += (v[j].x + v[j].y) + (v[j].z + v[j].w); }
        const float mean = wave_sum(s) * (1.f / D); float s2 = 0.f;
#pragma unroll
        for (int j = 0; j < 4; ++j) { v[j] = v[j] - mean; s2 += (v[j].x * v[j].x + v[j].y * v[j].y) + (v[j].z * v[j].z + v[j].w * v[j].w); }
        const float rstd = 1.f / sqrtf(wave_sum(s2) * (1.f / D) + LN_EPS);
        float fl[8];
#pragma unroll
        for (int hh = 0; hh < 8; ++hh) fl[hh] = 0.f;
        u32x2* hrow = (u32x2*)(F.H + (size_t)m * D) + lane;
#pragma unroll
        for (int j = 0; j < 4; ++j) { const int col = 4 * lane + 256 * j;
            const f32x4 sh = *(const LAS f32x4*)(ada1 + b * 2048 + col), sc = *(const LAS f32x4*)(ada1 + b * 2048 + 1024 + col);
            const f32x4 h = v[j] * rstd * (sc + 1.0f) + sh;
            u32x2 o; o.x = pk2(h.x, h.y); o.y = pk2(h.z, h.w); hrow[64 * j] = o;
#pragma unroll
            for (int hh = 0; hh < 8; ++hh) { const f32x4 w = *(const LAS f32x4*)(wf + hh * 1024 + col); fl[hh] += (h.x * w.x + h.y * w.y) + (h.z * w.z + h.w * w.w); } }
#pragma unroll
        for (int hh = 0; hh < 8; ++hh) fl[hh] = wave_sum(fl[hh]);
        float f = fl[0];
#pragma unroll
        for (int hh = 1; hh < 8; ++hh) f = (lane == hh) ? fl[hh] : f;
        if (lane < 8) { const float z = f + F.b_forget[lane]; F.LOGF[(size_t)m * 8 + lane] = fminf(z, 0.f) - log1pf(expf(-fabsf(z))); }
    }
}

__device__ __forceinline__ void ph_scan(Frame& F) {
    F.lane = ltid(); F.tid = F.wave * 64 + F.lane;
    if (blockIdx.x >= 16) return;
    LAS double* sc = (LAS double*)F.lds;
    const int bh = blockIdx.x, b = bh >> 3, hh = bh & 7, s0 = F.tid * 16;
    double loc[16]; double run = 0.0;
#pragma unroll
    for (int i = 0; i < 16; ++i) { run += (double)F.LOGF[(size_t)(b * S + s0 + i) * 8 + hh]; loc[i] = run; }
    sc[F.tid] = run;
    __syncthreads();
    double off = 0.0;
    for (int i = 0; i < F.tid; ++i) off += sc[i];
#pragma unroll
    for (int i = 0; i < 16; ++i) F.CUM[(size_t)bh * S + s0 + i] = (float)(off + loc[i]);
    __syncthreads();
}

__device__ __forceinline__ void ph_inproj_simple(Frame& F) {
    F.lane = ltid(); F.tid = F.wave * 64 + F.lane;
    LAS float* sm = (LAS float*)F.lds;
    const bf16_t* H = F.H; const float* w_in = F.w_in; float* PROJ = F.PROJ;
    constexpr int NTN = (INC + 127) / 128;
    for (int u = blockIdx.x; u < (T / 64) * NTN; u += gridDim.x) {
        const int m0 = (u / NTN) * 64, n0 = (u % NTN) * 128;
        ngemm_tile<false>(sm, D,
            [=](int r, int k) -> float { return bf2f(H[(size_t)(m0 + r) * D + k]); },
            [=](int k, int n) -> float { return (n0 + n < INC) ? w_in[(size_t)k * INC + n0 + n] : 0.f; },
            NOFB2,
            [=](int r, int n, float a, float) { if (n0 + n < INC) PROJ[(size_t)(m0 + r) * INC + n0 + n] = a; });
    }
}
__device__ __forceinline__ void ph_split_simple(Frame& F) {
    F.lane = ltid(); F.tid = F.wave * 64 + F.lane;
    const float* PROJ = F.PROJ;
    const size_t total = (size_t)T * INC;
    for (size_t i = (size_t)blockIdx.x * NTHR + F.tid; i < total; i += (size_t)gridDim.x * NTHR) {
        const int m = (int)(i / INC), col = (int)(i % INC); const float v = PROJ[i];
        if (col < 512) F.U[(size_t)m * 512 + col] = (bf16_t)f2bf(v * sigmoidf_(PROJ[i + 512]));
        else if (col < O_Q) {}
        else if (col < O_K) F.Q[(size_t)m * 512 + col - O_Q] = (bf16_t)f2bf(v * QSCALE);
        else if (col < O_V) F.K[(size_t)m * 512 + col - O_K] = (bf16_t)f2bf(v);
        else if (col < O_F) F.V[(size_t)m * 512 + col - O_V] = (bf16_t)f2bf(v);
        else if (col < O_GA) {}
        else if (col < O_GB) F.GA[(size_t)m * D + col - O_GA] = (bf16_t)f2bf(sigmoidf_(v));
        else F.GB[(size_t)m * D + col - O_GB] = (bf16_t)f2bf(sigmoidf_(v));
    }
}

__device__ __forceinline__ void ph_conv(Frame& F) {
    F.lane = ltid(); F.tid = F.wave * 64 + F.lane;
    LAS float* cw = (LAS float*)F.lds;
    LAS float* cb = cw + CW * CC;
    for (int i = F.tid; i < CW * CC; i += NTHR) cw[i] = F.conv_w[i];
    for (int i = F.tid; i < CC; i += NTHR) { cb[i] = F.conv_b[i]; cb[CC + i] = F.conv_ln_g[i]; cb[2 * CC + i] = F.conv_ln_b[i]; }
    __syncthreads();
    const int lane = F.lane, c0 = lane * 8;
    for (int m = F.gw; m < T; m += F.NGW) {
        const int t = m & (S - 1);
        float a[8];
#pragma unroll
        for (int i = 0; i < 8; ++i) a[i] = cb[c0 + i];
        for (int j = 0; j < CW; ++j) {
            const int tt = t - (CW - 1) + j;
            if (tt >= 0) {
                const u32x4 uv = *(const u32x4*)(F.U + (size_t)(m - (CW - 1) + j) * CC + c0);
                const f32x4 w0 = *(const LAS f32x4*)(cw + j * CC + c0), w1 = *(const LAS f32x4*)(cw + j * CC + c0 + 4);
                a[0] += __uint_as_float(uv.x << 16) * w0.x; a[1] += __uint_as_float(uv.x & 0xffff0000u) * w0.y;
                a[2] += __uint_as_float(uv.y << 16) * w0.z; a[3] += __uint_as_float(uv.y & 0xffff0000u) * w0.w;
                a[4] += __uint_as_float(uv.z << 16) * w1.x; a[5] += __uint_as_float(uv.z & 0xffff0000u) * w1.y;
                a[6] += __uint_as_float(uv.w << 16) * w1.z; a[7] += __uint_as_float(uv.w & 0xffff0000u) * w1.w;
            }
        }
        float s = 0.f;
#pragma unroll
        for (int i = 0; i < 8; ++i) s += a[i];
        const float mean = wave_sum(s) * (1.f / CC); float s2 = 0.f;
#pragma unroll
        for (int i = 0; i < 8; ++i) { a[i] -= mean; s2 += a[i] * a[i]; }
        const float rstd = 1.f / sqrtf(wave_sum(s2) * (1.f / CC) + LN_EPS);
        float y[8];
#pragma unroll
        for (int i = 0; i < 8; ++i) y[i] = siluf_(a[i] * rstd * cb[CC + c0 + i] + cb[2 * CC + c0 + i]);
        u32x4 o; o.x = pk2(y[0], y[1]); o.y = pk2(y[2], y[3]); o.z = pk2(y[4], y[5]); o.w = pk2(y[6], y[7]);
        *(u32x4*)(F.AC + (size_t)m * CC + c0) = o;
    }
}

__device__ __forceinline__ void ph_attn_simple(Frame& F) {
    F.lane = ltid(); F.tid = F.wave * 64 + F.lane;
    const int lane = F.lane;
    for (int idx = F.gw; idx < 16 * S; idx += F.NGW) {
        const int bh = idx & 15, q = idx >> 4, b = bh >> 3, hh = bh & 7;
        const size_t m = (size_t)b * S + q;
        float qv[64];
        { const u32x4* qp = (const u32x4*)(F.Q + m * FW + hh * HD);
#pragma unroll
          for (int c = 0; c < 8; ++c) { const u32x4 w = qp[c];
              qv[8 * c + 0] = __uint_as_float(w.x << 16); qv[8 * c + 1] = __uint_as_float(w.x & 0xffff0000u); qv[8 * c + 2] = __uint_as_float(w.y << 16); qv[8 * c + 3] = __uint_as_float(w.y & 0xffff0000u);
              qv[8 * c + 4] = __uint_as_float(w.z << 16); qv[8 * c + 5] = __uint_as_float(w.z & 0xffff0000u); qv[8 * c + 6] = __uint_as_float(w.w << 16); qv[8 * c + 7] = __uint_as_float(w.w & 0xffff0000u); } }
        const float* cum = F.CUM + (size_t)bh * S;
        const float Fq = cum[q];
        const bf16_t* Kb = F.K + (size_t)b * S * FW + hh * HD; const bf16_t* Vb = F.V + (size_t)b * S * FW + hh * HD;
        float mx = -3.0e38f;
        for (int s0 = 0; s0 <= q; s0 += 64) {
            const int s = s0 + lane, sc = s <= q ? s : q;
            const u32x4* kp = (const u32x4*)(Kb + (size_t)sc * FW);
            float dot = 0.f;
#pragma unroll
            for (int c = 0; c < 8; ++c) { const u32x4 w = kp[c];
                dot += qv[8 * c + 0] * __uint_as_float(w.x << 16) + qv[8 * c + 1] * __uint_as_float(w.x & 0xffff0000u) + qv[8 * c + 2] * __uint_as_float(w.y << 16) + qv[8 * c + 3] * __uint_as_float(w.y & 0xffff0000u)
                     + qv[8 * c + 4] * __uint_as_float(w.z << 16) + qv[8 * c + 5] * __uint_as_float(w.z & 0xffff0000u) + qv[8 * c + 6] * __uint_as_float(w.w << 16) + qv[8 * c + 7] * __uint_as_float(w.w & 0xffff0000u); }
            const float s2 = dot + (Fq - cum[sc]) * LOG2E;
            if (s <= q) mx = fmaxf(mx, s2);
        }
        mx = wave_max(mx);
        float l = 0.f; float o[64];
#pragma unroll
        for (int d = 0; d < 64; ++d) o[d] = 0.f;
        for (int s0 = 0; s0 <= q; s0 += 64) {
            const int s = s0 + lane, sc = s <= q ? s : q;
            const u32x4* kp = (const u32x4*)(Kb + (size_t)sc * FW);
            float dot = 0.f;
#pragma unroll
            for (int c = 0; c < 8; ++c) { const u32x4 w = kp[c];
                dot += qv[8 * c + 0] * __uint_as_float(w.x << 16) + qv[8 * c + 1] * __uint_as_float(w.x & 0xffff0000u) + qv[8 * c + 2] * __uint_as_float(w.y << 16) + qv[8 * c + 3] * __uint_as_float(w.y & 0xffff0000u)
                     + qv[8 * c + 4] * __uint_as_float(w.z << 16) + qv[8 * c + 5] * __uint_as_float(w.z & 0xffff0000u) + qv[8 * c + 6] * __uint_as_float(w.w << 16) + qv[8 * c + 7] * __uint_as_float(w.w & 0xffff0000u); }
            const float s2 = dot + (Fq - cum[sc]) * LOG2E;
            const float p = (s <= q) ? exp2f(s2 - mx) : 0.f;
            l += p;
            const u32x4* vp = (const u32x4*)(Vb + (size_t)sc * FW);
#pragma unroll
            for (int c = 0; c < 8; ++c) { const u32x4 w = vp[c];
                o[8 * c + 0] += p * __uint_as_float(w.x << 16); o[8 * c + 1] += p * __uint_as_float(w.x & 0xffff0000u); o[8 * c + 2] += p * __uint_as_float(w.y << 16); o[8 * c + 3] += p * __uint_as_float(w.y & 0xffff0000u);
                o[8 * c + 4] += p * __uint_as_float(w.z << 16); o[8 * c + 5] += p * __uint_as_float(w.z & 0xffff0000u); o[8 * c + 6] += p * __uint_as_float(w.w << 16); o[8 * c + 7] += p * __uint_as_float(w.w & 0xffff0000u); }
        }
        l = wave_sum(l);
        float res = 0.f;
#pragma unroll
        for (int d = 0; d < 64; ++d) { const float od = wave_sum(o[d]); res = (lane == d) ? od : res; }
        F.O[m * FW + hh * HD + lane] = (bf16_t)f2bf(res / l);
    }
}

__device__ __forceinline__ void ph_merge_simple(Frame& F) {
    F.lane = ltid(); F.tid = F.wave * 64 + F.lane;
    LAS float* sm = (LAS float*)F.lds;
    const bf16_t *AC = F.AC, *O = F.O, *GA = F.GA, *GB = F.GB; bf16_t *YA = F.YA, *MG = F.MG; const float *wc = F.w_conv_out, *wf = F.w_fox_out;
    for (int u = blockIdx.x; u < (T / 64) * 8; u += gridDim.x) {
        const int m0 = (u >> 3) * 64, n0 = (u & 7) * 128;
        ngemm_tile<false>(sm, CC,
            [=](int r, int k) -> float { return bf2f(AC[(size_t)(m0 + r) * CC + k]); },
            [=](int k, int n) -> float { return wc[(size_t)k * D + n0 + n]; }, NOFB2,
            [=](int r, int n, float a, float) { const size_t i = (size_t)(m0 + r) * D + n0 + n; YA[i] = (bf16_t)f2bf(bf2f(GA[i]) * a); });
        ngemm_tile<false>(sm, FW,
            [=](int r, int k) -> float { return bf2f(O[(size_t)(m0 + r) * FW + k]); },
            [=](int k, int n) -> float { return wf[(size_t)k * D + n0 + n]; }, NOFB2,
            [=](int r, int n, float a, float) { const size_t i = (size_t)(m0 + r) * D + n0 + n; MG[i] = (bf16_t)f2bf(bf2f(YA[i]) + bf2f(GB[i]) * a); });
    }
}
__device__ __forceinline__ void ph_mix_simple(Frame& F) {
    F.lane = ltid(); F.tid = F.wave * 64 + F.lane;
    LAS float* sm = (LAS float*)F.lds;
    const bf16_t* MG = F.MG; const float *wm = F.w_mix_out, *x = F.x, *ADA = F.ADA; float* Z = F.X1;
    for (int u = blockIdx.x; u < (T / 64) * 8; u += gridDim.x) {
        const int m0 = (u >> 3) * 64, n0 = (u & 7) * 128, b = m0 >> 13;
        ngemm_tile<false>(sm, D,
            [=](int r, int k) -> float { return bf2f(MG[(size_t)(m0 + r) * D + k]); },
            [=](int k, int n) -> float { return wm[(size_t)k * D + n0 + n]; }, NOFB2,
            [=](int r, int n, float a, float) { const size_t i = (size_t)(m0 + r) * D + n0 + n; Z[i] = ALPHA * x[i] + (1.0f + ADA[b * 6144 + 2048 + n0 + n]) * a; });
    }
}

__device__ __forceinline__ void ph_ln2(Frame& F) {
    F.lane = ltid(); F.tid = F.wave * 64 + F.lane;
    const int lane = F.lane;
    for (int m = F.gw; m < T; m += F.NGW) {
        const int b = m >> 13;
        f32x4* zr = (f32x4*)(F.X1 + (size_t)m * D) + lane;
        f32x4 v[4]; float s = 0.f;
#pragma unroll
        for (int j = 0; j < 4; ++j) { v[j] = zr[64 * j]; s += (v[j].x + v[j].y) + (v[j].z + v[j].w); }
        float mean = wave_sum(s) * (1.f / D); float s2 = 0.f;
#pragma unroll
        for (int j = 0; j < 4; ++j) { v[j] = v[j] - mean; s2 += (v[j].x * v[j].x + v[j].y * v[j].y) + (v[j].z * v[j].z + v[j].w * v[j].w); }
        float rstd = 1.f / sqrtf(wave_sum(s2) * (1.f / D) + LN_EPS);
        s = 0.f;
#pragma unroll
        for (int j = 0; j < 4; ++j) { const int col = 4 * lane + 256 * j;
            v[j] = v[j] * rstd * *(const f32x4*)(F.ln1_g + col) + *(const f32x4*)(F.ln1_b + col);
            zr[64 * j] = v[j]; s += (v[j].x + v[j].y) + (v[j].z + v[j].w); }
        mean = wave_sum(s) * (1.f / D); s2 = 0.f;
#pragma unroll
        for (int j = 0; j < 4; ++j) { v[j] = v[j] - mean; s2 += (v[j].x * v[j].x + v[j].y * v[j].y) + (v[j].z * v[j].z + v[j].w * v[j].w); }
        rstd = 1.f / sqrtf(wave_sum(s2) * (1.f / D) + LN_EPS);
        u32x2* hr = (u32x2*)(F.H2 + (size_t)m * D) + lane; u32x2* lr = (u32x2*)(F.H2LO + (size_t)m * D) + lane;
#pragma unroll
        for (int j = 0; j < 4; ++j) { const int col = 4 * lane + 256 * j;
            const f32x4 sh = *(const f32x4*)(F.ADA + b * 6144 + 3072 + col), sc = *(const f32x4*)(F.ADA + b * 6144 + 4096 + col);
            const f32x4 h = v[j] * rstd * (sc + 1.0f) + sh;
            const unsigned h0 = f2bf(h.x), h1 = f2bf(h.y), h2 = f2bf(h.z), h3 = f2bf(h.w);
            u32x2 o; o.x = h0 | (h1 << 16); o.y = h2 | (h3 << 16); hr[64 * j] = o;
            u32x2 l; l.x = pk2(h.x - __uint_as_float(h0 << 16), h.y - __uint_as_float(h1 << 16)); l.y = pk2(h.z - __uint_as_float(h2 << 16), h.w - __uint_as_float(h3 << 16)); lr[64 * j] = l; }
    }
}

__device__ __forceinline__ void ph_router_simple(Frame& F) {
    F.lane = ltid(); F.tid = F.wave * 64 + F.lane;
    LAS float* sm = (LAS float*)F.lds;
    const bf16_t *H2 = F.H2, *H2LO = F.H2LO; const float *wr = F.w_router, *wg = F.w_sh_gate, *wu = F.w_sh_up; float* RL = F.RL; bf16_t* SHID = F.SHID;
    for (int u = blockIdx.x; u < (T / 64) * 4; u += gridDim.x) {
        const int m0 = (u >> 2) * 64, which = (u & 3) >> 1, n0 = (u & 1) * 128;
        if (which == 0)
            ngemm_tile<false>(sm, D,
                [=](int r, int k) -> float { const size_t i = (size_t)(m0 + r) * D + k; return bf2f(H2[i]) + bf2f(H2LO[i]); },
                [=](int k, int n) -> float { return wr[(size_t)k * NE + n0 + n]; }, NOFB2,
                [=](int r, int n, float a, float) { RL[(size_t)(m0 + r) * NE + n0 + n] = a; });
        else
            ngemm_tile<true>(sm, D,
                [=](int r, int k) -> float { return bf2f(H2[(size_t)(m0 + r) * D + k]); },
                [=](int k, int n) -> float { return wg[(size_t)k * SHH + n0 + n]; },
                [=](int k, int n) -> float { return wu[(size_t)k * SHH + n0 + n]; },
                [=](int r, int n, float g, float up) { SHID[(size_t)(m0 + r) * SHH + n0 + n] = (bf16_t)f2bf(siluf_(g) * up); });
    }
}

__device__ __forceinline__ void ph_route(Frame& F, int nparts) {
    F.lane = ltid(); F.tid = F.wave * 64 + F.lane;
    const int lane = F.lane;
    for (int t = F.gw; t < T; t += F.NGW) {
        f32x4 lg = *(const f32x4*)(F.RL + (size_t)t * NE + lane * 4);
        for (int p = 1; p < nparts; ++p) lg += *(const f32x4*)(F.RL + (size_t)p * T * NE + (size_t)t * NE + lane * 4);
        const f32x4 bias = *(const f32x4*)(F.router_bias + lane * 4);
        float sc[4], sel[4];
#pragma unroll
        for (int i = 0; i < 4; ++i) { sc[i] = sigmoidf_(lg[i]); sel[i] = sc[i] + bias[i]; }
        float a1 = fmaxf(sel[0], sel[1]), a2 = fminf(sel[0], sel[1]);
        { const float b1 = fmaxf(sel[2], sel[3]), b2 = fminf(sel[2], sel[3]); const float n1 = fmaxf(a1, b1), n2 = fmaxf(fminf(a1, b1), fmaxf(a2, b2)); a1 = n1; a2 = n2; }
#pragma unroll
        for (int o = 1; o < 8; o <<= 1) { const float b1 = __shfl_xor(a1, o), b2 = __shfl_xor(a2, o); const float n1 = fmaxf(a1, b1), n2 = fmaxf(fminf(a1, b1), fmaxf(a2, b2)); a1 = n1; a2 = n2; }
        const float gs = a1 + a2; const int g = lane >> 3;
        int rank = 0;
#pragma unroll
        for (int gg = 0; gg < NG; ++gg) { const float og = __shfl(gs, gg * 8); rank += (og > gs || (og == gs && gg < g)) ? 1 : 0; }
        const bool gsel = rank < 4;
        float mv[4];
#pragma unroll
        for (int i = 0; i < 4; ++i) mv[i] = gsel ? sel[i] : -INFINITY;
        float myw = 0.f; int mye = 0; float wsum = 0.f;
#pragma unroll
        for (int k = 0; k < TOPK; ++k) {
            float bv = mv[0]; int bi = 0;
#pragma unroll
            for (int i = 1; i < 4; ++i) if (mv[i] > bv) { bv = mv[i]; bi = i; }
            int be = lane * 4 + bi; float bs = sc[0];
#pragma unroll
            for (int i = 1; i < 4; ++i) bs = (bi == i) ? sc[i] : bs;
            float v = bv; int e = be; float s = bs;
#pragma unroll
            for (int o = 1; o < 64; o <<= 1) { const float ov = __shfl_xor(v, o); const int oe = __shfl_xor(e, o); const float os = __shfl_xor(s, o);
                if (ov > v || (ov == v && oe < e)) { v = ov; e = oe; s = os; } }
            if ((e >> 2) == lane) {
#pragma unroll
                for (int i = 0; i < 4; ++i) if ((e & 3) == i) mv[i] = -INFINITY; }
            wsum += s;
            if (lane == k) { myw = s; mye = e; }
        }
        if (lane < TOPK) {
            const float w = myw / wsum * ROUTED_SCALE;
            const unsigned p = atomicAdd(F.ctl + CW_CNT + mye, 1u);
            F.LIST[(size_t)mye * LCAP + p] = t * TOPK + lane;
            F.LISTW[(size_t)mye * LCAP + p] = w;
        }
    }
}

__device__ __forceinline__ void build_expert_map(Frame& F, LAS int* pref, LAS int* base, int rows_per_chunk) {
    __syncthreads();
    if (F.tid == 0) { int p = 0, bsum = 0;
        for (int e = 0; e < NE; ++e) { const int n = (int)F.ctl[CW_CNT + e]; pref[e] = p; base[e] = bsum; p += (n + rows_per_chunk - 1) / rows_per_chunk; bsum += n; }
        pref[NE] = p; base[NE] = bsum; }
    __syncthreads();
}
__device__ __forceinline__ int find_expert(const LAS int* pref, int u) { int lo = 0, hi = NE - 1;
    while (lo < hi) { const int mid = (lo + hi + 1) >> 1; if (pref[mid] <= u) lo = mid; else hi = mid - 1; }
    return lo; }

__device__ __forceinline__ void ph_moe1_simple(Frame& F) {
    F.lane = ltid(); F.tid = F.wave * 64 + F.lane;
    LAS float* sm = (LAS float*)F.lds; LAS int* pref = (LAS int*)(sm + 1088 + 4096); LAS int* base = pref + 260;
    build_expert_map(F, pref, base, 64);
    const bf16_t* H2 = F.H2; const int* LIST = F.LIST; bf16_t* HID = F.HID; const float *weg = F.w_exp_gate, *weu = F.w_exp_up;
    const int nchunks = pref[NE];
    for (int u = blockIdx.x; u < nchunks * 2; u += gridDim.x) {
        const int ch = u >> 1, n0 = (u & 1) * 128, e = find_expert(pref, ch), p0 = (ch - pref[e]) * 64, ne = base[e + 1] - base[e], bs = base[e];
        const float* wg = weg + (size_t)e * D * EH; const float* wu = weu + (size_t)e * D * EH; const int* le = LIST + (size_t)e * LCAP;
        ngemm_tile<true>(sm, D,
            [=](int r, int k) -> float { const int p = p0 + r; return p < ne ? bf2f(H2[(size_t)(le[p] >> 3) * D + k]) : 0.f; },
            [=](int k, int n) -> float { return wg[(size_t)k * EH + n0 + n]; },
            [=](int k, int n) -> float { return wu[(size_t)k * EH + n0 + n]; },
            [=](int r, int n, float g, float up) { const int p = p0 + r; if (p < ne) HID[(size_t)(bs + p) * EH + n0 + n] = (bf16_t)f2bf(siluf_(g) * up); });
    }
    const bf16_t* SHID = F.SHID; const float* wd = F.w_sh_down; bf16_t* YAS = F.YAS;
    for (int u = blockIdx.x; u < (T / 64) * 8; u += gridDim.x) {
        const int m0 = (u >> 3) * 64, n0 = (u & 7) * 128;
        ngemm_tile<false>(sm, SHH,
            [=](int r, int k) -> float { return bf2f(SHID[(size_t)(m0 + r) * SHH + k]); },
            [=](int k, int n) -> float { return wd[(size_t)k * D + n0 + n]; }, NOFB2,
            [=](int r, int n, float a, float) { YAS[((size_t)(m0 + r) * NSLOT + 8) * D + n0 + n] = (bf16_t)f2bf(a); });
    }
}
__device__ __forceinline__ void ph_moe2_simple(Frame& F) {
    F.lane = ltid(); F.tid = F.wave * 64 + F.lane;
    LAS float* sm = (LAS float*)F.lds; LAS int* pref = (LAS int*)(sm + 1088 + 4096); LAS int* base = pref + 260;
    build_expert_map(F, pref, base, 64);
    const int* LIST = F.LIST; const float* LISTW = F.LISTW; const bf16_t* HID = F.HID; bf16_t* YAS = F.YAS; const float* wed = F.w_exp_down;
    const int nchunks = pref[NE];
    for (int u = blockIdx.x; u < nchunks * 8; u += gridDim.x) {
        const int ch = u >> 3, n0 = (u & 7) * 128, e = find_expert(pref, ch), p0 = (ch - pref[e]) * 64, ne = base[e + 1] - base[e], bs = base[e];
        const float* wd = wed + (size_t)e * EH * D; const int* le = LIST + (size_t)e * LCAP; const float* lw = LISTW + (size_t)e * LCAP;
        ngemm_tile<false>(sm, EH,
            [=](int r, int k) -> float { const int p = p0 + r; return p < ne ? bf2f(HID[(size_t)(bs + p) * EH + k]) : 0.f; },
            [=](int k, int n) -> float { return wd[(size_t)k * D + n0 + n]; }, NOFB2,
            [=](int r, int n, float a, float) { const int p = p0 + r; if (p < ne) { const int as = le[p]; YAS[((size_t)(as >> 3) * NSLOT + (as & 7)) * D + n0 + n] = (bf16_t)f2bf(lw[p] * a); } });
    }
}

__device__ __forceinline__ void ph_combine(Frame& F) {
    F.lane = ltid(); F.tid = F.wave * 64 + F.lane;
    const int lane = F.lane;
    for (int m = F.gw; m < T; m += F.NGW) {
        const int b = m >> 13;
        f32x4 y[4];
#pragma unroll
        for (int j = 0; j < 4; ++j) y[j] = (f32x4){0.f, 0.f, 0.f, 0.f};
        for (int k = 0; k < NSLOT; ++k) { const u32x2* yr = (const u32x2*)(F.YAS + ((size_t)m * NSLOT + k) * D) + lane;
#pragma unroll
            for (int j = 0; j < 4; ++j) { const u32x2 w = yr[64 * j];
                y[j].x += __uint_as_float(w.x << 16); y[j].y += __uint_as_float(w.x & 0xffff0000u); y[j].z += __uint_as_float(w.y << 16); y[j].w += __uint_as_float(w.y & 0xffff0000u); } }
        const f32x4* xr = (const f32x4*)(F.X1 + (size_t)m * D) + lane;
        f32x4 v[4]; float s = 0.f;
#pragma unroll
        for (int j = 0; j < 4; ++j) { const int col = 4 * lane + 256 * j; const f32x4 g2 = *(const f32x4*)(F.ADA + b * 6144 + 5120 + col);
            v[j] = xr[64 * j] * ALPHA + (g2 + 1.0f) * y[j]; s += (v[j].x + v[j].y) + (v[j].z + v[j].w); }
        const float mean = wave_sum(s) * (1.f / D); float s2 = 0.f;
#pragma unroll
        for (int j = 0; j < 4; ++j) { v[j] = v[j] - mean; s2 += (v[j].x * v[j].x + v[j].y * v[j].y) + (v[j].z * v[j].z + v[j].w * v[j].w); }
        const float rstd = 1.f / sqrtf(wave_sum(s2) * (1.f / D) + LN_EPS);
        f32x4* orow = (f32x4*)(F.out + (size_t)m * D) + lane;
#pragma unroll
        for (int j = 0; j < 4; ++j) { const int col = 4 * lane + 256 * j; orow[64 * j] = v[j] * rstd * *(const f32x4*)(F.ln2_g + col) + *(const f32x4*)(F.ln2_b + col); }
    }
}

namespace pg8 {
typedef short bf16x8 __attribute__((ext_vector_type(8)));
constexpr int BM = 256, BK = 64, HALF = 128, HTB = HALF * BK * 2, STAGE_BYTES = 8 * HTB, NXCD = 8, WGM = 8;
constexpr int RTAB_OFF = 131072 + 4096;
__host__ __device__ __forceinline__ int lds_byte(int r, int c) { const int st = (r >> 4) * 2 + (c >> 5), rr = r & 15, cc = c & 31, ob = rr * 64 + cc * 2; return st * 1024 + (ob ^ (((ob >> 9) & 1) << 5)); }
__host__ __device__ __forceinline__ void stage_rc(int b, int& R, int& C) { const int st = b / 1024, sb = b % 1024, swz = sb ^ (((sb >> 9) & 1) << 5); R = (st >> 1) * 16 + swz / 64; C = (st & 1) * 32 + (swz % 64) / 2; }
__host__ __device__ __forceinline__ int perm32(int rho) { const int n = rho >> 4, i = rho & 15; return 8 * (i >> 2) + 4 * n + (i & 3); }

struct Unit { const char* A; const char* B; int pm, pn, e, p0, ne, bs; };

struct TileOrder {
    int nM, nN, nwg, G, c;
    __device__ void init(int nM_, int nN_, int G_, int c_) { nM = nM_; nN = nN_; nwg = nM * nN; G = G_; c = c_; }
    __device__ bool tile(int i, int& pm, int& pn) const {
        const long L = (long)i * G + c; if (L >= nwg) return false;
        int wgid = (int)L; { const int q = nwg / NXCD, r = nwg % NXCD, xcd = wgid % NXCD, off = wgid / NXCD; wgid = (xcd < r ? xcd * (q + 1) : r * (q + 1) + (xcd - r) * q) + off; }
        const int nig = WGM * nN, gid = wgid / nig, fm = gid * WGM, gsz = (nM - fm) < WGM ? (nM - fm) : WGM;
        pm = fm + ((wgid % nig) % gsz); pn = (wgid % nig) / gsz; return true;
    }
};

__device__ __forceinline__ unsigned cvt_pk_bf16(float lo, float hi) { unsigned r; asm volatile("v_cvt_pk_bf16_f32 %0, %1, %2" : "=v"(r) : "v"(lo), "v"(hi)); return r; }
__device__ __forceinline__ float fsigmoid(float x) { return __builtin_amdgcn_rcpf(1.0f + __builtin_amdgcn_exp2f(-LOG2E * x)); }

template <class Epi, class Sched, bool ALIGN_EPI>
__device__ __forceinline__ void gemm_phase(LAS unsigned char* lds, const int K, const int lda, const int ldb, const Sched& S, const Epi& E) {
    const int wid = __builtin_amdgcn_readfirstlane((int)threadIdx.x >> 6), lane = ltid(), tid = wid * 64 + lane, wr = wid >> 2, wc = wid & 3, fr = lane & 15, fq = lane >> 4;
    int nt = K / BK; asm volatile("" : "+s"(nt));
    int RA[2]; unsigned CA[2], voffB[2];
#pragma unroll
    for (int i = 0; i < 2; ++i) { int R, C; stage_rc(tid * 16 + i * 8192, R, C); const int Rb = (R & ~31) + perm32(R & 31);
        RA[i] = R; CA[i] = (unsigned)C * 2u; voffB[i] = (unsigned)(Rb * ldb + C) * 2u; }
    const size_t kstep = (size_t)(BK * 2);
    const size_t hstepB = (size_t)HALF * ldb * 2;
    const unsigned ldsw = (unsigned)wid * 1024u;
    const int aoff = lds_byte(wr * 64 + fr, fq * 8), boff = lds_byte(wc * 32 + fr, fq * 8);
#define PG8_SA(b, h) (((b) * 2 + (h)) * HTB)
#define PG8_SB(b, h) ((4 + (b) * 2 + (h)) * HTB)
#define PG8_STAGE(bufoff, gbase, voff) do { _Pragma("unroll") for (int _i = 0; _i < 2; ++_i) \
        __builtin_amdgcn_global_load_lds((const unsigned*)((const char*)(gbase) + (voff)[_i]), (LAS unsigned*)(lds + (bufoff) + ldsw + _i * 8192), 16, 0, 0); } while (0)
#define PG8_LDA(dst, b, h) do { _Pragma("unroll") for (int m = 0; m < 4; ++m) _Pragma("unroll") for (int k = 0; k < 2; ++k) dst[m][k] = *(const LAS bf16x8*)(lds + PG8_SA(b, h) + aoff + m * 2048 + k * 1024); } while (0)
#define PG8_LDB(dst, b, h) do { _Pragma("unroll") for (int n = 0; n < 2; ++n) _Pragma("unroll") for (int k = 0; k < 2; ++k) dst[n][k] = *(const LAS bf16x8*)(lds + PG8_SB(b, h) + boff + n * 2048 + k * 1024); } while (0)
#define PG8_MMA(ai, bj, At, Bt) do { __builtin_amdgcn_s_setprio(1); _Pragma("unroll") for (int m = 0; m < 4; ++m) _Pragma("unroll") for (int n = 0; n < 2; ++n) _Pragma("unroll") for (int k = 0; k < 2; ++k) \
        acc[ai][bj][m][n] = __builtin_amdgcn_mfma_f32_16x16x32_bf16(Bt[n][k], At[m][k], acc[ai][bj][m][n], 0, 0, 0); __builtin_amdgcn_s_setprio(0); } while (0)
#define PG8_WAIT_V(n) asm volatile("s_waitcnt vmcnt(" #n ")" ::: "memory")
#define PG8_WAIT_L(n) asm volatile("s_waitcnt lgkmcnt(" #n ")" ::: "memory")
#define PG8_BAR __builtin_amdgcn_s_barrier()
#define PG8_SCHED __builtin_amdgcn_sched_barrier(0)
    Unit cur, nxt; int ui = 0;
    if (!S.next(0, cur)) return;
    f32x4 acc[2][2][4][2];
#pragma unroll
    for (int a = 0; a < 2; ++a)
#pragma unroll
        for (int b = 0; b < 2; ++b)
#pragma unroll
            for (int m = 0; m < 4; ++m)
#pragma unroll
                for (int n = 0; n < 2; ++n) acc[a][b][m][n] = (f32x4){0.f, 0.f, 0.f, 0.f};
    bf16x8 At[4][2], B0[2][2], B1[2][2];
    const char* cA = cur.A; const char* cB = cur.B;
    LAS unsigned* rtab = (LAS unsigned*)(lds + RTAB_OFF);
    int tb = 0;
#define PG8_STAGE_A(bufoff, gbase, h) do { unsigned _v[2]; _Pragma("unroll") for (int _j = 0; _j < 2; ++_j) \
        _v[_j] = (Sched::GATHER ? rtab[tb * 256 + (h) * HALF + RA[_j]] : S.a_row_off(cur, (h) * HALF + RA[_j])) + CA[_j]; PG8_STAGE(bufoff, gbase, _v); } while (0)
    if constexpr (Sched::GATHER) { if (tid < 256) rtab[tid] = S.a_row_off(cur, tid); PG8_WAIT_L(0); PG8_BAR; }
    PG8_STAGE(PG8_SB(0, 0), cB, voffB); PG8_STAGE(PG8_SB(0, 1), cB + hstepB, voffB); PG8_STAGE_A(PG8_SA(0, 0), cA, 0); PG8_STAGE_A(PG8_SA(0, 1), cA, 1);
    if (wr == 1) PG8_BAR;
    PG8_WAIT_V(2); PG8_BAR;
    PG8_STAGE(PG8_SB(1, 0), cB + kstep, voffB); PG8_STAGE_A(PG8_SA(1, 0), cA + kstep, 0); PG8_STAGE(PG8_SB(1, 1), cB + hstepB + kstep, voffB);
    PG8_WAIT_V(6); PG8_BAR;
    for (;;) {
        const bool has_next = S.next(ui + 1, nxt);
        const char* nA = has_next ? nxt.A : cA; const char* nB = has_next ? nxt.B : cB;
        if constexpr (Sched::GATHER) { if (has_next && tid < 256) rtab[((ui + 1) & 1) * 256 + tid] = S.a_row_off(nxt, tid); }
        for (int t = 0; t < nt; t += 2) {
            const bool last = (t == nt - 2);
            const char* a1 = cA + (size_t)(t + 1) * kstep;
            const char* a2 = last ? nA : cA + (size_t)(t + 2) * kstep; const char* b2 = last ? nB : cB + (size_t)(t + 2) * kstep;
            const char* a3 = a2 + kstep; const char* b3 = b2 + kstep;
            PG8_LDB(B0, 0, 0); PG8_LDB(B1, 0, 1); PG8_SCHED; PG8_LDA(At, 0, 0); PG8_STAGE_A(PG8_SA(1, 1), a1, 1);
            if (last && has_next) tb ^= 1;
            PG8_WAIT_V(8); PG8_WAIT_L(0); PG8_BAR; PG8_MMA(0, 0, At, B0); PG8_MMA(0, 1, At, B1); PG8_BAR; PG8_SCHED;
            PG8_LDA(At, 0, 1); PG8_STAGE(PG8_SB(0, 0), b2, voffB); PG8_STAGE(PG8_SB(0, 1), b2 + hstepB, voffB); PG8_STAGE_A(PG8_SA(0, 0), a2, 0);
            PG8_WAIT_V(8); PG8_WAIT_L(0); PG8_BAR; PG8_MMA(1, 0, At, B0); PG8_MMA(1, 1, At, B1); PG8_BAR; PG8_SCHED;
            PG8_LDB(B0, 1, 0); PG8_LDB(B1, 1, 1); PG8_SCHED; PG8_LDA(At, 1, 0); PG8_STAGE_A(PG8_SA(0, 1), a2, 1);
            PG8_WAIT_V(8); PG8_WAIT_L(0); PG8_BAR; PG8_MMA(0, 0, At, B0); PG8_MMA(0, 1, At, B1); PG8_BAR; PG8_SCHED;
            PG8_LDA(At, 1, 1); PG8_STAGE(PG8_SB(1, 0), b3, voffB); PG8_STAGE(PG8_SB(1, 1), b3 + hstepB, voffB); PG8_STAGE_A(PG8_SA(1, 0), a3, 0);
            PG8_WAIT_V(8); PG8_WAIT_L(0); PG8_BAR; PG8_MMA(1, 0, At, B0); PG8_MMA(1, 1, At, B1); PG8_BAR; PG8_SCHED;
        }
        if constexpr (ALIGN_EPI) { if (wr == 0) PG8_BAR; }
        E(acc, cur, wr, wc, fr, fq);
        if (!has_next) break;
#pragma unroll
        for (int a = 0; a < 2; ++a)
#pragma unroll
            for (int b = 0; b < 2; ++b)
#pragma unroll
                for (int m = 0; m < 4; ++m)
#pragma unroll
                    for (int n = 0; n < 2; ++n) acc[a][b][m][n] = (f32x4){0.f, 0.f, 0.f, 0.f};
        cur = nxt; cA = nA; cB = nB; ++ui;
        if constexpr (ALIGN_EPI) { if (wr == 1) PG8_BAR; }
    }
    PG8_WAIT_V(0);
    if constexpr (!ALIGN_EPI) { if (wr == 0) PG8_BAR; }
    PG8_BAR;
#undef PG8_SA
#undef PG8_SB
#undef PG8_STAGE
#undef PG8_STAGE_A
#undef PG8_LDA
#undef PG8_LDB
#undef PG8_MMA
#undef PG8_WAIT_V
#undef PG8_WAIT_L
#undef PG8_BAR
#undef PG8_SCHED
}
}

constexpr size_t WS_WIN_T = 4 * MiB, WS_WC_T = 13 * MiB, WS_WF_T = 14 * MiB, WS_WMIX_T = 15 * MiB, WS_WR_HI = 17 * MiB, WS_WR_LO = 17 * MiB + 512 * 1024, WS_WSHGU_T = 18 * MiB, WS_WSHD_T = 19 * MiB;
constexpr size_t WS_WEGU_T = 640 * MiB, WS_WED_T = 896 * MiB;
constexpr int NINW = 4608;

__device__ __forceinline__ void tr_block(const float* src, int ldw, bf16_t* dst, bf16_t* dst2, int ldt, LAS float* scr, int lane) {
#pragma unroll 8
    for (int i = 0; i < 32; ++i) { const int kk = 2 * i + (lane >> 5); scr[kk * 33 + (lane & 31)] = src[(size_t)kk * ldw + (lane & 31)]; }
    asm volatile("s_waitcnt lgkmcnt(0)" ::: "memory");
    const int c = lane & 7;
#pragma unroll
    for (int j = 0; j < 4; ++j) { const int n = (lane >> 3) + 8 * j; const LAS float* s = scr + (8 * c) * 33 + n;
        float v[8];
#pragma unroll
        for (int q = 0; q < 8; ++q) v[q] = s[q * 33];
        u32x4 o; o.x = pk2(v[0], v[1]); o.y = pk2(v[2], v[3]); o.z = pk2(v[4], v[5]); o.w = pk2(v[6], v[7]);
        *(u32x4*)(dst + (size_t)n * ldt + 8 * c) = o;
        if (dst2) { u32x4 l;
            l.x = pk2(v[0] - __uint_as_float(o.x << 16), v[1] - __uint_as_float(o.x & 0xffff0000u)); l.y = pk2(v[2] - __uint_as_float(o.y << 16), v[3] - __uint_as_float(o.y & 0xffff0000u));
            l.z = pk2(v[4] - __uint_as_float(o.z << 16), v[5] - __uint_as_float(o.z & 0xffff0000u)); l.w = pk2(v[6] - __uint_as_float(o.w << 16), v[7] - __uint_as_float(o.w & 0xffff0000u));
            *(u32x4*)(dst2 + (size_t)n * ldt + 8 * c) = l; } }
    asm volatile("s_waitcnt lgkmcnt(0)" ::: "memory");
}
__device__ __forceinline__ int inproj_src_col(int d) { const int pn = d >> 3, c0 = (d & 7) * 32;
    if (pn < 4) return c0 < 128 ? 128 * pn + c0 : 512 + 128 * pn + (c0 - 128);
    if (pn < 6) return O_Q + (pn - 4) * 256 + c0; if (pn < 8) return O_K + (pn - 6) * 256 + c0; if (pn < 10) return O_V + (pn - 8) * 256 + c0;
    if (pn < 14) return O_GA + (pn - 10) * 256 + c0; return O_GB + (pn - 14) * 256 + c0; }
__device__ __forceinline__ void ph_convert(Frame& F, bool experts) {
    F.lane = ltid(); F.tid = F.wave * 64 + F.lane;
    LAS float* scr = (LAS float*)(F.lds + F.wave * 16384);
    unsigned char* ws = F.ws; const int lane = F.lane;
    constexpr int I0 = 144 * 16, I1 = 32 * 8, I2 = 32 * 8, I3 = 32 * 16, I4 = 8 * 16, I5 = 16 * 16, I6 = 32 * 4, ISMALL = I0 + I1 + I2 + I3 + I4 + I5 + I6;
    for (int it = F.gw; it < ISMALL; it += F.NGW) {
        int r = it;
        if (r < I0) { const int d = r % 144, kb = r / 144; tr_block(F.w_in + (size_t)kb * 64 * INC + inproj_src_col(d), INC, (bf16_t*)(ws + WS_WIN_T) + (size_t)d * 32 * D + kb * 64, nullptr, D, scr, lane); continue; } r -= I0;
        if (r < I1) { const int d = r % 32, kb = r / 32; tr_block(F.w_conv_out + (size_t)kb * 64 * D + d * 32, D, (bf16_t*)(ws + WS_WC_T) + (size_t)d * 32 * CC + kb * 64, nullptr, CC, scr, lane); continue; } r -= I1;
        if (r < I2) { const int d = r % 32, kb = r / 32; tr_block(F.w_fox_out + (size_t)kb * 64 * D + d * 32, D, (bf16_t*)(ws + WS_WF_T) + (size_t)d * 32 * FW + kb * 64, nullptr, FW, scr, lane); continue; } r -= I2;
        if (r < I3) { const int d = r % 32, kb = r / 32; tr_block(F.w_mix_out + (size_t)kb * 64 * D + d * 32, D, (bf16_t*)(ws + WS_WMIX_T) + (size_t)d * 32 * D + kb * 64, nullptr, D, scr, lane); continue; } r -= I3;
        if (r < I4) { const int d = r % 8, kb = r / 8; tr_block(F.w_router + (size_t)kb * 64 * NE + d * 32, NE, (bf16_t*)(ws + WS_WR_HI) + (size_t)d * 32 * D + kb * 64, (bf16_t*)(ws + WS_WR_LO) + (size_t)d * 32 * D + kb * 64, D, scr, lane); continue; } r -= I4;
        if (r < I5) { const int d = r % 16, kb = r / 16, ct = d >> 3, c0 = (d & 7) * 32; const float* w = c0 < 128 ? F.w_sh_gate + 128 * ct + c0 : F.w_sh_up + 128 * ct + c0 - 128;
            tr_block(w + (size_t)kb * 64 * SHH, SHH, (bf16_t*)(ws + WS_WSHGU_T) + (size_t)d * 32 * D + kb * 64, nullptr, D, scr, lane); continue; } r -= I5;
        { const int d = r % 32, kb = r / 32; tr_block(F.w_sh_down + (size_t)kb * 64 * D + d * 32, D, (bf16_t*)(ws + WS_WSHD_T) + (size_t)d * 32 * SHH + kb * 64, nullptr, SHH, scr, lane); }
    }
    if (experts) {
        for (int it = F.gw; it < NE * 256; it += F.NGW) {
            const int e = it >> 8, kb = (it >> 4) & 15, d = it & 15, ct = d >> 3, c0 = (d & 7) * 32;
            const float* w = (c0 < 128 ? F.w_exp_gate + 128 * ct + c0 : F.w_exp_up + 128 * ct + c0 - 128) + (size_t)e * D * EH + (size_t)kb * 64 * EH;
            tr_block(w, EH, (bf16_t*)(ws + WS_WEGU_T) + ((size_t)e * 512 + d * 32) * D + kb * 64, nullptr, D, scr, lane);
        }
        for (int it = F.gw; it < NE * 128; it += F.NGW) {
            const int e = it >> 7, kb = (it >> 5) & 3, d = it & 31;
            tr_block(F.w_exp_down + (size_t)e * EH * D + (size_t)kb * 64 * D + d * 32, D, (bf16_t*)(ws + WS_WED_T) + ((size_t)e * D + d * 32) * EH + kb * 64, nullptr, EH, scr, lane);
        }
    }
}

struct SchedPlain {
    static constexpr bool GATHER = false;
    pg8::TileOrder o; const char* A; const char* B; unsigned arow, brow;
    __device__ __forceinline__ bool next(int i, pg8::Unit& u) const { int pm, pn; if (!o.tile(i, pm, pn)) return false; u.pm = pm; u.pn = pn; u.e = 0; u.p0 = 0; u.ne = 0; u.bs = 0;
        u.A = A + (size_t)pm * 256 * arow; u.B = B + (size_t)pn * 256 * brow; return true; }
    __device__ __forceinline__ unsigned a_row_off(const pg8::Unit&, int r) const { return (unsigned)r * arow; }
};
typedef f32x4 AccT[2][2][4][2];
#define EPI_ARGS const AccT& acc, const pg8::Unit& u, int wr, int wc, int fr, int fq
#define EPI_LAUNDER asm volatile("" : "+v"(fr), "+v"(fq))

struct EpiInProj {
    bf16_t *U, *Q, *GA;
    __device__ __forceinline__ void operator()(EPI_ARGS) const {
        EPI_LAUNDER;
        const int row0 = u.pm * 256 + wr * 64 + fr, pn = u.pn, cin = wc * 32 + 8 * fq;
        if (pn < 4) {
#pragma unroll
            for (int ai = 0; ai < 2; ++ai)
#pragma unroll
                for (int m = 0; m < 4; ++m) { const f32x4 a0 = acc[ai][0][m][0], a1 = acc[ai][0][m][1], b0 = acc[ai][1][m][0], b1 = acc[ai][1][m][1]; u32x4 w;
                    w.x = pg8::cvt_pk_bf16(a0[0] * pg8::fsigmoid(b0[0]), a0[1] * pg8::fsigmoid(b0[1])); w.y = pg8::cvt_pk_bf16(a0[2] * pg8::fsigmoid(b0[2]), a0[3] * pg8::fsigmoid(b0[3]));
                    w.z = pg8::cvt_pk_bf16(a1[0] * pg8::fsigmoid(b1[0]), a1[1] * pg8::fsigmoid(b1[1])); w.w = pg8::cvt_pk_bf16(a1[2] * pg8::fsigmoid(b1[2]), a1[3] * pg8::fsigmoid(b1[3]));
                    *(u32x4*)(U + (size_t)(row0 + ai * 128 + m * 16) * CC + 128 * pn + cin) = w; }
        } else {
            const bool sg = pn >= 10; const int ld = sg ? D : FW, cb = sg ? ((pn - 10) & 3) * 256 : ((pn - 4) & 1) * 256;
            bf16_t* dst = sg ? GA + (size_t)((pn - 10) >> 2) * (16u << 20) : Q + (size_t)((pn - 4) >> 1) * (8u << 20);
            const float sc = pn < 6 ? QSCALE : 1.f;
#pragma unroll
            for (int ai = 0; ai < 2; ++ai)
#pragma unroll
                for (int m = 0; m < 4; ++m) { bf16_t* rowp = dst + (size_t)(row0 + ai * 128 + m * 16) * ld + cb + cin;
#pragma unroll
                    for (int bj = 0; bj < 2; ++bj) { f32x4 v0 = acc[ai][bj][m][0], v1 = acc[ai][bj][m][1];
                        if (sg) {
#pragma unroll
                            for (int j = 0; j < 4; ++j) { v0[j] = pg8::fsigmoid(v0[j]); v1[j] = pg8::fsigmoid(v1[j]); } }
                        else { v0 = v0 * sc; v1 = v1 * sc; }
                        u32x4 w; w.x = pg8::cvt_pk_bf16(v0[0], v0[1]); w.y = pg8::cvt_pk_bf16(v0[2], v0[3]); w.z = pg8::cvt_pk_bf16(v1[0], v1[1]); w.w = pg8::cvt_pk_bf16(v1[2], v1[3]);
                        *(u32x4*)(rowp + bj * 128) = w; } }
        }
    }
};
__device__ __forceinline__ f32x4 bf4lo(u32x4 w) { return (f32x4){__uint_as_float(w.x << 16), __uint_as_float(w.x & 0xffff0000u), __uint_as_float(w.y << 16), __uint_as_float(w.y & 0xffff0000u)}; }
__device__ __forceinline__ f32x4 bf4hi(u32x4 w) { return (f32x4){__uint_as_float(w.z << 16), __uint_as_float(w.z & 0xffff0000u), __uint_as_float(w.w << 16), __uint_as_float(w.w & 0xffff0000u)}; }
__device__ __forceinline__ u32x4 pack8(f32x4 v0, f32x4 v1) { u32x4 w; w.x = pg8::cvt_pk_bf16(v0[0], v0[1]); w.y = pg8::cvt_pk_bf16(v0[2], v0[3]); w.z = pg8::cvt_pk_bf16(v1[0], v1[1]); w.w = pg8::cvt_pk_bf16(v1[2], v1[3]); return w; }

struct SchedMerge {
    static constexpr bool GATHER = false;
    pg8::TileOrder o; const char *AC, *O, *WC, *WF;
    __device__ __forceinline__ bool next(int i, pg8::Unit& u) const { int pm, pn; if (!o.tile(i >> 1, pm, pn)) return false; u.pm = pm; u.pn = pn; u.e = i & 1; u.p0 = 0; u.ne = 0; u.bs = 0;
        u.A = ((i & 1) ? O : AC) + (size_t)pm * 256 * 1024; u.B = ((i & 1) ? WF : WC) + (size_t)pn * 256 * 1024; return true; }
    __device__ __forceinline__ unsigned a_row_off(const pg8::Unit&, int r) const { return (unsigned)r * 1024u; }
};
struct EpiMerge {
    const bf16_t *GA, *GB; bf16_t *YA, *MG;
    __device__ __forceinline__ void operator()(EPI_ARGS) const {
        EPI_LAUNDER;
        const int row0 = u.pm * 256 + wr * 64 + fr, col0 = u.pn * 256 + wc * 32 + 8 * fq; const bool second = u.e != 0;
        const bf16_t* G = second ? GB : GA; bf16_t* dst = second ? MG : YA;
#pragma unroll
        for (int ai = 0; ai < 2; ++ai)
#pragma unroll
            for (int m = 0; m < 4; ++m) { const size_t off = (size_t)(row0 + ai * 128 + m * 16) * D + col0;
#pragma unroll
                for (int bj = 0; bj < 2; ++bj) { const u32x4 g = *(const u32x4*)(G + off + bj * 128);
                    f32x4 v0 = acc[ai][bj][m][0] * bf4lo(g), v1 = acc[ai][bj][m][1] * bf4hi(g);
                    if (second) { const u32x4 y = *(const u32x4*)(YA + off + bj * 128); v0 += bf4lo(y); v1 += bf4hi(y); }
                    *(u32x4*)(dst + off + bj * 128) = pack8(v0, v1); } }
    }
};
struct EpiMix {
    const float *x, *ADA; float* Z;
    __device__ __forceinline__ void operator()(EPI_ARGS) const {
        EPI_LAUNDER;
        const int row0 = u.pm * 256 + wr * 64 + fr, col0 = u.pn * 256 + wc * 32 + 8 * fq, b = (u.pm * 256) >> 13;
        f32x4 g[2][2];
#pragma unroll
        for (int bj = 0; bj < 2; ++bj)
#pragma unroll
            for (int n = 0; n < 2; ++n) g[bj][n] = *(const f32x4*)(ADA + b * 6144 + 2048 + col0 + bj * 128 + 4 * n) + 1.0f;
#pragma unroll
        for (int ai = 0; ai < 2; ++ai)
#pragma unroll
            for (int m = 0; m < 4; ++m) { const size_t off = (size_t)(row0 + ai * 128 + m * 16) * D + col0;
#pragma unroll
                for (int bj = 0; bj < 2; ++bj)
#pragma unroll
                    for (int n = 0; n < 2; ++n) { const f32x4 xv = *(const f32x4*)(x + off + bj * 128 + 4 * n); *(f32x4*)(Z + off + bj * 128 + 4 * n) = xv * ALPHA + g[bj][n] * acc[ai][bj][m][n]; } }
    }
};
struct SchedRS {
    static constexpr bool GATHER = false;
    int G, c; const char *H2, *H2LO, *WRH, *WRL, *WSH;
    __device__ __forceinline__ bool next(int i, pg8::Unit& u) const { const int L = i * G + c; if (L >= 64 * 5) return false; const int pm = L / 5, j = L % 5; u.pm = pm; u.e = j; u.p0 = 0; u.ne = 0; u.bs = 0;
        if (j < 3) { u.pn = 0; u.A = (j == 2 ? H2LO : H2) + (size_t)pm * 256 * 2048; u.B = (j == 1 ? WRL : WRH); }
        else { u.pn = j - 3; u.A = H2 + (size_t)pm * 256 * 2048; u.B = WSH + (size_t)(j - 3) * 256 * 2048; }
        return true; }
    __device__ __forceinline__ unsigned a_row_off(const pg8::Unit&, int r) const { return (unsigned)r * 2048u; }
};
struct EpiRS {
    float* RL; bf16_t* SHID;
    __device__ __forceinline__ void operator()(EPI_ARGS) const {
        EPI_LAUNDER;
        const int row0 = u.pm * 256 + wr * 64 + fr, cin = wc * 32 + 8 * fq;
        if (u.e < 3) { float* R = RL + (size_t)u.e * T * NE;
#pragma unroll
            for (int ai = 0; ai < 2; ++ai)
#pragma unroll
                for (int m = 0; m < 4; ++m) { float* rp = R + (size_t)(row0 + ai * 128 + m * 16) * NE + cin;
#pragma unroll
                    for (int bj = 0; bj < 2; ++bj)
#pragma unroll
                        for (int n = 0; n < 2; ++n) *(f32x4*)(rp + bj * 128 + 4 * n) = acc[ai][bj][m][n]; }
        } else {
#pragma unroll
            for (int ai = 0; ai < 2; ++ai)
#pragma unroll
                for (int m = 0; m < 4; ++m) { const f32x4 g0 = acc[ai][0][m][0], g1 = acc[ai][0][m][1], u0 = acc[ai][1][m][0], u1 = acc[ai][1][m][1]; f32x4 h0, h1;
#pragma unroll
                    for (int j = 0; j < 4; ++j) { h0[j] = g0[j] * pg8::fsigmoid(g0[j]) * u0[j]; h1[j] = g1[j] * pg8::fsigmoid(g1[j]) * u1[j]; }
                    *(u32x4*)(SHID + (size_t)(row0 + ai * 128 + m * 16) * SHH + 128 * u.pn + cin) = pack8(h0, h1); }
        }
    }
};
__device__ __forceinline__ void ph_inproj_fast(Frame& F) {
    F.lane = ltid(); F.tid = F.wave * 64 + F.lane;
    SchedPlain S; S.o.init(T / 256, NINW / 256, gridDim.x, blockIdx.x); S.A = (const char*)F.H; S.B = (const char*)(F.ws + WS_WIN_T); S.arow = 2048; S.brow = 2048;
    EpiInProj E{F.U, F.Q, F.GA};
    static_assert(WS_K - WS_Q == 16 * MiB && WS_V - WS_K == 16 * MiB && WS_GB - WS_GA == 32 * MiB, "EpiInProj destination arithmetic");
    pg8::gemm_phase<EpiInProj, SchedPlain, true>(F.lds, D, D, D, S, E);
}
__device__ __forceinline__ void ph_merge_fast(Frame& F) {
    F.lane = ltid(); F.tid = F.wave * 64 + F.lane;
    SchedMerge S; S.o.init(T / 256, D / 256, gridDim.x, blockIdx.x); S.AC = (const char*)F.AC; S.O = (const char*)F.O; S.WC = (const char*)(F.ws + WS_WC_T); S.WF = (const char*)(F.ws + WS_WF_T);
    EpiMerge E{F.GA, F.GB, F.YA, F.MG};
    pg8::gemm_phase<EpiMerge, SchedMerge, false>(F.lds, CC, CC, CC, S, E);
}
__device__ __forceinline__ void ph_mix_fast(Frame& F) {
    F.lane = ltid(); F.tid = F.wave * 64 + F.lane;
    SchedPlain S; S.o.init(T / 256, D / 256, gridDim.x, blockIdx.x); S.A = (const char*)F.MG; S.B = (const char*)(F.ws + WS_WMIX_T); S.arow = 2048; S.brow = 2048;
    EpiMix E{F.x, F.ADA, F.X1};
    pg8::gemm_phase<EpiMix, SchedPlain, false>(F.lds, D, D, D, S, E);
}
__device__ __forceinline__ void ph_router_fast(Frame& F) {
    F.lane = ltid(); F.tid = F.wave * 64 + F.lane;
    SchedRS S{(int)gridDim.x, (int)blockIdx.x, (const char*)F.H2, (const char*)F.H2LO, (const char*)(F.ws + WS_WR_HI), (const char*)(F.ws + WS_WR_LO), (const char*)(F.ws + WS_WSHGU_T)};
    EpiRS E{F.RL, F.SHID};
    pg8::gemm_phase<EpiRS, SchedRS, true>(F.lds, D, D, D, S, E);
}

constexpr int EMAP_OFF = 131072 + 1024;
struct SchedMoe1 {
    static constexpr bool GATHER = true;
    int G, c, nunits; const LAS int* pref; const LAS int* base; const char* H2; const char* W; const int* LIST;
    __device__ __forceinline__ bool next(int i, pg8::Unit& u) const { const int L = i * G + c; if (L >= nunits) return false; const int ch = L >> 1, ct = L & 1, e = __builtin_amdgcn_readfirstlane(find_expert(pref, ch));
        u.pm = 0; u.pn = ct; u.e = e; u.p0 = __builtin_amdgcn_readfirstlane((ch - pref[e]) * 256); u.bs = __builtin_amdgcn_readfirstlane(base[e]); u.ne = __builtin_amdgcn_readfirstlane(base[e + 1]) - u.bs;
        u.A = H2; u.B = W + ((size_t)e * 512 + ct * 256) * 2048; return true; }
    __device__ __forceinline__ unsigned a_row_off(const pg8::Unit& u, int r) const { int p = u.p0 + r; p = p < u.ne ? p : u.ne - 1; return (unsigned)(LIST[(size_t)u.e * LCAP + p] >> 3) * 2048u; }
};
struct EpiMoe1 {
    bf16_t* HID;
    __device__ __forceinline__ void operator()(EPI_ARGS) const {
        EPI_LAUNDER;
        const int r0 = wr * 64 + fr, cin = wc * 32 + 8 * fq;
#pragma unroll
        for (int ai = 0; ai < 2; ++ai)
#pragma unroll
            for (int m = 0; m < 4; ++m) { const int p = u.p0 + r0 + ai * 128 + m * 16;
                const f32x4 g0 = acc[ai][0][m][0], g1 = acc[ai][0][m][1], u0 = acc[ai][1][m][0], u1 = acc[ai][1][m][1]; f32x4 h0, h1;
#pragma unroll
                for (int j = 0; j < 4; ++j) { h0[j] = g0[j] * pg8::fsigmoid(g0[j]) * u0[j]; h1[j] = g1[j] * pg8::fsigmoid(g1[j]) * u1[j]; }
                if (p < u.ne) *(u32x4*)(HID + (size_t)(u.bs + p) * EH + 128 * u.pn + cin) = pack8(h0, h1); }
    }
};
struct SchedMoe2 {
    static constexpr bool GATHER = true;
    int G, c, nunits; const LAS int* pref; const LAS int* base; const char* HID; const char* W;
    __device__ __forceinline__ bool next(int i, pg8::Unit& u) const { const int L = i * G + c; if (L >= nunits) return false; const int ch = L >> 2, ct = L & 3, e = __builtin_amdgcn_readfirstlane(find_expert(pref, ch));
        u.pm = 0; u.pn = ct; u.e = e; u.p0 = __builtin_amdgcn_readfirstlane((ch - pref[e]) * 256); u.bs = __builtin_amdgcn_readfirstlane(base[e]); u.ne = __builtin_amdgcn_readfirstlane(base[e + 1]) - u.bs;
        u.A = HID + (size_t)(u.bs + u.p0) * 512; u.B = W + ((size_t)e * 1024 + ct * 256) * 512; return true; }
    __device__ __forceinline__ unsigned a_row_off(const pg8::Unit& u, int r) const { const int lim = u.ne - 1 - u.p0; return (unsigned)(r < lim ? r : lim) * 512u; }
};
struct EpiMoe2 {
    const int* LIST; const float* LISTW; bf16_t* YAS;
    __device__ __forceinline__ void operator()(EPI_ARGS) const {
        EPI_LAUNDER;
        const int r0 = wr * 64 + fr, col0 = u.pn * 256 + wc * 32 + 8 * fq;
#pragma unroll
        for (int ai = 0; ai < 2; ++ai)
#pragma unroll
            for (int m = 0; m < 4; ++m) { const int p = u.p0 + r0 + ai * 128 + m * 16;
                if (p < u.ne) { const int as = LIST[(size_t)u.e * LCAP + p]; const float w = LISTW[(size_t)u.e * LCAP + p];
                    bf16_t* rowp = YAS + ((size_t)(as >> 3) * NSLOT + (as & 7)) * D + col0;
#pragma unroll
                    for (int bj = 0; bj < 2; ++bj) *(u32x4*)(rowp + bj * 128) = pack8(acc[ai][bj][m][0] * w, acc[ai][bj][m][1] * w); }
                if (m & 1) asm volatile("" ::: "memory"); }
    }
};
struct EpiShDown {
    bf16_t* YAS;
    __device__ __forceinline__ void operator()(EPI_ARGS) const {
        EPI_LAUNDER;
        const int row0 = u.pm * 256 + wr * 64 + fr, col0 = u.pn * 256 + wc * 32 + 8 * fq;
#pragma unroll
        for (int ai = 0; ai < 2; ++ai)
#pragma unroll
            for (int m = 0; m < 4; ++m) { bf16_t* rowp = YAS + ((size_t)(row0 + ai * 128 + m * 16) * NSLOT + 8) * D + col0;
#pragma unroll
                for (int bj = 0; bj < 2; ++bj) *(u32x4*)(rowp + bj * 128) = pack8(acc[ai][bj][m][0], acc[ai][bj][m][1]); }
    }
};
__device__ __forceinline__ void ph_moe1_fast(Frame& F) {
    F.lane = ltid(); F.tid = F.wave * 64 + F.lane;
    LAS int* pref = (LAS int*)(F.lds + EMAP_OFF); LAS int* base = pref + 260;
    build_expert_map(F, pref, base, 256);
    { SchedMoe1 S{(int)gridDim.x, (int)blockIdx.x, __builtin_amdgcn_readfirstlane(pref[NE]) * 2, pref, base, (const char*)F.H2, (const char*)(F.ws + WS_WEGU_T), F.LIST};
      EpiMoe1 E{F.HID};
      pg8::gemm_phase<EpiMoe1, SchedMoe1, true>(F.lds, D, D, D, S, E); }
    { SchedPlain S; S.o.init(T / 256, D / 256, gridDim.x, blockIdx.x); S.A = (const char*)F.SHID; S.B = (const char*)(F.ws + WS_WSHD_T); S.arow = 512; S.brow = 512;
      EpiShDown E{F.YAS};
      pg8::gemm_phase<EpiShDown, SchedPlain, true>(F.lds, SHH, SHH, SHH, S, E); }
}
__device__ __forceinline__ void ph_moe2_fast(Frame& F) {
    F.lane = ltid(); F.tid = F.wave * 64 + F.lane;
    LAS int* pref = (LAS int*)(F.lds + EMAP_OFF); LAS int* base = pref + 260;
    build_expert_map(F, pref, base, 256);
    SchedMoe2 S{(int)gridDim.x, (int)blockIdx.x, __builtin_amdgcn_readfirstlane(pref[NE]) * 4, pref, base, (const char*)F.HID, (const char*)(F.ws + WS_WED_T)};
    EpiMoe2 E{F.LIST, F.LISTW, F.YAS};
    pg8::gemm_phase<EpiMoe2, SchedMoe2, true>(F.lds, EH, EH, EH, S, E);
}

namespace attn_body {
using bf16=__hip_bfloat16;
using bf16x8=__attribute__((ext_vector_type(8)))short;
using s16x4=__attribute__((ext_vector_type(4)))short;
using f32x16=__attribute__((ext_vector_type(16)))float;
using u32x4=__attribute__((ext_vector_type(4)))unsigned;
using f32x4_t=__attribute__((ext_vector_type(4)))float;
constexpr int BATCH=2,NHEAD=8,SEQ=8192,D=64,DM=NHEAD*D;
constexpr int NW=8,QBLK=32,QB=QBLK*NW,KVBLK=64,NQB=SEQ/QB;
constexpr int ATTN_PITCH=DM, ATTN_UNIT_ROWS=QB;
__device__ __forceinline__ int crow(int r,int hi){return (r&3)+8*(r>>2)+4*hi;}
#define SBAR() __builtin_amdgcn_sched_barrier(0)
__device__ __forceinline__ void cmask(f32x16&p0,f32x16&p1,int jb,int qrel,int hi){
  const float NEG=-INFINITY; int kb=64*jb+4*hi;
  #pragma unroll
  for(int r=0;r<16;++r){int kv=kb+(r&3)+8*(r>>2); if(kv>qrel)p0[r]=NEG; if(kv+32>qrel)p1[r]=NEG;}
}

constexpr int NSLOT=3, SLOTB=8192;
constexpr int LDS_K=0, LDS_V=NSLOT*SLOTB, LDS_WS=2*NSLOT*SLOTB, LDS_OST=LDS_WS+NW*64*4, LDS_NB=LDS_OST+NW*4096, LDS_BYTES=LDS_NB+SEQ*4;
constexpr float C2=0.125f*1.4426950408889634f;
__device__ __forceinline__ void glds16(const void*gsrc,unsigned lds_dst){unsigned keep;
  asm volatile("s_mov_b32 %0, m0\n\ts_mov_b32 m0, %2\n\ts_nop 0\n\tglobal_load_lds_dwordx4 %1, off\n\ts_mov_b32 m0, %0":"=&s"(keep):"v"(gsrc),"s"(lds_dst):"memory");}
__device__ __forceinline__ float max3f(float a,float b,float c){float r;asm("v_max3_f32 %0, %1, %2, %3":"=v"(r):"v"(a),"v"(b),"v"(c));return r;}
__device__ __forceinline__ float max2f(float a,float b){float r;asm("v_max_f32_e32 %0, %1, %2":"=v"(r):"v"(a),"v"(b));return r;}
__device__ __forceinline__ float fadd_s(float a,float b){float r;asm("v_add_f32_e32 %0, %1, %2":"=v"(r):"v"(a),"v"(b));return r;}
__device__ __forceinline__ float fsub_s(float a,float b){float r;asm("v_sub_f32_e32 %0, %1, %2":"=v"(r):"v"(a),"v"(b));return r;}
typedef float f32x2_t __attribute__((ext_vector_type(2))); typedef __bf16 bf16x2_t __attribute__((ext_vector_type(2)));
__device__ __forceinline__ unsigned cvtpk_s(float lo,float hi){f32x2_t v={lo,hi};bf16x2_t b=__builtin_convertvector(v,bf16x2_t);return __builtin_bit_cast(unsigned,b);}
#define WAIT_BAR(N) asm volatile("s_waitcnt vmcnt(" #N ") lgkmcnt(0)\n\ts_barrier":::"memory")

__device__ __forceinline__ void qkt(f32x16&p0,f32x16&p1,const char*Kslot,const bf16x8*qr,int r32,int hi){
  const char*kb=Kslot+hi*1024+r32*16;
  #pragma unroll
  for(int d0=0;d0<4;++d0){
    const bf16x8 b0=*reinterpret_cast<const bf16x8*>(kb+d0*2048);
    const bf16x8 b1=*reinterpret_cast<const bf16x8*>(kb+d0*2048+512);
    {p0=__builtin_amdgcn_mfma_f32_32x32x16_bf16(b0,qr[d0],p0,0,0,0);p1=__builtin_amdgcn_mfma_f32_32x32x16_bf16(b1,qr[d0],p1,0,0,0);}}
}
typedef __attribute__((address_space(3))) const char* lds_cptr;
typedef short v4i16_t __attribute__((ext_vector_type(4)));
__device__ __forceinline__ void kload8(bf16x8*kf,lds_cptr kp){
  kf[0]=*(const __attribute__((address_space(3))) bf16x8*)(kp);      kf[1]=*(const __attribute__((address_space(3))) bf16x8*)(kp+512);
  kf[2]=*(const __attribute__((address_space(3))) bf16x8*)(kp+2048); kf[3]=*(const __attribute__((address_space(3))) bf16x8*)(kp+2560);
  kf[4]=*(const __attribute__((address_space(3))) bf16x8*)(kp+4096); kf[5]=*(const __attribute__((address_space(3))) bf16x8*)(kp+4608);
  kf[6]=*(const __attribute__((address_space(3))) bf16x8*)(kp+6144); kf[7]=*(const __attribute__((address_space(3))) bf16x8*)(kp+6656);
}
__device__ __forceinline__ void kload2(bf16x8*kf,lds_cptr kp,int j){ kf[2*j]=*(const __attribute__((address_space(3))) bf16x8*)(kp+j*2048); kf[2*j+1]=*(const __attribute__((address_space(3))) bf16x8*)(kp+j*2048+512); }
__device__ __forceinline__ s16x4 vtr(lds_cptr p){ return __builtin_bit_cast(s16x4,__builtin_amdgcn_ds_read_tr16_b64_v4i16((__attribute__((address_space(3))) v4i16_t*)p)); }
__device__ __forceinline__ float rowmax(const f32x16&p0,const f32x16&p1){
  float a=max3f(p0[0],p0[1],p1[0]),b=max3f(p0[2],p0[3],p1[1]);a=max3f(a,p1[2],p1[3]);
  #pragma unroll
  for(int r=4;r<16;r+=4){a=max3f(a,p0[r],p0[r+1]);b=max3f(b,p0[r+2],p0[r+3]);a=max3f(a,p1[r],p1[r+1]);b=max3f(b,p1[r+2],p1[r+3]);}
  const float m=max2f(a,b);
  auto rr=__builtin_amdgcn_permlane32_swap(__float_as_uint(m),__float_as_uint(m),false,false);
  return max2f(__uint_as_float(rr[0]),__uint_as_float(rr[1]));
}
__device__ __forceinline__ void pv(f32x16*o,int vb,bf16x8 pa0,bf16x8 pa1,bf16x8 pa2,bf16x8 pa3){
  #pragma unroll
  for(int d0=0;d0<2;++d0){s16x4 lo[4],hi[4];
    #pragma unroll
    for(int ks=0;ks<4;++ks){
      asm volatile("ds_read_b64_tr_b16 %0,%1 offset:%c2":"=&v"(lo[ks]):"v"(vb),"i"(d0*4096+ks*1024):"memory");
      asm volatile("ds_read_b64_tr_b16 %0,%1 offset:%c2":"=&v"(hi[ks]):"v"(vb),"i"(d0*4096+ks*1024+512):"memory");}
    asm volatile("s_waitcnt lgkmcnt(0)":::"memory");SBAR();
    #define PK(k) (bf16x8){lo[k][0],lo[k][1],lo[k][2],lo[k][3],hi[k][0],hi[k][1],hi[k][2],hi[k][3]}
    o[d0]=__builtin_amdgcn_mfma_f32_32x32x16_bf16(pa0,PK(0),o[d0],0,0,0);
    o[d0]=__builtin_amdgcn_mfma_f32_32x32x16_bf16(pa1,PK(1),o[d0],0,0,0);
    o[d0]=__builtin_amdgcn_mfma_f32_32x32x16_bf16(pa2,PK(2),o[d0],0,0,0);
    o[d0]=__builtin_amdgcn_mfma_f32_32x32x16_bf16(pa3,PK(3),o[d0],0,0,0);
    #undef PK
  }
}

#ifndef ATTN_STORE16
#define ATTN_STORE16(p,v) (*(u32x4*)(p)=(v))
#endif
template<int THRL> __device__ __forceinline__ void attn_unit(int b,int h,int qb,const bf16*Q,const bf16*__restrict__ K,const bf16*__restrict__ V,bf16*O,char*shm,const float*__restrict__ cum,float skip_thr){
  const int tid=threadIdx.x,lane=tid&63,r32=lane&31,hi=lane>>5; const int wid=__builtin_amdgcn_readfirstlane(tid>>6);
  const long rowbase=(long)b*SEQ; const int q0=qb*QB;
  const bf16*Qw=Q+(rowbase+q0+wid*QBLK)*DM+h*D;
  const bf16*Kh=K+rowbase*DM+h*D,*Vh=V+rowbase*DM+h*D;
  const unsigned lds0=(unsigned)(uintptr_t)shm;
  float*wsf=(float*)(shm+LDS_WS)+wid*64;
  const bf16*ksrc=Kh+(long)lane*DM+wid*8;
  const bf16*vsrc=Vh+(long)(16*(wid&3)+(lane>>2))*DM+(wid>>2)*32+(lane&3)*8;
  const unsigned kdst=lds0+LDS_K+wid*1024, vdst=lds0+LDS_V+wid*1024;
  #define DMA_K(t,slot) glds16(ksrc+(long)(NTF-1-(t))*KVBLK*DM,(unsigned)__builtin_amdgcn_readfirstlane(kdst+(slot)))
  #define DMA_V(t,slot) glds16(vsrc+(long)(NTF-1-(t))*KVBLK*DM,(unsigned)__builtin_amdgcn_readfirstlane(vdst+(slot)))
  const int vb0=(int)(lds0+LDS_V)+((lane>>4)&1)*32+(lane&3)*8+(4*hi+((lane&15)>>2))*64;
  const char*Kbase=shm+LDS_K; bf16x8 kf[8];
  const lds_cptr shm3=(lds_cptr)shm; const lds_cptr kp0=shm3+LDS_K+hi*1024+r32*16; const lds_cptr vp0=shm3+LDS_V+((lane>>4)&1)*32+(lane&3)*8+(4*hi+((lane&15)>>2))*64;
  const int NTF=(q0+QB)/KVBLK;
  const float F0=cum[q0]; int nskip;
  { const int j0=lane,j1=lane+64; bool s0=false,s1=false;
    if(j0<NTF-4) s0=(F0-cum[64*j0+63])*1.4426950408889634f < -skip_thr;
    if(j1<NTF-4) s1=(F0-cum[64*j1+63])*1.4426950408889634f < -skip_thr;
    const unsigned long long m0=__ballot(s0),m1=__ballot(s1);
    nskip=(m0==~0ull)?64+(int)__builtin_ctzll(~m1|(1ull<<63)):(int)__builtin_ctzll(~m0); nskip&=~1; nskip=__builtin_amdgcn_readfirstlane(nskip); }
  const int NT=NTF-nskip, sbase=64*nskip;
  typedef __attribute__((address_space(3))) float* lds_fptr; const lds_fptr nbL=(lds_fptr)(__attribute__((address_space(3))) char*)shm+LDS_NB/4;
  for(int i4=tid*4;i4<q0+QB-sbase;i4+=NW*64*4){ const f32x4_t c4=*reinterpret_cast<const f32x4_t*>(cum+sbase+i4); f32x4_t n4; n4[0]=(F0-c4[0])*1.4426950408889634f; n4[1]=(F0-c4[1])*1.4426950408889634f; n4[2]=(F0-c4[2])*1.4426950408889634f; n4[3]=(F0-c4[3])*1.4426950408889634f; *(__attribute__((address_space(3))) f32x4_t*)(nbL+i4)=n4; }
  asm volatile("s_waitcnt vmcnt(0) lgkmcnt(0)\n\ts_barrier":::"memory");
  DMA_K(0,0);DMA_V(0,0);DMA_K(1,SLOTB);
  bf16x8 qr[4];
  #pragma unroll
  for(int d0=0;d0<4;++d0)qr[d0]=*reinterpret_cast<const bf16x8*>(&Qw[(long)r32*DM+d0*16+hi*8]);
  float l_reg=0.f;f32x16 o[2];o[0]=f32x16{};o[1]=f32x16{};
  const int qrel=wid*QBLK+r32;
  float mhat=nbL[q0-sbase+qrel];
  #define NBRD(X0,X1,i) do{ const lds_fptr nb_=nbL+(64*(NT-1-(i))+4*hi); _Pragma("unroll") for(int g_=0;g_<4;++g_){ const f32x4_t a_=*(const __attribute__((address_space(3))) f32x4_t*)(nb_+8*g_); const f32x4_t b_=*(const __attribute__((address_space(3))) f32x4_t*)(nb_+8*g_+32); \
      X0[4*g_]=a_[0];X0[4*g_+1]=a_[1];X0[4*g_+2]=a_[2];X0[4*g_+3]=a_[3]; X1[4*g_]=b_[0];X1[4*g_+1]=b_[1];X1[4*g_+2]=b_[2];X1[4*g_+3]=b_[3]; } }while(0)
  #define NBSUB(X0,X1) do{ _Pragma("unroll") for(int r=0;r<16;++r){X0[r]-=mhat;X1[r]-=mhat;} }while(0)
  #define CMASK(P0,P1,t) do{int jb_=3-(t); if(jb_>=0)cmask(P0,P1,jb_,qrel,hi);}while(0)
  bool resc=false;
  #define START(P0,P1) do{ const float rm=rowmax(P0,P1); resc=false; \
    { const float dl=max2f(rm,0.f); mhat=fadd_s(mhat,dl); \
      _Pragma("unroll") for(int r=0;r<16;++r){P0[r]=fsub_s(P0[r],dl);P1[r]=fsub_s(P1[r],dl);} } \
    _Pragma("unroll") for(int r=0;r<16;++r)P0[r]=__builtin_amdgcn_exp2f(P0[r]); }while(0)
  #define RESC() do{ if(resc){ asm volatile("s_waitcnt lgkmcnt(0)":::"memory"); \
      _Pragma("unroll") for(int d_=0;d_<2;++d_) _Pragma("unroll") for(int r=0;r<16;++r)o[d_][r]*=wsf[crow(r,hi)]; } }while(0)
  f32x16 pA0,pA1,pB0,pB1;
  int sl_prev=0,sl_cur=0,sl_next=SLOTB;
  #define ROT() do{sl_prev=sl_cur;sl_cur=sl_next;sl_next=(sl_next==(NSLOT-1)*SLOTB)?0:sl_next+SLOTB;}while(0)
  DMA_K(2,2*SLOTB);
  WAIT_BAR(3);
  NBRD(pA0,pA1,0); NBSUB(pA0,pA1);
  qkt(pA0,pA1,Kbase,qr,r32,hi);asm volatile("s_nop 15\n\ts_nop 7":"+v"(pA0),"+v"(pA1));CMASK(pA0,pA1,0);
  START(pA0,pA1);
  _Pragma("unroll") for(int r=0;r<16;++r)pA1[r]=__builtin_amdgcn_exp2f(pA1[r]);
  NBRD(pB0,pB1,1);
  WAIT_BAR(0);
  DMA_K(3,0);DMA_V(1,SLOTB);
  ROT();
  kload8(kf,kp0+sl_cur);
  WAIT_BAR(2);
  s16x4 vlo[8],vhi[8]; u32x4 pw0,pw1,pw2,pw3;
  #define PKW(P,B) cvtpk_s(P[B],P[B+1])
  #define PAF(k) __builtin_bit_cast(bf16x8,pw##k)
  #define VFR(i) (bf16x8){vlo[i][0],vlo[i][1],vlo[i][2],vlo[i][3],vhi[i][0],vhi[i][1],vhi[i][2],vhi[i][3]}
  #define PIN(x) asm volatile("":"+v"(x))
  #define MX3(a,b,c) __builtin_fmaxf(__builtin_fmaxf((a),(b)),(c))
  #define GAPA(MF,A0,A1,A2,A3,W0,W1,PW) do{ MF; sacc+=A0; sacc+=A1; sacc+=A2; sacc+=A3; PIN(sacc); W0; W1; PIN(PW); SBAR(); }while(0)
  #define EX(v) __builtin_amdgcn_exp2f(v)
  #define GAPB(MF,X,B) do{ MF; X[B]=EX(X[B]); X[B+1]=EX(X[B+1]); X[B+2]=EX(X[B+2]); X[B+3]=EX(X[B+3]); PIN(X); SBAR(); }while(0)
  #define VRD(i) do{ vlo[i]=vtr(vp_+(((i)>>2)*4096+((i)&3)*1024)); vhi[i]=vtr(vp_+(((i)>>2)*4096+((i)&3)*1024+512)); }while(0)
  #define KRD(G,j) do{ if(G){ kload2(kf,kp0+sl_next,j); SBAR(); } }while(0)
  #define STEP(C0,C1,P0,P1,t,GK,GV,GL) do{ SBAR(); NBSUB(C0,C1); \
    const lds_cptr vp_=vp0+sl_prev; \
    VRD(0); SBAR(); float sacc=(P0[0]+P0[1]); \
    GAPA(C0=__builtin_amdgcn_mfma_f32_32x32x16_bf16(kf[0],qr[0],C0,0,0,0), P0[2],P0[3],P0[4],P0[5],     pw0[0]=PKW(P0,0), pw0[1]=PKW(P0,2), pw0); \
    VRD(4); SBAR(); GAPA(C1=__builtin_amdgcn_mfma_f32_32x32x16_bf16(kf[1],qr[0],C1,0,0,0), P0[6],P0[7],P0[8],P0[9],     pw0[2]=PKW(P0,4), pw0[3]=PKW(P0,6), pw0); \
    VRD(1); SBAR(); GAPA(C0=__builtin_amdgcn_mfma_f32_32x32x16_bf16(kf[2],qr[1],C0,0,0,0),   P0[10],P0[11],P0[12],P0[13], pw1[0]=PKW(P0,8), pw1[1]=PKW(P0,10), pw1); \
    VRD(5); SBAR(); GAPA(C1=__builtin_amdgcn_mfma_f32_32x32x16_bf16(kf[3],qr[1],C1,0,0,0),   P0[14],P0[15],P1[0],P1[1],   pw1[2]=PKW(P0,12),pw1[3]=PKW(P0,14), pw1); \
    VRD(2); SBAR(); GAPA(C0=__builtin_amdgcn_mfma_f32_32x32x16_bf16(kf[4],qr[2],C0,0,0,0),   P1[2],P1[3],P1[4],P1[5],     pw2[0]=PKW(P1,0), pw2[1]=PKW(P1,2), pw2); \
    VRD(6); SBAR(); GAPA(C1=__builtin_amdgcn_mfma_f32_32x32x16_bf16(kf[5],qr[2],C1,0,0,0),   P1[6],P1[7],P1[8],P1[9],     pw2[2]=PKW(P1,4), pw2[3]=PKW(P1,6), pw2); \
    VRD(3); SBAR(); GAPA(C0=__builtin_amdgcn_mfma_f32_32x32x16_bf16(kf[6],qr[3],C0,0,0,0),   P1[10],P1[11],P1[12],P1[13], pw3[0]=PKW(P1,8), pw3[1]=PKW(P1,10), pw3); \
    VRD(7); SBAR(); GAPA(C1=__builtin_amdgcn_mfma_f32_32x32x16_bf16(kf[7],qr[3],C1,0,0,0),   P1[14],P1[15],0.f,0.f,       pw3[2]=PKW(P1,12),pw3[3]=PKW(P1,14), pw3); \
    l_reg+=sacc; \
    if(GK){DMA_K((t)+3,sl_cur);} if(GV){DMA_V((t)+1,sl_next);} \
    CMASK(C0,C1,t); \
    { float a=MX3(C0[0],C0[1],C1[0]),b=MX3(C0[2],C0[3],C1[1]); a=MX3(a,C1[2],C1[3]); \
      _Pragma("unroll") for(int r=4;r<16;r+=4){a=MX3(a,C0[r],C0[r+1]);b=MX3(b,C0[r+2],C0[r+3]);a=MX3(a,C1[r],C1[r+1]);b=MX3(b,C1[r+2],C1[r+3]);} \
      float rm=__builtin_fmaxf(a,b); { auto rr=__builtin_amdgcn_permlane32_swap(__float_as_uint(rm),__float_as_uint(rm),false,false); rm=__builtin_fmaxf(__uint_as_float(rr[0]),__uint_as_float(rr[1])); } \
      resc=false; \
      if(__builtin_expect(__any(rm>(float)THRL),0)){ const float dl=__builtin_fmaxf(rm,0.f); mhat+=dl; \
        _Pragma("unroll") for(int r=0;r<16;++r){C0[r]-=dl;C1[r]-=dl;} \
        const float f=__builtin_amdgcn_exp2f(-dl); l_reg*=f; if(hi==0)wsf[r32]=f; resc=true; } } \
    SBAR(); \
    if(GL){ NBRD(P0,P1,(t)+1); SBAR(); } \
    GAPB(o[0]=__builtin_amdgcn_mfma_f32_32x32x16_bf16(PAF(0),VFR(0),o[0],0,0,0), C0,0); \
    GAPB(o[1]=__builtin_amdgcn_mfma_f32_32x32x16_bf16(PAF(0),VFR(4),o[1],0,0,0), C0,4); \
    KRD(GL,0); GAPB(o[0]=__builtin_amdgcn_mfma_f32_32x32x16_bf16(PAF(1),VFR(1),o[0],0,0,0), C0,8); \
    KRD(GL,1); GAPB(o[1]=__builtin_amdgcn_mfma_f32_32x32x16_bf16(PAF(1),VFR(5),o[1],0,0,0), C0,12); \
    KRD(GL,2); GAPB(o[0]=__builtin_amdgcn_mfma_f32_32x32x16_bf16(PAF(2),VFR(2),o[0],0,0,0), C1,0); \
    KRD(GL,3); GAPB(o[1]=__builtin_amdgcn_mfma_f32_32x32x16_bf16(PAF(2),VFR(6),o[1],0,0,0), C1,4); \
    GAPB(o[0]=__builtin_amdgcn_mfma_f32_32x32x16_bf16(PAF(3),VFR(3),o[0],0,0,0), C1,8); \
    GAPB(o[1]=__builtin_amdgcn_mfma_f32_32x32x16_bf16(PAF(3),VFR(7),o[1],0,0,0), C1,12); \
    }while(0)
  #define ENDW(tt) do{ if((tt)+3<NT){WAIT_BAR(2);} else if((tt)+2<NT){WAIT_BAR(1);} else {WAIT_BAR(0);} }while(0)
  int t=1;
  for(;t<=3&&t+1<NT;t+=2){
    STEP(pB0,pB1,pA0,pA1,t,(t+3<NT),(t+1<NT),(t+1<NT));       ENDW(t);   RESC(); ROT();
    STEP(pA0,pA1,pB0,pB1,t+1,(t+4<NT),(t+2<NT),(t+2<NT));     ENDW(t+1); RESC(); ROT();
  }
  #undef CMASK
  #define CMASK(P0,P1,t) do{}while(0)
  for(;t+5<NT;t+=2){
    STEP(pB0,pB1,pA0,pA1,t,true,true,true);     WAIT_BAR(2); RESC(); ROT();
    STEP(pA0,pA1,pB0,pB1,t+1,true,true,true);   WAIT_BAR(2); RESC(); ROT();
  }
  for(;t+1<NT;t+=2){
    STEP(pB0,pB1,pA0,pA1,t,(t+3<NT),(t+1<NT),(t+1<NT));       ENDW(t);   RESC(); ROT();
    STEP(pA0,pA1,pB0,pB1,t+1,(t+4<NT),(t+2<NT),(t+2<NT));     ENDW(t+1); RESC(); ROT();
  }
  #undef CMASK
  #define CMASK(P0,P1,t) do{int jb_=3-(t); if(jb_>=0)cmask(P0,P1,jb_,qrel,hi);}while(0)
  STEP(pB0,pB1,pA0,pA1,NT-1,false,false,false); RESC();
  { float sacc=pB0[0]+pB0[1]; _Pragma("unroll") for(int r=2;r<16;++r)sacc+=pB0[r]; _Pragma("unroll") for(int r=0;r<16;++r)sacc+=pB1[r]; l_reg+=sacc;
    pw0=(u32x4){PKW(pB0,0),PKW(pB0,2),PKW(pB0,4),PKW(pB0,6)};pw1=(u32x4){PKW(pB0,8),PKW(pB0,10),PKW(pB0,12),PKW(pB0,14)};pw2=(u32x4){PKW(pB1,0),PKW(pB1,2),PKW(pB1,4),PKW(pB1,6)};pw3=(u32x4){PKW(pB1,8),PKW(pB1,10),PKW(pB1,12),PKW(pB1,14)};
    SBAR(); pv(o,vb0+sl_cur,PAF(0),PAF(1),PAF(2),PAF(3)); }
  #undef PKW
  #undef PAF
  #undef VFR
  #undef PIN
  #undef MX3
  #undef GAPA
  #undef GAPB
  #undef EX
  #undef VRD
  #undef KRD
  #undef STEP
  #undef ENDW
  {auto rr=__builtin_amdgcn_permlane32_swap(__float_as_uint(l_reg),__float_as_uint(l_reg),false,false);l_reg=__uint_as_float(rr[0])+__uint_as_float(rr[1]);}
  if(hi==0)wsf[32+r32]=l_reg;asm volatile("s_waitcnt lgkmcnt(0)":::"memory");
  float rli[16];
  #pragma unroll
  for(int r=0;r<16;++r)rli[r]=__builtin_amdgcn_rcpf(wsf[32+crow(r,hi)]);
  bf16*Ow=O+(rowbase+q0+wid*QBLK)*DM+h*D;
  { bf16*stg=(bf16*)(shm+LDS_OST)+wid*2048;
    #pragma unroll
    for(int r=0;r<16;++r){const int orow=crow(r,hi);
      #pragma unroll
      for(int d0=0;d0<2;++d0)stg[orow*64+d0*32+r32]=__float2bfloat16(o[d0][r]*rli[r]);}
    asm volatile("s_waitcnt lgkmcnt(0)":::"memory");
    #pragma unroll
    for(int i=0;i<4;++i){const int row=i*8+(lane>>3),ch=lane&7; const u32x4 v=*(const u32x4*)(stg+row*64+ch*8); ATTN_STORE16(Ow+(long)row*DM+ch*8,v);} }
  asm volatile("s_waitcnt lgkmcnt(0)\n\ts_barrier":::"memory");
  #undef DMA_K
  #undef DMA_V
  #undef CMASK
  #undef START
  #undef NBRD
  #undef NBSUB
  #undef RESC
  #undef ROT
}
constexpr int ATTN_LDS_BYTES=LDS_BYTES;
struct AttnTensors { const bf16* Q; const bf16* K; const bf16* V; bf16* O; const float* cum; float skip_thr; };
struct AttnUnit { int bh; int qb; };
struct StaticOrder {
  int vcu;
  __device__ __forceinline__ explicit StaticOrder(int grid,int block):vcu((block%8)*(grid/8)+block/8){}
  __device__ __forceinline__ bool next(int i,AttnUnit&u)const{ if(i>=2)return false; const int s=vcu&15; u.bh=vcu>>4; u.qb=(i==0)?31-s:s; return true; }
  __device__ __forceinline__ void a_ready(const AttnUnit&)const{}
  __device__ __forceinline__ void done(const AttnUnit&)const{}
};
template<class Sched,int THRL=8> __device__ __forceinline__ void attn_phase(char*lds,const AttnTensors&T,const Sched&S){
  AttnUnit u;
  for(int i=0;S.next(i,u);++i){ S.a_ready(u); attn_unit<THRL>(u.bh/NHEAD,u.bh%NHEAD,u.qb,T.Q,T.K,T.V,T.O,lds,T.cum+(long)u.bh*SEQ,T.skip_thr); S.done(u); }
}
#undef SBAR
#undef WAIT_BAR
}

__device__ __forceinline__ void ph_attn_fast(Frame& F) {
    F.lane = ltid(); F.tid = F.wave * 64 + F.lane;
    static_assert(attn_body::ATTN_LDS_BYTES <= 131072, "attention LDS");
    const attn_body::AttnTensors AT{(const attn_body::bf16*)F.Q, (const attn_body::bf16*)F.K, (const attn_body::bf16*)F.V, (attn_body::bf16*)F.O, F.CUM, __builtin_inff()};
    const attn_body::StaticOrder S((int)gridDim.x, (int)blockIdx.x);
    attn_body::attn_phase<attn_body::StaticOrder>((char*)F.lds_generic, AT, S);
}

constexpr int NPHASE = 13;
constexpr int LDS_BYTES = 147456, MISC_OFF = 131072 + 320;
constexpr int N_LAUNCHES = 1;
__global__ void __launch_bounds__(NTHR, 2) fwd_kernel(Args args) {
    extern __shared__ __attribute__((aligned(16))) unsigned char lds_raw[];
    Frame F;
    F.lds = (LAS unsigned char*)lds_raw; F.lds_generic = lds_raw;
    F.tid = threadIdx.x; F.lane = F.tid & 63; F.wave = __builtin_amdgcn_readfirstlane(F.tid >> 6);
    F.gw = blockIdx.x * NWAVES + F.wave; F.NGW = gridDim.x * NWAVES;
    F.x = args.in[0]; F.c = args.in[1]; F.w_ada = args.in[2]; F.b_ada = args.in[3]; F.w_in = args.in[4]; F.b_forget = args.in[5]; F.conv_w = args.in[6]; F.conv_b = args.in[7];
    F.conv_ln_g = args.in[8]; F.conv_ln_b = args.in[9]; F.w_conv_out = args.in[10]; F.w_fox_out = args.in[11]; F.w_mix_out = args.in[12]; F.ln1_g = args.in[13]; F.ln1_b = args.in[14];
    F.w_router = args.in[15]; F.router_bias = args.in[16]; F.w_exp_gate = args.in[17]; F.w_exp_up = args.in[18]; F.w_exp_down = args.in[19]; F.w_sh_gate = args.in[20]; F.w_sh_up = args.in[21];
    F.w_sh_down = args.in[22]; F.ln2_g = args.in[23]; F.ln2_b = args.in[24];
    F.out = args.out; F.ws = args.ws; unsigned char* ws = args.ws;
    F.ctl = (unsigned*)(ws + WS_CTL);
    F.ADA = (float*)(ws + WS_ADA); F.ADAP = (float*)(ws + WS_ADAP); F.CUM = (float*)(ws + WS_CUM); F.LOGF = (float*)(ws + WS_LOGF); F.X1 = (float*)(ws + WS_X1); F.RL = (float*)(ws + WS_RL);
    F.LISTW = (float*)(ws + WS_LISTW); F.PROJ = (float*)(ws + WS_PROJ); F.LIST = (int*)(ws + WS_LIST);
    F.H = (bf16_t*)(ws + WS_H); F.U = (bf16_t*)(ws + WS_U); F.Q = (bf16_t*)(ws + WS_Q); F.K = (bf16_t*)(ws + WS_K); F.V = (bf16_t*)(ws + WS_V); F.AC = (bf16_t*)(ws + WS_AC); F.O = (bf16_t*)(ws + WS_O);
    F.GA = (bf16_t*)(ws + WS_GA); F.GB = (bf16_t*)(ws + WS_GB); F.YA = (bf16_t*)(ws + WS_YA); F.MG = (bf16_t*)(ws + WS_MG); F.YAS = (bf16_t*)(ws + WS_YAS); F.H2 = (bf16_t*)(ws + WS_H2);
    F.H2LO = (bf16_t*)(ws + WS_H2LO); F.SHID = (bf16_t*)(ws + WS_SHID); F.HID = (bf16_t*)(ws + WS_HID);
    const int lo = args.ph_lo, hi = args.ph_hi;
    volatile LAS unsigned* MISC = (volatile LAS unsigned*)(F.lds + MISC_OFF);
    for (int u = F.tid; u < 32; u += NTHR) MISC[u] = 0u;
    __syncthreads();
    XcdBarrier bar; bar.bar = F.ctl + CW_BAR; bar.x = 0; bar.st = MISC + 8;
    if (hi - lo > 1) bar = xcd_barrier_post(F.ctl + CW_BAR, MISC + 8);
#define IN(k) (lo <= (k) && (k) < hi)
#define SEAM(k) do { if (IN(k) && IN((k) + 1)) xcd_barrier(bar); } while (0)
    if (IN(0)) { ph_ada(F); ph_convert(F, true); }
    SEAM(0);
    if (IN(1)) ph_lnmod(F);
    SEAM(1);
    if (IN(2)) { ph_scan(F); ph_inproj_fast(F); }
    SEAM(2);
    if (IN(3)) {}
    SEAM(3);
    if (IN(4)) { ph_conv(F); __syncthreads(); ph_attn_fast(F); }
    SEAM(4);
    if (IN(5)) ph_merge_fast(F);
    SEAM(5);
    if (IN(6)) ph_mix_fast(F);
    SEAM(6);
    if (IN(7)) ph_ln2(F);
    SEAM(7);
    if (IN(8)) ph_router_fast(F);
    SEAM(8);
    if (IN(9)) ph_route(F, 3);
    SEAM(9);
    if (IN(10)) ph_moe1_fast(F);
    SEAM(10);
    if (IN(11)) ph_moe2_fast(F);
    SEAM(11);
    if (IN(12)) ph_combine(F);
#undef IN
#undef SEAM
}

extern "C" void kernel_launch(void* const* d_in, const int* in_sizes, int n_in, void* d_out, int out_size, void* d_ws, size_t ws_size, hipStream_t stream) {
    static int grid = 0;
    if (grid == 0) {
        if (n_in != 25 || out_size != T * D || ws_size < WS_END) { fprintf(stderr, "kernel_launch: unexpected sizes: n_in %d out %d ws %zu (need %zu)\n", n_in, out_size, ws_size, (size_t)WS_END); grid = -1; return; }
        int dev = 0, cus = 0, per_cu = 0;
        (void)hipGetDevice(&dev); (void)hipDeviceGetAttribute(&cus, hipDeviceAttributeMultiprocessorCount, dev);
        (void)hipFuncSetAttribute((const void*)fwd_kernel, hipFuncAttributeMaxDynamicSharedMemorySize, LDS_BYTES);
        (void)hipOccupancyMaxActiveBlocksPerMultiprocessor(&per_cu, (const void*)fwd_kernel, NTHR, LDS_BYTES);
        (void)hipGetLastError();
        if (per_cu < 1) { fprintf(stderr, "kernel_launch: occupancy query says %d blocks/CU\n", per_cu); }
        grid = cus > 0 ? cus : 256;
    }
    if (grid < 0) return;
    (void)hipMemsetAsync((char*)d_ws + WS_CTL, 0, CTL_BYTES, stream);
    Args a{};
    for (int i = 0; i < 25; ++i) a.in[i] = (const float*)d_in[i];
    a.out = (float*)d_out; a.ws = (unsigned char*)d_ws;
    if (N_LAUNCHES == 1) {
        a.ph_lo = 0; a.ph_hi = NPHASE;
        void* kargs[] = {(void*)&a};
        const hipError_t e = hipLaunchCooperativeKernel((const void*)fwd_kernel, dim3(grid), dim3(NTHR), kargs, LDS_BYTES, stream);
        if (e != hipSuccess) fprintf(stderr, "kernel_launch: cooperative launch failed: %s (grid %d)\n", hipGetErrorString(e), grid);
    } else {
        for (int p = 0; p < NPHASE; ++p) { a.ph_lo = p; a.ph_hi = p + 1; hipLaunchKernelGGL(fwd_kernel, dim3(grid), dim3(NTHR), LDS_BYTES, stream, a); }
    }
}
```

```cpp
#include <hip/hip_runtime.h>
#include <cstdio>
#include <cstdint>
#include <hip/hip_bf16.h>

#define LAS __attribute__((address_space(3)))
typedef unsigned short bf16_t;
typedef float f32x4 __attribute__((ext_vector_type(4)));
typedef unsigned u32x4 __attribute__((ext_vector_type(4)));
typedef unsigned u32x2 __attribute__((ext_vector_type(2)));

constexpr int NB = 2, S = 8192, D = 1024, T = NB * S;
constexpr int CC = 512, CW = 31, NH = 8, HD = 64, FW = 512;
constexpr int NE = 256, TOPK = 8, NG = 8, EH = 256, SHH = 256;
constexpr int INC = 4616;
constexpr int O_Q = 1024, O_K = 1536, O_V = 2048, O_F = 2560, O_GA = 2568, O_GB = 3592;
constexpr float LN_EPS = 1e-5f;
constexpr float ALPHA = 1.189207115002721f;
constexpr float LOG2E = 1.4426950408889634f;
constexpr float QSCALE = 0.125f * LOG2E;
constexpr float ROUTED_SCALE = 2.5f;
constexpr int NWAVES = 8, NTHR = 512;
constexpr int LCAP = 16384;
constexpr int NSLOT = 9;
constexpr int LDS_BYTES = 147456, MISC_OFF = 131072 + 320;

constexpr size_t MiB = 1u << 20;
constexpr size_t WS_CTL = 0, CTL_BYTES = 1 * MiB;
constexpr size_t WS_ADA = 1 * MiB;
constexpr size_t WS_ADAP = 1 * MiB + 64 * 1024;
constexpr size_t WS_CUM = 2 * MiB;
constexpr size_t WS_LOGF = 2 * MiB + 512 * 1024;
constexpr size_t WS_WFC = 3 * MiB + 512 * 1024;
constexpr size_t WS_H = 20 * MiB;
constexpr size_t WS_U = 52 * MiB, WS_Q = 68 * MiB, WS_K = 84 * MiB, WS_V = 100 * MiB, WS_AC = 116 * MiB, WS_O = 132 * MiB;
constexpr size_t WS_GA = 148 * MiB, WS_GB = 180 * MiB, WS_YA = 212 * MiB, WS_MG = 244 * MiB;
constexpr size_t WS_YAS = 20 * MiB;
constexpr size_t WS_X1 = 308 * MiB;
constexpr size_t WS_H2 = 372 * MiB, WS_H2LO = 404 * MiB;
constexpr size_t WS_RL = 436 * MiB;
constexpr size_t WS_SHID = 484 * MiB;
constexpr size_t WS_LIST = 492 * MiB, WS_LISTW = 508 * MiB;
constexpr size_t WS_HID = 524 * MiB;
constexpr size_t WS_END = 1024 * MiB;
constexpr int CW_CNT = 1024;
constexpr int CW_NORM = 2048;
constexpr int CW_AQ = 2304;

__device__ __forceinline__ float bf2f(bf16_t v) { return __uint_as_float((unsigned)v << 16); }
__device__ __forceinline__ unsigned f2bf(float f) { unsigned u = __float_as_uint(f); return (u + 0x7fffu + ((u >> 16) & 1u)) >> 16; }
__device__ __forceinline__ unsigned pk2(float lo, float hi) { return f2bf(lo) | (f2bf(hi) << 16); }
__device__ __forceinline__ float wave_sum(float v) {
#pragma unroll
    for (int o = 1; o < 64; o <<= 1) v += __shfl_xor(v, o);
    return v;
}
__device__ __forceinline__ float wave_max(float v) {
#pragma unroll
    for (int o = 1; o < 64; o <<= 1) v = fmaxf(v, __shfl_xor(v, o));
    return v;
}
__device__ __forceinline__ int ltid() { int t = (int)__builtin_amdgcn_mbcnt_hi(~0u, __builtin_amdgcn_mbcnt_lo(~0u, 0u)); asm volatile("" : "+v"(t)); return t; }
__device__ __forceinline__ float sigmoidf_(float x) { return 1.0f / (1.0f + expf(-x)); }
__device__ __forceinline__ float siluf_(float x) { return x / (1.0f + expf(-x)); }


constexpr int CW_BAR = 4096;
#define XB_TMO      128
#define XB_XCNT(j)  (256  + 64 * (j))
#define XB_XSUB(j)  (1280 + 64 * (j))
#define XB_XGEN(j)  (2304 + 64 * (j))
#define XB_TOP      3328
#define XB_TOPGEN   3392
#define XCD_BAR_WORDS 3456
#define XB_SPIN_CAP (1u << 20)
__device__ __forceinline__ unsigned xb_ld(unsigned* p)              { return __hip_atomic_load(p, __ATOMIC_RELAXED, __HIP_MEMORY_SCOPE_AGENT); }
__device__ __forceinline__ unsigned xb_add(unsigned* p, unsigned v) { return __hip_atomic_fetch_add(p, v, __ATOMIC_RELAXED, __HIP_MEMORY_SCOPE_AGENT); }
__device__ __forceinline__ unsigned xb_xcc_id() { return (unsigned)__builtin_amdgcn_s_getreg((3 << 11) | 20) & 0xFu; }
#define XB_SPIN(cond, bar) do { unsigned _sp = 0; while (cond) { __builtin_amdgcn_s_sleep(1); \
    if ((++_sp & 255u) == 0u) { if (xb_ld(&(bar)[XB_TMO])) break; if (_sp > XB_SPIN_CAP) { atomicAdd(&(bar)[XB_TMO], 1u); break; } } } } while (0)
struct XcdBarrier { unsigned* bar; unsigned x; volatile LAS unsigned* st; };
__device__ __forceinline__ XcdBarrier xcd_barrier_post(unsigned* bar, volatile LAS unsigned* st) {
    XcdBarrier b; b.bar = bar; b.x = xb_xcc_id(); b.st = st;
    if (threadIdx.x == 0) (void)xb_add(&bar[XB_XCNT(b.x)], 1u);
    return b;
}
__device__ __forceinline__ void xcd_barrier_complete(unsigned* bar, unsigned x, unsigned& nloc, unsigned& nx) {
    const unsigned G = gridDim.x * gridDim.y * gridDim.z;
    unsigned sum, cnt, mine, sp = 0u;
    for (;;) {
        sum = 0u; cnt = 0u; mine = 0u;
#pragma unroll
        for (unsigned j = 0; j < 16; ++j) { const unsigned c = xb_ld(&bar[XB_XCNT(j)]); sum += c; cnt += (c > 0u) ? 1u : 0u; mine = (j == x) ? c : mine; }
        if (sum == G) break;
        __builtin_amdgcn_s_sleep(1);
        if ((++sp & 255u) == 0u) { if (xb_ld(&bar[XB_TMO])) break; if (sp > XB_SPIN_CAP) { atomicAdd(&bar[XB_TMO], 1u); break; } }
    }
    nloc = mine > 0u ? mine : 1u; nx = cnt > 0u ? cnt : 1u;
}
__device__ __forceinline__ void xcd_barrier(const XcdBarrier& b) {
    asm volatile("s_waitcnt vmcnt(0)" ::: "memory");
    __syncthreads();
    if (threadIdx.x == 0) {
        unsigned* bar = b.bar;
        __builtin_amdgcn_s_waitcnt(0);
        unsigned nloc = b.st[0], nx = b.st[1];
        if (nloc == 0u) { xcd_barrier_complete(bar, b.x, nloc, nx); b.st[0] = nloc; b.st[1] = nx; }
        const unsigned old = xb_add(&bar[XB_XSUB(b.x)], 1u);
        const unsigned gen = old / nloc;
        if (old + 1u == (gen + 1u) * nloc) {
            __builtin_amdgcn_fence(__ATOMIC_RELEASE, "agent");
            asm volatile("s_waitcnt vmcnt(0)" ::: "memory");
            const unsigned og = xb_add(&bar[XB_TOP], 1u);
            const unsigned tg = og / nx;
            if (og + 1u == (tg + 1u) * nx) xb_add(&bar[XB_TOPGEN], 1u);
            else XB_SPIN(xb_ld(&bar[XB_TOPGEN]) == tg, bar);
            __builtin_amdgcn_fence(__ATOMIC_ACQUIRE, "agent");
            xb_add(&bar[XB_XGEN(b.x)], 1u);
            asm volatile("s_waitcnt vmcnt(0)" ::: "memory");
        } else {
            XB_SPIN(xb_ld(&bar[XB_XGEN(b.x)]) == gen, bar);
            __builtin_amdgcn_fence(__ATOMIC_ACQUIRE, "agent");
            asm volatile("s_waitcnt vmcnt(0)" ::: "memory");
        }
    }
    __syncthreads();
}

struct Args { const float* in[25]; float* out; unsigned char* ws; int ph_lo, ph_hi; };

struct Frame {
    LAS unsigned char* lds; unsigned char* lds_generic;
    int tid, lane, wave, gw, NGW;
    const float *x, *c, *w_ada, *b_ada, *w_in, *b_forget, *conv_w, *conv_b, *conv_ln_g, *conv_ln_b, *w_conv_out, *w_fox_out, *w_mix_out, *ln1_g, *ln1_b,
        *w_router, *router_bias, *w_exp_gate, *w_exp_up, *w_exp_down, *w_sh_gate, *w_sh_up, *w_sh_down, *ln2_g, *ln2_b;
    float* out; unsigned char* ws;
    unsigned* ctl;
    float *ADA, *ADAP, *CUM, *LOGF, *X1, *RL, *LISTW, *WFC;
    bf16_t *H, *U, *Q, *K, *V, *AC, *O, *GA, *GB, *YA, *MG, *YAS, *H2, *H2LO, *SHID, *HID;
    int* LIST;
};

__device__ __forceinline__ void ph_ada(Frame& F) {
    F.lane = ltid(); F.tid = F.wave * 64 + F.lane;
    if (blockIdx.x == gridDim.x - 1) for (int i = F.tid; i < 8192; i += NTHR) { const int k = i >> 3, hh = i & 7; F.WFC[hh * 1024 + k] = F.w_in[(size_t)k * INC + O_F + hh]; }
    if (blockIdx.x >= 24) return;
    LAS float* part = (LAS float*)F.lds;
    const float* c = F.c; const float* w = F.w_ada;
    const int j0 = blockIdx.x * 256 + F.lane * 4, kc = F.wave;
    f32x4 a0 = {0.f, 0.f, 0.f, 0.f}, a1 = {0.f, 0.f, 0.f, 0.f};
#pragma unroll 8
    for (int k = kc * 128; k < kc * 128 + 128; ++k) {
        const f32x4 wv = *(const f32x4*)(w + (size_t)k * 6144 + j0);
        const float c0 = siluf_(c[k]), c1 = siluf_(c[D + k]);
        a0 += wv * c0; a1 += wv * c1;
    }
    *(LAS f32x4*)(part + (kc * 2 + 0) * 256 + F.lane * 4) = a0;
    *(LAS f32x4*)(part + (kc * 2 + 1) * 256 + F.lane * 4) = a1;
    __syncthreads();
    { const int b = F.tid >> 8, j = F.tid & 255; float s = F.b_ada[blockIdx.x * 256 + j];
#pragma unroll
      for (int p = 0; p < 8; ++p) s += part[(p * 2 + b) * 256 + j];
      F.ADA[b * 6144 + blockIdx.x * 256 + j] = s; }
    __syncthreads();
}

__device__ __forceinline__ float wave_sum8(const float (&a)[8], int lane) {
    float b[4], c[2];
#pragma unroll
    for (int i = 0; i < 4; ++i) { const float keep = (lane & 1) ? a[2 * i + 1] : a[2 * i], send = (lane & 1) ? a[2 * i] : a[2 * i + 1]; b[i] = keep + __shfl_xor(send, 1); }
#pragma unroll
    for (int i = 0; i < 2; ++i) { const float keep = (lane & 2) ? b[2 * i + 1] : b[2 * i], send = (lane & 2) ? b[2 * i] : b[2 * i + 1]; c[i] = keep + __shfl_xor(send, 2); }
    float d = ((lane & 4) ? c[1] : c[0]) + __shfl_xor((lane & 4) ? c[0] : c[1], 4);
    d += __shfl_xor(d, 8); d += __shfl_xor(d, 16); d += __shfl_xor(d, 32);
    return d;
}
__device__ __forceinline__ void ph_lnmod(Frame& F) {
    F.lane = ltid(); F.tid = F.wave * 64 + F.lane;
    LAS float* ada1 = (LAS float*)F.lds;
    LAS float* wf = ada1 + 4096;
    for (int i = F.tid; i < 1024; i += NTHR) { const int b = i >> 9, j = (i & 511) * 4; *(LAS f32x4*)(ada1 + b * 2048 + j) = *(const f32x4*)(F.ADA + b * 6144 + j); }
    for (int i = F.tid; i < 2048; i += NTHR) *(LAS f32x4*)(wf + 4 * i) = *(const f32x4*)(F.WFC + 4 * i);
    __syncthreads();
    const int lane = F.lane;
    constexpr int R = 4;
    for (int m0 = F.gw * R; m0 < T; m0 += F.NGW * R) {
        f32x4 v[R][4]; float mean[R], rstd[R];
#pragma unroll
        for (int r = 0; r < R; ++r) { const f32x4* xr = (const f32x4*)(F.x + (size_t)(m0 + r) * D) + lane;
#pragma unroll
            for (int j = 0; j < 4; ++j) v[r][j] = xr[64 * j]; }
#pragma unroll
        for (int r = 0; r < R; ++r) { float s = 0.f;
#pragma unroll
            for (int j = 0; j < 4; ++j) s += (v[r][j].x + v[r][j].y) + (v[r][j].z + v[r][j].w);
            mean[r] = wave_sum(s) * (1.f / D); }
#pragma unroll
        for (int r = 0; r < R; ++r) { float s2 = 0.f;
#pragma unroll
            for (int j = 0; j < 4; ++j) { v[r][j] = v[r][j] - mean[r]; s2 += (v[r][j].x * v[r][j].x + v[r][j].y * v[r][j].y) + (v[r][j].z * v[r][j].z + v[r][j].w * v[r][j].w); }
            rstd[r] = 1.f / sqrtf(wave_sum(s2) * (1.f / D) + LN_EPS); }
#pragma unroll
        for (int r = 0; r < R; ++r) { const int m = m0 + r, b = m >> 13;
            float fl[8];
#pragma unroll
            for (int hh = 0; hh < 8; ++hh) fl[hh] = 0.f;
            u32x2* hrow = (u32x2*)(F.H + (size_t)m * D) + lane;
#pragma unroll
            for (int j = 0; j < 4; ++j) { const int col = 4 * lane + 256 * j;
                const f32x4 sh = *(const LAS f32x4*)(ada1 + b * 2048 + col), sc = *(const LAS f32x4*)(ada1 + b * 2048 + 1024 + col);
                const f32x4 h = v[r][j] * rstd[r] * (sc + 1.0f) + sh;
                u32x2 o; o.x = pk2(h.x, h.y); o.y = pk2(h.z, h.w); hrow[64 * j] = o;
#pragma unroll
                for (int hh = 0; hh < 8; ++hh) { const f32x4 w = *(const LAS f32x4*)(wf + hh * 1024 + col); fl[hh] += (h.x * w.x + h.y * w.y) + (h.z * w.z + h.w * w.w); }
                asm volatile("" ::: "memory"); }
            const float f = wave_sum8(fl, lane);
            if (lane < 8) { const float z = f + F.b_forget[lane]; F.LOGF[(size_t)m * 8 + lane] = fminf(z, 0.f) - log1pf(expf(-fabsf(z))); } }
    }
}

__device__ __forceinline__ void ph_scan(Frame& F) {
    F.lane = ltid(); F.tid = F.wave * 64 + F.lane;
    if (blockIdx.x >= 16) return;
    LAS double* sc = (LAS double*)F.lds;
    const int bh = blockIdx.x, b = bh >> 3, hh = bh & 7, s0 = F.tid * 16;
    double loc[16]; double run = 0.0;
#pragma unroll
    for (int i = 0; i < 16; ++i) { run += (double)F.LOGF[(size_t)(b * S + s0 + i) * 8 + hh]; loc[i] = run; }
    sc[F.tid] = run;
    __syncthreads();
    double off = 0.0;
    for (int i = 0; i < F.tid; ++i) off += sc[i];
#pragma unroll
    for (int i = 0; i < 16; ++i) F.CUM[(size_t)bh * S + s0 + i] = (float)(off + loc[i]);
    __syncthreads();
}

__device__ __forceinline__ void ph_conv(Frame& F) {
    F.lane = ltid(); F.tid = F.wave * 64 + F.lane;
    constexpr int RUN = 8, NIN = RUN + CW - 1, PADJ = RUN - 1, NTAB = CW + 2 * PADJ + 2;
    LAS float* cw = (LAS float*)F.lds;
    LAS float* cb = cw + NTAB * CC;
    for (int i = F.tid; i < NTAB * CC / 4; i += NTHR) { const int jj = (4 * i) / CC, j = jj - PADJ;
        *(LAS f32x4*)(cw + 4 * i) = (j >= 0 && j < CW) ? *(const f32x4*)(F.conv_w + (size_t)j * CC + (4 * i) % CC) : (f32x4){0.f, 0.f, 0.f, 0.f}; }
    for (int i = F.tid; i < CC; i += NTHR) { cb[i] = F.conv_b[i]; cb[CC + i] = F.conv_ln_g[i]; cb[2 * CC + i] = F.conv_ln_b[i]; }
    __syncthreads();
    const int lane = F.lane, c0 = lane * 8;
    for (int run = F.gw; run < T / RUN; run += F.NGW) {
        const int m0 = run * RUN, t0 = m0 & (S - 1);
        float a[RUN][8];
#pragma unroll
        for (int r = 0; r < RUN; ++r)
#pragma unroll
            for (int i = 0; i < 8; ++i) a[r][i] = cb[c0 + i];
#pragma unroll 1
        for (int c = 0; c < (NIN + 7) / 8; ++c) {
            u32x4 uv[8];
#pragma unroll
            for (int k = 0; k < 8; ++k) { const int i = 8 * c + k; uv[k] = (u32x4){0u, 0u, 0u, 0u};
                if (i < NIN && t0 - (CW - 1) + i >= 0) uv[k] = *(const u32x4*)(F.U + (size_t)(m0 - (CW - 1) + i) * CC + c0); }
            float u[8][8];
#pragma unroll
            for (int k = 0; k < 8; ++k) {
                u[k][0] = __uint_as_float(uv[k].x << 16); u[k][1] = __uint_as_float(uv[k].x & 0xffff0000u); u[k][2] = __uint_as_float(uv[k].y << 16); u[k][3] = __uint_as_float(uv[k].y & 0xffff0000u);
                u[k][4] = __uint_as_float(uv[k].z << 16); u[k][5] = __uint_as_float(uv[k].z & 0xffff0000u); u[k][6] = __uint_as_float(uv[k].w << 16); u[k][7] = __uint_as_float(uv[k].w & 0xffff0000u); }
#pragma unroll
            for (int d = -(RUN - 1); d < 8; ++d) {
                const LAS float* wrow = cw + (8 * c + d + PADJ) * CC + c0;
                const f32x4 w0 = *(const LAS f32x4*)(wrow), w1 = *(const LAS f32x4*)(wrow + 4);
#pragma unroll
                for (int r = 0; r < RUN; ++r) { const int k = r + d;
                    if (k >= 0 && k < 8) {
                        a[r][0] += u[k][0] * w0.x; a[r][1] += u[k][1] * w0.y; a[r][2] += u[k][2] * w0.z; a[r][3] += u[k][3] * w0.w;
                        a[r][4] += u[k][4] * w1.x; a[r][5] += u[k][5] * w1.y; a[r][6] += u[k][6] * w1.z; a[r][7] += u[k][7] * w1.w; } }
                asm volatile("" ::: "memory"); }
        }
#pragma unroll
        for (int r = 0; r < RUN; ++r) {
            float s = 0.f;
#pragma unroll
            for (int i = 0; i < 8; ++i) s += a[r][i];
            const float mean = wave_sum(s) * (1.f / CC); float s2 = 0.f;
#pragma unroll
            for (int i = 0; i < 8; ++i) { a[r][i] -= mean; s2 += a[r][i] * a[r][i]; }
            const float rstd = 1.f / sqrtf(wave_sum(s2) * (1.f / CC) + LN_EPS);
            float y[8];
#pragma unroll
            for (int i = 0; i < 8; ++i) y[i] = siluf_(a[r][i] * rstd * cb[CC + c0 + i] + cb[2 * CC + c0 + i]);
            u32x4 o; o.x = pk2(y[0], y[1]); o.y = pk2(y[2], y[3]); o.z = pk2(y[4], y[5]); o.w = pk2(y[6], y[7]);
            *(u32x4*)(F.AC + (size_t)(m0 + r) * CC + c0) = o;
        }
    }
}

__device__ __forceinline__ void ph_ln2(Frame& F) {
    F.lane = ltid(); F.tid = F.wave * 64 + F.lane;
    const int lane = F.lane;
    constexpr int R = 4;
    for (int m0 = F.gw * R; m0 < T; m0 += F.NGW * R) {
        f32x4 v[R][4]; float mean[R], rstd[R];
#pragma unroll
        for (int r = 0; r < R; ++r) { const f32x4* zr = (const f32x4*)(F.X1 + (size_t)(m0 + r) * D) + lane;
#pragma unroll
            for (int j = 0; j < 4; ++j) v[r][j] = zr[64 * j]; }
#pragma unroll
        for (int r = 0; r < R; ++r) { float s = 0.f;
#pragma unroll
            for (int j = 0; j < 4; ++j) s += (v[r][j].x + v[r][j].y) + (v[r][j].z + v[r][j].w);
            mean[r] = wave_sum(s) * (1.f / D); }
#pragma unroll
        for (int r = 0; r < R; ++r) { float s2 = 0.f;
#pragma unroll
            for (int j = 0; j < 4; ++j) { v[r][j] = v[r][j] - mean[r]; s2 += (v[r][j].x * v[r][j].x + v[r][j].y * v[r][j].y) + (v[r][j].z * v[r][j].z + v[r][j].w * v[r][j].w); }
            rstd[r] = 1.f / sqrtf(wave_sum(s2) * (1.f / D) + LN_EPS); }
#pragma unroll
        for (int r = 0; r < R; ++r) { f32x4* zr = (f32x4*)(F.X1 + (size_t)(m0 + r) * D) + lane; float s = 0.f;
#pragma unroll
            for (int j = 0; j < 4; ++j) { const int col = 4 * lane + 256 * j;
                v[r][j] = v[r][j] * rstd[r] * *(const f32x4*)(F.ln1_g + col) + *(const f32x4*)(F.ln1_b + col);
                zr[64 * j] = v[r][j]; s += (v[r][j].x + v[r][j].y) + (v[r][j].z + v[r][j].w); }
            mean[r] = wave_sum(s) * (1.f / D); }
#pragma unroll
        for (int r = 0; r < R; ++r) { float s2 = 0.f;
#pragma unroll
            for (int j = 0; j < 4; ++j) { v[r][j] = v[r][j] - mean[r]; s2 += (v[r][j].x * v[r][j].x + v[r][j].y * v[r][j].y) + (v[r][j].z * v[r][j].z + v[r][j].w * v[r][j].w); }
            rstd[r] = 1.f / sqrtf(wave_sum(s2) * (1.f / D) + LN_EPS); }
#pragma unroll
        for (int r = 0; r < R; ++r) { const int m = m0 + r, b = m >> 13;
            u32x2* hr = (u32x2*)(F.H2 + (size_t)m * D) + lane; u32x2* lr = (u32x2*)(F.H2LO + (size_t)m * D) + lane;
#pragma unroll
            for (int j = 0; j < 4; ++j) { const int col = 4 * lane + 256 * j;
                const f32x4 sh = *(const f32x4*)(F.ADA + b * 6144 + 3072 + col), sc = *(const f32x4*)(F.ADA + b * 6144 + 4096 + col);
                const f32x4 h = v[r][j] * rstd[r] * (sc + 1.0f) + sh;
                const unsigned h0 = f2bf(h.x), h1 = f2bf(h.y), h2 = f2bf(h.z), h3 = f2bf(h.w);
                u32x2 o; o.x = h0 | (h1 << 16); o.y = h2 | (h3 << 16); hr[64 * j] = o;
                u32x2 l; l.x = pk2(h.x - __uint_as_float(h0 << 16), h.y - __uint_as_float(h1 << 16)); l.y = pk2(h.z - __uint_as_float(h2 << 16), h.w - __uint_as_float(h3 << 16)); lr[64 * j] = l; } }
    }
}

__device__ __forceinline__ void ph_route(Frame& F, int nparts) {
    F.lane = ltid(); F.tid = F.wave * 64 + F.lane;
    const int lane = F.lane;
    for (int t = F.gw; t < T; t += F.NGW) {
        f32x4 lg = *(const f32x4*)(F.RL + (size_t)t * NE + lane * 4);
        for (int p = 1; p < nparts; ++p) lg += *(const f32x4*)(F.RL + (size_t)p * T * NE + (size_t)t * NE + lane * 4);
        const f32x4 bias = *(const f32x4*)(F.router_bias + lane * 4);
        float sc[4], sel[4];
#pragma unroll
        for (int i = 0; i < 4; ++i) { sc[i] = sigmoidf_(lg[i]); sel[i] = sc[i] + bias[i]; }
        float a1 = fmaxf(sel[0], sel[1]), a2 = fminf(sel[0], sel[1]);
        { const float b1 = fmaxf(sel[2], sel[3]), b2 = fminf(sel[2], sel[3]); const float n1 = fmaxf(a1, b1), n2 = fmaxf(fminf(a1, b1), fmaxf(a2, b2)); a1 = n1; a2 = n2; }
#pragma unroll
        for (int o = 1; o < 8; o <<= 1) { const float b1 = __shfl_xor(a1, o), b2 = __shfl_xor(a2, o); const float n1 = fmaxf(a1, b1), n2 = fmaxf(fminf(a1, b1), fmaxf(a2, b2)); a1 = n1; a2 = n2; }
        const float gs = a1 + a2; const int g = lane >> 3;
        int rank = 0;
#pragma unroll
        for (int gg = 0; gg < NG; ++gg) { const float og = __shfl(gs, gg * 8); rank += (og > gs || (og == gs && gg < g)) ? 1 : 0; }
        const bool gsel = rank < 4;
        float mv[4];
#pragma unroll
        for (int i = 0; i < 4; ++i) mv[i] = gsel ? sel[i] : -INFINITY;
        float myw = 0.f; int mye = 0; float wsum = 0.f;
#pragma unroll
        for (int k = 0; k < TOPK; ++k) {
            float bv = mv[0]; int bi = 0;
#pragma unroll
            for (int i = 1; i < 4; ++i) if (mv[i] > bv) { bv = mv[i]; bi = i; }
            int be = lane * 4 + bi; float bs = sc[0];
#pragma unroll
            for (int i = 1; i < 4; ++i) bs = (bi == i) ? sc[i] : bs;
            float v = bv; int e = be; float s = bs;
#pragma unroll
            for (int o = 1; o < 64; o <<= 1) { const float ov = __shfl_xor(v, o); const int oe = __shfl_xor(e, o); const float os = __shfl_xor(s, o);
                if (ov > v || (ov == v && oe < e)) { v = ov; e = oe; s = os; } }
            if ((e >> 2) == lane) {
#pragma unroll
                for (int i = 0; i < 4; ++i) if ((e & 3) == i) mv[i] = -INFINITY; }
            wsum += s;
            if (lane == k) { myw = s; mye = e; }
        }
        if (lane < TOPK) {
            const float w = myw / wsum * ROUTED_SCALE;
            const unsigned p = atomicAdd(F.ctl + CW_CNT + mye, 1u);
            F.LIST[(size_t)mye * LCAP + p] = t * TOPK + lane;
            F.LISTW[(size_t)mye * LCAP + p] = w;
        }
    }
}

__device__ __forceinline__ void build_expert_map(Frame& F, LAS int* pref, LAS int* base, int rows_per_chunk) {
    __syncthreads();
    if (F.tid == 0) { int p = 0, bsum = 0;
        for (int e = 0; e < NE; ++e) { const int n = (int)F.ctl[CW_CNT + e]; pref[e] = p; base[e] = bsum; p += (n + rows_per_chunk - 1) / rows_per_chunk; bsum += n; }
        pref[NE] = p; base[NE] = bsum; }
    __syncthreads();
}
__device__ __forceinline__ int find_expert(const LAS int* pref, int u) { int lo = 0, hi = NE - 1;
    while (lo < hi) { const int mid = (lo + hi + 1) >> 1; if (pref[mid] <= u) lo = mid; else hi = mid - 1; }
    return lo; }

__device__ __forceinline__ void ph_combine(Frame& F) {
    F.lane = ltid(); F.tid = F.wave * 64 + F.lane;
    const int lane = F.lane;
    constexpr int R = 2;
    for (int m0 = F.gw * R; m0 < T; m0 += F.NGW * R) {
        f32x4 y[R][4];
#pragma unroll
        for (int r = 0; r < R; ++r) {
            u32x4 w[NSLOT][2];
#pragma unroll
            for (int k = 0; k < NSLOT; ++k) { const u32x4* yr = (const u32x4*)(F.YAS + ((size_t)(m0 + r) * NSLOT + k) * D) + lane; w[k][0] = yr[0]; w[k][1] = yr[64]; }
#pragma unroll
            for (int j = 0; j < 4; ++j) y[r][j] = (f32x4){0.f, 0.f, 0.f, 0.f};
#pragma unroll
            for (int k = 0; k < NSLOT; ++k)
#pragma unroll
                for (int q = 0; q < 2; ++q) { const u32x4 t = w[k][q];
                    y[r][2 * q].x += __uint_as_float(t.x << 16); y[r][2 * q].y += __uint_as_float(t.x & 0xffff0000u); y[r][2 * q].z += __uint_as_float(t.y << 16); y[r][2 * q].w += __uint_as_float(t.y & 0xffff0000u);
                    y[r][2 * q + 1].x += __uint_as_float(t.z << 16); y[r][2 * q + 1].y += __uint_as_float(t.z & 0xffff0000u); y[r][2 * q + 1].z += __uint_as_float(t.w << 16); y[r][2 * q + 1].w += __uint_as_float(t.w & 0xffff0000u); }
        }
#pragma unroll
        for (int r = 0; r < R; ++r) { const int m = m0 + r, b = m >> 13;
            f32x4 v[4]; float s = 0.f;
#pragma unroll
            for (int j = 0; j < 4; ++j) { const int col = (j >> 1) * 512 + 8 * lane + 4 * (j & 1); const f32x4 g2 = *(const f32x4*)(F.ADA + b * 6144 + 5120 + col);
                v[j] = *(const f32x4*)(F.X1 + (size_t)m * D + col) * ALPHA + (g2 + 1.0f) * y[r][j]; s += (v[j].x + v[j].y) + (v[j].z + v[j].w); }
            const float mean = wave_sum(s) * (1.f / D); float s2 = 0.f;
#pragma unroll
            for (int j = 0; j < 4; ++j) { v[j] = v[j] - mean; s2 += (v[j].x * v[j].x + v[j].y * v[j].y) + (v[j].z * v[j].z + v[j].w * v[j].w); }
            const float rstd = 1.f / sqrtf(wave_sum(s2) * (1.f / D) + LN_EPS);
#pragma unroll
            for (int j = 0; j < 4; ++j) { const int col = (j >> 1) * 512 + 8 * lane + 4 * (j & 1); *(f32x4*)(F.out + (size_t)m * D + col) = v[j] * rstd * *(const f32x4*)(F.ln2_g + col) + *(const f32x4*)(F.ln2_b + col); } }
    }
}

namespace pg8 {
typedef short bf16x8 __attribute__((ext_vector_type(8)));
constexpr int BM = 256, BK = 64, HALF = 128, HTB = HALF * BK * 2, STAGE_BYTES = 8 * HTB, NXCD = 8, WGM = 8;
constexpr int RTAB_OFF = 131072 + 4096;
__host__ __device__ __forceinline__ int lds_byte(int r, int c) { const int st = (r >> 4) * 2 + (c >> 5), rr = r & 15, cc = c & 31, ob = rr * 64 + cc * 2; return st * 1024 + (ob ^ (((ob >> 9) & 1) << 5)); }
__host__ __device__ __forceinline__ void stage_rc(int b, int& R, int& C) { const int st = b / 1024, sb = b % 1024, swz = sb ^ (((sb >> 9) & 1) << 5); R = (st >> 1) * 16 + swz / 64; C = (st & 1) * 32 + (swz % 64) / 2; }
__host__ __device__ __forceinline__ int perm32(int rho) { const int n = rho >> 4, i = rho & 15; return 8 * (i >> 2) + 4 * n + (i & 3); }

struct Unit { const char* A; const char* B; int pm, pn, e, p0, ne, bs; };

struct TileOrder {
    int nM, nN, nwg, G, c;
    __device__ void init(int nM_, int nN_, int G_, int c_) { nM = nM_; nN = nN_; nwg = nM * nN; G = G_; c = c_; }
    __device__ bool tile(int i, int& pm, int& pn) const {
        const long L = (long)i * G + c; if (L >= nwg) return false;
        int wgid = (int)L; { const int q = nwg / NXCD, r = nwg % NXCD, xcd = wgid % NXCD, off = wgid / NXCD; wgid = (xcd < r ? xcd * (q + 1) : r * (q + 1) + (xcd - r) * q) + off; }
        const int nig = WGM * nN, gid = wgid / nig, fm = gid * WGM, gsz = (nM - fm) < WGM ? (nM - fm) : WGM;
        pm = fm + ((wgid % nig) % gsz); pn = (wgid % nig) / gsz; return true;
    }
};

__device__ __forceinline__ unsigned cvt_pk_bf16(float lo, float hi) { unsigned r; asm volatile("v_cvt_pk_bf16_f32 %0, %1, %2" : "=v"(r) : "v"(lo), "v"(hi)); return r; }
__device__ __forceinline__ float fsigmoid(float x) { return __builtin_amdgcn_rcpf(1.0f + __builtin_amdgcn_exp2f(-LOG2E * x)); }

template <class Epi, class Sched, bool ALIGN_EPI>
__device__ __forceinline__ void gemm_phase(LAS unsigned char* lds, const int K, const int lda, const int ldb, const Sched& S, const Epi& E) {
    const int wid = __builtin_amdgcn_readfirstlane((int)threadIdx.x >> 6), lane = ltid(), tid = wid * 64 + lane, wr = wid >> 2, wc = wid & 3, fr = lane & 15, fq = lane >> 4;
    int nt = K / BK; asm volatile("" : "+s"(nt));
    int RA[2]; unsigned CA[2], voffB[2];
#pragma unroll
    for (int i = 0; i < 2; ++i) { int R, C; stage_rc(tid * 16 + i * 8192, R, C); const int Rb = (R & ~31) + perm32(R & 31);
        RA[i] = R; CA[i] = (unsigned)C * 2u; voffB[i] = (unsigned)(Rb * ldb + C) * 2u; }
    const size_t kstep = (size_t)(BK * 2);
    const size_t hstepB = (size_t)HALF * ldb * 2;
    const unsigned ldsw = (unsigned)wid * 1024u;
    const int aoff = lds_byte(wr * 64 + fr, fq * 8), boff = lds_byte(wc * 32 + fr, fq * 8);
#define PG8_SA(b, h) (((b) * 2 + (h)) * HTB)
#define PG8_SB(b, h) ((4 + (b) * 2 + (h)) * HTB)
#define PG8_STAGE(bufoff, gbase, voff) do { _Pragma("unroll") for (int _i = 0; _i < 2; ++_i) \
        __builtin_amdgcn_global_load_lds((const unsigned*)((const char*)(gbase) + (voff)[_i]), (LAS unsigned*)(lds + (bufoff) + ldsw + _i * 8192), 16, 0, 0); } while (0)
#define PG8_LDA(dst, b, h) do { _Pragma("unroll") for (int m = 0; m < 4; ++m) _Pragma("unroll") for (int k = 0; k < 2; ++k) dst[m][k] = *(const LAS bf16x8*)(lds + PG8_SA(b, h) + aoff + m * 2048 + k * 1024); } while (0)
#define PG8_LDB(dst, b, h) do { _Pragma("unroll") for (int n = 0; n < 2; ++n) _Pragma("unroll") for (int k = 0; k < 2; ++k) dst[n][k] = *(const LAS bf16x8*)(lds + PG8_SB(b, h) + boff + n * 2048 + k * 1024); } while (0)
#define PG8_MMA(ai, bj, At, Bt) do { __builtin_amdgcn_s_setprio(1); _Pragma("unroll") for (int m = 0; m < 4; ++m) _Pragma("unroll") for (int n = 0; n < 2; ++n) _Pragma("unroll") for (int k = 0; k < 2; ++k) \
        acc[ai][bj][m][n] = __builtin_amdgcn_mfma_f32_16x16x32_bf16(Bt[n][k], At[m][k], acc[ai][bj][m][n], 0, 0, 0); __builtin_amdgcn_s_setprio(0); } while (0)
#define PG8_WAIT_V(n) asm volatile("s_waitcnt vmcnt(" #n ")" ::: "memory")
#define PG8_WAIT_L(n) asm volatile("s_waitcnt lgkmcnt(" #n ")" ::: "memory")
#define PG8_BAR __builtin_amdgcn_s_barrier()
#define PG8_SCHED __builtin_amdgcn_sched_barrier(0)
    Unit cur, nxt; int ui = 0;
    if (!S.next(0, cur)) return;
    f32x4 acc[2][2][4][2];
#pragma unroll
    for (int a = 0; a < 2; ++a)
#pragma unroll
        for (int b = 0; b < 2; ++b)
#pragma unroll
            for (int m = 0; m < 4; ++m)
#pragma unroll
                for (int n = 0; n < 2; ++n) acc[a][b][m][n] = (f32x4){0.f, 0.f, 0.f, 0.f};
    bf16x8 At[4][2], B0[2][2], B1[2][2];
    const char* cA = cur.A; const char* cB = cur.B;
    LAS unsigned* rtab = (LAS unsigned*)(lds + RTAB_OFF);
    int tb = 0;
#define PG8_STAGE_A(bufoff, gbase, h) do { unsigned _v[2]; _Pragma("unroll") for (int _j = 0; _j < 2; ++_j) \
        _v[_j] = (Sched::GATHER ? rtab[tb * 256 + (h) * HALF + RA[_j]] : S.a_row_off(cur, (h) * HALF + RA[_j])) + CA[_j]; PG8_STAGE(bufoff, gbase, _v); } while (0)
    if constexpr (Sched::GATHER) { if (tid < 256) rtab[tid] = S.a_row_off(cur, tid); PG8_WAIT_L(0); PG8_BAR; }
    PG8_STAGE(PG8_SB(0, 0), cB, voffB); PG8_STAGE(PG8_SB(0, 1), cB + hstepB, voffB); PG8_STAGE_A(PG8_SA(0, 0), cA, 0); PG8_STAGE_A(PG8_SA(0, 1), cA, 1);
    if (wr == 1) PG8_BAR;
    PG8_WAIT_V(2); PG8_BAR;
    PG8_STAGE(PG8_SB(1, 0), cB + kstep, voffB); PG8_STAGE_A(PG8_SA(1, 0), cA + kstep, 0); PG8_STAGE(PG8_SB(1, 1), cB + hstepB + kstep, voffB);
    PG8_WAIT_V(6); PG8_BAR;
    for (;;) {
        const bool has_next = S.next(ui + 1, nxt);
        const char* nA = has_next ? nxt.A : cA; const char* nB = has_next ? nxt.B : cB;
        if constexpr (Sched::GATHER) { if (has_next && tid < 256) rtab[((ui + 1) & 1) * 256 + tid] = S.a_row_off(nxt, tid); }
        for (int t = 0; t < nt; t += 2) {
            const bool last = (t == nt - 2);
            const char* a1 = cA + (size_t)(t + 1) * kstep;
            const char* a2 = last ? nA : cA + (size_t)(t + 2) * kstep; const char* b2 = last ? nB : cB + (size_t)(t + 2) * kstep;
            const char* a3 = a2 + kstep; const char* b3 = b2 + kstep;
            PG8_LDB(B0, 0, 0); PG8_LDB(B1, 0, 1); PG8_SCHED; PG8_LDA(At, 0, 0); PG8_STAGE_A(PG8_SA(1, 1), a1, 1);
            if (last && has_next) tb ^= 1;
            PG8_WAIT_V(8); PG8_WAIT_L(0); PG8_BAR; PG8_MMA(0, 0, At, B0); PG8_MMA(0, 1, At, B1); PG8_BAR; PG8_SCHED;
            PG8_LDA(At, 0, 1); PG8_STAGE(PG8_SB(0, 0), b2, voffB); PG8_STAGE(PG8_SB(0, 1), b2 + hstepB, voffB); PG8_STAGE_A(PG8_SA(0, 0), a2, 0);
            PG8_WAIT_V(8); PG8_WAIT_L(0); PG8_BAR; PG8_MMA(1, 0, At, B0); PG8_MMA(1, 1, At, B1); PG8_BAR; PG8_SCHED;
            PG8_LDB(B0, 1, 0); PG8_LDB(B1, 1, 1); PG8_SCHED; PG8_LDA(At, 1, 0); PG8_STAGE_A(PG8_SA(0, 1), a2, 1);
            PG8_WAIT_V(8); PG8_WAIT_L(0); PG8_BAR; PG8_MMA(0, 0, At, B0); PG8_MMA(0, 1, At, B1); PG8_BAR; PG8_SCHED;
            PG8_LDA(At, 1, 1); PG8_STAGE(PG8_SB(1, 0), b3, voffB); PG8_STAGE(PG8_SB(1, 1), b3 + hstepB, voffB); PG8_STAGE_A(PG8_SA(1, 0), a3, 0);
            PG8_WAIT_V(8); PG8_WAIT_L(0); PG8_BAR; PG8_MMA(1, 0, At, B0); PG8_MMA(1, 1, At, B1); PG8_BAR; PG8_SCHED;
        }
        if constexpr (ALIGN_EPI) { if (wr == 0) PG8_BAR; }
        E(acc, cur, wr, wc, fr, fq);
        if (!has_next) break;
#pragma unroll
        for (int a = 0; a < 2; ++a)
#pragma unroll
            for (int b = 0; b < 2; ++b)
#pragma unroll
                for (int m = 0; m < 4; ++m)
#pragma unroll
                    for (int n = 0; n < 2; ++n) acc[a][b][m][n] = (f32x4){0.f, 0.f, 0.f, 0.f};
        cur = nxt; cA = nA; cB = nB; ++ui;
        if constexpr (ALIGN_EPI) { if (wr == 1) PG8_BAR; }
    }
    PG8_WAIT_V(0);
    if constexpr (!ALIGN_EPI) { if (wr == 0) PG8_BAR; }
    PG8_BAR;
#undef PG8_SA
#undef PG8_SB
#undef PG8_STAGE
#undef PG8_STAGE_A
#undef PG8_LDA
#undef PG8_LDB
#undef PG8_MMA
#undef PG8_WAIT_V
#undef PG8_WAIT_L
#undef PG8_BAR
#undef PG8_SCHED
}
}

constexpr size_t WS_WIN_T = 4 * MiB, WS_WC_T = 13 * MiB, WS_WF_T = 14 * MiB, WS_WMIX_T = 15 * MiB, WS_WR_HI = 17 * MiB, WS_WR_LO = 17 * MiB + 512 * 1024, WS_WSHGU_T = 18 * MiB, WS_WSHD_T = 19 * MiB;
constexpr size_t WS_WEGU_T = 640 * MiB, WS_WED_T = 896 * MiB;
constexpr int NINW = 4608;

__device__ __forceinline__ void tr_block(const float* src, int ldw, bf16_t* dst, bf16_t* dst2, int ldt, LAS float* scr, int lane) {
#pragma unroll 8
    for (int i = 0; i < 32; ++i) { const int kk = 2 * i + (lane >> 5); scr[kk * 33 + (lane & 31)] = src[(size_t)kk * ldw + (lane & 31)]; }
    asm volatile("s_waitcnt lgkmcnt(0)" ::: "memory");
    const int c = lane & 7;
#pragma unroll
    for (int j = 0; j < 4; ++j) { const int n = (lane >> 3) + 8 * j; const LAS float* s = scr + (8 * c) * 33 + n;
        float v[8];
#pragma unroll
        for (int q = 0; q < 8; ++q) v[q] = s[q * 33];
        u32x4 o; o.x = pk2(v[0], v[1]); o.y = pk2(v[2], v[3]); o.z = pk2(v[4], v[5]); o.w = pk2(v[6], v[7]);
        *(u32x4*)(dst + (size_t)n * ldt + 8 * c) = o;
        if (dst2) { u32x4 l;
            l.x = pk2(v[0] - __uint_as_float(o.x << 16), v[1] - __uint_as_float(o.x & 0xffff0000u)); l.y = pk2(v[2] - __uint_as_float(o.y << 16), v[3] - __uint_as_float(o.y & 0xffff0000u));
            l.z = pk2(v[4] - __uint_as_float(o.z << 16), v[5] - __uint_as_float(o.z & 0xffff0000u)); l.w = pk2(v[6] - __uint_as_float(o.w << 16), v[7] - __uint_as_float(o.w & 0xffff0000u));
            *(u32x4*)(dst2 + (size_t)n * ldt + 8 * c) = l; } }
    asm volatile("s_waitcnt lgkmcnt(0)" ::: "memory");
}
__device__ __forceinline__ int inproj_src_col(int d) { const int pn = d >> 3, c0 = (d & 7) * 32;
    if (pn < 4) return c0 < 128 ? 128 * pn + c0 : 512 + 128 * pn + (c0 - 128);
    if (pn < 6) return O_Q + (pn - 4) * 256 + c0; if (pn < 8) return O_K + (pn - 6) * 256 + c0; if (pn < 10) return O_V + (pn - 8) * 256 + c0;
    if (pn < 14) return O_GA + (pn - 10) * 256 + c0; return O_GB + (pn - 14) * 256 + c0; }
__device__ __forceinline__ void ph_convert(Frame& F, bool experts) {
    F.lane = ltid(); F.tid = F.wave * 64 + F.lane;
    LAS float* scr = (LAS float*)(F.lds + F.wave * 16384);
    unsigned char* ws = F.ws; const int lane = F.lane;
    constexpr int I0 = 144 * 16, I1 = 32 * 8, I2 = 32 * 8, I3 = 32 * 16, I4 = 8 * 16, I5 = 16 * 16, I6 = 32 * 4, ISMALL = I0 + I1 + I2 + I3 + I4 + I5 + I6;
    for (int it = F.gw; it < ISMALL; it += F.NGW) {
        int r = it;
        if (r < I0) { const int d = r % 144, kb = r / 144; tr_block(F.w_in + (size_t)kb * 64 * INC + inproj_src_col(d), INC, (bf16_t*)(ws + WS_WIN_T) + (size_t)d * 32 * D + kb * 64, nullptr, D, scr, lane); continue; } r -= I0;
        if (r < I1) { const int d = r % 32, kb = r / 32; tr_block(F.w_conv_out + (size_t)kb * 64 * D + d * 32, D, (bf16_t*)(ws + WS_WC_T) + (size_t)d * 32 * CC + kb * 64, nullptr, CC, scr, lane); continue; } r -= I1;
        if (r < I2) { const int d = r % 32, kb = r / 32; tr_block(F.w_fox_out + (size_t)kb * 64 * D + d * 32, D, (bf16_t*)(ws + WS_WF_T) + (size_t)d * 32 * FW + kb * 64, nullptr, FW, scr, lane); continue; } r -= I2;
        if (r < I3) { const int d = r % 32, kb = r / 32; tr_block(F.w_mix_out + (size_t)kb * 64 * D + d * 32, D, (bf16_t*)(ws + WS_WMIX_T) + (size_t)d * 32 * D + kb * 64, nullptr, D, scr, lane); continue; } r -= I3;
        if (r < I4) { const int d = r % 8, kb = r / 8; tr_block(F.w_router + (size_t)kb * 64 * NE + d * 32, NE, (bf16_t*)(ws + WS_WR_HI) + (size_t)d * 32 * D + kb * 64, (bf16_t*)(ws + WS_WR_LO) + (size_t)d * 32 * D + kb * 64, D, scr, lane); continue; } r -= I4;
        if (r < I5) { const int d = r % 16, kb = r / 16, ct = d >> 3, c0 = (d & 7) * 32; const float* w = c0 < 128 ? F.w_sh_gate + 128 * ct + c0 : F.w_sh_up + 128 * ct + c0 - 128;
            tr_block(w + (size_t)kb * 64 * SHH, SHH, (bf16_t*)(ws + WS_WSHGU_T) + (size_t)d * 32 * D + kb * 64, nullptr, D, scr, lane); continue; } r -= I5;
        { const int d = r % 32, kb = r / 32; tr_block(F.w_sh_down + (size_t)kb * 64 * D + d * 32, D, (bf16_t*)(ws + WS_WSHD_T) + (size_t)d * 32 * SHH + kb * 64, nullptr, SHH, scr, lane); }
    }
    if (experts) {
        for (int it = F.gw; it < NE * 256; it += F.NGW) {
            const int e = it >> 8, kb = (it >> 4) & 15, d = it & 15, ct = d >> 3, c0 = (d & 7) * 32;
            const float* w = (c0 < 128 ? F.w_exp_gate + 128 * ct + c0 : F.w_exp_up + 128 * ct + c0 - 128) + (size_t)e * D * EH + (size_t)kb * 64 * EH;
            tr_block(w, EH, (bf16_t*)(ws + WS_WEGU_T) + ((size_t)e * 512 + d * 32) * D + kb * 64, nullptr, D, scr, lane);
        }
        for (int it = F.gw; it < NE * 128; it += F.NGW) {
            const int e = it >> 7, kb = (it >> 5) & 3, d = it & 31;
            tr_block(F.w_exp_down + (size_t)e * EH * D + (size_t)kb * 64 * D + d * 32, D, (bf16_t*)(ws + WS_WED_T) + ((size_t)e * D + d * 32) * EH + kb * 64, nullptr, EH, scr, lane);
        }
    }
}

struct SchedPlain {
    static constexpr bool GATHER = false;
    pg8::TileOrder o; const char* A; const char* B; unsigned arow, brow;
    __device__ __forceinline__ bool next(int i, pg8::Unit& u) const { int pm, pn; if (!o.tile(i, pm, pn)) return false; u.pm = pm; u.pn = pn; u.e = 0; u.p0 = 0; u.ne = 0; u.bs = 0;
        u.A = A + (size_t)pm * 256 * arow; u.B = B + (size_t)pn * 256 * brow; return true; }
    __device__ __forceinline__ unsigned a_row_off(const pg8::Unit&, int r) const { return (unsigned)r * arow; }
};
typedef f32x4 AccT[2][2][4][2];
#define EPI_ARGS const AccT& acc, const pg8::Unit& u, int wr, int wc, int fr, int fq
#define EPI_LAUNDER asm volatile("" : "+v"(fr), "+v"(fq))

struct EpiInProj {
    bf16_t *U, *Q, *GA; unsigned* NORM;
    __device__ __forceinline__ void operator()(EPI_ARGS) const {
        EPI_LAUNDER;
        const int row0 = u.pm * 256 + wr * 64 + fr, pn = u.pn, cin = wc * 32 + 8 * fq;
        if (pn < 4) {
#pragma unroll
            for (int ai = 0; ai < 2; ++ai)
#pragma unroll
                for (int m = 0; m < 4; ++m) { const f32x4 a0 = acc[ai][0][m][0], a1 = acc[ai][0][m][1], b0 = acc[ai][1][m][0], b1 = acc[ai][1][m][1]; u32x4 w;
                    w.x = pg8::cvt_pk_bf16(a0[0] * pg8::fsigmoid(b0[0]), a0[1] * pg8::fsigmoid(b0[1])); w.y = pg8::cvt_pk_bf16(a0[2] * pg8::fsigmoid(b0[2]), a0[3] * pg8::fsigmoid(b0[3]));
                    w.z = pg8::cvt_pk_bf16(a1[0] * pg8::fsigmoid(b1[0]), a1[1] * pg8::fsigmoid(b1[1])); w.w = pg8::cvt_pk_bf16(a1[2] * pg8::fsigmoid(b1[2]), a1[3] * pg8::fsigmoid(b1[3]));
                    *(u32x4*)(U + (size_t)(row0 + ai * 128 + m * 16) * CC + 128 * pn + cin) = w; }
        } else {
            const bool sg = pn >= 10; const int ld = sg ? D : FW, cb = sg ? ((pn - 10) & 3) * 256 : ((pn - 4) & 1) * 256;
            bf16_t* dst = sg ? GA + (size_t)((pn - 10) >> 2) * (16u << 20) : Q + (size_t)((pn - 4) >> 1) * (8u << 20);
            const float sc = pn < 6 ? QSCALE : 1.f; float nmx[2] = {0.f, 0.f};
#pragma unroll
            for (int ai = 0; ai < 2; ++ai)
#pragma unroll
                for (int m = 0; m < 4; ++m) { bf16_t* rowp = dst + (size_t)(row0 + ai * 128 + m * 16) * ld + cb + cin;
#pragma unroll
                    for (int bj = 0; bj < 2; ++bj) { f32x4 v0 = acc[ai][bj][m][0], v1 = acc[ai][bj][m][1];
                        if (sg) {
#pragma unroll
                            for (int j = 0; j < 4; ++j) { v0[j] = pg8::fsigmoid(v0[j]); v1[j] = pg8::fsigmoid(v1[j]); } }
                        else { v0 = v0 * sc; v1 = v1 * sc; }
                        if (pn < 8) { float ss = (v0[0] * v0[0] + v0[1] * v0[1]) + (v0[2] * v0[2] + v0[3] * v0[3]) + (v1[0] * v1[0] + v1[1] * v1[1]) + (v1[2] * v1[2] + v1[3] * v1[3]);
                            ss += __shfl_xor(ss, 16); ss += __shfl_xor(ss, 32); nmx[bj] = fmaxf(nmx[bj], ss); }
                        u32x4 w; w.x = pg8::cvt_pk_bf16(v0[0], v0[1]); w.y = pg8::cvt_pk_bf16(v0[2], v0[3]); w.z = pg8::cvt_pk_bf16(v1[0], v1[1]); w.w = pg8::cvt_pk_bf16(v1[2], v1[3]);
                        *(u32x4*)(rowp + bj * 128) = w; } }
            if (pn < 8) {
#pragma unroll
                for (int bj = 0; bj < 2; ++bj) { float v = nmx[bj];
#pragma unroll
                    for (int o = 1; o < 16; o <<= 1) v = fmaxf(v, __shfl_xor(v, o));
                    if ((fr | fq) == 0) { const int bh = ((u.pm * 256) >> 13) * NH + (pn & 1) * 4 + 2 * bj + (wc >> 1);
                        atomicMax(NORM + ((pn >= 6 ? 1 : 0) * 16 + bh) * 2 + (wc & 1), __float_as_uint(v)); } }
            }
        }
    }
};
__device__ __forceinline__ f32x4 bf4lo(u32x4 w) { return (f32x4){__uint_as_float(w.x << 16), __uint_as_float(w.x & 0xffff0000u), __uint_as_float(w.y << 16), __uint_as_float(w.y & 0xffff0000u)}; }
__device__ __forceinline__ f32x4 bf4hi(u32x4 w) { return (f32x4){__uint_as_float(w.z << 16), __uint_as_float(w.z & 0xffff0000u), __uint_as_float(w.w << 16), __uint_as_float(w.w & 0xffff0000u)}; }
__device__ __forceinline__ u32x4 pack8(f32x4 v0, f32x4 v1) { u32x4 w; w.x = pg8::cvt_pk_bf16(v0[0], v0[1]); w.y = pg8::cvt_pk_bf16(v0[2], v0[3]); w.z = pg8::cvt_pk_bf16(v1[0], v1[1]); w.w = pg8::cvt_pk_bf16(v1[2], v1[3]); return w; }

struct SchedMerge {
    static constexpr bool GATHER = false;
    pg8::TileOrder o; const char *AC, *O, *WC, *WF;
    __device__ __forceinline__ bool next(int i, pg8::Unit& u) const { int pm, pn; if (!o.tile(i >> 1, pm, pn)) return false; u.pm = pm; u.pn = pn; u.e = i & 1; u.p0 = 0; u.ne = 0; u.bs = 0;
        u.A = ((i & 1) ? O : AC) + (size_t)pm * 256 * 1024; u.B = ((i & 1) ? WF : WC) + (size_t)pn * 256 * 1024; return true; }
    __device__ __forceinline__ unsigned a_row_off(const pg8::Unit&, int r) const { return (unsigned)r * 1024u; }
};
struct EpiMerge {
    const bf16_t *GA, *GB; bf16_t *YA, *MG;
    __device__ __forceinline__ void operator()(EPI_ARGS) const {
        EPI_LAUNDER;
        const int row0 = u.pm * 256 + wr * 64 + fr, col0 = u.pn * 256 + wc * 32 + 8 * fq; const bool second = u.e != 0;
        const bf16_t* G = second ? GB : GA; bf16_t* dst = second ? MG : YA;
#pragma unroll
        for (int ai = 0; ai < 2; ++ai)
#pragma unroll
            for (int m = 0; m < 4; ++m) { const size_t off = (size_t)(row0 + ai * 128 + m * 16) * D + col0;
#pragma unroll
                for (int bj = 0; bj < 2; ++bj) { const u32x4 g = *(const u32x4*)(G + off + bj * 128);
                    f32x4 v0 = acc[ai][bj][m][0] * bf4lo(g), v1 = acc[ai][bj][m][1] * bf4hi(g);
                    if (second) { const u32x4 y = *(const u32x4*)(YA + off + bj * 128); v0 += bf4lo(y); v1 += bf4hi(y); }
                    *(u32x4*)(dst + off + bj * 128) = pack8(v0, v1); } }
    }
};
struct EpiMix {
    const float *x, *ADA; float* Z;
    __device__ __forceinline__ void operator()(EPI_ARGS) const {
        EPI_LAUNDER;
        const int row0 = u.pm * 256 + wr * 64 + fr, col0 = u.pn * 256 + wc * 32 + 8 * fq, b = (u.pm * 256) >> 13;
        f32x4 g[2][2];
#pragma unroll
        for (int bj = 0; bj < 2; ++bj)
#pragma unroll
            for (int n = 0; n < 2; ++n) g[bj][n] = *(const f32x4*)(ADA + b * 6144 + 2048 + col0 + bj * 128 + 4 * n) + 1.0f;
#pragma unroll
        for (int ai = 0; ai < 2; ++ai)
#pragma unroll
            for (int m = 0; m < 4; ++m) { const size_t off = (size_t)(row0 + ai * 128 + m * 16) * D + col0;
#pragma unroll
                for (int bj = 0; bj < 2; ++bj)
#pragma unroll
                    for (int n = 0; n < 2; ++n) { const f32x4 xv = *(const f32x4*)(x + off + bj * 128 + 4 * n); *(f32x4*)(Z + off + bj * 128 + 4 * n) = xv * ALPHA + g[bj][n] * acc[ai][bj][m][n]; } }
    }
};
struct SchedRS {
    static constexpr bool GATHER = false;
    int G, c; const char *H2, *H2LO, *WRH, *WRL, *WSH;
    __device__ __forceinline__ bool next(int i, pg8::Unit& u) const { const int L = i * G + c; if (L >= 64 * 5) return false; const int pm = L / 5, j = L % 5; u.pm = pm; u.e = j; u.p0 = 0; u.ne = 0; u.bs = 0;
        if (j < 3) { u.pn = 0; u.A = (j == 2 ? H2LO : H2) + (size_t)pm * 256 * 2048; u.B = (j == 1 ? WRL : WRH); }
        else { u.pn = j - 3; u.A = H2 + (size_t)pm * 256 * 2048; u.B = WSH + (size_t)(j - 3) * 256 * 2048; }
        return true; }
    __device__ __forceinline__ unsigned a_row_off(const pg8::Unit&, int r) const { return (unsigned)r * 2048u; }
};
struct EpiRS {
    float* RL; bf16_t* SHID;
    __device__ __forceinline__ void operator()(EPI_ARGS) const {
        EPI_LAUNDER;
        const int row0 = u.pm * 256 + wr * 64 + fr, cin = wc * 32 + 8 * fq;
        if (u.e < 3) { float* R = RL + (size_t)u.e * T * NE;
#pragma unroll
            for (int ai = 0; ai < 2; ++ai)
#pragma unroll
                for (int m = 0; m < 4; ++m) { float* rp = R + (size_t)(row0 + ai * 128 + m * 16) * NE + cin;
#pragma unroll
                    for (int bj = 0; bj < 2; ++bj)
#pragma unroll
                        for (int n = 0; n < 2; ++n) *(f32x4*)(rp + bj * 128 + 4 * n) = acc[ai][bj][m][n]; }
        } else {
#pragma unroll
            for (int ai = 0; ai < 2; ++ai)
#pragma unroll
                for (int m = 0; m < 4; ++m) { const f32x4 g0 = acc[ai][0][m][0], g1 = acc[ai][0][m][1], u0 = acc[ai][1][m][0], u1 = acc[ai][1][m][1]; f32x4 h0, h1;
#pragma unroll
                    for (int j = 0; j < 4; ++j) { h0[j] = g0[j] * pg8::fsigmoid(g0[j]) * u0[j]; h1[j] = g1[j] * pg8::fsigmoid(g1[j]) * u1[j]; }
                    *(u32x4*)(SHID + (size_t)(row0 + ai * 128 + m * 16) * SHH + 128 * u.pn + cin) = pack8(h0, h1); }
        }
    }
};
__device__ __forceinline__ void ph_inproj_fast(Frame& F) {
    F.lane = ltid(); F.tid = F.wave * 64 + F.lane;
    SchedPlain S; S.o.init(T / 256, NINW / 256, gridDim.x, blockIdx.x); S.A = (const char*)F.H; S.B = (const char*)(F.ws + WS_WIN_T); S.arow = 2048; S.brow = 2048;
    EpiInProj E{F.U, F.Q, F.GA, F.ctl + CW_NORM};
    static_assert(WS_K - WS_Q == 16 * MiB && WS_V - WS_K == 16 * MiB && WS_GB - WS_GA == 32 * MiB, "EpiInProj destination arithmetic");
    pg8::gemm_phase<EpiInProj, SchedPlain, true>(F.lds, D, D, D, S, E);
}
__device__ __forceinline__ void ph_merge_fast(Frame& F) {
    F.lane = ltid(); F.tid = F.wave * 64 + F.lane;
    SchedMerge S; S.o.init(T / 256, D / 256, gridDim.x, blockIdx.x); S.AC = (const char*)F.AC; S.O = (const char*)F.O; S.WC = (const char*)(F.ws + WS_WC_T); S.WF = (const char*)(F.ws + WS_WF_T);
    EpiMerge E{F.GA, F.GB, F.YA, F.MG};
    pg8::gemm_phase<EpiMerge, SchedMerge, false>(F.lds, CC, CC, CC, S, E);
}
__device__ __forceinline__ void ph_mix_fast(Frame& F) {
    F.lane = ltid(); F.tid = F.wave * 64 + F.lane;
    SchedPlain S; S.o.init(T / 256, D / 256, gridDim.x, blockIdx.x); S.A = (const char*)F.MG; S.B = (const char*)(F.ws + WS_WMIX_T); S.arow = 2048; S.brow = 2048;
    EpiMix E{F.x, F.ADA, F.X1};
    pg8::gemm_phase<EpiMix, SchedPlain, false>(F.lds, D, D, D, S, E);
}
__device__ __forceinline__ void ph_router_fast(Frame& F) {
    F.lane = ltid(); F.tid = F.wave * 64 + F.lane;
    SchedRS S{(int)gridDim.x, (int)blockIdx.x, (const char*)F.H2, (const char*)F.H2LO, (const char*)(F.ws + WS_WR_HI), (const char*)(F.ws + WS_WR_LO), (const char*)(F.ws + WS_WSHGU_T)};
    EpiRS E{F.RL, F.SHID};
    pg8::gemm_phase<EpiRS, SchedRS, true>(F.lds, D, D, D, S, E);
}

constexpr int EMAP_OFF = 131072 + 1024;
struct SchedMoe1 {
    static constexpr bool GATHER = true;
    int G, c, nunits; const LAS int* pref; const LAS int* base; const char* H2; const char* W; const int* LIST;
    __device__ __forceinline__ bool next(int i, pg8::Unit& u) const { const int L = i * G + c; if (L >= nunits) return false; const int ch = L >> 1, ct = L & 1, e = __builtin_amdgcn_readfirstlane(find_expert(pref, ch));
        u.pm = 0; u.pn = ct; u.e = e; u.p0 = __builtin_amdgcn_readfirstlane((ch - pref[e]) * 256); u.bs = __builtin_amdgcn_readfirstlane(base[e]); u.ne = __builtin_amdgcn_readfirstlane(base[e + 1]) - u.bs;
        u.A = H2; u.B = W + ((size_t)e * 512 + ct * 256) * 2048; return true; }
    __device__ __forceinline__ unsigned a_row_off(const pg8::Unit& u, int r) const { int p = u.p0 + r; p = p < u.ne ? p : u.ne - 1; return (unsigned)(LIST[(size_t)u.e * LCAP + p] >> 3) * 2048u; }
};
struct EpiMoe1 {
    bf16_t* HID;
    __device__ __forceinline__ void operator()(EPI_ARGS) const {
        EPI_LAUNDER;
        const int r0 = wr * 64 + fr, cin = wc * 32 + 8 * fq;
#pragma unroll
        for (int ai = 0; ai < 2; ++ai)
#pragma unroll
            for (int m = 0; m < 4; ++m) { const int p = u.p0 + r0 + ai * 128 + m * 16;
                const f32x4 g0 = acc[ai][0][m][0], g1 = acc[ai][0][m][1], u0 = acc[ai][1][m][0], u1 = acc[ai][1][m][1]; f32x4 h0, h1;
#pragma unroll
                for (int j = 0; j < 4; ++j) { h0[j] = g0[j] * pg8::fsigmoid(g0[j]) * u0[j]; h1[j] = g1[j] * pg8::fsigmoid(g1[j]) * u1[j]; }
                if (p < u.ne) *(u32x4*)(HID + (size_t)(u.bs + p) * EH + 128 * u.pn + cin) = pack8(h0, h1); }
    }
};
struct SchedMoe2 {
    static constexpr bool GATHER = true;
    int G, c, nunits; const LAS int* pref; const LAS int* base; const char* HID; const char* W;
    __device__ __forceinline__ bool next(int i, pg8::Unit& u) const { const int L = i * G + c; if (L >= nunits) return false; const int ch = L >> 2, ct = L & 3, e = __builtin_amdgcn_readfirstlane(find_expert(pref, ch));
        u.pm = 0; u.pn = ct; u.e = e; u.p0 = __builtin_amdgcn_readfirstlane((ch - pref[e]) * 256); u.bs = __builtin_amdgcn_readfirstlane(base[e]); u.ne = __builtin_amdgcn_readfirstlane(base[e + 1]) - u.bs;
        u.A = HID + (size_t)(u.bs + u.p0) * 512; u.B = W + ((size_t)e * 1024 + ct * 256) * 512; return true; }
    __device__ __forceinline__ unsigned a_row_off(const pg8::Unit& u, int r) const { const int lim = u.ne - 1 - u.p0; return (unsigned)(r < lim ? r : lim) * 512u; }
};
struct EpiMoe2 {
    const int* LIST; const float* LISTW; bf16_t* YAS;
    __device__ __forceinline__ void operator()(EPI_ARGS) const {
        EPI_LAUNDER;
        const int r0 = wr * 64 + fr, col0 = u.pn * 256 + wc * 32 + 8 * fq;
#pragma unroll
        for (int ai = 0; ai < 2; ++ai)
#pragma unroll
            for (int m = 0; m < 4; ++m) { const int p = u.p0 + r0 + ai * 128 + m * 16;
                if (p < u.ne) { const int as = LIST[(size_t)u.e * LCAP + p]; const float w = LISTW[(size_t)u.e * LCAP + p];
                    bf16_t* rowp = YAS + ((size_t)(as >> 3) * NSLOT + (as & 7)) * D + col0;
#pragma unroll
                    for (int bj = 0; bj < 2; ++bj) *(u32x4*)(rowp + bj * 128) = pack8(acc[ai][bj][m][0] * w, acc[ai][bj][m][1] * w); }
                if (m & 1) asm volatile("" ::: "memory"); }
    }
};
struct EpiShDown {
    bf16_t* YAS;
    __device__ __forceinline__ void operator()(EPI_ARGS) const {
        EPI_LAUNDER;
        const int row0 = u.pm * 256 + wr * 64 + fr, col0 = u.pn * 256 + wc * 32 + 8 * fq;
#pragma unroll
        for (int ai = 0; ai < 2; ++ai)
#pragma unroll
            for (int m = 0; m < 4; ++m) { bf16_t* rowp = YAS + ((size_t)(row0 + ai * 128 + m * 16) * NSLOT + 8) * D + col0;
#pragma unroll
                for (int bj = 0; bj < 2; ++bj) *(u32x4*)(rowp + bj * 128) = pack8(acc[ai][bj][m][0], acc[ai][bj][m][1]); }
    }
};
__device__ __forceinline__ void ph_moe1_fast(Frame& F) {
    F.lane = ltid(); F.tid = F.wave * 64 + F.lane;
    LAS int* pref = (LAS int*)(F.lds + EMAP_OFF); LAS int* base = pref + 260;
    build_expert_map(F, pref, base, 256);
    { SchedMoe1 S{(int)gridDim.x, (int)blockIdx.x, __builtin_amdgcn_readfirstlane(pref[NE]) * 2, pref, base, (const char*)F.H2, (const char*)(F.ws + WS_WEGU_T), F.LIST};
      EpiMoe1 E{F.HID};
      pg8::gemm_phase<EpiMoe1, SchedMoe1, true>(F.lds, D, D, D, S, E); }
    { SchedPlain S; S.o.init(T / 256, D / 256, gridDim.x, blockIdx.x); S.A = (const char*)F.SHID; S.B = (const char*)(F.ws + WS_WSHD_T); S.arow = 512; S.brow = 512;
      EpiShDown E{F.YAS};
      pg8::gemm_phase<EpiShDown, SchedPlain, true>(F.lds, SHH, SHH, SHH, S, E); }
}
__device__ __forceinline__ void ph_moe2_fast(Frame& F) {
    F.lane = ltid(); F.tid = F.wave * 64 + F.lane;
    LAS int* pref = (LAS int*)(F.lds + EMAP_OFF); LAS int* base = pref + 260;
    build_expert_map(F, pref, base, 256);
    SchedMoe2 S{(int)gridDim.x, (int)blockIdx.x, __builtin_amdgcn_readfirstlane(pref[NE]) * 4, pref, base, (const char*)F.HID, (const char*)(F.ws + WS_WED_T)};
    EpiMoe2 E{F.LIST, F.LISTW, F.YAS};
    pg8::gemm_phase<EpiMoe2, SchedMoe2, true>(F.lds, EH, EH, EH, S, E);
}

namespace attn_body {
using bf16=__hip_bfloat16;
using bf16x8=__attribute__((ext_vector_type(8)))short;
using s16x4=__attribute__((ext_vector_type(4)))short;
using f32x16=__attribute__((ext_vector_type(16)))float;
using u32x4=__attribute__((ext_vector_type(4)))unsigned;
using f32x4_t=__attribute__((ext_vector_type(4)))float;
constexpr int BATCH=2,NHEAD=8,SEQ=8192,D=64,DM=NHEAD*D;
constexpr int NW=8,QBLK=32,QB=QBLK*NW,KVBLK=64,NQB=SEQ/QB;
constexpr int ATTN_PITCH=DM, ATTN_UNIT_ROWS=QB;
__device__ __forceinline__ int crow(int r,int hi){return (r&3)+8*(r>>2)+4*hi;}
#define SBAR() __builtin_amdgcn_sched_barrier(0)
__device__ __forceinline__ void cmask(f32x16&p0,f32x16&p1,int jb,int qrel,int hi){
  const float NEG=-INFINITY; int kb=64*jb+4*hi;
  #pragma unroll
  for(int r=0;r<16;++r){int kv=kb+(r&3)+8*(r>>2); if(kv>qrel)p0[r]=NEG; if(kv+32>qrel)p1[r]=NEG;}
}

constexpr int NSLOT=3, SLOTB=8192;
constexpr int LDS_K=0, LDS_V=NSLOT*SLOTB, LDS_WS=2*NSLOT*SLOTB, LDS_OST=LDS_WS+NW*64*4, LDS_NB=LDS_OST+NW*4096, LDS_BYTES=LDS_NB+SEQ*4;
constexpr float C2=0.125f*1.4426950408889634f;
__device__ __forceinline__ void glds16(const void*gsrc,unsigned lds_dst){unsigned keep;
  asm volatile("s_mov_b32 %0, m0\n\ts_mov_b32 m0, %2\n\ts_nop 0\n\tglobal_load_lds_dwordx4 %1, off\n\ts_mov_b32 m0, %0":"=&s"(keep):"v"(gsrc),"s"(lds_dst):"memory");}
__device__ __forceinline__ float max3f(float a,float b,float c){float r;asm("v_max3_f32 %0, %1, %2, %3":"=v"(r):"v"(a),"v"(b),"v"(c));return r;}
__device__ __forceinline__ float max2f(float a,float b){float r;asm("v_max_f32_e32 %0, %1, %2":"=v"(r):"v"(a),"v"(b));return r;}
__device__ __forceinline__ float fadd_s(float a,float b){float r;asm("v_add_f32_e32 %0, %1, %2":"=v"(r):"v"(a),"v"(b));return r;}
__device__ __forceinline__ float fsub_s(float a,float b){float r;asm("v_sub_f32_e32 %0, %1, %2":"=v"(r):"v"(a),"v"(b));return r;}
typedef float f32x2_t __attribute__((ext_vector_type(2))); typedef __bf16 bf16x2_t __attribute__((ext_vector_type(2)));
__device__ __forceinline__ unsigned cvtpk_s(float lo,float hi){f32x2_t v={lo,hi};bf16x2_t b=__builtin_convertvector(v,bf16x2_t);return __builtin_bit_cast(unsigned,b);}
#define WAIT_BAR(N) asm volatile("s_waitcnt vmcnt(" #N ") lgkmcnt(0)\n\ts_barrier":::"memory")

__device__ __forceinline__ void qkt(f32x16&p0,f32x16&p1,const char*Kslot,const bf16x8*qr,int r32,int hi){
  const char*kb=Kslot+hi*1024+r32*16;
  #pragma unroll
  for(int d0=0;d0<4;++d0){
    const bf16x8 b0=*reinterpret_cast<const bf16x8*>(kb+d0*2048);
    const bf16x8 b1=*reinterpret_cast<const bf16x8*>(kb+d0*2048+512);
    {p0=__builtin_amdgcn_mfma_f32_32x32x16_bf16(b0,qr[d0],p0,0,0,0);p1=__builtin_amdgcn_mfma_f32_32x32x16_bf16(b1,qr[d0],p1,0,0,0);}}
}
typedef __attribute__((address_space(3))) const char* lds_cptr;
typedef short v4i16_t __attribute__((ext_vector_type(4)));
__device__ __forceinline__ void kload8(bf16x8*kf,lds_cptr kp){
  kf[0]=*(const __attribute__((address_space(3))) bf16x8*)(kp);      kf[1]=*(const __attribute__((address_space(3))) bf16x8*)(kp+512);
  kf[2]=*(const __attribute__((address_space(3))) bf16x8*)(kp+2048); kf[3]=*(const __attribute__((address_space(3))) bf16x8*)(kp+2560);
  kf[4]=*(const __attribute__((address_space(3))) bf16x8*)(kp+4096); kf[5]=*(const __attribute__((address_space(3))) bf16x8*)(kp+4608);
  kf[6]=*(const __attribute__((address_space(3))) bf16x8*)(kp+6144); kf[7]=*(const __attribute__((address_space(3))) bf16x8*)(kp+6656);
}
__device__ __forceinline__ void kload2(bf16x8*kf,lds_cptr kp,int j){ kf[2*j]=*(const __attribute__((address_space(3))) bf16x8*)(kp+j*2048); kf[2*j+1]=*(const __attribute__((address_space(3))) bf16x8*)(kp+j*2048+512); }
__device__ __forceinline__ s16x4 vtr(lds_cptr p){ return __builtin_bit_cast(s16x4,__builtin_amdgcn_ds_read_tr16_b64_v4i16((__attribute__((address_space(3))) v4i16_t*)p)); }
__device__ __forceinline__ float rowmax(const f32x16&p0,const f32x16&p1){
  float a=max3f(p0[0],p0[1],p1[0]),b=max3f(p0[2],p0[3],p1[1]);a=max3f(a,p1[2],p1[3]);
  #pragma unroll
  for(int r=4;r<16;r+=4){a=max3f(a,p0[r],p0[r+1]);b=max3f(b,p0[r+2],p0[r+3]);a=max3f(a,p1[r],p1[r+1]);b=max3f(b,p1[r+2],p1[r+3]);}
  const float m=max2f(a,b);
  auto rr=__builtin_amdgcn_permlane32_swap(__float_as_uint(m),__float_as_uint(m),false,false);
  return max2f(__uint_as_float(rr[0]),__uint_as_float(rr[1]));
}
__device__ __forceinline__ void pv(f32x16*o,int vb,bf16x8 pa0,bf16x8 pa1,bf16x8 pa2,bf16x8 pa3){
  #pragma unroll
  for(int d0=0;d0<2;++d0){s16x4 lo[4],hi[4];
    #pragma unroll
    for(int ks=0;ks<4;++ks){
      asm volatile("ds_read_b64_tr_b16 %0,%1 offset:%c2":"=&v"(lo[ks]):"v"(vb),"i"(d0*4096+ks*1024):"memory");
      asm volatile("ds_read_b64_tr_b16 %0,%1 offset:%c2":"=&v"(hi[ks]):"v"(vb),"i"(d0*4096+ks*1024+512):"memory");}
    asm volatile("s_waitcnt lgkmcnt(0)":::"memory");SBAR();
    #define PK(k) (bf16x8){lo[k][0],lo[k][1],lo[k][2],lo[k][3],hi[k][0],hi[k][1],hi[k][2],hi[k][3]}
    o[d0]=__builtin_amdgcn_mfma_f32_32x32x16_bf16(pa0,PK(0),o[d0],0,0,0);
    o[d0]=__builtin_amdgcn_mfma_f32_32x32x16_bf16(pa1,PK(1),o[d0],0,0,0);
    o[d0]=__builtin_amdgcn_mfma_f32_32x32x16_bf16(pa2,PK(2),o[d0],0,0,0);
    o[d0]=__builtin_amdgcn_mfma_f32_32x32x16_bf16(pa3,PK(3),o[d0],0,0,0);
    #undef PK
  }
}

#ifndef ATTN_STORE16
#define ATTN_STORE16(p,v) (*(u32x4*)(p)=(v))
#endif
template<int THRL> __device__ __forceinline__ void attn_unit(int b,int h,int qb,const bf16*Q,const bf16*__restrict__ K,const bf16*__restrict__ V,bf16*O,char*shm,const float*__restrict__ cum,float skip_thr){
  const int tid=threadIdx.x,lane=tid&63,r32=lane&31,hi=lane>>5; const int wid=__builtin_amdgcn_readfirstlane(tid>>6);
  const long rowbase=(long)b*SEQ; const int q0=qb*QB;
  const bf16*Qw=Q+(rowbase+q0+wid*QBLK)*DM+h*D;
  const bf16*Kh=K+rowbase*DM+h*D,*Vh=V+rowbase*DM+h*D;
  const unsigned lds0=(unsigned)(uintptr_t)shm;
  float*wsf=(float*)(shm+LDS_WS)+wid*64;
  const bf16*ksrc=Kh+(long)lane*DM+wid*8;
  const bf16*vsrc=Vh+(long)(16*(wid&3)+(lane>>2))*DM+(wid>>2)*32+(lane&3)*8;
  const unsigned kdst=lds0+LDS_K+wid*1024, vdst=lds0+LDS_V+wid*1024;
  #define DMA_K(t,slot) glds16(ksrc+(long)(NTF-1-(t))*KVBLK*DM,(unsigned)__builtin_amdgcn_readfirstlane(kdst+(slot)))
  #define DMA_V(t,slot) glds16(vsrc+(long)(NTF-1-(t))*KVBLK*DM,(unsigned)__builtin_amdgcn_readfirstlane(vdst+(slot)))
  const int vb0=(int)(lds0+LDS_V)+((lane>>4)&1)*32+(lane&3)*8+(4*hi+((lane&15)>>2))*64;
  const char*Kbase=shm+LDS_K; bf16x8 kf[8];
  const lds_cptr shm3=(lds_cptr)shm; const lds_cptr kp0=shm3+LDS_K+hi*1024+r32*16; const lds_cptr vp0=shm3+LDS_V+((lane>>4)&1)*32+(lane&3)*8+(4*hi+((lane&15)>>2))*64;
  const int NTF=(q0+QB)/KVBLK;
  const float F0=cum[q0]; int nskip;
  { const int j0=lane,j1=lane+64; bool s0=false,s1=false;
    if(j0<NTF-4) s0=(F0-cum[64*j0+63])*1.4426950408889634f < -skip_thr;
    if(j1<NTF-4) s1=(F0-cum[64*j1+63])*1.4426950408889634f < -skip_thr;
    const unsigned long long m0=__ballot(s0),m1=__ballot(s1);
    nskip=(m0==~0ull)?64+(int)__builtin_ctzll(~m1|(1ull<<63)):(int)__builtin_ctzll(~m0); nskip&=~1; nskip=__builtin_amdgcn_readfirstlane(nskip); }
  const int NT=NTF-nskip, sbase=64*nskip;
  typedef __attribute__((address_space(3))) float* lds_fptr; const lds_fptr nbL=(lds_fptr)(__attribute__((address_space(3))) char*)shm+LDS_NB/4;
  for(int i4=tid*4;i4<q0+QB-sbase;i4+=NW*64*4){ const f32x4_t c4=*reinterpret_cast<const f32x4_t*>(cum+sbase+i4); f32x4_t n4; n4[0]=(F0-c4[0])*1.4426950408889634f; n4[1]=(F0-c4[1])*1.4426950408889634f; n4[2]=(F0-c4[2])*1.4426950408889634f; n4[3]=(F0-c4[3])*1.4426950408889634f; *(__attribute__((address_space(3))) f32x4_t*)(nbL+i4)=n4; }
  asm volatile("s_waitcnt vmcnt(0) lgkmcnt(0)\n\ts_barrier":::"memory");
  DMA_K(0,0);DMA_V(0,0);DMA_K(1,SLOTB);
  bf16x8 qr[4];
  #pragma unroll
  for(int d0=0;d0<4;++d0)qr[d0]=*reinterpret_cast<const bf16x8*>(&Qw[(long)r32*DM+d0*16+hi*8]);
  float l_reg=0.f;f32x16 o[2];o[0]=f32x16{};o[1]=f32x16{};
  const int qrel=wid*QBLK+r32;
  float mhat=nbL[q0-sbase+qrel];
  #define NBRD(X0,X1,i) do{ const lds_fptr nb_=nbL+(64*(NT-1-(i))+4*hi); _Pragma("unroll") for(int g_=0;g_<4;++g_){ const f32x4_t a_=*(const __attribute__((address_space(3))) f32x4_t*)(nb_+8*g_); const f32x4_t b_=*(const __attribute__((address_space(3))) f32x4_t*)(nb_+8*g_+32); \
      X0[4*g_]=a_[0];X0[4*g_+1]=a_[1];X0[4*g_+2]=a_[2];X0[4*g_+3]=a_[3]; X1[4*g_]=b_[0];X1[4*g_+1]=b_[1];X1[4*g_+2]=b_[2];X1[4*g_+3]=b_[3]; } }while(0)
  #define NBSUB(X0,X1) do{ _Pragma("unroll") for(int r=0;r<16;++r){X0[r]-=mhat;X1[r]-=mhat;} }while(0)
  #define CMASK(P0,P1,t) do{int jb_=3-(t); if(jb_>=0)cmask(P0,P1,jb_,qrel,hi);}while(0)
  bool resc=false;
  #define START(P0,P1) do{ const float rm=rowmax(P0,P1); resc=false; \
    { const float dl=max2f(rm,0.f); mhat=fadd_s(mhat,dl); \
      _Pragma("unroll") for(int r=0;r<16;++r){P0[r]=fsub_s(P0[r],dl);P1[r]=fsub_s(P1[r],dl);} } \
    _Pragma("unroll") for(int r=0;r<16;++r)P0[r]=__builtin_amdgcn_exp2f(P0[r]); }while(0)
  #define RESC() do{ if(resc){ asm volatile("s_waitcnt lgkmcnt(0)":::"memory"); \
      _Pragma("unroll") for(int d_=0;d_<2;++d_) _Pragma("unroll") for(int r=0;r<16;++r)o[d_][r]*=wsf[crow(r,hi)]; } }while(0)
  f32x16 pA0,pA1,pB0,pB1;
  int sl_prev=0,sl_cur=0,sl_next=SLOTB;
  #define ROT() do{sl_prev=sl_cur;sl_cur=sl_next;sl_next=(sl_next==(NSLOT-1)*SLOTB)?0:sl_next+SLOTB;}while(0)
  DMA_K(2,2*SLOTB);
  WAIT_BAR(3);
  NBRD(pA0,pA1,0); NBSUB(pA0,pA1);
  qkt(pA0,pA1,Kbase,qr,r32,hi);asm volatile("s_nop 15\n\ts_nop 7":"+v"(pA0),"+v"(pA1));CMASK(pA0,pA1,0);
  START(pA0,pA1);
  _Pragma("unroll") for(int r=0;r<16;++r)pA1[r]=__builtin_amdgcn_exp2f(pA1[r]);
  NBRD(pB0,pB1,1);
  WAIT_BAR(0);
  DMA_K(3,0);DMA_V(1,SLOTB);
  ROT();
  kload8(kf,kp0+sl_cur);
  WAIT_BAR(2);
  s16x4 vlo[8],vhi[8]; u32x4 pw0,pw1,pw2,pw3;
  #define PKW(P,B) cvtpk_s(P[B],P[B+1])
  #define PAF(k) __builtin_bit_cast(bf16x8,pw##k)
  #define VFR(i) (bf16x8){vlo[i][0],vlo[i][1],vlo[i][2],vlo[i][3],vhi[i][0],vhi[i][1],vhi[i][2],vhi[i][3]}
  #define PIN(x) asm volatile("":"+v"(x))
  #define MX3(a,b,c) __builtin_fmaxf(__builtin_fmaxf((a),(b)),(c))
  #define GAPA(MF,A0,A1,A2,A3,W0,W1,PW) do{ MF; sacc+=A0; sacc+=A1; sacc+=A2; sacc+=A3; PIN(sacc); W0; W1; PIN(PW); SBAR(); }while(0)
  #define EX(v) __builtin_amdgcn_exp2f(v)
  #define GAPB(MF,X,B) do{ MF; X[B]=EX(X[B]); X[B+1]=EX(X[B+1]); X[B+2]=EX(X[B+2]); X[B+3]=EX(X[B+3]); PIN(X); SBAR(); }while(0)
  #define VRD(i) do{ vlo[i]=vtr(vp_+(((i)>>2)*4096+((i)&3)*1024)); vhi[i]=vtr(vp_+(((i)>>2)*4096+((i)&3)*1024+512)); }while(0)
  #define KRD(G,j) do{ if(G){ kload2(kf,kp0+sl_next,j); SBAR(); } }while(0)
  #define STEP(C0,C1,P0,P1,t,GK,GV,GL) do{ SBAR(); NBSUB(C0,C1); \
    const lds_cptr vp_=vp0+sl_prev; \
    VRD(0); SBAR(); float sacc=(P0[0]+P0[1]); \
    GAPA(C0=__builtin_amdgcn_mfma_f32_32x32x16_bf16(kf[0],qr[0],C0,0,0,0), P0[2],P0[3],P0[4],P0[5],     pw0[0]=PKW(P0,0), pw0[1]=PKW(P0,2), pw0); \
    VRD(4); SBAR(); GAPA(C1=__builtin_amdgcn_mfma_f32_32x32x16_bf16(kf[1],qr[0],C1,0,0,0), P0[6],P0[7],P0[8],P0[9],     pw0[2]=PKW(P0,4), pw0[3]=PKW(P0,6), pw0); \
    VRD(1); SBAR(); GAPA(C0=__builtin_amdgcn_mfma_f32_32x32x16_bf16(kf[2],qr[1],C0,0,0,0),   P0[10],P0[11],P0[12],P0[13], pw1[0]=PKW(P0,8), pw1[1]=PKW(P0,10), pw1); \
    VRD(5); SBAR(); GAPA(C1=__builtin_amdgcn_mfma_f32_32x32x16_bf16(kf[3],qr[1],C1,0,0,0),   P0[14],P0[15],P1[0],P1[1],   pw1[2]=PKW(P0,12),pw1[3]=PKW(P0,14), pw1); \
    VRD(2); SBAR(); GAPA(C0=__builtin_amdgcn_mfma_f32_32x32x16_bf16(kf[4],qr[2],C0,0,0,0),   P1[2],P1[3],P1[4],P1[5],     pw2[0]=PKW(P1,0), pw2[1]=PKW(P1,2), pw2); \
    VRD(6); SBAR(); GAPA(C1=__builtin_amdgcn_mfma_f32_32x32x16_bf16(kf[5],qr[2],C1,0,0,0),   P1[6],P1[7],P1[8],P1[9],     pw2[2]=PKW(P1,4), pw2[3]=PKW(P1,6), pw2); \
    VRD(3); SBAR(); GAPA(C0=__builtin_amdgcn_mfma_f32_32x32x16_bf16(kf[6],qr[3],C0,0,0,0),   P1[10],P1[11],P1[12],P1[13], pw3[0]=PKW(P1,8), pw3[1]=PKW(P1,10), pw3); \
    VRD(7); SBAR(); GAPA(C1=__builtin_amdgcn_mfma_f32_32x32x16_bf16(kf[7],qr[3],C1,0,0,0),   P1[14],P1[15],0.f,0.f,       pw3[2]=PKW(P1,12),pw3[3]=PKW(P1,14), pw3); \
    l_reg+=sacc; \
    if(GK){DMA_K((t)+3,sl_cur);} if(GV){DMA_V((t)+1,sl_next);} \
    CMASK(C0,C1,t); \
    { float a=MX3(C0[0],C0[1],C1[0]),b=MX3(C0[2],C0[3],C1[1]); a=MX3(a,C1[2],C1[3]); \
      _Pragma("unroll") for(int r=4;r<16;r+=4){a=MX3(a,C0[r],C0[r+1]);b=MX3(b,C0[r+2],C0[r+3]);a=MX3(a,C1[r],C1[r+1]);b=MX3(b,C1[r+2],C1[r+3]);} \
      float rm=__builtin_fmaxf(a,b); { auto rr=__builtin_amdgcn_permlane32_swap(__float_as_uint(rm),__float_as_uint(rm),false,false); rm=__builtin_fmaxf(__uint_as_float(rr[0]),__uint_as_float(rr[1])); } \
      resc=false; \
      if(__builtin_expect(__any(rm>(float)THRL),0)){ const float dl=__builtin_fmaxf(rm,0.f); mhat+=dl; \
        _Pragma("unroll") for(int r=0;r<16;++r){C0[r]-=dl;C1[r]-=dl;} \
        const float f=__builtin_amdgcn_exp2f(-dl); l_reg*=f; if(hi==0)wsf[r32]=f; resc=true; } } \
    SBAR(); \
    if(GL){ NBRD(P0,P1,(t)+1); SBAR(); } \
    GAPB(o[0]=__builtin_amdgcn_mfma_f32_32x32x16_bf16(PAF(0),VFR(0),o[0],0,0,0), C0,0); \
    GAPB(o[1]=__builtin_amdgcn_mfma_f32_32x32x16_bf16(PAF(0),VFR(4),o[1],0,0,0), C0,4); \
    KRD(GL,0); GAPB(o[0]=__builtin_amdgcn_mfma_f32_32x32x16_bf16(PAF(1),VFR(1),o[0],0,0,0), C0,8); \
    KRD(GL,1); GAPB(o[1]=__builtin_amdgcn_mfma_f32_32x32x16_bf16(PAF(1),VFR(5),o[1],0,0,0), C0,12); \
    KRD(GL,2); GAPB(o[0]=__builtin_amdgcn_mfma_f32_32x32x16_bf16(PAF(2),VFR(2),o[0],0,0,0), C1,0); \
    KRD(GL,3); GAPB(o[1]=__builtin_amdgcn_mfma_f32_32x32x16_bf16(PAF(2),VFR(6),o[1],0,0,0), C1,4); \
    GAPB(o[0]=__builtin_amdgcn_mfma_f32_32x32x16_bf16(PAF(3),VFR(3),o[0],0,0,0), C1,8); \
    GAPB(o[1]=__builtin_amdgcn_mfma_f32_32x32x16_bf16(PAF(3),VFR(7),o[1],0,0,0), C1,12); \
    }while(0)
  #define ENDW(tt) do{ if((tt)+3<NT){WAIT_BAR(2);} else if((tt)+2<NT){WAIT_BAR(1);} else {WAIT_BAR(0);} }while(0)
  int t=1;
  for(;t<=3&&t+1<NT;t+=2){
    STEP(pB0,pB1,pA0,pA1,t,(t+3<NT),(t+1<NT),(t+1<NT));       ENDW(t);   RESC(); ROT();
    STEP(pA0,pA1,pB0,pB1,t+1,(t+4<NT),(t+2<NT),(t+2<NT));     ENDW(t+1); RESC(); ROT();
  }
  #undef CMASK
  #define CMASK(P0,P1,t) do{}while(0)
  for(;t+5<NT;t+=2){
    STEP(pB0,pB1,pA0,pA1,t,true,true,true);     WAIT_BAR(2); RESC(); ROT();
    STEP(pA0,pA1,pB0,pB1,t+1,true,true,true);   WAIT_BAR(2); RESC(); ROT();
  }
  for(;t+1<NT;t+=2){
    STEP(pB0,pB1,pA0,pA1,t,(t+3<NT),(t+1<NT),(t+1<NT));       ENDW(t);   RESC(); ROT();
    STEP(pA0,pA1,pB0,pB1,t+1,(t+4<NT),(t+2<NT),(t+2<NT));     ENDW(t+1); RESC(); ROT();
  }
  #undef CMASK
  #define CMASK(P0,P1,t) do{int jb_=3-(t); if(jb_>=0)cmask(P0,P1,jb_,qrel,hi);}while(0)
  STEP(pB0,pB1,pA0,pA1,NT-1,false,false,false); RESC();
  { float sacc=pB0[0]+pB0[1]; _Pragma("unroll") for(int r=2;r<16;++r)sacc+=pB0[r]; _Pragma("unroll") for(int r=0;r<16;++r)sacc+=pB1[r]; l_reg+=sacc;
    pw0=(u32x4){PKW(pB0,0),PKW(pB0,2),PKW(pB0,4),PKW(pB0,6)};pw1=(u32x4){PKW(pB0,8),PKW(pB0,10),PKW(pB0,12),PKW(pB0,14)};pw2=(u32x4){PKW(pB1,0),PKW(pB1,2),PKW(pB1,4),PKW(pB1,6)};pw3=(u32x4){PKW(pB1,8),PKW(pB1,10),PKW(pB1,12),PKW(pB1,14)};
    SBAR(); pv(o,vb0+sl_cur,PAF(0),PAF(1),PAF(2),PAF(3)); }
  #undef PKW
  #undef PAF
  #undef VFR
  #undef PIN
  #undef MX3
  #undef GAPA
  #undef GAPB
  #undef EX
  #undef VRD
  #undef KRD
  #undef STEP
  #undef ENDW
  {auto rr=__builtin_amdgcn_permlane32_swap(__float_as_uint(l_reg),__float_as_uint(l_reg),false,false);l_reg=__uint_as_float(rr[0])+__uint_as_float(rr[1]);}
  if(hi==0)wsf[32+r32]=l_reg;asm volatile("s_waitcnt lgkmcnt(0)":::"memory");
  float rli[16];
  #pragma unroll
  for(int r=0;r<16;++r)rli[r]=__builtin_amdgcn_rcpf(wsf[32+crow(r,hi)]);
  bf16*Ow=O+(rowbase+q0+wid*QBLK)*DM+h*D;
  { bf16*stg=(bf16*)(shm+LDS_OST)+wid*2048;
    #pragma unroll
    for(int r=0;r<16;++r){const int orow=crow(r,hi);
      #pragma unroll
      for(int d0=0;d0<2;++d0)stg[orow*64+d0*32+r32]=__float2bfloat16(o[d0][r]*rli[r]);}
    asm volatile("s_waitcnt lgkmcnt(0)":::"memory");
    #pragma unroll
    for(int i=0;i<4;++i){const int row=i*8+(lane>>3),ch=lane&7; const u32x4 v=*(const u32x4*)(stg+row*64+ch*8); ATTN_STORE16(Ow+(long)row*DM+ch*8,v);} }
  asm volatile("s_waitcnt lgkmcnt(0)\n\ts_barrier":::"memory");
  #undef DMA_K
  #undef DMA_V
  #undef CMASK
  #undef START
  #undef NBRD
  #undef NBSUB
  #undef RESC
  #undef ROT
}
constexpr int ATTN_LDS_BYTES=LDS_BYTES;
struct AttnTensors { const bf16* Q; const bf16* K; const bf16* V; bf16* O; const float* cum; };
struct AttnUnit { int bh; int qb; };
template<int THRL=8> __device__ __forceinline__ void attn_phase(char*lds,const AttnTensors&T,unsigned*qheads,const unsigned*norm,volatile __attribute__((address_space(3))) unsigned*bc){
  const int x=blockIdx.x&7;
  for(;;){
    if(threadIdx.x==0) bc[0]=__hip_atomic_fetch_add(qheads+64*x,1u,__ATOMIC_RELAXED,__HIP_MEMORY_SCOPE_AGENT);
    __syncthreads(); const unsigned idx=bc[0]; __syncthreads();
    if(idx>=64u) break;
    const int b=x>>2, h=(idx&1)?(x&3):7-(x&3), qb=31-(int)(idx>>1), bh=b*NHEAD+h;
    const float qn=(__uint_as_float(norm[(0*16+bh)*2])+__uint_as_float(norm[(0*16+bh)*2+1]))*1.02f, kn=(__uint_as_float(norm[(1*16+bh)*2])+__uint_as_float(norm[(1*16+bh)*2+1]))*1.02f;
    const float thr=2.0f*sqrtf(qn*kn)+160.0f;
    attn_unit<THRL>(b,h,qb,T.Q,T.K,T.V,T.O,lds,T.cum+(long)bh*SEQ,thr);
  }
}
#undef SBAR
#undef WAIT_BAR
}

__device__ __forceinline__ void ph_attn_fast(Frame& F) {
    F.lane = ltid(); F.tid = F.wave * 64 + F.lane;
    static_assert(attn_body::ATTN_LDS_BYTES <= 131072, "attention LDS");
    const attn_body::AttnTensors AT{(const attn_body::bf16*)F.Q, (const attn_body::bf16*)F.K, (const attn_body::bf16*)F.V, (attn_body::bf16*)F.O, F.CUM};
    attn_body::attn_phase<8>((char*)F.lds_generic, AT, F.ctl + CW_AQ, F.ctl + CW_NORM, (volatile LAS unsigned*)(F.lds + MISC_OFF + 64));
}

constexpr int NPHASE = 13;
#ifndef PROBE_PHASE
#define PROBE_PHASE -1
#endif
constexpr int N_LAUNCHES = 1;
__global__ void __launch_bounds__(NTHR, 2) fwd_kernel(Args args) {
    extern __shared__ __attribute__((aligned(16))) unsigned char lds_raw[];
    Frame F;
    F.lds = (LAS unsigned char*)lds_raw; F.lds_generic = lds_raw;
    F.tid = threadIdx.x; F.lane = F.tid & 63; F.wave = __builtin_amdgcn_readfirstlane(F.tid >> 6);
    F.gw = blockIdx.x * NWAVES + F.wave; F.NGW = gridDim.x * NWAVES;
    F.x = args.in[0]; F.c = args.in[1]; F.w_ada = args.in[2]; F.b_ada = args.in[3]; F.w_in = args.in[4]; F.b_forget = args.in[5]; F.conv_w = args.in[6]; F.conv_b = args.in[7];
    F.conv_ln_g = args.in[8]; F.conv_ln_b = args.in[9]; F.w_conv_out = args.in[10]; F.w_fox_out = args.in[11]; F.w_mix_out = args.in[12]; F.ln1_g = args.in[13]; F.ln1_b = args.in[14];
    F.w_router = args.in[15]; F.router_bias = args.in[16]; F.w_exp_gate = args.in[17]; F.w_exp_up = args.in[18]; F.w_exp_down = args.in[19]; F.w_sh_gate = args.in[20]; F.w_sh_up = args.in[21];
    F.w_sh_down = args.in[22]; F.ln2_g = args.in[23]; F.ln2_b = args.in[24];
    F.out = args.out; F.ws = args.ws; unsigned char* ws = args.ws;
    F.ctl = (unsigned*)(ws + WS_CTL);
    F.ADA = (float*)(ws + WS_ADA); F.ADAP = (float*)(ws + WS_ADAP); F.CUM = (float*)(ws + WS_CUM); F.LOGF = (float*)(ws + WS_LOGF); F.X1 = (float*)(ws + WS_X1); F.RL = (float*)(ws + WS_RL);
    F.LISTW = (float*)(ws + WS_LISTW); F.WFC = (float*)(ws + WS_WFC); F.LIST = (int*)(ws + WS_LIST);
    F.H = (bf16_t*)(ws + WS_H); F.U = (bf16_t*)(ws + WS_U); F.Q = (bf16_t*)(ws + WS_Q); F.K = (bf16_t*)(ws + WS_K); F.V = (bf16_t*)(ws + WS_V); F.AC = (bf16_t*)(ws + WS_AC); F.O = (bf16_t*)(ws + WS_O);
    F.GA = (bf16_t*)(ws + WS_GA); F.GB = (bf16_t*)(ws + WS_GB); F.YA = (bf16_t*)(ws + WS_YA); F.MG = (bf16_t*)(ws + WS_MG); F.YAS = (bf16_t*)(ws + WS_YAS); F.H2 = (bf16_t*)(ws + WS_H2);
    F.H2LO = (bf16_t*)(ws + WS_H2LO); F.SHID = (bf16_t*)(ws + WS_SHID); F.HID = (bf16_t*)(ws + WS_HID);
    const int lo = args.ph_lo, hi = args.ph_hi;
    volatile LAS unsigned* MISC = (volatile LAS unsigned*)(F.lds + MISC_OFF);
    for (int u = F.tid; u < 32; u += NTHR) MISC[u] = 0u;
    __syncthreads();
    XcdBarrier bar; bar.bar = F.ctl + CW_BAR; bar.x = 0; bar.st = MISC + 8;
    if (hi - lo > 1) bar = xcd_barrier_post(F.ctl + CW_BAR, MISC + 8);
#define IN(k) (lo <= (k) && (k) < hi)
#define SEAM(k) do { if (IN(k) && IN((k) + 1)) xcd_barrier(bar); } while (0)
    if (IN(0)) { { ph_ada(F); ph_convert(F, true); } if (PROBE_PHASE == 0) { __syncthreads(); { ph_ada(F); ph_convert(F, true); } } }
    SEAM(0);
    if (IN(1)) { ph_lnmod(F); if (PROBE_PHASE == 1) { __syncthreads(); ph_lnmod(F); } }
    SEAM(1);
    if (IN(2)) { { ph_scan(F); ph_inproj_fast(F); } if (PROBE_PHASE == 2) { __syncthreads(); { ph_scan(F); ph_inproj_fast(F); } } }
    SEAM(2);
    if (IN(3)) { {} if (PROBE_PHASE == 3) { __syncthreads(); {} } }
    SEAM(3);
    if (IN(4)) { ph_conv(F); __syncthreads(); if (PROBE_PHASE == 4) { ph_conv(F); __syncthreads(); } ph_attn_fast(F); }
    SEAM(4);
    if (IN(5)) { ph_merge_fast(F); if (PROBE_PHASE == 5) { __syncthreads(); ph_merge_fast(F); } }
    SEAM(5);
    if (IN(6)) { ph_mix_fast(F); if (PROBE_PHASE == 6) { __syncthreads(); ph_mix_fast(F); } }
    SEAM(6);
    if (IN(7)) { ph_ln2(F); if (PROBE_PHASE == 7) { __syncthreads(); ph_ln2(F); } }
    SEAM(7);
    if (IN(8)) { ph_router_fast(F); if (PROBE_PHASE == 8) { __syncthreads(); ph_router_fast(F); } }
    SEAM(8);
    if (IN(9)) { ph_route(F, 3); if (PROBE_PHASE == 9) { __syncthreads(); ph_route(F, 3); } }
    SEAM(9);
    if (IN(10)) { ph_moe1_fast(F); if (PROBE_PHASE == 10) { __syncthreads(); ph_moe1_fast(F); } }
    SEAM(10);
    if (IN(11)) { ph_moe2_fast(F); if (PROBE_PHASE == 11) { __syncthreads(); ph_moe2_fast(F); } }
    SEAM(11);
    if (IN(12)) { ph_combine(F); if (PROBE_PHASE == 12) { __syncthreads(); ph_combine(F); } }
#undef IN
#undef SEAM
}

extern "C" void kernel_launch(void* const* d_in, const int* in_sizes, int n_in, void* d_out, int out_size, void* d_ws, size_t ws_size, hipStream_t stream) {
    static int grid = 0;
    if (grid == 0) {
        if (n_in != 25 || out_size != T * D || ws_size < WS_END) { fprintf(stderr, "kernel_launch: unexpected sizes: n_in %d out %d ws %zu (need %zu)\n", n_in, out_size, ws_size, (size_t)WS_END); grid = -1; return; }
        int dev = 0, cus = 0, per_cu = 0;
        (void)hipGetDevice(&dev); (void)hipDeviceGetAttribute(&cus, hipDeviceAttributeMultiprocessorCount, dev);
        (void)hipFuncSetAttribute((const void*)fwd_kernel, hipFuncAttributeMaxDynamicSharedMemorySize, LDS_BYTES);
        (void)hipOccupancyMaxActiveBlocksPerMultiprocessor(&per_cu, (const void*)fwd_kernel, NTHR, LDS_BYTES);
        (void)hipGetLastError();
        if (per_cu < 1) { fprintf(stderr, "kernel_launch: occupancy query says %d blocks/CU\n", per_cu); }
        grid = cus > 0 ? cus : 256;
    }
    if (grid < 0) return;
    (void)hipMemsetAsync((char*)d_ws + WS_CTL, 0, CTL_BYTES, stream);
    Args a{};
    for (int i = 0; i < 25; ++i) a.in[i] = (const float*)d_in[i];
    a.out = (float*)d_out; a.ws = (unsigned char*)d_ws;
    if (N_LAUNCHES == 1) {
        a.ph_lo = 0; a.ph_hi = NPHASE;
        void* kargs[] = {(void*)&a};
        const hipError_t e = hipLaunchCooperativeKernel((const void*)fwd_kernel, dim3(grid), dim3(NTHR), kargs, LDS_BYTES, stream);
        if (e != hipSuccess) fprintf(stderr, "kernel_launch: cooperative launch failed: %s (grid %d)\n", hipGetErrorString(e), grid);
    } else {
        for (int p = 0; p < NPHASE; ++p) { a.ph_lo = p; a.ph_hi = p + 1; hipLaunchKernelGGL(fwd_kernel, dim3(grid), dim3(NTHR), LDS_BYTES, stream, a); }
    }
}
```

```cpp
#include <hip/hip_runtime.h>
#include <cstdio>
#include <cstdint>
#include <hip/hip_bf16.h>

#define LAS __attribute__((address_space(3)))
typedef unsigned short bf16_t;
typedef float f32x4 __attribute__((ext_vector_type(4)));
typedef unsigned u32x4 __attribute__((ext_vector_type(4)));
typedef unsigned u32x2 __attribute__((ext_vector_type(2)));

constexpr int NB = 2, S = 8192, D = 1024, T = NB * S;
constexpr int CC = 512, CW = 31, NH = 8, HD = 64, FW = 512;
constexpr int NE = 256, TOPK = 8, NG = 8, EH = 256, SHH = 256;
constexpr int INC = 4616;
constexpr int O_Q = 1024, O_K = 1536, O_V = 2048, O_F = 2560, O_GA = 2568, O_GB = 3592;
constexpr float LN_EPS = 1e-5f;
constexpr float ALPHA = 1.189207115002721f;
constexpr float LOG2E = 1.4426950408889634f;
constexpr float QSCALE = 0.125f * LOG2E;
constexpr float ROUTED_SCALE = 2.5f;
constexpr int NWAVES = 8, NTHR = 512;
constexpr int LCAP = 16384;
constexpr int NSLOT = 9;
constexpr int LDS_BYTES = 147456, MISC_OFF = 131072 + 320;

constexpr size_t MiB = 1u << 20;
constexpr size_t WS_CTL = 0, CTL_BYTES = 1 * MiB;
constexpr size_t WS_ADA = 1 * MiB;
constexpr size_t WS_ADAP = 1 * MiB + 64 * 1024;
constexpr size_t WS_CUM = 2 * MiB;
constexpr size_t WS_LOGF = 2 * MiB + 512 * 1024;
constexpr size_t WS_WFC = 3 * MiB + 512 * 1024;
constexpr size_t WS_H = 20 * MiB;
constexpr size_t WS_U = 52 * MiB, WS_Q = 68 * MiB, WS_K = 84 * MiB, WS_V = 100 * MiB, WS_AC = 116 * MiB, WS_O = 132 * MiB;
constexpr size_t WS_GA = 148 * MiB, WS_GB = 180 * MiB, WS_YA = 212 * MiB, WS_MG = 244 * MiB;
constexpr size_t WS_YAS = 20 * MiB;
constexpr size_t WS_X1 = 308 * MiB;
constexpr size_t WS_H2 = 372 * MiB, WS_H2LO = 404 * MiB;
constexpr size_t WS_RL = 436 * MiB;
constexpr size_t WS_SHID = 484 * MiB;
constexpr size_t WS_LIST = 492 * MiB, WS_LISTW = 508 * MiB;
constexpr size_t WS_HID = 524 * MiB;
constexpr size_t WS_END = 1024 * MiB;
constexpr int CW_CNT = 1024;
constexpr int CW_NORM = 2048;
constexpr int CW_AQ = 2304;

__device__ __forceinline__ float bf2f(bf16_t v) { return __uint_as_float((unsigned)v << 16); }
__device__ __forceinline__ unsigned f2bf(float f) { unsigned u = __float_as_uint(f); return (u + 0x7fffu + ((u >> 16) & 1u)) >> 16; }
__device__ __forceinline__ unsigned pk2(float lo, float hi) { return f2bf(lo) | (f2bf(hi) << 16); }
__device__ __forceinline__ float wave_sum(float v) {
#pragma unroll
    for (int o = 1; o < 64; o <<= 1) v += __shfl_xor(v, o);
    return v;
}
__device__ __forceinline__ float wave_max(float v) {
#pragma unroll
    for (int o = 1; o < 64; o <<= 1) v = fmaxf(v, __shfl_xor(v, o));
    return v;
}
__device__ __forceinline__ int ltid() { int t = (int)__builtin_amdgcn_mbcnt_hi(~0u, __builtin_amdgcn_mbcnt_lo(~0u, 0u)); asm volatile("" : "+v"(t)); return t; }
__device__ __forceinline__ float sigmoidf_(float x) { return 1.0f / (1.0f + expf(-x)); }
__device__ __forceinline__ float siluf_(float x) { return x / (1.0f + expf(-x)); }


constexpr int CW_BAR = 4096;
#define XB_TMO      128
#define XB_XCNT(j)  (256  + 64 * (j))
#define XB_XSUB(j)  (1280 + 64 * (j))
#define XB_XGEN(j)  (2304 + 64 * (j))
#define XB_TOP      3328
#define XB_TOPGEN   3392
#define XCD_BAR_WORDS 3456
#define XB_SPIN_CAP (1u << 20)
__device__ __forceinline__ unsigned xb_ld(unsigned* p)              { return __hip_atomic_load(p, __ATOMIC_RELAXED, __HIP_MEMORY_SCOPE_AGENT); }
__device__ __forceinline__ unsigned xb_add(unsigned* p, unsigned v) { return __hip_atomic_fetch_add(p, v, __ATOMIC_RELAXED, __HIP_MEMORY_SCOPE_AGENT); }
__device__ __forceinline__ unsigned xb_xcc_id() { return (unsigned)__builtin_amdgcn_s_getreg((3 << 11) | 20) & 0xFu; }
#define XB_SPIN(cond, bar) do { unsigned _sp = 0; while (cond) { __builtin_amdgcn_s_sleep(1); \
    if ((++_sp & 255u) == 0u) { if (xb_ld(&(bar)[XB_TMO])) break; if (_sp > XB_SPIN_CAP) { atomicAdd(&(bar)[XB_TMO], 1u); break; } } } } while (0)
struct XcdBarrier { unsigned* bar; unsigned x; volatile LAS unsigned* st; };
__device__ __forceinline__ XcdBarrier xcd_barrier_post(unsigned* bar, volatile LAS unsigned* st) {
    XcdBarrier b; b.bar = bar; b.x = xb_xcc_id(); b.st = st;
    if (threadIdx.x == 0) st[4] = xb_add(&bar[XB_XCNT(b.x)], 1u);
    return b;
}
__device__ __forceinline__ void xcd_barrier_complete(unsigned* bar, unsigned x, unsigned& nloc, unsigned& nx) {
    const unsigned G = gridDim.x * gridDim.y * gridDim.z;
    unsigned sum, cnt, mine, sp = 0u;
    for (;;) {
        sum = 0u; cnt = 0u; mine = 0u;
#pragma unroll
        for (unsigned j = 0; j < 16; ++j) { const unsigned c = xb_ld(&bar[XB_XCNT(j)]); sum += c; cnt += (c > 0u) ? 1u : 0u; mine = (j == x) ? c : mine; }
        if (sum == G) break;
        __builtin_amdgcn_s_sleep(1);
        if ((++sp & 255u) == 0u) { if (xb_ld(&bar[XB_TMO])) break; if (sp > XB_SPIN_CAP) { atomicAdd(&bar[XB_TMO], 1u); break; } }
    }
    nloc = mine > 0u ? mine : 1u; nx = cnt > 0u ? cnt : 1u;
}
__device__ __forceinline__ void xcd_barrier(const XcdBarrier& b) {
    asm volatile("s_waitcnt vmcnt(0)" ::: "memory");
    __syncthreads();
    if (threadIdx.x == 0) {
        unsigned* bar = b.bar;
        __builtin_amdgcn_s_waitcnt(0);
        unsigned nloc = b.st[0], nx = b.st[1];
        if (nloc == 0u) { xcd_barrier_complete(bar, b.x, nloc, nx); b.st[0] = nloc; b.st[1] = nx; }
        const unsigned old = xb_add(&bar[XB_XSUB(b.x)], 1u);
        const unsigned gen = old / nloc;
        if (old + 1u == (gen + 1u) * nloc) {
            __builtin_amdgcn_fence(__ATOMIC_RELEASE, "agent");
            asm volatile("s_waitcnt vmcnt(0)" ::: "memory");
            const unsigned og = xb_add(&bar[XB_TOP], 1u);
            const unsigned tg = og / nx;
            if (og + 1u == (tg + 1u) * nx) xb_add(&bar[XB_TOPGEN], 1u);
            else XB_SPIN(xb_ld(&bar[XB_TOPGEN]) == tg, bar);
            __builtin_amdgcn_fence(__ATOMIC_ACQUIRE, "agent");
            xb_add(&bar[XB_XGEN(b.x)], 1u);
            asm volatile("s_waitcnt vmcnt(0)" ::: "memory");
        } else {
            XB_SPIN(xb_ld(&bar[XB_XGEN(b.x)]) == gen, bar);
            __builtin_amdgcn_fence(__ATOMIC_ACQUIRE, "agent");
            asm volatile("s_waitcnt vmcnt(0)" ::: "memory");
        }
    }
    __syncthreads();
}

struct Args { const float* in[25]; float* out; unsigned char* ws; int ph_lo, ph_hi; };

struct Frame {
    LAS unsigned char* lds; unsigned char* lds_generic;
    int tid, lane, wave, gw, NGW, vid;
    const float *x, *c, *w_ada, *b_ada, *w_in, *b_forget, *conv_w, *conv_b, *conv_ln_g, *conv_ln_b, *w_conv_out, *w_fox_out, *w_mix_out, *ln1_g, *ln1_b,
        *w_router, *router_bias, *w_exp_gate, *w_exp_up, *w_exp_down, *w_sh_gate, *w_sh_up, *w_sh_down, *ln2_g, *ln2_b;
    float* out; unsigned char* ws;
    unsigned* ctl;
    float *ADA, *ADAP, *CUM, *LOGF, *X1, *RL, *LISTW, *WFC;
    bf16_t *H, *U, *Q, *K, *V, *AC, *O, *GA, *GB, *YA, *MG, *YAS, *H2, *H2LO, *SHID, *HID;
    int* LIST;
};

__device__ __forceinline__ void ph_ada(Frame& F) {
    F.lane = ltid(); F.tid = F.wave * 64 + F.lane;
    if (blockIdx.x == gridDim.x - 1) for (int i = F.tid; i < 8192; i += NTHR) { const int k = i >> 3, hh = i & 7; F.WFC[hh * 1024 + k] = F.w_in[(size_t)k * INC + O_F + hh]; }
    if (blockIdx.x >= 24) return;
    LAS float* part = (LAS float*)F.lds;
    const float* c = F.c; const float* w = F.w_ada;
    const int j0 = blockIdx.x * 256 + F.lane * 4, kc = F.wave;
    f32x4 a0 = {0.f, 0.f, 0.f, 0.f}, a1 = {0.f, 0.f, 0.f, 0.f};
#pragma unroll 8
    for (int k = kc * 128; k < kc * 128 + 128; ++k) {
        const f32x4 wv = *(const f32x4*)(w + (size_t)k * 6144 + j0);
        const float c0 = siluf_(c[k]), c1 = siluf_(c[D + k]);
        a0 += wv * c0; a1 += wv * c1;
    }
    *(LAS f32x4*)(part + (kc * 2 + 0) * 256 + F.lane * 4) = a0;
    *(LAS f32x4*)(part + (kc * 2 + 1) * 256 + F.lane * 4) = a1;
    __syncthreads();
    { const int b = F.tid >> 8, j = F.tid & 255; float s = F.b_ada[blockIdx.x * 256 + j];
#pragma unroll
      for (int p = 0; p < 8; ++p) s += part[(p * 2 + b) * 256 + j];
      F.ADA[b * 6144 + blockIdx.x * 256 + j] = s; }
    __syncthreads();
}

__device__ __forceinline__ float wave_sum8(const float (&a)[8], int lane) {
    float b[4], c[2];
#pragma unroll
    for (int i = 0; i < 4; ++i) { const float keep = (lane & 1) ? a[2 * i + 1] : a[2 * i], send = (lane & 1) ? a[2 * i] : a[2 * i + 1]; b[i] = keep + __shfl_xor(send, 1); }
#pragma unroll
    for (int i = 0; i < 2; ++i) { const float keep = (lane & 2) ? b[2 * i + 1] : b[2 * i], send = (lane & 2) ? b[2 * i] : b[2 * i + 1]; c[i] = keep + __shfl_xor(send, 2); }
    float d = ((lane & 4) ? c[1] : c[0]) + __shfl_xor((lane & 4) ? c[0] : c[1], 4);
    d += __shfl_xor(d, 8); d += __shfl_xor(d, 16); d += __shfl_xor(d, 32);
    return d;
}
__device__ __forceinline__ void ph_lnmod(Frame& F) {
    F.lane = ltid(); F.tid = F.wave * 64 + F.lane;
    LAS float* ada1 = (LAS float*)F.lds;
    LAS float* wf = ada1 + 4096;
    for (int i = F.tid; i < 1024; i += NTHR) { const int b = i >> 9, j = (i & 511) * 4; *(LAS f32x4*)(ada1 + b * 2048 + j) = *(const f32x4*)(F.ADA + b * 6144 + j); }
    for (int i = F.tid; i < 2048; i += NTHR) *(LAS f32x4*)(wf + 4 * i) = *(const f32x4*)(F.WFC + 4 * i);
    __syncthreads();
    const int lane = F.lane;
    constexpr int R = 4;
    for (int m0 = F.gw * R; m0 < T; m0 += F.NGW * R) {
        f32x4 v[R][4]; float mean[R], rstd[R];
#pragma unroll
        for (int r = 0; r < R; ++r) { const f32x4* xr = (const f32x4*)(F.x + (size_t)(m0 + r) * D) + lane;
#pragma unroll
            for (int j = 0; j < 4; ++j) v[r][j] = xr[64 * j]; }
#pragma unroll
        for (int r = 0; r < R; ++r) { float s = 0.f;
#pragma unroll
            for (int j = 0; j < 4; ++j) s += (v[r][j].x + v[r][j].y) + (v[r][j].z + v[r][j].w);
            mean[r] = wave_sum(s) * (1.f / D); }
#pragma unroll
        for (int r = 0; r < R; ++r) { float s2 = 0.f;
#pragma unroll
            for (int j = 0; j < 4; ++j) { v[r][j] = v[r][j] - mean[r]; s2 += (v[r][j].x * v[r][j].x + v[r][j].y * v[r][j].y) + (v[r][j].z * v[r][j].z + v[r][j].w * v[r][j].w); }
            rstd[r] = 1.f / sqrtf(wave_sum(s2) * (1.f / D) + LN_EPS); }
#pragma unroll
        for (int r = 0; r < R; ++r) { const int m = m0 + r, b = m >> 13;
            float fl[8];
#pragma unroll
            for (int hh = 0; hh < 8; ++hh) fl[hh] = 0.f;
            u32x2* hrow = (u32x2*)(F.H + (size_t)m * D) + lane;
#pragma unroll
            for (int j = 0; j < 4; ++j) { const int col = 4 * lane + 256 * j;
                const f32x4 sh = *(const LAS f32x4*)(ada1 + b * 2048 + col), sc = *(const LAS f32x4*)(ada1 + b * 2048 + 1024 + col);
                const f32x4 h = v[r][j] * rstd[r] * (sc + 1.0f) + sh;
                u32x2 o; o.x = pk2(h.x, h.y); o.y = pk2(h.z, h.w); hrow[64 * j] = o;
#pragma unroll
                for (int hh = 0; hh < 8; ++hh) { const f32x4 w = *(const LAS f32x4*)(wf + hh * 1024 + col); fl[hh] += (h.x * w.x + h.y * w.y) + (h.z * w.z + h.w * w.w); }
                asm volatile("" ::: "memory"); }
            const float f = wave_sum8(fl, lane);
            if (lane < 8) { const float z = f + F.b_forget[lane]; F.LOGF[(size_t)m * 8 + lane] = fminf(z, 0.f) - log1pf(expf(-fabsf(z))); } }
    }
}

__device__ __forceinline__ void ph_scan(Frame& F) {
    F.lane = ltid(); F.tid = F.wave * 64 + F.lane;
    if (blockIdx.x >= 16) return;
    LAS double* sc = (LAS double*)F.lds;
    const int bh = blockIdx.x, b = bh >> 3, hh = bh & 7, s0 = F.tid * 16;
    double loc[16]; double run = 0.0;
#pragma unroll
    for (int i = 0; i < 16; ++i) { run += (double)F.LOGF[(size_t)(b * S + s0 + i) * 8 + hh]; loc[i] = run; }
    sc[F.tid] = run;
    __syncthreads();
    double off = 0.0;
    for (int i = 0; i < F.tid; ++i) off += sc[i];
#pragma unroll
    for (int i = 0; i < 16; ++i) F.CUM[(size_t)bh * S + s0 + i] = (float)(off + loc[i]);
    __syncthreads();
}

__device__ __forceinline__ void ph_conv(Frame& F) {
    F.lane = ltid(); F.tid = F.wave * 64 + F.lane;
    constexpr int RUN = 8, NIN = RUN + CW - 1, PADJ = RUN - 1, NTAB = CW + 2 * PADJ + 2;
    LAS float* cw = (LAS float*)F.lds;
    LAS float* cb = cw + NTAB * CC;
    for (int i = F.tid; i < NTAB * CC / 4; i += NTHR) { const int jj = (4 * i) / CC, j = jj - PADJ;
        *(LAS f32x4*)(cw + 4 * i) = (j >= 0 && j < CW) ? *(const f32x4*)(F.conv_w + (size_t)j * CC + (4 * i) % CC) : (f32x4){0.f, 0.f, 0.f, 0.f}; }
    for (int i = F.tid; i < CC; i += NTHR) { cb[i] = F.conv_b[i]; cb[CC + i] = F.conv_ln_g[i]; cb[2 * CC + i] = F.conv_ln_b[i]; }
    __syncthreads();
    const int lane = F.lane, c0 = lane * 8;
    for (int run = F.gw; run < T / RUN; run += F.NGW) {
        const int m0 = run * RUN, t0 = m0 & (S - 1);
        float a[RUN][8];
#pragma unroll
        for (int r = 0; r < RUN; ++r)
#pragma unroll
            for (int i = 0; i < 8; ++i) a[r][i] = cb[c0 + i];
#pragma unroll 1
        for (int c = 0; c < (NIN + 7) / 8; ++c) {
            u32x4 uv[8];
#pragma unroll
            for (int k = 0; k < 8; ++k) { const int i = 8 * c + k; uv[k] = (u32x4){0u, 0u, 0u, 0u};
                if (i < NIN && t0 - (CW - 1) + i >= 0) uv[k] = *(const u32x4*)(F.U + (size_t)(m0 - (CW - 1) + i) * CC + c0); }
            float u[8][8];
#pragma unroll
            for (int k = 0; k < 8; ++k) {
                u[k][0] = __uint_as_float(uv[k].x << 16); u[k][1] = __uint_as_float(uv[k].x & 0xffff0000u); u[k][2] = __uint_as_float(uv[k].y << 16); u[k][3] = __uint_as_float(uv[k].y & 0xffff0000u);
                u[k][4] = __uint_as_float(uv[k].z << 16); u[k][5] = __uint_as_float(uv[k].z & 0xffff0000u); u[k][6] = __uint_as_float(uv[k].w << 16); u[k][7] = __uint_as_float(uv[k].w & 0xffff0000u); }
#pragma unroll
            for (int d = -(RUN - 1); d < 8; ++d) {
                const LAS float* wrow = cw + (8 * c + d + PADJ) * CC + c0;
                const f32x4 w0 = *(const LAS f32x4*)(wrow), w1 = *(const LAS f32x4*)(wrow + 4);
#pragma unroll
                for (int r = 0; r < RUN; ++r) { const int k = r + d;
                    if (k >= 0 && k < 8) {
                        a[r][0] += u[k][0] * w0.x; a[r][1] += u[k][1] * w0.y; a[r][2] += u[k][2] * w0.z; a[r][3] += u[k][3] * w0.w;
                        a[r][4] += u[k][4] * w1.x; a[r][5] += u[k][5] * w1.y; a[r][6] += u[k][6] * w1.z; a[r][7] += u[k][7] * w1.w; } }
                asm volatile("" ::: "memory"); }
        }
#pragma unroll
        for (int r = 0; r < RUN; ++r) {
            float s = 0.f;
#pragma unroll
            for (int i = 0; i < 8; ++i) s += a[r][i];
            const float mean = wave_sum(s) * (1.f / CC); float s2 = 0.f;
#pragma unroll
            for (int i = 0; i < 8; ++i) { a[r][i] -= mean; s2 += a[r][i] * a[r][i]; }
            const float rstd = 1.f / sqrtf(wave_sum(s2) * (1.f / CC) + LN_EPS);
            float y[8];
#pragma unroll
            for (int i = 0; i < 8; ++i) y[i] = siluf_(a[r][i] * rstd * cb[CC + c0 + i] + cb[2 * CC + c0 + i]);
            u32x4 o; o.x = pk2(y[0], y[1]); o.y = pk2(y[2], y[3]); o.z = pk2(y[4], y[5]); o.w = pk2(y[6], y[7]);
            *(u32x4*)(F.AC + (size_t)(m0 + r) * CC + c0) = o;
        }
    }
}

__device__ __forceinline__ void ph_ln2(Frame& F) {
    F.lane = ltid(); F.tid = F.wave * 64 + F.lane;
    const int lane = F.lane;
    constexpr int R = 4;
    for (int m0 = F.gw * R; m0 < T; m0 += F.NGW * R) {
        f32x4 v[R][4]; float mean[R], rstd[R];
#pragma unroll
        for (int r = 0; r < R; ++r) { const f32x4* zr = (const f32x4*)(F.X1 + (size_t)(m0 + r) * D) + lane;
#pragma unroll
            for (int j = 0; j < 4; ++j) v[r][j] = zr[64 * j]; }
#pragma unroll
        for (int r = 0; r < R; ++r) { float s = 0.f;
#pragma unroll
            for (int j = 0; j < 4; ++j) s += (v[r][j].x + v[r][j].y) + (v[r][j].z + v[r][j].w);
            mean[r] = wave_sum(s) * (1.f / D); }
#pragma unroll
        for (int r = 0; r < R; ++r) { float s2 = 0.f;
#pragma unroll
            for (int j = 0; j < 4; ++j) { v[r][j] = v[r][j] - mean[r]; s2 += (v[r][j].x * v[r][j].x + v[r][j].y * v[r][j].y) + (v[r][j].z * v[r][j].z + v[r][j].w * v[r][j].w); }
            rstd[r] = 1.f / sqrtf(wave_sum(s2) * (1.f / D) + LN_EPS); }
#pragma unroll
        for (int r = 0; r < R; ++r) { f32x4* zr = (f32x4*)(F.X1 + (size_t)(m0 + r) * D) + lane; float s = 0.f;
#pragma unroll
            for (int j = 0; j < 4; ++j) { const int col = 4 * lane + 256 * j;
                v[r][j] = v[r][j] * rstd[r] * *(const f32x4*)(F.ln1_g + col) + *(const f32x4*)(F.ln1_b + col);
                zr[64 * j] = v[r][j]; s += (v[r][j].x + v[r][j].y) + (v[r][j].z + v[r][j].w); }
            mean[r] = wave_sum(s) * (1.f / D); }
#pragma unroll
        for (int r = 0; r < R; ++r) { float s2 = 0.f;
#pragma unroll
            for (int j = 0; j < 4; ++j) { v[r][j] = v[r][j] - mean[r]; s2 += (v[r][j].x * v[r][j].x + v[r][j].y * v[r][j].y) + (v[r][j].z * v[r][j].z + v[r][j].w * v[r][j].w); }
            rstd[r] = 1.f / sqrtf(wave_sum(s2) * (1.f / D) + LN_EPS); }
#pragma unroll
        for (int r = 0; r < R; ++r) { const int m = m0 + r, b = m >> 13;
            u32x2* hr = (u32x2*)(F.H2 + (size_t)m * D) + lane; u32x2* lr = (u32x2*)(F.H2LO + (size_t)m * D) + lane;
#pragma unroll
            for (int j = 0; j < 4; ++j) { const int col = 4 * lane + 256 * j;
                const f32x4 sh = *(const f32x4*)(F.ADA + b * 6144 + 3072 + col), sc = *(const f32x4*)(F.ADA + b * 6144 + 4096 + col);
                const f32x4 h = v[r][j] * rstd[r] * (sc + 1.0f) + sh;
                const unsigned h0 = f2bf(h.x), h1 = f2bf(h.y), h2 = f2bf(h.z), h3 = f2bf(h.w);
                u32x2 o; o.x = h0 | (h1 << 16); o.y = h2 | (h3 << 16); hr[64 * j] = o;
                u32x2 l; l.x = pk2(h.x - __uint_as_float(h0 << 16), h.y - __uint_as_float(h1 << 16)); l.y = pk2(h.z - __uint_as_float(h2 << 16), h.w - __uint_as_float(h3 << 16)); lr[64 * j] = l; } }
    }
}

__device__ __forceinline__ void ph_route(Frame& F, int nparts) {
    F.lane = ltid(); F.tid = F.wave * 64 + F.lane;
    const int lane = F.lane;
    for (int t = F.gw; t < T; t += F.NGW) {
        f32x4 lg = *(const f32x4*)(F.RL + (size_t)t * NE + lane * 4);
        for (int p = 1; p < nparts; ++p) lg += *(const f32x4*)(F.RL + (size_t)p * T * NE + (size_t)t * NE + lane * 4);
        const f32x4 bias = *(const f32x4*)(F.router_bias + lane * 4);
        float sc[4], sel[4];
#pragma unroll
        for (int i = 0; i < 4; ++i) { sc[i] = sigmoidf_(lg[i]); sel[i] = sc[i] + bias[i]; }
        float a1 = fmaxf(sel[0], sel[1]), a2 = fminf(sel[0], sel[1]);
        { const float b1 = fmaxf(sel[2], sel[3]), b2 = fminf(sel[2], sel[3]); const float n1 = fmaxf(a1, b1), n2 = fmaxf(fminf(a1, b1), fmaxf(a2, b2)); a1 = n1; a2 = n2; }
#pragma unroll
        for (int o = 1; o < 8; o <<= 1) { const float b1 = __shfl_xor(a1, o), b2 = __shfl_xor(a2, o); const float n1 = fmaxf(a1, b1), n2 = fmaxf(fminf(a1, b1), fmaxf(a2, b2)); a1 = n1; a2 = n2; }
        const float gs = a1 + a2; const int g = lane >> 3;
        int rank = 0;
#pragma unroll
        for (int gg = 0; gg < NG; ++gg) { const float og = __shfl(gs, gg * 8); rank += (og > gs || (og == gs && gg < g)) ? 1 : 0; }
        const bool gsel = rank < 4;
        float mv[4];
#pragma unroll
        for (int i = 0; i < 4; ++i) mv[i] = gsel ? sel[i] : -INFINITY;
        float myw = 0.f; int mye = 0; float wsum = 0.f;
#pragma unroll
        for (int k = 0; k < TOPK; ++k) {
            float bv = mv[0]; int bi = 0;
#pragma unroll
            for (int i = 1; i < 4; ++i) if (mv[i] > bv) { bv = mv[i]; bi = i; }
            int be = lane * 4 + bi; float bs = sc[0];
#pragma unroll
            for (int i = 1; i < 4; ++i) bs = (bi == i) ? sc[i] : bs;
            float v = bv; int e = be; float s = bs;
#pragma unroll
            for (int o = 1; o < 64; o <<= 1) { const float ov = __shfl_xor(v, o); const int oe = __shfl_xor(e, o); const float os = __shfl_xor(s, o);
                if (ov > v || (ov == v && oe < e)) { v = ov; e = oe; s = os; } }
            if ((e >> 2) == lane) {
#pragma unroll
                for (int i = 0; i < 4; ++i) if ((e & 3) == i) mv[i] = -INFINITY; }
            wsum += s;
            if (lane == k) { myw = s; mye = e; }
        }
        if (lane < TOPK) {
            const float w = myw / wsum * ROUTED_SCALE;
            const unsigned p = atomicAdd(F.ctl + CW_CNT + mye, 1u);
            F.LIST[(size_t)mye * LCAP + p] = t * TOPK + lane;
            F.LISTW[(size_t)mye * LCAP + p] = w;
        }
    }
}

__device__ __forceinline__ void build_expert_map(Frame& F, LAS int* pref, LAS int* base, int rows_per_chunk) {
    __syncthreads();
    if (F.tid == 0) { int p = 0, bsum = 0;
        for (int e = 0; e < NE; ++e) { const int n = (int)F.ctl[CW_CNT + e]; pref[e] = p; base[e] = bsum; p += (n + rows_per_chunk - 1) / rows_per_chunk; bsum += n; }
        pref[NE] = p; base[NE] = bsum; }
    __syncthreads();
}
__device__ __forceinline__ int find_expert(const LAS int* pref, int u) { int lo = 0, hi = NE - 1;
    while (lo < hi) { const int mid = (lo + hi + 1) >> 1; if (pref[mid] <= u) lo = mid; else hi = mid - 1; }
    return lo; }

__device__ __forceinline__ void ph_combine(Frame& F) {
    F.lane = ltid(); F.tid = F.wave * 64 + F.lane;
    const int lane = F.lane;
    constexpr int R = 2;
    for (int m0 = F.gw * R; m0 < T; m0 += F.NGW * R) {
        f32x4 y[R][4];
#pragma unroll
        for (int r = 0; r < R; ++r) {
            u32x4 w[NSLOT][2];
#pragma unroll
            for (int k = 0; k < NSLOT; ++k) { const u32x4* yr = (const u32x4*)(F.YAS + ((size_t)(m0 + r) * NSLOT + k) * D) + lane; w[k][0] = yr[0]; w[k][1] = yr[64]; }
#pragma unroll
            for (int j = 0; j < 4; ++j) y[r][j] = (f32x4){0.f, 0.f, 0.f, 0.f};
#pragma unroll
            for (int k = 0; k < NSLOT; ++k)
#pragma unroll
                for (int q = 0; q < 2; ++q) { const u32x4 t = w[k][q];
                    y[r][2 * q].x += __uint_as_float(t.x << 16); y[r][2 * q].y += __uint_as_float(t.x & 0xffff0000u); y[r][2 * q].z += __uint_as_float(t.y << 16); y[r][2 * q].w += __uint_as_float(t.y & 0xffff0000u);
                    y[r][2 * q + 1].x += __uint_as_float(t.z << 16); y[r][2 * q + 1].y += __uint_as_float(t.z & 0xffff0000u); y[r][2 * q + 1].z += __uint_as_float(t.w << 16); y[r][2 * q + 1].w += __uint_as_float(t.w & 0xffff0000u); }
        }
#pragma unroll
        for (int r = 0; r < R; ++r) { const int m = m0 + r, b = m >> 13;
            f32x4 v[4]; float s = 0.f;
#pragma unroll
            for (int j = 0; j < 4; ++j) { const int col = (j >> 1) * 512 + 8 * lane + 4 * (j & 1); const f32x4 g2 = *(const f32x4*)(F.ADA + b * 6144 + 5120 + col);
                v[j] = *(const f32x4*)(F.X1 + (size_t)m * D + col) * ALPHA + (g2 + 1.0f) * y[r][j]; s += (v[j].x + v[j].y) + (v[j].z + v[j].w); }
            const float mean = wave_sum(s) * (1.f / D); float s2 = 0.f;
#pragma unroll
            for (int j = 0; j < 4; ++j) { v[j] = v[j] - mean; s2 += (v[j].x * v[j].x + v[j].y * v[j].y) + (v[j].z * v[j].z + v[j].w * v[j].w); }
            const float rstd = 1.f / sqrtf(wave_sum(s2) * (1.f / D) + LN_EPS);
#pragma unroll
            for (int j = 0; j < 4; ++j) { const int col = (j >> 1) * 512 + 8 * lane + 4 * (j & 1); *(f32x4*)(F.out + (size_t)m * D + col) = v[j] * rstd * *(const f32x4*)(F.ln2_g + col) + *(const f32x4*)(F.ln2_b + col); } }
    }
}

namespace pg8 {
typedef short bf16x8 __attribute__((ext_vector_type(8)));
constexpr int BM = 256, BK = 64, HALF = 128, HTB = HALF * BK * 2, STAGE_BYTES = 8 * HTB, NXCD = 8, WGM = 8;
constexpr int RTAB_OFF = 131072 + 4096;
constexpr int XTAB_OFF = RTAB_OFF + 2048;
__host__ __device__ __forceinline__ int lds_byte(int r, int c) { const int st = (r >> 4) * 2 + (c >> 5), rr = r & 15, cc = c & 31, ob = rr * 64 + cc * 2; return st * 1024 + (ob ^ (((ob >> 9) & 1) << 5)); }
__host__ __device__ __forceinline__ void stage_rc(int b, int& R, int& C) { const int st = b / 1024, sb = b % 1024, swz = sb ^ (((sb >> 9) & 1) << 5); R = (st >> 1) * 16 + swz / 64; C = (st & 1) * 32 + (swz % 64) / 2; }
__host__ __device__ __forceinline__ int perm32(int rho) { const int n = rho >> 4, i = rho & 15; return 8 * (i >> 2) + 4 * n + (i & 3); }

struct Unit { const char* A; const char* B; const char* B2; int pm, pn, e, p0, ne, bs; };

struct TileOrder {
    int nM, nN, nwg, G, c;
    __device__ void init(int nM_, int nN_, int G_, int c_) { nM = nM_; nN = nN_; nwg = nM * nN; G = G_; c = c_; }
    __device__ bool tile(int i, int& pm, int& pn) const {
        const long L = (long)i * G + c; if (L >= nwg) return false;
        int wgid = (int)L; { const int q = nwg / NXCD, r = nwg % NXCD, xcd = wgid % NXCD, off = wgid / NXCD; wgid = (xcd < r ? xcd * (q + 1) : r * (q + 1) + (xcd - r) * q) + off; }
        const int nig = WGM * nN, gid = wgid / nig, fm = gid * WGM, gsz = (nM - fm) < WGM ? (nM - fm) : WGM;
        pm = fm + ((wgid % nig) % gsz); pn = (wgid % nig) / gsz; return true;
    }
};

__device__ __forceinline__ unsigned cvt_pk_bf16(float lo, float hi) { unsigned r; asm volatile("v_cvt_pk_bf16_f32 %0, %1, %2" : "=v"(r) : "v"(lo), "v"(hi)); return r; }
__device__ __forceinline__ float fsigmoid(float x) { return __builtin_amdgcn_rcpf(1.0f + __builtin_amdgcn_exp2f(-LOG2E * x)); }

template <class Epi, class Sched, bool ALIGN_EPI>
__device__ __forceinline__ void gemm_phase(LAS unsigned char* lds, const int K, const int lda, const int ldb, const Sched& S, const Epi& E) {
    const int wid = __builtin_amdgcn_readfirstlane((int)threadIdx.x >> 6), lane = ltid(), tid = wid * 64 + lane, wr = wid >> 2, wc = wid & 3, fr = lane & 15, fq = lane >> 4;
    int nt = K / BK; asm volatile("" : "+s"(nt));
    int RA[2]; unsigned CA[2], voffB[2];
#pragma unroll
    for (int i = 0; i < 2; ++i) { int R, C; stage_rc(tid * 16 + i * 8192, R, C); const int Rb = (R & ~31) + perm32(R & 31);
        RA[i] = R; CA[i] = (unsigned)C * 2u; voffB[i] = (unsigned)(Rb * ldb + C) * 2u; }
    const size_t kstep = (size_t)(BK * 2);
    const size_t hstepB = (size_t)HALF * ldb * 2;
    const unsigned ldsw = (unsigned)wid * 1024u;
    const int aoff = lds_byte(wr * 64 + fr, fq * 8), boff = lds_byte(wc * 32 + fr, fq * 8);
#define PG8_SA(b, h) (((b) * 2 + (h)) * HTB)
#define PG8_SB(b, h) ((4 + (b) * 2 + (h)) * HTB)
#define PG8_STAGE(bufoff, gbase, voff) do { _Pragma("unroll") for (int _i = 0; _i < 2; ++_i) \
        __builtin_amdgcn_global_load_lds((const unsigned*)((const char*)(gbase) + (voff)[_i]), (LAS unsigned*)(lds + (bufoff) + ldsw + _i * 8192), 16, 0, 0); } while (0)
#define PG8_STAGE_NT(bufoff, gbase, voff) do { _Pragma("unroll") for (int _i = 0; _i < 2; ++_i) \
        __builtin_amdgcn_global_load_lds((const unsigned*)((const char*)(gbase) + (voff)[_i]), (LAS unsigned*)(lds + (bufoff) + ldsw + _i * 8192), 16, 0, 2); } while (0)
#define PG8_LDA(dst, b, h) do { _Pragma("unroll") for (int m = 0; m < 4; ++m) _Pragma("unroll") for (int k = 0; k < 2; ++k) dst[m][k] = *(const LAS bf16x8*)(lds + PG8_SA(b, h) + aoff + m * 2048 + k * 1024); } while (0)
#define PG8_LDB(dst, b, h) do { _Pragma("unroll") for (int n = 0; n < 2; ++n) _Pragma("unroll") for (int k = 0; k < 2; ++k) dst[n][k] = *(const LAS bf16x8*)(lds + PG8_SB(b, h) + boff + n * 2048 + k * 1024); } while (0)
#define PG8_MMA(ai, bj, At, Bt) do { __builtin_amdgcn_s_setprio(1); _Pragma("unroll") for (int m = 0; m < 4; ++m) _Pragma("unroll") for (int n = 0; n < 2; ++n) _Pragma("unroll") for (int k = 0; k < 2; ++k) \
        acc[ai][bj][m][n] = __builtin_amdgcn_mfma_f32_16x16x32_bf16(Bt[n][k], At[m][k], acc[ai][bj][m][n], 0, 0, 0); __builtin_amdgcn_s_setprio(0); } while (0)
#define PG8_WAIT_V(n) asm volatile("s_waitcnt vmcnt(" #n ")" ::: "memory")
#define PG8_WAIT_L(n) asm volatile("s_waitcnt lgkmcnt(" #n ")" ::: "memory")
#define PG8_BAR __builtin_amdgcn_s_barrier()
#define PG8_SCHED __builtin_amdgcn_sched_barrier(0)
    Unit cur, nxt; int ui = 0;
    if (!S.next(0, cur)) return;
    f32x4 acc[2][2][4][2];
#pragma unroll
    for (int a = 0; a < 2; ++a)
#pragma unroll
        for (int b = 0; b < 2; ++b)
#pragma unroll
            for (int m = 0; m < 4; ++m)
#pragma unroll
                for (int n = 0; n < 2; ++n) acc[a][b][m][n] = (f32x4){0.f, 0.f, 0.f, 0.f};
    bf16x8 At[4][2], B0[2][2], B1[2][2];
    const char* cA = cur.A; const char* cB = cur.B;
    LAS unsigned* rtab = (LAS unsigned*)(lds + RTAB_OFF);
    int tb = 0;
#define PG8_STAGE_A(bufoff, gbase, h) do { unsigned _v[2]; _Pragma("unroll") for (int _j = 0; _j < 2; ++_j) \
        _v[_j] = (Sched::GATHER ? rtab[tb * 256 + (h) * HALF + RA[_j]] : S.a_row_off(cur, (h) * HALF + RA[_j])) + CA[_j]; \
        if constexpr (false) PG8_STAGE_NT(bufoff, gbase, _v); else PG8_STAGE(bufoff, gbase, _v); } while (0)
    LAS unsigned* xtab = (LAS unsigned*)(lds + XTAB_OFF); int tbx = 0;
    if constexpr (Sched::GATHER) { if (tid < 256) { rtab[tid] = S.a_row_off(cur, tid); if constexpr (Sched::AUX) { unsigned x0, x1; S.row_aux(cur, tid, x0, x1); xtab[2 * tid] = x0; xtab[2 * tid + 1] = x1; } } PG8_WAIT_L(0); PG8_BAR; }
    [[maybe_unused]] f32x4 breg[8];
    [[maybe_unused]] const int hB = wid >> 2, kcB = (lane & 3) + 4 * (wid & 1), n4B = (lane >> 2) + 16 * ((wid >> 1) & 1);
    [[maybe_unused]] unsigned rowb = 0, bvoff = 0, bdst = 0;
    [[maybe_unused]] const char* cBh = nullptr;
    if constexpr (Sched::BREG) { rowb = S.b_row_bytes(); bvoff = (unsigned)(kcB * 8) * rowb + (unsigned)n4B * 16u;
        const int rho0 = 32 * (n4B >> 3) + 16 * (n4B & 1) + 4 * ((n4B & 7) >> 1);
        bdst = (unsigned)(4 * HTB + hB * HTB + lds_byte(rho0, 8 * kcB)); cBh = hB ? cur.B2 : cur.B; }
#define PG8_BLOAD(gB) do { const char* _g = (gB); _Pragma("unroll") for (int _j = 0; _j < 8; ++_j) \
        asm volatile("global_load_dwordx4 %0, %1, %2" : "=v"(breg[_j]) : "v"(bvoff), "s"(_g + (size_t)_j * rowb) : "memory"); } while (0)
#define PG8_BCVT(b) do { asm volatile("s_waitcnt vmcnt(2)" : "+v"(breg[0]), "+v"(breg[1]), "+v"(breg[2]), "+v"(breg[3]), "+v"(breg[4]), "+v"(breg[5]), "+v"(breg[6]), "+v"(breg[7]) :: "memory"); \
        _Pragma("unroll") for (int _q = 0; _q < 4; ++_q) { u32x4 _w; _w.x = cvt_pk_bf16(breg[0][_q], breg[1][_q]); _w.y = cvt_pk_bf16(breg[2][_q], breg[3][_q]); \
            _w.z = cvt_pk_bf16(breg[4][_q], breg[5][_q]); _w.w = cvt_pk_bf16(breg[6][_q], breg[7][_q]); *(LAS u32x4*)(lds + bdst + (b) * 2 * HTB + 64 * _q) = _w; } } while (0)
    if constexpr (Sched::BREG) {
        PG8_STAGE_A(PG8_SA(0, 0), cA, 0); PG8_BLOAD(cBh); PG8_STAGE_A(PG8_SA(0, 1), cA, 1);
        if (wr == 1) PG8_BAR;
        PG8_BCVT(0); PG8_WAIT_L(0); PG8_BAR;
        PG8_STAGE_A(PG8_SA(1, 0), cA + kstep, 0); PG8_BLOAD(cBh + (size_t)BK * rowb);
        PG8_BAR;
    } else {
    PG8_STAGE(PG8_SB(0, 0), cB, voffB); PG8_STAGE(PG8_SB(0, 1), cB + hstepB, voffB); PG8_STAGE_A(PG8_SA(0, 0), cA, 0); PG8_STAGE_A(PG8_SA(0, 1), cA, 1);
    if (wr == 1) PG8_BAR;
    PG8_WAIT_V(2); PG8_BAR;
    PG8_STAGE(PG8_SB(1, 0), cB + kstep, voffB); PG8_STAGE_A(PG8_SA(1, 0), cA + kstep, 0); PG8_STAGE(PG8_SB(1, 1), cB + hstepB + kstep, voffB);
    PG8_WAIT_V(6); PG8_BAR;
    }
    for (;;) {
        const bool has_next = S.next(ui + 1, nxt);
        const char* nA = has_next ? nxt.A : cA; const char* nB = has_next ? nxt.B : cB;
        if constexpr (Sched::GATHER) { if (has_next && tid < 256) { rtab[((ui + 1) & 1) * 256 + tid] = S.a_row_off(nxt, tid);
            if constexpr (Sched::AUX) { unsigned x0, x1; S.row_aux(nxt, tid, x0, x1); const int nb3 = tbx == 2 ? 0 : tbx + 1; xtab[nb3 * 512 + 2 * tid] = x0; xtab[nb3 * 512 + 2 * tid + 1] = x1; } } }
        for (int t = 0; t < nt; t += 2) {
            const bool last = (t == nt - 2);
            const char* a1 = cA + (size_t)(t + 1) * kstep;
            const char* a2 = last ? nA : cA + (size_t)(t + 2) * kstep; const char* b2 = last ? nB : cB + (size_t)(t + 2) * kstep;
            const char* a3 = a2 + kstep; const char* b3 = b2 + kstep;
            if constexpr (Sched::BREG) {
            const char* nBh = has_next ? (hB ? nxt.B2 : nxt.B) : cBh;
            const char* bp2 = last ? nBh : cBh + (size_t)(t + 2) * BK * rowb; const char* bp3 = bp2 + (size_t)BK * rowb;
            PG8_LDB(B0, 0, 0); PG8_LDB(B1, 0, 1); PG8_SCHED; PG8_LDA(At, 0, 0); PG8_STAGE_A(PG8_SA(1, 1), a1, 1);
            if (last && has_next) tb ^= 1;
            PG8_WAIT_V(12); PG8_WAIT_L(0); PG8_BAR; PG8_MMA(0, 0, At, B0); PG8_MMA(0, 1, At, B1); PG8_BAR; PG8_SCHED;
            PG8_LDA(At, 0, 1); PG8_BCVT(1); PG8_STAGE_A(PG8_SA(0, 0), a2, 0); PG8_BLOAD(bp2);
            PG8_WAIT_L(0); PG8_BAR; PG8_MMA(1, 0, At, B0); PG8_MMA(1, 1, At, B1); PG8_BAR; PG8_SCHED;
            PG8_LDB(B0, 1, 0); PG8_LDB(B1, 1, 1); PG8_SCHED; PG8_LDA(At, 1, 0); PG8_STAGE_A(PG8_SA(0, 1), a2, 1);
            PG8_WAIT_V(12); PG8_WAIT_L(0); PG8_BAR; PG8_MMA(0, 0, At, B0); PG8_MMA(0, 1, At, B1); PG8_BAR; PG8_SCHED;
            PG8_LDA(At, 1, 1); PG8_BCVT(0); PG8_STAGE_A(PG8_SA(1, 0), a3, 0); PG8_BLOAD(bp3);
            PG8_WAIT_L(0); PG8_BAR; PG8_MMA(1, 0, At, B0); PG8_MMA(1, 1, At, B1); PG8_BAR; PG8_SCHED;
            } else {
            PG8_LDB(B0, 0, 0); PG8_LDB(B1, 0, 1); PG8_SCHED; PG8_LDA(At, 0, 0); PG8_STAGE_A(PG8_SA(1, 1), a1, 1);
            if (last && has_next) tb ^= 1;
            PG8_WAIT_V(8); PG8_WAIT_L(0); PG8_BAR; PG8_MMA(0, 0, At, B0); PG8_MMA(0, 1, At, B1); PG8_BAR; PG8_SCHED;
            PG8_LDA(At, 0, 1); PG8_STAGE(PG8_SB(0, 0), b2, voffB); PG8_STAGE(PG8_SB(0, 1), b2 + hstepB, voffB); PG8_STAGE_A(PG8_SA(0, 0), a2, 0);
            PG8_WAIT_V(8); PG8_WAIT_L(0); PG8_BAR; PG8_MMA(1, 0, At, B0); PG8_MMA(1, 1, At, B1); PG8_BAR; PG8_SCHED;
            PG8_LDB(B0, 1, 0); PG8_LDB(B1, 1, 1); PG8_SCHED; PG8_LDA(At, 1, 0); PG8_STAGE_A(PG8_SA(0, 1), a2, 1);
            PG8_WAIT_V(8); PG8_WAIT_L(0); PG8_BAR; PG8_MMA(0, 0, At, B0); PG8_MMA(0, 1, At, B1); PG8_BAR; PG8_SCHED;
            PG8_LDA(At, 1, 1); PG8_STAGE(PG8_SB(1, 0), b3, voffB); PG8_STAGE(PG8_SB(1, 1), b3 + hstepB, voffB); PG8_STAGE_A(PG8_SA(1, 0), a3, 0);
            PG8_WAIT_V(8); PG8_WAIT_L(0); PG8_BAR; PG8_MMA(1, 0, At, B0); PG8_MMA(1, 1, At, B1); PG8_BAR; PG8_SCHED;
            }
        }
        if constexpr (ALIGN_EPI) { if (wr == 0) PG8_BAR; }
        E(acc, cur, wr, wc, fr, fq, xtab + tbx * 512);
        if (!has_next) break;
#pragma unroll
        for (int a = 0; a < 2; ++a)
#pragma unroll
            for (int b = 0; b < 2; ++b)
#pragma unroll
                for (int m = 0; m < 4; ++m)
#pragma unroll
                    for (int n = 0; n < 2; ++n) acc[a][b][m][n] = (f32x4){0.f, 0.f, 0.f, 0.f};
        cur = nxt; cA = nA; cB = nB; ++ui; tbx = tbx == 2 ? 0 : tbx + 1;
        if constexpr (Sched::BREG) cBh = hB ? cur.B2 : cur.B;
        if constexpr (ALIGN_EPI) { if (wr == 1) PG8_BAR; }
    }
    PG8_WAIT_V(0);
    if constexpr (!ALIGN_EPI) { if (wr == 0) PG8_BAR; }
    PG8_BAR;
#undef PG8_SA
#undef PG8_SB
#undef PG8_STAGE
#undef PG8_STAGE_NT
#undef PG8_STAGE_A
#undef PG8_BLOAD
#undef PG8_BCVT
#undef PG8_LDA
#undef PG8_LDB
#undef PG8_MMA
#undef PG8_WAIT_V
#undef PG8_WAIT_L
#undef PG8_BAR
#undef PG8_SCHED
}
}

constexpr size_t WS_WIN_T = 4 * MiB, WS_WC_T = 13 * MiB, WS_WF_T = 14 * MiB, WS_WMIX_T = 15 * MiB, WS_WR_HI = 17 * MiB, WS_WR_LO = 17 * MiB + 512 * 1024, WS_WSHGU_T = 18 * MiB, WS_WSHD_T = 19 * MiB;
constexpr size_t WS_WEGU_T = 640 * MiB, WS_WED_T = 896 * MiB;
constexpr int NINW = 4608;

__device__ __forceinline__ void tr_block(const float* src, int ldw, bf16_t* dst, bf16_t* dst2, int ldt, LAS float* scr, int lane) {
#pragma unroll 8
    for (int i = 0; i < 32; ++i) { const int kk = 2 * i + (lane >> 5); scr[kk * 33 + (lane & 31)] = src[(size_t)kk * ldw + (lane & 31)]; }
    asm volatile("s_waitcnt lgkmcnt(0)" ::: "memory");
    const int c = lane & 7;
#pragma unroll
    for (int j = 0; j < 4; ++j) { const int n = (lane >> 3) + 8 * j; const LAS float* s = scr + (8 * c) * 33 + n;
        float v[8];
#pragma unroll
        for (int q = 0; q < 8; ++q) v[q] = s[q * 33];
        u32x4 o; o.x = pk2(v[0], v[1]); o.y = pk2(v[2], v[3]); o.z = pk2(v[4], v[5]); o.w = pk2(v[6], v[7]);
        *(u32x4*)(dst + (size_t)n * ldt + 8 * c) = o;
        if (dst2) { u32x4 l;
            l.x = pk2(v[0] - __uint_as_float(o.x << 16), v[1] - __uint_as_float(o.x & 0xffff0000u)); l.y = pk2(v[2] - __uint_as_float(o.y << 16), v[3] - __uint_as_float(o.y & 0xffff0000u));
            l.z = pk2(v[4] - __uint_as_float(o.z << 16), v[5] - __uint_as_float(o.z & 0xffff0000u)); l.w = pk2(v[6] - __uint_as_float(o.w << 16), v[7] - __uint_as_float(o.w & 0xffff0000u));
            *(u32x4*)(dst2 + (size_t)n * ldt + 8 * c) = l; } }
    asm volatile("s_waitcnt lgkmcnt(0)" ::: "memory");
}
__device__ __forceinline__ int inproj_src_col(int d) { const int pn = d >> 3, c0 = (d & 7) * 32;
    if (pn < 4) return c0 < 128 ? 128 * pn + c0 : 512 + 128 * pn + (c0 - 128);
    if (pn < 6) return O_Q + (pn - 4) * 256 + c0; if (pn < 8) return O_K + (pn - 6) * 256 + c0; if (pn < 10) return O_V + (pn - 8) * 256 + c0;
    if (pn < 14) return O_GA + (pn - 10) * 256 + c0; return O_GB + (pn - 14) * 256 + c0; }
__device__ __forceinline__ void ph_convert(Frame& F, bool experts) {
    F.lane = ltid(); F.tid = F.wave * 64 + F.lane;
    LAS float* scr = (LAS float*)(F.lds + F.wave * 16384);
    unsigned char* ws = F.ws; const int lane = F.lane;
    constexpr int I0 = 144 * 16, I1 = 32 * 8, I2 = 32 * 8, I3 = 32 * 16, I4 = 8 * 16, I5 = 16 * 16, I6 = 32 * 4, ISMALL = I0 + I1 + I2 + I3 + I4 + I5 + I6;
    for (int it = F.gw; it < ISMALL; it += F.NGW) {
        int r = it;
        if (r < I0) { const int d = r % 144, kb = r / 144; tr_block(F.w_in + (size_t)kb * 64 * INC + inproj_src_col(d), INC, (bf16_t*)(ws + WS_WIN_T) + (size_t)d * 32 * D + kb * 64, nullptr, D, scr, lane); continue; } r -= I0;
        if (r < I1) { const int d = r % 32, kb = r / 32; tr_block(F.w_conv_out + (size_t)kb * 64 * D + d * 32, D, (bf16_t*)(ws + WS_WC_T) + (size_t)d * 32 * CC + kb * 64, nullptr, CC, scr, lane); continue; } r -= I1;
        if (r < I2) { const int d = r % 32, kb = r / 32; tr_block(F.w_fox_out + (size_t)kb * 64 * D + d * 32, D, (bf16_t*)(ws + WS_WF_T) + (size_t)d * 32 * FW + kb * 64, nullptr, FW, scr, lane); continue; } r -= I2;
        if (r < I3) { const int d = r % 32, kb = r / 32; tr_block(F.w_mix_out + (size_t)kb * 64 * D + d * 32, D, (bf16_t*)(ws + WS_WMIX_T) + (size_t)d * 32 * D + kb * 64, nullptr, D, scr, lane); continue; } r -= I3;
        if (r < I4) { const int d = r % 8, kb = r / 8; tr_block(F.w_router + (size_t)kb * 64 * NE + d * 32, NE, (bf16_t*)(ws + WS_WR_HI) + (size_t)d * 32 * D + kb * 64, (bf16_t*)(ws + WS_WR_LO) + (size_t)d * 32 * D + kb * 64, D, scr, lane); continue; } r -= I4;
        if (r < I5) { const int d = r % 16, kb = r / 16, ct = d >> 3, c0 = (d & 7) * 32; const float* w = c0 < 128 ? F.w_sh_gate + 128 * ct + c0 : F.w_sh_up + 128 * ct + c0 - 128;
            tr_block(w + (size_t)kb * 64 * SHH, SHH, (bf16_t*)(ws + WS_WSHGU_T) + (size_t)d * 32 * D + kb * 64, nullptr, D, scr, lane); continue; } r -= I5;
        { const int d = r % 32, kb = r / 32; tr_block(F.w_sh_down + (size_t)kb * 64 * D + d * 32, D, (bf16_t*)(ws + WS_WSHD_T) + (size_t)d * 32 * SHH + kb * 64, nullptr, SHH, scr, lane); }
    }
    if (experts) {
        for (int it = F.gw; it < NE * 256; it += F.NGW) {
            const int e = it >> 8, kb = (it >> 4) & 15, d = it & 15, ct = d >> 3, c0 = (d & 7) * 32;
            const float* w = (c0 < 128 ? F.w_exp_gate + 128 * ct + c0 : F.w_exp_up + 128 * ct + c0 - 128) + (size_t)e * D * EH + (size_t)kb * 64 * EH;
            tr_block(w, EH, (bf16_t*)(ws + WS_WEGU_T) + ((size_t)e * 512 + d * 32) * D + kb * 64, nullptr, D, scr, lane);
        }
        for (int it = F.gw; it < NE * 128; it += F.NGW) {
            const int e = it >> 7, kb = (it >> 5) & 3, d = it & 31;
            tr_block(F.w_exp_down + (size_t)e * EH * D + (size_t)kb * 64 * D + d * 32, D, (bf16_t*)(ws + WS_WED_T) + ((size_t)e * D + d * 32) * EH + kb * 64, nullptr, EH, scr, lane);
        }
    }
}

struct SchedPlain {
    static constexpr bool GATHER = false, BREG = false, AUX = false;
    __device__ __forceinline__ unsigned b_row_bytes() const { return 0u; }
    pg8::TileOrder o; const char* A; const char* B; unsigned arow, brow;
    __device__ __forceinline__ bool next(int i, pg8::Unit& u) const { int pm, pn; if (!o.tile(i, pm, pn)) return false; u.pm = pm; u.pn = pn; u.e = 0; u.p0 = 0; u.ne = 0; u.bs = 0;
        u.A = A + (size_t)pm * 256 * arow; u.B = B + (size_t)pn * 256 * brow; u.B2 = nullptr; return true; }
    __device__ __forceinline__ unsigned a_row_off(const pg8::Unit&, int r) const { return (unsigned)r * arow; }
};
typedef f32x4 AccT[2][2][4][2];
#define EPI_ARGS const AccT& acc, const pg8::Unit& u, int wr, int wc, int fr, int fq, const LAS unsigned* xt
#define EPI_LAUNDER asm volatile("" : "+v"(fr), "+v"(fq))

struct EpiInProj {
    bf16_t *U, *Q, *GA; unsigned* NORM;
    __device__ __forceinline__ void operator()(EPI_ARGS) const {
        EPI_LAUNDER;
        const int row0 = u.pm * 256 + wr * 64 + fr, pn = u.pn, cin = wc * 32 + 8 * fq;
        if (pn < 4) {
#pragma unroll
            for (int ai = 0; ai < 2; ++ai)
#pragma unroll
                for (int m = 0; m < 4; ++m) { const f32x4 a0 = acc[ai][0][m][0], a1 = acc[ai][0][m][1], b0 = acc[ai][1][m][0], b1 = acc[ai][1][m][1]; u32x4 w;
                    w.x = pg8::cvt_pk_bf16(a0[0] * pg8::fsigmoid(b0[0]), a0[1] * pg8::fsigmoid(b0[1])); w.y = pg8::cvt_pk_bf16(a0[2] * pg8::fsigmoid(b0[2]), a0[3] * pg8::fsigmoid(b0[3]));
                    w.z = pg8::cvt_pk_bf16(a1[0] * pg8::fsigmoid(b1[0]), a1[1] * pg8::fsigmoid(b1[1])); w.w = pg8::cvt_pk_bf16(a1[2] * pg8::fsigmoid(b1[2]), a1[3] * pg8::fsigmoid(b1[3]));
                    *(u32x4*)(U + (size_t)(row0 + ai * 128 + m * 16) * CC + 128 * pn + cin) = w; }
        } else {
            const bool sg = pn >= 10; const int ld = sg ? D : FW, cb = sg ? ((pn - 10) & 3) * 256 : ((pn - 4) & 1) * 256;
            bf16_t* dst = sg ? GA + (size_t)((pn - 10) >> 2) * (16u << 20) : Q + (size_t)((pn - 4) >> 1) * (8u << 20);
            const float sc = pn < 6 ? QSCALE : 1.f; float nmx[2] = {0.f, 0.f};
#pragma unroll
            for (int ai = 0; ai < 2; ++ai)
#pragma unroll
                for (int m = 0; m < 4; ++m) { bf16_t* rowp = dst + (size_t)(row0 + ai * 128 + m * 16) * ld + cb + cin;
#pragma unroll
                    for (int bj = 0; bj < 2; ++bj) { f32x4 v0 = acc[ai][bj][m][0], v1 = acc[ai][bj][m][1];
                        if (sg) {
#pragma unroll
                            for (int j = 0; j < 4; ++j) { v0[j] = pg8::fsigmoid(v0[j]); v1[j] = pg8::fsigmoid(v1[j]); } }
                        else { v0 = v0 * sc; v1 = v1 * sc; }
                        if (pn < 8) { float ss = (v0[0] * v0[0] + v0[1] * v0[1]) + (v0[2] * v0[2] + v0[3] * v0[3]) + (v1[0] * v1[0] + v1[1] * v1[1]) + (v1[2] * v1[2] + v1[3] * v1[3]);
                            ss += __shfl_xor(ss, 16); ss += __shfl_xor(ss, 32); nmx[bj] = fmaxf(nmx[bj], ss); }
                        u32x4 w; w.x = pg8::cvt_pk_bf16(v0[0], v0[1]); w.y = pg8::cvt_pk_bf16(v0[2], v0[3]); w.z = pg8::cvt_pk_bf16(v1[0], v1[1]); w.w = pg8::cvt_pk_bf16(v1[2], v1[3]);
                        *(u32x4*)(rowp + bj * 128) = w; } }
            if (pn < 8) {
#pragma unroll
                for (int bj = 0; bj < 2; ++bj) { float v = nmx[bj];
#pragma unroll
                    for (int o = 1; o < 16; o <<= 1) v = fmaxf(v, __shfl_xor(v, o));
                    if ((fr | fq) == 0) { const int bh = ((u.pm * 256) >> 13) * NH + (pn & 1) * 4 + 2 * bj + (wc >> 1);
                        atomicMax(NORM + ((pn >= 6 ? 1 : 0) * 16 + bh) * 2 + (wc & 1), __float_as_uint(v)); } }
            }
        }
    }
};
__device__ __forceinline__ f32x4 bf4lo(u32x4 w) { return (f32x4){__uint_as_float(w.x << 16), __uint_as_float(w.x & 0xffff0000u), __uint_as_float(w.y << 16), __uint_as_float(w.y & 0xffff0000u)}; }
__device__ __forceinline__ f32x4 bf4hi(u32x4 w) { return (f32x4){__uint_as_float(w.z << 16), __uint_as_float(w.z & 0xffff0000u), __uint_as_float(w.w << 16), __uint_as_float(w.w & 0xffff0000u)}; }
__device__ __forceinline__ u32x4 pack8(f32x4 v0, f32x4 v1) { u32x4 w; w.x = pg8::cvt_pk_bf16(v0[0], v0[1]); w.y = pg8::cvt_pk_bf16(v0[2], v0[3]); w.z = pg8::cvt_pk_bf16(v1[0], v1[1]); w.w = pg8::cvt_pk_bf16(v1[2], v1[3]); return w; }

struct SchedMerge {
    static constexpr bool GATHER = false, BREG = false, AUX = false;
    __device__ __forceinline__ unsigned b_row_bytes() const { return 0u; }
    pg8::TileOrder o; const char *AC, *O, *WC, *WF;
    __device__ __forceinline__ bool next(int i, pg8::Unit& u) const { int pm, pn; if (!o.tile(i >> 1, pm, pn)) return false; u.pm = pm; u.pn = pn; u.e = i & 1; u.p0 = 0; u.ne = 0; u.bs = 0;
        u.A = ((i & 1) ? O : AC) + (size_t)pm * 256 * 1024; u.B = ((i & 1) ? WF : WC) + (size_t)pn * 256 * 1024; u.B2 = nullptr; return true; }
    __device__ __forceinline__ unsigned a_row_off(const pg8::Unit&, int r) const { return (unsigned)r * 1024u; }
};
struct EpiMerge {
    const bf16_t *GA, *GB; bf16_t *YA, *MG;
    __device__ __forceinline__ void operator()(EPI_ARGS) const {
        EPI_LAUNDER;
        const int row0 = u.pm * 256 + wr * 64 + fr, col0 = u.pn * 256 + wc * 32 + 8 * fq; const bool second = u.e != 0;
        const bf16_t* G = second ? GB : GA; bf16_t* dst = second ? MG : YA;
#pragma unroll
        for (int ai = 0; ai < 2; ++ai)
#pragma unroll
            for (int m = 0; m < 4; ++m) { const size_t off = (size_t)(row0 + ai * 128 + m * 16) * D + col0;
#pragma unroll
                for (int bj = 0; bj < 2; ++bj) { const u32x4 g = *(const u32x4*)(G + off + bj * 128);
                    f32x4 v0 = acc[ai][bj][m][0] * bf4lo(g), v1 = acc[ai][bj][m][1] * bf4hi(g);
                    if (second) { const u32x4 y = *(const u32x4*)(YA + off + bj * 128); v0 += bf4lo(y); v1 += bf4hi(y); }
                    *(u32x4*)(dst + off + bj * 128) = pack8(v0, v1); } }
    }
};
struct EpiMix {
    const float *x, *ADA; float* Z;
    __device__ __forceinline__ void operator()(EPI_ARGS) const {
        EPI_LAUNDER;
        const int row0 = u.pm * 256 + wr * 64 + fr, col0 = u.pn * 256 + wc * 32 + 8 * fq, b = (u.pm * 256) >> 13;
        f32x4 g[2][2];
#pragma unroll
        for (int bj = 0; bj < 2; ++bj)
#pragma unroll
            for (int n = 0; n < 2; ++n) g[bj][n] = *(const f32x4*)(ADA + b * 6144 + 2048 + col0 + bj * 128 + 4 * n) + 1.0f;
#pragma unroll
        for (int ai = 0; ai < 2; ++ai)
#pragma unroll
            for (int m = 0; m < 4; ++m) { const size_t off = (size_t)(row0 + ai * 128 + m * 16) * D + col0;
#pragma unroll
                for (int bj = 0; bj < 2; ++bj)
#pragma unroll
                    for (int n = 0; n < 2; ++n) { const f32x4 xv = *(const f32x4*)(x + off + bj * 128 + 4 * n); *(f32x4*)(Z + off + bj * 128 + 4 * n) = xv * ALPHA + g[bj][n] * acc[ai][bj][m][n]; } }
    }
};
struct SchedRS {
    static constexpr bool GATHER = false, BREG = false, AUX = false;
    __device__ __forceinline__ unsigned b_row_bytes() const { return 0u; }
    int G, c; const char *H2, *H2LO, *WRH, *WRL, *WSH;
    __device__ __forceinline__ bool next(int i, pg8::Unit& u) const { const int L = i * G + c; if (L >= 64 * 5) return false; const int pm = L / 5, j = L % 5; u.pm = pm; u.e = j; u.p0 = 0; u.ne = 0; u.bs = 0; u.B2 = nullptr;
        if (j < 3) { u.pn = 0; u.A = (j == 2 ? H2LO : H2) + (size_t)pm * 256 * 2048; u.B = (j == 1 ? WRL : WRH); }
        else { u.pn = j - 3; u.A = H2 + (size_t)pm * 256 * 2048; u.B = WSH + (size_t)(j - 3) * 256 * 2048; }
        return true; }
    __device__ __forceinline__ unsigned a_row_off(const pg8::Unit&, int r) const { return (unsigned)r * 2048u; }
};
struct EpiRS {
    float* RL; bf16_t* SHID;
    __device__ __forceinline__ void operator()(EPI_ARGS) const {
        EPI_LAUNDER;
        const int row0 = u.pm * 256 + wr * 64 + fr, cin = wc * 32 + 8 * fq;
        if (u.e < 3) { float* R = RL + (size_t)u.e * T * NE;
#pragma unroll
            for (int ai = 0; ai < 2; ++ai)
#pragma unroll
                for (int m = 0; m < 4; ++m) { float* rp = R + (size_t)(row0 + ai * 128 + m * 16) * NE + cin;
#pragma unroll
                    for (int bj = 0; bj < 2; ++bj)
#pragma unroll
                        for (int n = 0; n < 2; ++n) *(f32x4*)(rp + bj * 128 + 4 * n) = acc[ai][bj][m][n]; }
        } else {
#pragma unroll
            for (int ai = 0; ai < 2; ++ai)
#pragma unroll
                for (int m = 0; m < 4; ++m) { const f32x4 g0 = acc[ai][0][m][0], g1 = acc[ai][0][m][1], u0 = acc[ai][1][m][0], u1 = acc[ai][1][m][1]; f32x4 h0, h1;
#pragma unroll
                    for (int j = 0; j < 4; ++j) { h0[j] = g0[j] * pg8::fsigmoid(g0[j]) * u0[j]; h1[j] = g1[j] * pg8::fsigmoid(g1[j]) * u1[j]; }
                    *(u32x4*)(SHID + (size_t)(row0 + ai * 128 + m * 16) * SHH + 128 * u.pn + cin) = pack8(h0, h1); }
        }
    }
};
__device__ __forceinline__ void ph_inproj_fast(Frame& F) {
    F.lane = ltid(); F.tid = F.wave * 64 + F.lane;
    SchedPlain S; S.o.init(T / 256, NINW / 256, gridDim.x, blockIdx.x); S.A = (const char*)F.H; S.B = (const char*)(F.ws + WS_WIN_T); S.arow = 2048; S.brow = 2048;
    EpiInProj E{F.U, F.Q, F.GA, F.ctl + CW_NORM};
    static_assert(WS_K - WS_Q == 16 * MiB && WS_V - WS_K == 16 * MiB && WS_GB - WS_GA == 32 * MiB, "EpiInProj destination arithmetic");
    pg8::gemm_phase<EpiInProj, SchedPlain, true>(F.lds, D, D, D, S, E);
}
__device__ __forceinline__ void ph_merge_fast(Frame& F) {
    F.lane = ltid(); F.tid = F.wave * 64 + F.lane;
    SchedMerge S; S.o.init(T / 256, D / 256, gridDim.x, blockIdx.x); S.AC = (const char*)F.AC; S.O = (const char*)F.O; S.WC = (const char*)(F.ws + WS_WC_T); S.WF = (const char*)(F.ws + WS_WF_T);
    EpiMerge E{F.GA, F.GB, F.YA, F.MG};
    pg8::gemm_phase<EpiMerge, SchedMerge, true>(F.lds, CC, CC, CC, S, E);
}
__device__ __forceinline__ void ph_mix_fast(Frame& F) {
    F.lane = ltid(); F.tid = F.wave * 64 + F.lane;
    SchedPlain S; S.o.init(T / 256, D / 256, gridDim.x, blockIdx.x); S.A = (const char*)F.MG; S.B = (const char*)(F.ws + WS_WMIX_T); S.arow = 2048; S.brow = 2048;
    EpiMix E{F.x, F.ADA, F.X1};
    pg8::gemm_phase<EpiMix, SchedPlain, true>(F.lds, D, D, D, S, E);
}
__device__ __forceinline__ void ph_router_fast(Frame& F) {
    F.lane = ltid(); F.tid = F.wave * 64 + F.lane;
    SchedRS S{(int)gridDim.x, (int)blockIdx.x, (const char*)F.H2, (const char*)F.H2LO, (const char*)(F.ws + WS_WR_HI), (const char*)(F.ws + WS_WR_LO), (const char*)(F.ws + WS_WSHGU_T)};
    EpiRS E{F.RL, F.SHID};
    pg8::gemm_phase<EpiRS, SchedRS, true>(F.lds, D, D, D, S, E);
}

constexpr int EMAP_OFF = 131072 + 1024;
template <int NCT> __device__ __forceinline__ bool expert_unit(int i, int G, int c, int nunits, const LAS int* pref, int& e, int& ct, int& ch) {
    const int gs = G >> 3, x = c / gs, s = c - x * gs, per = (nunits + 7) >> 3, q = i * gs + s; if (q >= per) return false;
    const int P = x * per + q; if (P >= nunits) return false;
    e = __builtin_amdgcn_readfirstlane(find_expert(pref, P / NCT));
    const int p0 = __builtin_amdgcn_readfirstlane(pref[e]), nch = __builtin_amdgcn_readfirstlane(pref[e + 1]) - p0, r = P - NCT * p0;
    ct = r / nch; ch = r - ct * nch; return true;
}
template <int VARIANT = 0> struct SchedMoe1T {
    static constexpr bool GATHER = true, BREG = true, AUX = false;
    int G, c, nunits; const LAS int* pref; const LAS int* base; const char* H2; const char* WG; const char* WU; const int* LIST;
    __device__ __forceinline__ unsigned b_row_bytes() const { return EH * 4u; }
    __device__ __forceinline__ bool next(int i, pg8::Unit& u) const { int e, ct, ch; if (!expert_unit<2>(i, G, c, nunits, pref, e, ct, ch)) return false;
        u.pm = 0; u.pn = ct; u.e = e; u.p0 = ch * 256; u.bs = __builtin_amdgcn_readfirstlane(base[e]); u.ne = __builtin_amdgcn_readfirstlane(base[e + 1]) - u.bs;
        const int ew = VARIANT == 1 ? (e & 7) : e;
        u.A = H2; u.B = WG + ((size_t)ew * D * EH + 128 * ct) * 4; u.B2 = WU + ((size_t)ew * D * EH + 128 * ct) * 4; return true; }
    __device__ __forceinline__ unsigned a_row_off(const pg8::Unit& u, int r) const { int p = u.p0 + r; p = p < u.ne ? p : u.ne - 1;
        if (VARIANT == 2) return (unsigned)((u.bs + p) & (T - 1)) * 2048u;
        return (unsigned)(LIST[(size_t)u.e * LCAP + p] >> 3) * 2048u; }
};
typedef SchedMoe1T<0> SchedMoe1;
struct EpiMoe1 {
    bf16_t* HID;
    __device__ __forceinline__ void operator()(EPI_ARGS) const {
        EPI_LAUNDER;
        const int r0 = wr * 64 + fr, cin = wc * 32 + 8 * fq;
#pragma unroll
        for (int ai = 0; ai < 2; ++ai)
#pragma unroll
            for (int m = 0; m < 4; ++m) { const int p = u.p0 + r0 + ai * 128 + m * 16;
                const f32x4 g0 = acc[ai][0][m][0], g1 = acc[ai][0][m][1], u0 = acc[ai][1][m][0], u1 = acc[ai][1][m][1]; f32x4 h0, h1;
#pragma unroll
                for (int j = 0; j < 4; ++j) { h0[j] = g0[j] * pg8::fsigmoid(g0[j]) * u0[j]; h1[j] = g1[j] * pg8::fsigmoid(g1[j]) * u1[j]; }
                if (p < u.ne) *(u32x4*)(HID + (size_t)(u.bs + p) * EH + 128 * u.pn + cin) = pack8(h0, h1); }
    }
};
struct SchedMoe2 {
    static constexpr bool GATHER = true, BREG = true, AUX = true;
    int G, c, nunits; const LAS int* pref; const LAS int* base; const char* HID; const char* WD; const int* LIST; const float* LISTW;
    __device__ __forceinline__ void row_aux(const pg8::Unit& u, int r, unsigned& x0, unsigned& x1) const { const int p = u.p0 + r; x0 = ~0u; x1 = 0u;
        if (p < u.ne) { const int as = LIST[(size_t)u.e * LCAP + p]; x0 = (unsigned)((as >> 3) * NSLOT + (as & 7)); x1 = __float_as_uint(LISTW[(size_t)u.e * LCAP + p]); } }
    __device__ __forceinline__ unsigned b_row_bytes() const { return D * 4u; }
    __device__ __forceinline__ bool next(int i, pg8::Unit& u) const { int e, ct, ch; if (!expert_unit<4>(i, G, c, nunits, pref, e, ct, ch)) return false;
        u.pm = 0; u.pn = ct; u.e = e; u.p0 = ch * 256; u.bs = __builtin_amdgcn_readfirstlane(base[e]); u.ne = __builtin_amdgcn_readfirstlane(base[e + 1]) - u.bs;
        u.A = HID + (size_t)(u.bs + u.p0) * 512; u.B = WD + ((size_t)e * EH * D + 256 * ct) * 4; u.B2 = u.B + 512; return true; }
    __device__ __forceinline__ unsigned a_row_off(const pg8::Unit& u, int r) const { const int lim = u.ne - 1 - u.p0; return (unsigned)(r < lim ? r : lim) * 512u; }
};
struct EpiMoe2 {
    bf16_t* YAS;
    __device__ __forceinline__ void operator()(EPI_ARGS) const {
        EPI_LAUNDER;
        const int r0 = wr * 64 + fr, col0 = u.pn * 256 + wc * 32 + 8 * fq;
#pragma unroll
        for (int ai = 0; ai < 2; ++ai)
#pragma unroll
            for (int m = 0; m < 4; ++m) { const int r = r0 + ai * 128 + m * 16; const u32x2 x = *(const LAS u32x2*)(xt + 2 * r);
                if (x.x != ~0u) { const float w = __uint_as_float(x.y); bf16_t* rowp = YAS + (size_t)x.x * D + col0;
#pragma unroll
                    for (int bj = 0; bj < 2; ++bj) *(u32x4*)(rowp + bj * 128) = pack8(acc[ai][bj][m][0] * w, acc[ai][bj][m][1] * w); }
                if (m & 1) asm volatile("" ::: "memory"); }
    }
};
struct EpiShDown {
    bf16_t* YAS;
    __device__ __forceinline__ void operator()(EPI_ARGS) const {
        EPI_LAUNDER;
        const int row0 = u.pm * 256 + wr * 64 + fr, col0 = u.pn * 256 + wc * 32 + 8 * fq;
#pragma unroll
        for (int ai = 0; ai < 2; ++ai)
#pragma unroll
            for (int m = 0; m < 4; ++m) { bf16_t* rowp = YAS + ((size_t)(row0 + ai * 128 + m * 16) * NSLOT + 8) * D + col0;
#pragma unroll
                for (int bj = 0; bj < 2; ++bj) *(u32x4*)(rowp + bj * 128) = pack8(acc[ai][bj][m][0], acc[ai][bj][m][1]); }
    }
};
template <int VARIANT> __device__ __forceinline__ void ph_moe1_experts(Frame& F, bf16_t* hid) {
    F.lane = ltid(); F.tid = F.wave * 64 + F.lane;
    LAS int* pref = (LAS int*)(F.lds + EMAP_OFF); LAS int* base = pref + 260;
    build_expert_map(F, pref, base, 256);
    SchedMoe1T<VARIANT> S{(int)gridDim.x, F.vid, __builtin_amdgcn_readfirstlane(pref[NE]) * 2, pref, base, (const char*)F.H2, (const char*)F.w_exp_gate, (const char*)F.w_exp_up, F.LIST};
    EpiMoe1 E{hid};
    pg8::gemm_phase<EpiMoe1, SchedMoe1T<VARIANT>, true>(F.lds, D, D, D, S, E);
}
__device__ __forceinline__ void ph_shdown(Frame& F) {
    F.lane = ltid(); F.tid = F.wave * 64 + F.lane;
    SchedPlain S; S.o.init(T / 256, D / 256, gridDim.x, blockIdx.x); S.A = (const char*)F.SHID; S.B = (const char*)(F.ws + WS_WSHD_T); S.arow = 512; S.brow = 512;
    EpiShDown E{F.YAS};
    pg8::gemm_phase<EpiShDown, SchedPlain, true>(F.lds, SHH, SHH, SHH, S, E);
}
__device__ __forceinline__ void ph_moe1_fast(Frame& F) { ph_moe1_experts<0>(F, F.HID); ph_shdown(F); }
__device__ __forceinline__ void ph_moe2_fast(Frame& F) {
    F.lane = ltid(); F.tid = F.wave * 64 + F.lane;
    LAS int* pref = (LAS int*)(F.lds + EMAP_OFF); LAS int* base = pref + 260;
    build_expert_map(F, pref, base, 256);
    SchedMoe2 S{(int)gridDim.x, F.vid, __builtin_amdgcn_readfirstlane(pref[NE]) * 4, pref, base, (const char*)F.HID, (const char*)F.w_exp_down, F.LIST, F.LISTW};
    EpiMoe2 E{F.YAS};
    pg8::gemm_phase<EpiMoe2, SchedMoe2, true>(F.lds, EH, EH, EH, S, E);
}

namespace attn_body {
using bf16=__hip_bfloat16;
using bf16x8=__attribute__((ext_vector_type(8)))short;
using s16x4=__attribute__((ext_vector_type(4)))short;
using f32x16=__attribute__((ext_vector_type(16)))float;
using u32x4=__attribute__((ext_vector_type(4)))unsigned;
using f32x4_t=__attribute__((ext_vector_type(4)))float;
constexpr int BATCH=2,NHEAD=8,SEQ=8192,D=64,DM=NHEAD*D;
constexpr int NW=8,QBLK=32,QB=QBLK*NW,KVBLK=64,NQB=SEQ/QB;
constexpr int ATTN_PITCH=DM, ATTN_UNIT_ROWS=QB;
__device__ __forceinline__ int crow(int r,int hi){return (r&3)+8*(r>>2)+4*hi;}
#define SBAR() __builtin_amdgcn_sched_barrier(0)
__device__ __forceinline__ void cmask(f32x16&p0,f32x16&p1,int jb,int qrel,int hi){
  const float NEG=-INFINITY; int kb=64*jb+4*hi;
  #pragma unroll
  for(int r=0;r<16;++r){int kv=kb+(r&3)+8*(r>>2); if(kv>qrel)p0[r]=NEG; if(kv+32>qrel)p1[r]=NEG;}
}

constexpr int NSLOT=3, SLOTB=8192;
constexpr int LDS_K=0, LDS_V=NSLOT*SLOTB, LDS_WS=2*NSLOT*SLOTB, LDS_OST=LDS_WS+NW*64*4, LDS_NB=LDS_OST+NW*4096, LDS_BYTES=LDS_NB+SEQ*4;
constexpr float C2=0.125f*1.4426950408889634f;
__device__ __forceinline__ void glds16(const void*gsrc,unsigned lds_dst){unsigned keep;
  asm volatile("s_mov_b32 %0, m0\n\ts_mov_b32 m0, %2\n\ts_nop 0\n\tglobal_load_lds_dwordx4 %1, off\n\ts_mov_b32 m0, %0":"=&s"(keep):"v"(gsrc),"s"(lds_dst):"memory");}
__device__ __forceinline__ float max3f(float a,float b,float c){float r;asm("v_max3_f32 %0, %1, %2, %3":"=v"(r):"v"(a),"v"(b),"v"(c));return r;}
__device__ __forceinline__ float max2f(float a,float b){float r;asm("v_max_f32_e32 %0, %1, %2":"=v"(r):"v"(a),"v"(b));return r;}
__device__ __forceinline__ float fadd_s(float a,float b){float r;asm("v_add_f32_e32 %0, %1, %2":"=v"(r):"v"(a),"v"(b));return r;}
__device__ __forceinline__ float fsub_s(float a,float b){float r;asm("v_sub_f32_e32 %0, %1, %2":"=v"(r):"v"(a),"v"(b));return r;}
typedef float f32x2_t __attribute__((ext_vector_type(2))); typedef __bf16 bf16x2_t __attribute__((ext_vector_type(2)));
__device__ __forceinline__ unsigned cvtpk_s(float lo,float hi){f32x2_t v={lo,hi};bf16x2_t b=__builtin_convertvector(v,bf16x2_t);return __builtin_bit_cast(unsigned,b);}
#define WAIT_BAR(N) asm volatile("s_waitcnt vmcnt(" #N ") lgkmcnt(0)\n\ts_barrier":::"memory")

__device__ __forceinline__ void qkt(f32x16&p0,f32x16&p1,const char*Kslot,const bf16x8*qr,int r32,int hi){
  const char*kb=Kslot+hi*1024+r32*16;
  #pragma unroll
  for(int d0=0;d0<4;++d0){
    const bf16x8 b0=*reinterpret_cast<const bf16x8*>(kb+d0*2048);
    const bf16x8 b1=*reinterpret_cast<const bf16x8*>(kb+d0*2048+512);
    {p0=__builtin_amdgcn_mfma_f32_32x32x16_bf16(b0,qr[d0],p0,0,0,0);p1=__builtin_amdgcn_mfma_f32_32x32x16_bf16(b1,qr[d0],p1,0,0,0);}}
}
typedef __attribute__((address_space(3))) const char* lds_cptr;
typedef short v4i16_t __attribute__((ext_vector_type(4)));
__device__ __forceinline__ void kload8(bf16x8*kf,lds_cptr kp){
  kf[0]=*(const __attribute__((address_space(3))) bf16x8*)(kp);      kf[1]=*(const __attribute__((address_space(3))) bf16x8*)(kp+512);
  kf[2]=*(const __attribute__((address_space(3))) bf16x8*)(kp+2048); kf[3]=*(const __attribute__((address_space(3))) bf16x8*)(kp+2560);
  kf[4]=*(const __attribute__((address_space(3))) bf16x8*)(kp+4096); kf[5]=*(const __attribute__((address_space(3))) bf16x8*)(kp+4608);
  kf[6]=*(const __attribute__((address_space(3))) bf16x8*)(kp+6144); kf[7]=*(const __attribute__((address_space(3))) bf16x8*)(kp+6656);
}
__device__ __forceinline__ void kload2(bf16x8*kf,lds_cptr kp,int j){ kf[2*j]=*(const __attribute__((address_space(3))) bf16x8*)(kp+j*2048); kf[2*j+1]=*(const __attribute__((address_space(3))) bf16x8*)(kp+j*2048+512); }
__device__ __forceinline__ s16x4 vtr(lds_cptr p){ return __builtin_bit_cast(s16x4,__builtin_amdgcn_ds_read_tr16_b64_v4i16((__attribute__((address_space(3))) v4i16_t*)p)); }
__device__ __forceinline__ float rowmax(const f32x16&p0,const f32x16&p1){
  float a=max3f(p0[0],p0[1],p1[0]),b=max3f(p0[2],p0[3],p1[1]);a=max3f(a,p1[2],p1[3]);
  #pragma unroll
  for(int r=4;r<16;r+=4){a=max3f(a,p0[r],p0[r+1]);b=max3f(b,p0[r+2],p0[r+3]);a=max3f(a,p1[r],p1[r+1]);b=max3f(b,p1[r+2],p1[r+3]);}
  const float m=max2f(a,b);
  auto rr=__builtin_amdgcn_permlane32_swap(__float_as_uint(m),__float_as_uint(m),false,false);
  return max2f(__uint_as_float(rr[0]),__uint_as_float(rr[1]));
}
__device__ __forceinline__ void pv(f32x16*o,int vb,bf16x8 pa0,bf16x8 pa1,bf16x8 pa2,bf16x8 pa3){
  #pragma unroll
  for(int d0=0;d0<2;++d0){s16x4 lo[4],hi[4];
    #pragma unroll
    for(int ks=0;ks<4;++ks){
      asm volatile("ds_read_b64_tr_b16 %0,%1 offset:%c2":"=&v"(lo[ks]):"v"(vb),"i"(d0*4096+ks*1024):"memory");
      asm volatile("ds_read_b64_tr_b16 %0,%1 offset:%c2":"=&v"(hi[ks]):"v"(vb),"i"(d0*4096+ks*1024+512):"memory");}
    asm volatile("s_waitcnt lgkmcnt(0)":::"memory");SBAR();
    #define PK(k) (bf16x8){lo[k][0],lo[k][1],lo[k][2],lo[k][3],hi[k][0],hi[k][1],hi[k][2],hi[k][3]}
    o[d0]=__builtin_amdgcn_mfma_f32_32x32x16_bf16(pa0,PK(0),o[d0],0,0,0);
    o[d0]=__builtin_amdgcn_mfma_f32_32x32x16_bf16(pa1,PK(1),o[d0],0,0,0);
    o[d0]=__builtin_amdgcn_mfma_f32_32x32x16_bf16(pa2,PK(2),o[d0],0,0,0);
    o[d0]=__builtin_amdgcn_mfma_f32_32x32x16_bf16(pa3,PK(3),o[d0],0,0,0);
    #undef PK
  }
}

#ifndef ATTN_STORE16
#define ATTN_STORE16(p,v) (*(u32x4*)(p)=(v))
#endif
template<int THRL> __device__ __forceinline__ void attn_unit(int b,int h,int qb,const bf16*Q,const bf16*__restrict__ K,const bf16*__restrict__ V,bf16*O,char*shm,const float*__restrict__ cum,float skip_thr){
  const int tid=threadIdx.x,lane=tid&63,r32=lane&31,hi=lane>>5; const int wid=__builtin_amdgcn_readfirstlane(tid>>6);
  const long rowbase=(long)b*SEQ; const int q0=qb*QB;
  const bf16*Qw=Q+(rowbase+q0+wid*QBLK)*DM+h*D;
  const bf16*Kh=K+rowbase*DM+h*D,*Vh=V+rowbase*DM+h*D;
  const unsigned lds0=(unsigned)(uintptr_t)shm;
  float*wsf=(float*)(shm+LDS_WS)+wid*64;
  const bf16*ksrc=Kh+(long)lane*DM+wid*8;
  const bf16*vsrc=Vh+(long)(16*(wid&3)+(lane>>2))*DM+(wid>>2)*32+(lane&3)*8;
  const unsigned kdst=lds0+LDS_K+wid*1024, vdst=lds0+LDS_V+wid*1024;
  #define DMA_K(t,slot) glds16(ksrc+(long)(NTF-1-(t))*KVBLK*DM,(unsigned)__builtin_amdgcn_readfirstlane(kdst+(slot)))
  #define DMA_V(t,slot) glds16(vsrc+(long)(NTF-1-(t))*KVBLK*DM,(unsigned)__builtin_amdgcn_readfirstlane(vdst+(slot)))
  const int vb0=(int)(lds0+LDS_V)+((lane>>4)&1)*32+(lane&3)*8+(4*hi+((lane&15)>>2))*64;
  const char*Kbase=shm+LDS_K; bf16x8 kf[8];
  const lds_cptr shm3=(lds_cptr)shm; const lds_cptr kp0=shm3+LDS_K+hi*1024+r32*16; const lds_cptr vp0=shm3+LDS_V+((lane>>4)&1)*32+(lane&3)*8+(4*hi+((lane&15)>>2))*64;
  const int NTF=(q0+QB)/KVBLK;
  const float F0=cum[q0]; int nskip;
  { const int j0=lane,j1=lane+64; bool s0=false,s1=false;
    if(j0<NTF-4) s0=(F0-cum[64*j0+63])*1.4426950408889634f < -skip_thr;
    if(j1<NTF-4) s1=(F0-cum[64*j1+63])*1.4426950408889634f < -skip_thr;
    const unsigned long long m0=__ballot(s0),m1=__ballot(s1);
    nskip=(m0==~0ull)?64+(int)__builtin_ctzll(~m1|(1ull<<63)):(int)__builtin_ctzll(~m0); nskip&=~1; nskip=__builtin_amdgcn_readfirstlane(nskip); }
  const int NT=NTF-nskip, sbase=64*nskip;
  typedef __attribute__((address_space(3))) float* lds_fptr; const lds_fptr nbL=(lds_fptr)(__attribute__((address_space(3))) char*)shm+LDS_NB/4;
  for(int i4=tid*4;i4<q0+QB-sbase;i4+=NW*64*4){ const f32x4_t c4=*reinterpret_cast<const f32x4_t*>(cum+sbase+i4); f32x4_t n4; n4[0]=(F0-c4[0])*1.4426950408889634f; n4[1]=(F0-c4[1])*1.4426950408889634f; n4[2]=(F0-c4[2])*1.4426950408889634f; n4[3]=(F0-c4[3])*1.4426950408889634f; *(__attribute__((address_space(3))) f32x4_t*)(nbL+i4)=n4; }
  asm volatile("s_waitcnt vmcnt(0) lgkmcnt(0)\n\ts_barrier":::"memory");
  DMA_K(0,0);DMA_V(0,0);DMA_K(1,SLOTB);
  bf16x8 qr[4];
  #pragma unroll
  for(int d0=0;d0<4;++d0)qr[d0]=*reinterpret_cast<const bf16x8*>(&Qw[(long)r32*DM+d0*16+hi*8]);
  float l_reg=0.f;f32x16 o[2];o[0]=f32x16{};o[1]=f32x16{};
  const int qrel=wid*QBLK+r32;
  float mhat=nbL[q0-sbase+qrel];
  #define NBRD(X0,X1,i) do{ const lds_fptr nb_=nbL+(64*(NT-1-(i))+4*hi); _Pragma("unroll") for(int g_=0;g_<4;++g_){ const f32x4_t a_=*(const __attribute__((address_space(3))) f32x4_t*)(nb_+8*g_); const f32x4_t b_=*(const __attribute__((address_space(3))) f32x4_t*)(nb_+8*g_+32); \
      X0[4*g_]=a_[0];X0[4*g_+1]=a_[1];X0[4*g_+2]=a_[2];X0[4*g_+3]=a_[3]; X1[4*g_]=b_[0];X1[4*g_+1]=b_[1];X1[4*g_+2]=b_[2];X1[4*g_+3]=b_[3]; } }while(0)
  #define NBSUB(X0,X1) do{ _Pragma("unroll") for(int r=0;r<16;++r){X0[r]-=mhat;X1[r]-=mhat;} }while(0)
  #define CMASK(P0,P1,t) do{int jb_=3-(t); if(jb_>=0)cmask(P0,P1,jb_,qrel,hi);}while(0)
  bool resc=false;
  #define START(P0,P1) do{ const float rm=rowmax(P0,P1); resc=false; \
    { const float dl=max2f(rm,0.f); mhat=fadd_s(mhat,dl); \
      _Pragma("unroll") for(int r=0;r<16;++r){P0[r]=fsub_s(P0[r],dl);P1[r]=fsub_s(P1[r],dl);} } \
    _Pragma("unroll") for(int r=0;r<16;++r)P0[r]=__builtin_amdgcn_exp2f(P0[r]); }while(0)
  #define RESC() do{ if(resc){ asm volatile("s_waitcnt lgkmcnt(0)":::"memory"); \
      _Pragma("unroll") for(int d_=0;d_<2;++d_) _Pragma("unroll") for(int r=0;r<16;++r)o[d_][r]*=wsf[crow(r,hi)]; } }while(0)
  f32x16 pA0,pA1,pB0,pB1;
  int sl_prev=0,sl_cur=0,sl_next=SLOTB;
  #define ROT() do{sl_prev=sl_cur;sl_cur=sl_next;sl_next=(sl_next==(NSLOT-1)*SLOTB)?0:sl_next+SLOTB;}while(0)
  DMA_K(2,2*SLOTB);
  WAIT_BAR(3);
  NBRD(pA0,pA1,0); NBSUB(pA0,pA1);
  qkt(pA0,pA1,Kbase,qr,r32,hi);asm volatile("s_nop 15\n\ts_nop 7":"+v"(pA0),"+v"(pA1));CMASK(pA0,pA1,0);
  START(pA0,pA1);
  _Pragma("unroll") for(int r=0;r<16;++r)pA1[r]=__builtin_amdgcn_exp2f(pA1[r]);
  NBRD(pB0,pB1,1);
  WAIT_BAR(0);
  DMA_K(3,0);DMA_V(1,SLOTB);
  ROT();
  kload8(kf,kp0+sl_cur);
  WAIT_BAR(2);
  s16x4 vlo[8],vhi[8]; u32x4 pw0,pw1,pw2,pw3;
  #define PKW(P,B) cvtpk_s(P[B],P[B+1])
  #define PAF(k) __builtin_bit_cast(bf16x8,pw##k)
  #define VFR(i) (bf16x8){vlo[i][0],vlo[i][1],vlo[i][2],vlo[i][3],vhi[i][0],vhi[i][1],vhi[i][2],vhi[i][3]}
  #define PIN(x) asm volatile("":"+v"(x))
  #define MX3(a,b,c) __builtin_fmaxf(__builtin_fmaxf((a),(b)),(c))
  #define GAPA(MF,A0,A1,A2,A3,W0,W1,PW) do{ MF; sacc+=A0; sacc+=A1; sacc+=A2; sacc+=A3; PIN(sacc); W0; W1; PIN(PW); SBAR(); }while(0)
  #define EX(v) __builtin_amdgcn_exp2f(v)
  #define GAPB(MF,X,B) do{ MF; X[B]=EX(X[B]); X[B+1]=EX(X[B+1]); X[B+2]=EX(X[B+2]); X[B+3]=EX(X[B+3]); PIN(X); SBAR(); }while(0)
  #define VRD(i) do{ vlo[i]=vtr(vp_+(((i)>>2)*4096+((i)&3)*1024)); vhi[i]=vtr(vp_+(((i)>>2)*4096+((i)&3)*1024+512)); }while(0)
  #define KRD(G,j) do{ if(G){ kload2(kf,kp0+sl_next,j); SBAR(); } }while(0)
  #define STEP(C0,C1,P0,P1,t,GK,GV,GL) do{ SBAR(); NBSUB(C0,C1); \
    const lds_cptr vp_=vp0+sl_prev; \
    VRD(0); SBAR(); float sacc=(P0[0]+P0[1]); \
    GAPA(C0=__builtin_amdgcn_mfma_f32_32x32x16_bf16(kf[0],qr[0],C0,0,0,0), P0[2],P0[3],P0[4],P0[5],     pw0[0]=PKW(P0,0), pw0[1]=PKW(P0,2), pw0); \
    VRD(4); SBAR(); GAPA(C1=__builtin_amdgcn_mfma_f32_32x32x16_bf16(kf[1],qr[0],C1,0,0,0), P0[6],P0[7],P0[8],P0[9],     pw0[2]=PKW(P0,4), pw0[3]=PKW(P0,6), pw0); \
    VRD(1); SBAR(); GAPA(C0=__builtin_amdgcn_mfma_f32_32x32x16_bf16(kf[2],qr[1],C0,0,0,0),   P0[10],P0[11],P0[12],P0[13], pw1[0]=PKW(P0,8), pw1[1]=PKW(P0,10), pw1); \
    VRD(5); SBAR(); GAPA(C1=__builtin_amdgcn_mfma_f32_32x32x16_bf16(kf[3],qr[1],C1,0,0,0),   P0[14],P0[15],P1[0],P1[1],   pw1[2]=PKW(P0,12),pw1[3]=PKW(P0,14), pw1); \
    VRD(2); SBAR(); GAPA(C0=__builtin_amdgcn_mfma_f32_32x32x16_bf16(kf[4],qr[2],C0,0,0,0),   P1[2],P1[3],P1[4],P1[5],     pw2[0]=PKW(P1,0), pw2[1]=PKW(P1,2), pw2); \
    VRD(6); SBAR(); GAPA(C1=__builtin_amdgcn_mfma_f32_32x32x16_bf16(kf[5],qr[2],C1,0,0,0),   P1[6],P1[7],P1[8],P1[9],     pw2[2]=PKW(P1,4), pw2[3]=PKW(P1,6), pw2); \
    VRD(3); SBAR(); GAPA(C0=__builtin_amdgcn_mfma_f32_32x32x16_bf16(kf[6],qr[3],C0,0,0,0),   P1[10],P1[11],P1[12],P1[13], pw3[0]=PKW(P1,8), pw3[1]=PKW(P1,10), pw3); \
    VRD(7); SBAR(); GAPA(C1=__builtin_amdgcn_mfma_f32_32x32x16_bf16(kf[7],qr[3],C1,0,0,0),   P1[14],P1[15],0.f,0.f,       pw3[2]=PKW(P1,12),pw3[3]=PKW(P1,14), pw3); \
    l_reg+=sacc; \
    if(GK){DMA_K((t)+3,sl_cur);} if(GV){DMA_V((t)+1,sl_next);} \
    CMASK(C0,C1,t); \
    { float a=MX3(C0[0],C0[1],C1[0]),b=MX3(C0[2],C0[3],C1[1]); a=MX3(a,C1[2],C1[3]); \
      _Pragma("unroll") for(int r=4;r<16;r+=4){a=MX3(a,C0[r],C0[r+1]);b=MX3(b,C0[r+2],C0[r+3]);a=MX3(a,C1[r],C1[r+1]);b=MX3(b,C1[r+2],C1[r+3]);} \
      float rm=__builtin_fmaxf(a,b); { auto rr=__builtin_amdgcn_permlane32_swap(__float_as_uint(rm),__float_as_uint(rm),false,false); rm=__builtin_fmaxf(__uint_as_float(rr[0]),__uint_as_float(rr[1])); } \
      resc=false; \
      if(__builtin_expect(__any(rm>(float)THRL),0)){ const float dl=__builtin_fmaxf(rm,0.f); mhat+=dl; \
        _Pragma("unroll") for(int r=0;r<16;++r){C0[r]-=dl;C1[r]-=dl;} \
        const float f=__builtin_amdgcn_exp2f(-dl); l_reg*=f; if(hi==0)wsf[r32]=f; resc=true; } } \
    SBAR(); \
    if(GL){ NBRD(P0,P1,(t)+1); SBAR(); } \
    GAPB(o[0]=__builtin_amdgcn_mfma_f32_32x32x16_bf16(PAF(0),VFR(0),o[0],0,0,0), C0,0); \
    GAPB(o[1]=__builtin_amdgcn_mfma_f32_32x32x16_bf16(PAF(0),VFR(4),o[1],0,0,0), C0,4); \
    KRD(GL,0); GAPB(o[0]=__builtin_amdgcn_mfma_f32_32x32x16_bf16(PAF(1),VFR(1),o[0],0,0,0), C0,8); \
    KRD(GL,1); GAPB(o[1]=__builtin_amdgcn_mfma_f32_32x32x16_bf16(PAF(1),VFR(5),o[1],0,0,0), C0,12); \
    KRD(GL,2); GAPB(o[0]=__builtin_amdgcn_mfma_f32_32x32x16_bf16(PAF(2),VFR(2),o[0],0,0,0), C1,0); \
    KRD(GL,3); GAPB(o[1]=__builtin_amdgcn_mfma_f32_32x32x16_bf16(PAF(2),VFR(6),o[1],0,0,0), C1,4); \
    GAPB(o[0]=__builtin_amdgcn_mfma_f32_32x32x16_bf16(PAF(3),VFR(3),o[0],0,0,0), C1,8); \
    GAPB(o[1]=__builtin_amdgcn_mfma_f32_32x32x16_bf16(PAF(3),VFR(7),o[1],0,0,0), C1,12); \
    }while(0)
  #define ENDW(tt) do{ if((tt)+3<NT){WAIT_BAR(2);} else if((tt)+2<NT){WAIT_BAR(1);} else {WAIT_BAR(0);} }while(0)
  int t=1;
  for(;t<=3&&t+1<NT;t+=2){
    STEP(pB0,pB1,pA0,pA1,t,(t+3<NT),(t+1<NT),(t+1<NT));       ENDW(t);   RESC(); ROT();
    STEP(pA0,pA1,pB0,pB1,t+1,(t+4<NT),(t+2<NT),(t+2<NT));     ENDW(t+1); RESC(); ROT();
  }
  #undef CMASK
  #define CMASK(P0,P1,t) do{}while(0)
  for(;t+5<NT;t+=2){
    STEP(pB0,pB1,pA0,pA1,t,true,true,true);     WAIT_BAR(2); RESC(); ROT();
    STEP(pA0,pA1,pB0,pB1,t+1,true,true,true);   WAIT_BAR(2); RESC(); ROT();
  }
  for(;t+1<NT;t+=2){
    STEP(pB0,pB1,pA0,pA1,t,(t+3<NT),(t+1<NT),(t+1<NT));       ENDW(t);   RESC(); ROT();
    STEP(pA0,pA1,pB0,pB1,t+1,(t+4<NT),(t+2<NT),(t+2<NT));     ENDW(t+1); RESC(); ROT();
  }
  #undef CMASK
  #define CMASK(P0,P1,t) do{int jb_=3-(t); if(jb_>=0)cmask(P0,P1,jb_,qrel,hi);}while(0)
  STEP(pB0,pB1,pA0,pA1,NT-1,false,false,false); RESC();
  { float sacc=pB0[0]+pB0[1]; _Pragma("unroll") for(int r=2;r<16;++r)sacc+=pB0[r]; _Pragma("unroll") for(int r=0;r<16;++r)sacc+=pB1[r]; l_reg+=sacc;
    pw0=(u32x4){PKW(pB0,0),PKW(pB0,2),PKW(pB0,4),PKW(pB0,6)};pw1=(u32x4){PKW(pB0,8),PKW(pB0,10),PKW(pB0,12),PKW(pB0,14)};pw2=(u32x4){PKW(pB1,0),PKW(pB1,2),PKW(pB1,4),PKW(pB1,6)};pw3=(u32x4){PKW(pB1,8),PKW(pB1,10),PKW(pB1,12),PKW(pB1,14)};
    SBAR(); pv(o,vb0+sl_cur,PAF(0),PAF(1),PAF(2),PAF(3)); }
  #undef PKW
  #undef PAF
  #undef VFR
  #undef PIN
  #undef MX3
  #undef GAPA
  #undef GAPB
  #undef EX
  #undef VRD
  #undef KRD
  #undef STEP
  #undef ENDW
  {auto rr=__builtin_amdgcn_permlane32_swap(__float_as_uint(l_reg),__float_as_uint(l_reg),false,false);l_reg=__uint_as_float(rr[0])+__uint_as_float(rr[1]);}
  if(hi==0)wsf[32+r32]=l_reg;asm volatile("s_waitcnt lgkmcnt(0)":::"memory");
  float rli[16];
  #pragma unroll
  for(int r=0;r<16;++r)rli[r]=__builtin_amdgcn_rcpf(wsf[32+crow(r,hi)]);
  bf16*Ow=O+(rowbase+q0+wid*QBLK)*DM+h*D;
  { bf16*stg=(bf16*)(shm+LDS_OST)+wid*2048;
    #pragma unroll
    for(int r=0;r<16;++r){const int orow=crow(r,hi);
      #pragma unroll
      for(int d0=0;d0<2;++d0)stg[orow*64+d0*32+r32]=__float2bfloat16(o[d0][r]*rli[r]);}
    asm volatile("s_waitcnt lgkmcnt(0)":::"memory");
    #pragma unroll
    for(int i=0;i<4;++i){const int row=i*8+(lane>>3),ch=lane&7; const u32x4 v=*(const u32x4*)(stg+row*64+ch*8); ATTN_STORE16(Ow+(long)row*DM+ch*8,v);} }
  asm volatile("s_waitcnt lgkmcnt(0)\n\ts_barrier":::"memory");
  #undef DMA_K
  #undef DMA_V
  #undef CMASK
  #undef START
  #undef NBRD
  #undef NBSUB
  #undef RESC
  #undef ROT
}
constexpr int ATTN_LDS_BYTES=LDS_BYTES;
struct AttnTensors { const bf16* Q; const bf16* K; const bf16* V; bf16* O; const float* cum; };
struct AttnUnit { int bh; int qb; };
template<int THRL=8> __device__ __forceinline__ void attn_phase(char*lds,const AttnTensors&T,unsigned*qheads,const unsigned*norm,volatile __attribute__((address_space(3))) unsigned*bc){
  const int x=blockIdx.x&7;
  for(;;){
    if(threadIdx.x==0) bc[0]=__hip_atomic_fetch_add(qheads+64*x,1u,__ATOMIC_RELAXED,__HIP_MEMORY_SCOPE_AGENT);
    __syncthreads(); const unsigned idx=bc[0]; __syncthreads();
    if(idx>=64u) break;
    const int b=x>>2, h=(idx&1)?(x&3):7-(x&3), qb=31-(int)(idx>>1), bh=b*NHEAD+h;
    const float qn=(__uint_as_float(norm[(0*16+bh)*2])+__uint_as_float(norm[(0*16+bh)*2+1]))*1.02f, kn=(__uint_as_float(norm[(1*16+bh)*2])+__uint_as_float(norm[(1*16+bh)*2+1]))*1.02f;
    const float thr=2.0f*sqrtf(qn*kn)+160.0f;
    attn_unit<THRL>(b,h,qb,T.Q,T.K,T.V,T.O,lds,T.cum+(long)bh*SEQ,thr);
  }
}
#undef SBAR
#undef WAIT_BAR
}

__device__ __forceinline__ void ph_attn_fast(Frame& F) {
    F.lane = ltid(); F.tid = F.wave * 64 + F.lane;
    static_assert(attn_body::ATTN_LDS_BYTES <= 131072, "attention LDS");
    const attn_body::AttnTensors AT{(const attn_body::bf16*)F.Q, (const attn_body::bf16*)F.K, (const attn_body::bf16*)F.V, (attn_body::bf16*)F.O, F.CUM};
    attn_body::attn_phase<8>((char*)F.lds_generic, AT, F.ctl + CW_AQ, F.ctl + CW_NORM, (volatile LAS unsigned*)(F.lds + MISC_OFF + 64));
}

constexpr int NPHASE = 13;
#ifndef PROBE_PHASE
#define PROBE_PHASE -1
#endif
constexpr int N_LAUNCHES = 1;
__global__ void __launch_bounds__(NTHR, 2) fwd_kernel(Args args) {
    extern __shared__ __attribute__((aligned(16))) unsigned char lds_raw[];
    Frame F;
    F.lds = (LAS unsigned char*)lds_raw; F.lds_generic = lds_raw;
    F.tid = threadIdx.x; F.lane = F.tid & 63; F.wave = __builtin_amdgcn_readfirstlane(F.tid >> 6);
    F.gw = blockIdx.x * NWAVES + F.wave; F.NGW = gridDim.x * NWAVES;
    F.x = args.in[0]; F.c = args.in[1]; F.w_ada = args.in[2]; F.b_ada = args.in[3]; F.w_in = args.in[4]; F.b_forget = args.in[5]; F.conv_w = args.in[6]; F.conv_b = args.in[7];
    F.conv_ln_g = args.in[8]; F.conv_ln_b = args.in[9]; F.w_conv_out = args.in[10]; F.w_fox_out = args.in[11]; F.w_mix_out = args.in[12]; F.ln1_g = args.in[13]; F.ln1_b = args.in[14];
    F.w_router = args.in[15]; F.router_bias = args.in[16]; F.w_exp_gate = args.in[17]; F.w_exp_up = args.in[18]; F.w_exp_down = args.in[19]; F.w_sh_gate = args.in[20]; F.w_sh_up = args.in[21];
    F.w_sh_down = args.in[22]; F.ln2_g = args.in[23]; F.ln2_b = args.in[24];
    F.out = args.out; F.ws = args.ws; unsigned char* ws = args.ws;
    F.ctl = (unsigned*)(ws + WS_CTL);
    F.ADA = (float*)(ws + WS_ADA); F.ADAP = (float*)(ws + WS_ADAP); F.CUM = (float*)(ws + WS_CUM); F.LOGF = (float*)(ws + WS_LOGF); F.X1 = (float*)(ws + WS_X1); F.RL = (float*)(ws + WS_RL);
    F.LISTW = (float*)(ws + WS_LISTW); F.WFC = (float*)(ws + WS_WFC); F.LIST = (int*)(ws + WS_LIST);
    F.H = (bf16_t*)(ws + WS_H); F.U = (bf16_t*)(ws + WS_U); F.Q = (bf16_t*)(ws + WS_Q); F.K = (bf16_t*)(ws + WS_K); F.V = (bf16_t*)(ws + WS_V); F.AC = (bf16_t*)(ws + WS_AC); F.O = (bf16_t*)(ws + WS_O);
    F.GA = (bf16_t*)(ws + WS_GA); F.GB = (bf16_t*)(ws + WS_GB); F.YA = (bf16_t*)(ws + WS_YA); F.MG = (bf16_t*)(ws + WS_MG); F.YAS = (bf16_t*)(ws + WS_YAS); F.H2 = (bf16_t*)(ws + WS_H2);
    F.H2LO = (bf16_t*)(ws + WS_H2LO); F.SHID = (bf16_t*)(ws + WS_SHID); F.HID = (bf16_t*)(ws + WS_HID);
    const int lo = args.ph_lo, hi = args.ph_hi;
    volatile LAS unsigned* MISC = (volatile LAS unsigned*)(F.lds + MISC_OFF);
    for (int u = F.tid; u < 32; u += NTHR) MISC[u] = 0u;
    __syncthreads();
    XcdBarrier bar; bar.bar = F.ctl + CW_BAR; bar.x = 0; bar.st = MISC + 8;
    if (hi - lo > 1) bar = xcd_barrier_post(F.ctl + CW_BAR, MISC + 8);
    F.vid = blockIdx.x;
#define IN(k) (lo <= (k) && (k) < hi)
#define SEAM(k) do { if (IN(k) && IN((k) + 1)) xcd_barrier(bar); } while (0)
    if (IN(0)) { { ph_ada(F); ph_convert(F, false); } if (PROBE_PHASE == 0) { __syncthreads(); { ph_ada(F); ph_convert(F, false); } } }
    SEAM(0);
    if (IN(0) && IN(1)) {
        if (F.tid == 0) { unsigned v = MISC[12]; for (unsigned j = 0; j < bar.x; ++j) v += xb_ld(&bar.bar[XB_XCNT(j)]); MISC[13] = v; }
        __syncthreads(); F.vid = __builtin_amdgcn_readfirstlane((int)MISC[13]); if (F.vid < 0 || F.vid >= (int)gridDim.x) F.vid = blockIdx.x; }
    if (IN(1)) { ph_lnmod(F); if (PROBE_PHASE == 1) { __syncthreads(); ph_lnmod(F); } }
    SEAM(1);
    if (IN(2)) { { ph_scan(F); ph_inproj_fast(F); } if (PROBE_PHASE == 2) { __syncthreads(); { ph_scan(F); ph_inproj_fast(F); } } }
    SEAM(2);
    if (IN(3)) { {} if (PROBE_PHASE == 3) { __syncthreads(); {} } }
    if (IN(4)) { ph_conv(F); __syncthreads(); if (PROBE_PHASE == 4) { ph_conv(F); __syncthreads(); } ph_attn_fast(F); }
    SEAM(4);
    if (IN(5)) { ph_merge_fast(F); if (PROBE_PHASE == 5) { __syncthreads(); ph_merge_fast(F); } }
    SEAM(5);
    if (IN(6)) { ph_mix_fast(F); if (PROBE_PHASE == 6) { __syncthreads(); ph_mix_fast(F); } }
    SEAM(6);
    if (IN(7)) { ph_ln2(F); if (PROBE_PHASE == 7) { __syncthreads(); ph_ln2(F); } }
    SEAM(7);
    if (IN(8)) { ph_router_fast(F); if (PROBE_PHASE == 8) { __syncthreads(); ph_router_fast(F); } }
    SEAM(8);
    if (IN(9)) { ph_route(F, 3); if (PROBE_PHASE == 9) { __syncthreads(); ph_route(F, 3); } }
    SEAM(9);
    if (IN(10)) { ph_moe1_fast(F); if (PROBE_PHASE == 10) { __syncthreads(); ph_moe1_fast(F); }
        if (PROBE_PHASE == 100) { __syncthreads(); ph_moe1_experts<0>(F, (bf16_t*)(F.ws + WS_WEGU_T)); } if (PROBE_PHASE == 101) { __syncthreads(); ph_moe1_experts<1>(F, (bf16_t*)(F.ws + WS_WEGU_T)); }
        if (PROBE_PHASE == 102) { __syncthreads(); ph_moe1_experts<2>(F, (bf16_t*)(F.ws + WS_WEGU_T)); } }
    SEAM(10);
    if (IN(11)) { ph_moe2_fast(F); if (PROBE_PHASE == 11) { __syncthreads(); ph_moe2_fast(F); } }
    SEAM(11);
    if (IN(12)) { ph_combine(F); if (PROBE_PHASE == 12) { __syncthreads(); ph_combine(F); } }
#undef IN
#undef SEAM
}

extern "C" void kernel_launch(void* const* d_in, const int* in_sizes, int n_in, void* d_out, int out_size, void* d_ws, size_t ws_size, hipStream_t stream) {
    static int grid = 0;
    if (grid == 0) {
        if (n_in != 25 || out_size != T * D || ws_size < WS_END) { fprintf(stderr, "kernel_launch: unexpected sizes: n_in %d out %d ws %zu (need %zu)\n", n_in, out_size, ws_size, (size_t)WS_END); grid = -1; return; }
        int dev = 0, cus = 0, per_cu = 0;
        (void)hipGetDevice(&dev); (void)hipDeviceGetAttribute(&cus, hipDeviceAttributeMultiprocessorCount, dev);
        (void)hipFuncSetAttribute((const void*)fwd_kernel, hipFuncAttributeMaxDynamicSharedMemorySize, LDS_BYTES);
        (void)hipOccupancyMaxActiveBlocksPerMultiprocessor(&per_cu, (const void*)fwd_kernel, NTHR, LDS_BYTES);
        (void)hipGetLastError();
        if (per_cu < 1) { fprintf(stderr, "kernel_launch: occupancy query says %d blocks/CU\n", per_cu); }
        grid = cus > 0 ? cus : 256;
    }
    if (grid < 0) return;
    (void)hipMemsetAsync((char*)d_ws + WS_CTL, 0, CTL_BYTES, stream);
    Args a{};
    for (int i = 0; i < 25; ++i) a.in[i] = (const float*)d_in[i];
    a.out = (float*)d_out; a.ws = (unsigned char*)d_ws;
    if (N_LAUNCHES == 1) {
        a.ph_lo = 0; a.ph_hi = NPHASE;
        void* kargs[] = {(void*)&a};
        const hipError_t e = hipLaunchCooperativeKernel((const void*)fwd_kernel, dim3(grid), dim3(NTHR), kargs, LDS_BYTES, stream);
        if (e != hipSuccess) fprintf(stderr, "kernel_launch: cooperative launch failed: %s (grid %d)\n", hipGetErrorString(e), grid);
    } else {
        for (int p = 0; p < NPHASE; ++p) { a.ph_lo = p; a.ph_hi = p + 1; hipLaunchKernelGGL(fwd_kernel, dim3(grid), dim3(NTHR), LDS_BYTES, stream, a); }
    }
}
```

```cpp
#include <hip/hip_runtime.h>
#include <cstdio>
#include <cstdint>
#include <hip/hip_bf16.h>

#define LAS __attribute__((address_space(3)))
typedef unsigned short bf16_t;
typedef float f32x4 __attribute__((ext_vector_type(4)));
typedef unsigned u32x4 __attribute__((ext_vector_type(4)));
typedef unsigned u32x2 __attribute__((ext_vector_type(2)));

constexpr int NB = 2, S = 8192, D = 1024, T = NB * S;
constexpr int CC = 512, CW = 31, NH = 8, HD = 64, FW = 512;
constexpr int NE = 256, TOPK = 8, NG = 8, EH = 256, SHH = 256;
constexpr int INC = 4616;
constexpr int O_Q = 1024, O_K = 1536, O_V = 2048, O_F = 2560, O_GA = 2568, O_GB = 3592;
constexpr float LN_EPS = 1e-5f;
constexpr float ALPHA = 1.189207115002721f;
constexpr float LOG2E = 1.4426950408889634f;
constexpr float QSCALE = 0.125f * LOG2E;
constexpr float ROUTED_SCALE = 2.5f;
constexpr int NWAVES = 8, NTHR = 512;
constexpr int LCAP = 16384;
constexpr int NSLOT = 9;
constexpr int LDS_BYTES = 147456, MISC_OFF = 131072 + 320;

constexpr size_t MiB = 1u << 20;
constexpr size_t WS_CTL = 0, CTL_BYTES = 1 * MiB;
constexpr size_t WS_ADA = 1 * MiB;
constexpr size_t WS_ADAP = 1 * MiB + 64 * 1024;
constexpr size_t WS_CUM = 2 * MiB;
constexpr size_t WS_LOGF = 2 * MiB + 512 * 1024;
constexpr size_t WS_WFC = 3 * MiB + 512 * 1024;
constexpr size_t WS_H = 20 * MiB;
constexpr size_t WS_U = 52 * MiB, WS_Q = 68 * MiB, WS_K = 84 * MiB, WS_V = 100 * MiB, WS_AC = 116 * MiB, WS_O = 132 * MiB;
constexpr size_t WS_GA = 148 * MiB, WS_GB = 180 * MiB, WS_YA = 212 * MiB, WS_MG = 244 * MiB;
constexpr size_t WS_YAS = 20 * MiB;
constexpr size_t WS_X1 = 308 * MiB;
constexpr size_t WS_H2 = 372 * MiB, WS_H2LO = 404 * MiB;
constexpr size_t WS_RL = 436 * MiB;
constexpr size_t WS_SHID = 484 * MiB;
constexpr size_t WS_LIST = 492 * MiB, WS_LISTW = 508 * MiB;
constexpr size_t WS_HID = 524 * MiB;
constexpr size_t WS_END = 1024 * MiB;
constexpr int CW_CNT = 1024;
constexpr int CW_NORM = 2048;
constexpr int CW_AQ = 2304;
constexpr int CW_FQ = 2816, CW_CQ = 3392;

__device__ __forceinline__ float bf2f(bf16_t v) { return __uint_as_float((unsigned)v << 16); }
__device__ __forceinline__ unsigned f2bf(float f) { unsigned u = __float_as_uint(f); return (u + 0x7fffu + ((u >> 16) & 1u)) >> 16; }
__device__ __forceinline__ unsigned pk2(float lo, float hi) { return f2bf(lo) | (f2bf(hi) << 16); }
__device__ __forceinline__ float wave_sum(float v) {
#pragma unroll
    for (int o = 1; o < 64; o <<= 1) v += __shfl_xor(v, o);
    return v;
}
__device__ __forceinline__ float wave_max(float v) {
#pragma unroll
    for (int o = 1; o < 64; o <<= 1) v = fmaxf(v, __shfl_xor(v, o));
    return v;
}
__device__ __forceinline__ int ltid() { int t = (int)__builtin_amdgcn_mbcnt_hi(~0u, __builtin_amdgcn_mbcnt_lo(~0u, 0u)); asm volatile("" : "+v"(t)); return t; }
__device__ __forceinline__ float sigmoidf_(float x) { return 1.0f / (1.0f + expf(-x)); }
__device__ __forceinline__ float siluf_(float x) { return x / (1.0f + expf(-x)); }


constexpr int CW_BAR = 4096;
#define XB_TMO      128
#define XB_XCNT(j)  (256  + 64 * (j))
#define XB_XSUB(j)  (1280 + 64 * (j))
#define XB_XGEN(j)  (2304 + 64 * (j))
#define XB_TOP      3328
#define XB_TOPGEN   3392
#define XCD_BAR_WORDS 3456
#define XB_SPIN_CAP (1u << 20)
__device__ __forceinline__ unsigned xb_ld(unsigned* p)              { return __hip_atomic_load(p, __ATOMIC_RELAXED, __HIP_MEMORY_SCOPE_AGENT); }
__device__ __forceinline__ unsigned xb_add(unsigned* p, unsigned v) { return __hip_atomic_fetch_add(p, v, __ATOMIC_RELAXED, __HIP_MEMORY_SCOPE_AGENT); }
__device__ __forceinline__ unsigned xb_xcc_id() { return (unsigned)__builtin_amdgcn_s_getreg((3 << 11) | 20) & 0xFu; }
#define XB_SPIN(cond, bar) do { unsigned _sp = 0; while (cond) { __builtin_amdgcn_s_sleep(1); \
    if ((++_sp & 255u) == 0u) { if (xb_ld(&(bar)[XB_TMO])) break; if (_sp > XB_SPIN_CAP) { atomicAdd(&(bar)[XB_TMO], 1u); break; } } } } while (0)
struct XcdBarrier { unsigned* bar; unsigned x; volatile LAS unsigned* st; };
__device__ __forceinline__ XcdBarrier xcd_barrier_post(unsigned* bar, volatile LAS unsigned* st) {
    XcdBarrier b; b.bar = bar; b.x = xb_xcc_id(); b.st = st;
    if (threadIdx.x == 0) st[4] = xb_add(&bar[XB_XCNT(b.x)], 1u);
    return b;
}
__device__ __forceinline__ void xcd_barrier_complete(unsigned* bar, unsigned x, unsigned& nloc, unsigned& nx) {
    const unsigned G = gridDim.x * gridDim.y * gridDim.z;
    unsigned sum, cnt, mine, sp = 0u;
    for (;;) {
        sum = 0u; cnt = 0u; mine = 0u;
#pragma unroll
        for (unsigned j = 0; j < 16; ++j) { const unsigned c = xb_ld(&bar[XB_XCNT(j)]); sum += c; cnt += (c > 0u) ? 1u : 0u; mine = (j == x) ? c : mine; }
        if (sum == G) break;
        __builtin_amdgcn_s_sleep(1);
        if ((++sp & 255u) == 0u) { if (xb_ld(&bar[XB_TMO])) break; if (sp > XB_SPIN_CAP) { atomicAdd(&bar[XB_TMO], 1u); break; } }
    }
    nloc = mine > 0u ? mine : 1u; nx = cnt > 0u ? cnt : 1u;
}
__device__ __forceinline__ void xcd_barrier(const XcdBarrier& b) {
    asm volatile("s_waitcnt vmcnt(0)" ::: "memory");
    __syncthreads();
    if (threadIdx.x == 0) {
        unsigned* bar = b.bar;
        __builtin_amdgcn_s_waitcnt(0);
        unsigned nloc = b.st[0], nx = b.st[1];
        if (nloc == 0u) { xcd_barrier_complete(bar, b.x, nloc, nx); b.st[0] = nloc; b.st[1] = nx; }
        const unsigned old = xb_add(&bar[XB_XSUB(b.x)], 1u);
        const unsigned gen = old / nloc;
        if (old + 1u == (gen + 1u) * nloc) {
            __builtin_amdgcn_fence(__ATOMIC_RELEASE, "agent");
            asm volatile("s_waitcnt vmcnt(0)" ::: "memory");
            const unsigned og = xb_add(&bar[XB_TOP], 1u);
            const unsigned tg = og / nx;
            if (og + 1u == (tg + 1u) * nx) xb_add(&bar[XB_TOPGEN], 1u);
            else XB_SPIN(xb_ld(&bar[XB_TOPGEN]) == tg, bar);
            __builtin_amdgcn_fence(__ATOMIC_ACQUIRE, "agent");
            xb_add(&bar[XB_XGEN(b.x)], 1u);
            asm volatile("s_waitcnt vmcnt(0)" ::: "memory");
        } else {
            XB_SPIN(xb_ld(&bar[XB_XGEN(b.x)]) == gen, bar);
            __builtin_amdgcn_fence(__ATOMIC_ACQUIRE, "agent");
            asm volatile("s_waitcnt vmcnt(0)" ::: "memory");
        }
    }
    __syncthreads();
}

struct Args { const float* in[25]; float* out; unsigned char* ws; int ph_lo, ph_hi; };

struct Frame {
    LAS unsigned char* lds; unsigned char* lds_generic;
    int tid, lane, wave, gw, NGW, vid;
    const float *x, *c, *w_ada, *b_ada, *w_in, *b_forget, *conv_w, *conv_b, *conv_ln_g, *conv_ln_b, *w_conv_out, *w_fox_out, *w_mix_out, *ln1_g, *ln1_b,
        *w_router, *router_bias, *w_exp_gate, *w_exp_up, *w_exp_down, *w_sh_gate, *w_sh_up, *w_sh_down, *ln2_g, *ln2_b;
    float* out; unsigned char* ws;
    unsigned* ctl;
    float *ADA, *ADAP, *CUM, *LOGF, *X1, *RL, *LISTW, *WFC;
    bf16_t *H, *U, *Q, *K, *V, *AC, *O, *GA, *GB, *YA, *MG, *YAS, *H2, *H2LO, *SHID, *HID;
    int* LIST;
};

__device__ __forceinline__ void ph_ada(Frame& F) {
    F.lane = ltid(); F.tid = F.wave * 64 + F.lane;
    if (blockIdx.x == gridDim.x - 1) for (int i = F.tid; i < 8192; i += NTHR) { const int k = i >> 3, hh = i & 7; F.WFC[hh * 1024 + k] = F.w_in[(size_t)k * INC + O_F + hh]; }
    if (blockIdx.x >= 24) return;
    LAS float* part = (LAS float*)F.lds;
    const float* c = F.c; const float* w = F.w_ada;
    const int j0 = blockIdx.x * 256 + F.lane * 4, kc = F.wave;
    f32x4 a0 = {0.f, 0.f, 0.f, 0.f}, a1 = {0.f, 0.f, 0.f, 0.f};
#pragma unroll 8
    for (int k = kc * 128; k < kc * 128 + 128; ++k) {
        const f32x4 wv = *(const f32x4*)(w + (size_t)k * 6144 + j0);
        const float c0 = siluf_(c[k]), c1 = siluf_(c[D + k]);
        a0 += wv * c0; a1 += wv * c1;
    }
    *(LAS f32x4*)(part + (kc * 2 + 0) * 256 + F.lane * 4) = a0;
    *(LAS f32x4*)(part + (kc * 2 + 1) * 256 + F.lane * 4) = a1;
    __syncthreads();
    { const int b = F.tid >> 8, j = F.tid & 255; float s = F.b_ada[blockIdx.x * 256 + j];
#pragma unroll
      for (int p = 0; p < 8; ++p) s += part[(p * 2 + b) * 256 + j];
      F.ADA[b * 6144 + blockIdx.x * 256 + j] = s; }
    __syncthreads();
}

__device__ __forceinline__ float wave_sum8(const float (&a)[8], int lane) {
    float b[4], c[2];
#pragma unroll
    for (int i = 0; i < 4; ++i) { const float keep = (lane & 1) ? a[2 * i + 1] : a[2 * i], send = (lane & 1) ? a[2 * i] : a[2 * i + 1]; b[i] = keep + __shfl_xor(send, 1); }
#pragma unroll
    for (int i = 0; i < 2; ++i) { const float keep = (lane & 2) ? b[2 * i + 1] : b[2 * i], send = (lane & 2) ? b[2 * i] : b[2 * i + 1]; c[i] = keep + __shfl_xor(send, 2); }
    float d = ((lane & 4) ? c[1] : c[0]) + __shfl_xor((lane & 4) ? c[0] : c[1], 4);
    d += __shfl_xor(d, 8); d += __shfl_xor(d, 16); d += __shfl_xor(d, 32);
    return d;
}
__device__ __forceinline__ void ph_lnmod(Frame& F) {
    F.lane = ltid(); F.tid = F.wave * 64 + F.lane;
    LAS float* ada1 = (LAS float*)F.lds;
    LAS float* wf = ada1 + 4096;
    for (int i = F.tid; i < 1024; i += NTHR) { const int b = i >> 9, j = (i & 511) * 4; *(LAS f32x4*)(ada1 + b * 2048 + j) = *(const f32x4*)(F.ADA + b * 6144 + j); }
    for (int i = F.tid; i < 2048; i += NTHR) *(LAS f32x4*)(wf + 4 * i) = *(const f32x4*)(F.WFC + 4 * i);
    __syncthreads();
    const int lane = F.lane;
    constexpr int R = 4;
    for (int m0 = F.gw * R; m0 < T; m0 += F.NGW * R) {
        f32x4 v[R][4]; float mean[R], rstd[R];
#pragma unroll
        for (int r = 0; r < R; ++r) { const f32x4* xr = (const f32x4*)(F.x + (size_t)(m0 + r) * D) + lane;
#pragma unroll
            for (int j = 0; j < 4; ++j) v[r][j] = xr[64 * j]; }
#pragma unroll
        for (int r = 0; r < R; ++r) { float s = 0.f;
#pragma unroll
            for (int j = 0; j < 4; ++j) s += (v[r][j].x + v[r][j].y) + (v[r][j].z + v[r][j].w);
            mean[r] = wave_sum(s) * (1.f / D); }
#pragma unroll
        for (int r = 0; r < R; ++r) { float s2 = 0.f;
#pragma unroll
            for (int j = 0; j < 4; ++j) { v[r][j] = v[r][j] - mean[r]; s2 += (v[r][j].x * v[r][j].x + v[r][j].y * v[r][j].y) + (v[r][j].z * v[r][j].z + v[r][j].w * v[r][j].w); }
            rstd[r] = 1.f / sqrtf(wave_sum(s2) * (1.f / D) + LN_EPS); }
#pragma unroll
        for (int r = 0; r < R; ++r) { const int m = m0 + r, b = m >> 13;
            float fl[8];
#pragma unroll
            for (int hh = 0; hh < 8; ++hh) fl[hh] = 0.f;
            u32x2* hrow = (u32x2*)(F.H + (size_t)m * D) + lane;
#pragma unroll
            for (int j = 0; j < 4; ++j) { const int col = 4 * lane + 256 * j;
                const f32x4 sh = *(const LAS f32x4*)(ada1 + b * 2048 + col), sc = *(const LAS f32x4*)(ada1 + b * 2048 + 1024 + col);
                const f32x4 h = v[r][j] * rstd[r] * (sc + 1.0f) + sh;
                u32x2 o; o.x = pk2(h.x, h.y); o.y = pk2(h.z, h.w); hrow[64 * j] = o;
#pragma unroll
                for (int hh = 0; hh < 8; ++hh) { const f32x4 w = *(const LAS f32x4*)(wf + hh * 1024 + col); fl[hh] += (h.x * w.x + h.y * w.y) + (h.z * w.z + h.w * w.w); }
                asm volatile("" ::: "memory"); }
            const float f = wave_sum8(fl, lane);
            if (lane < 8) { const float z = f + F.b_forget[lane]; F.LOGF[(size_t)m * 8 + lane] = fminf(z, 0.f) - log1pf(expf(-fabsf(z))); } }
    }
}

__device__ __forceinline__ void ph_scan(Frame& F) {
    F.lane = ltid(); F.tid = F.wave * 64 + F.lane;
    if (blockIdx.x >= 16) return;
    LAS double* sc = (LAS double*)F.lds;
    const int bh = blockIdx.x, b = bh >> 3, hh = bh & 7, s0 = F.tid * 16;
    double loc[16]; double run = 0.0;
#pragma unroll
    for (int i = 0; i < 16; ++i) { run += (double)F.LOGF[(size_t)(b * S + s0 + i) * 8 + hh]; loc[i] = run; }
    sc[F.tid] = run;
    __syncthreads();
    double off = 0.0;
    for (int i = 0; i < F.tid; ++i) off += sc[i];
#pragma unroll
    for (int i = 0; i < 16; ++i) F.CUM[(size_t)bh * S + s0 + i] = (float)(off + loc[i]);
    __syncthreads();
}

__device__ __forceinline__ void ph_conv(Frame& F) {
    F.lane = ltid(); F.tid = F.wave * 64 + F.lane;
    constexpr int RUN = 8, NIN = RUN + CW - 1, PADJ = RUN - 1, NTAB = CW + 2 * PADJ + 2;
    LAS float* cw = (LAS float*)F.lds;
    LAS float* cb = cw + NTAB * CC;
    for (int i = F.tid; i < NTAB * CC / 4; i += NTHR) { const int jj = (4 * i) / CC, j = jj - PADJ;
        *(LAS f32x4*)(cw + 4 * i) = (j >= 0 && j < CW) ? *(const f32x4*)(F.conv_w + (size_t)j * CC + (4 * i) % CC) : (f32x4){0.f, 0.f, 0.f, 0.f}; }
    for (int i = F.tid; i < CC; i += NTHR) { cb[i] = F.conv_b[i]; cb[CC + i] = F.conv_ln_g[i]; cb[2 * CC + i] = F.conv_ln_b[i]; }
    __syncthreads();
    const int lane = F.lane, c0 = lane * 8;
    for (int run = F.gw; run < T / RUN; run += F.NGW) {
        const int m0 = run * RUN, t0 = m0 & (S - 1);
        float a[RUN][8];
#pragma unroll
        for (int r = 0; r < RUN; ++r)
#pragma unroll
            for (int i = 0; i < 8; ++i) a[r][i] = cb[c0 + i];
#pragma unroll 1
        for (int c = 0; c < (NIN + 7) / 8; ++c) {
            u32x4 uv[8];
#pragma unroll
            for (int k = 0; k < 8; ++k) { const int i = 8 * c + k; uv[k] = (u32x4){0u, 0u, 0u, 0u};
                if (i < NIN && t0 - (CW - 1) + i >= 0) uv[k] = *(const u32x4*)(F.U + (size_t)(m0 - (CW - 1) + i) * CC + c0); }
            float u[8][8];
#pragma unroll
            for (int k = 0; k < 8; ++k) {
                u[k][0] = __uint_as_float(uv[k].x << 16); u[k][1] = __uint_as_float(uv[k].x & 0xffff0000u); u[k][2] = __uint_as_float(uv[k].y << 16); u[k][3] = __uint_as_float(uv[k].y & 0xffff0000u);
                u[k][4] = __uint_as_float(uv[k].z << 16); u[k][5] = __uint_as_float(uv[k].z & 0xffff0000u); u[k][6] = __uint_as_float(uv[k].w << 16); u[k][7] = __uint_as_float(uv[k].w & 0xffff0000u); }
#pragma unroll
            for (int d = -(RUN - 1); d < 8; ++d) {
                const LAS float* wrow = cw + (8 * c + d + PADJ) * CC + c0;
                const f32x4 w0 = *(const LAS f32x4*)(wrow), w1 = *(const LAS f32x4*)(wrow + 4);
#pragma unroll
                for (int r = 0; r < RUN; ++r) { const int k = r + d;
                    if (k >= 0 && k < 8) {
                        a[r][0] += u[k][0] * w0.x; a[r][1] += u[k][1] * w0.y; a[r][2] += u[k][2] * w0.z; a[r][3] += u[k][3] * w0.w;
                        a[r][4] += u[k][4] * w1.x; a[r][5] += u[k][5] * w1.y; a[r][6] += u[k][6] * w1.z; a[r][7] += u[k][7] * w1.w; } }
                asm volatile("" ::: "memory"); }
        }
#pragma unroll
        for (int r = 0; r < RUN; ++r) {
            float s = 0.f;
#pragma unroll
            for (int i = 0; i < 8; ++i) s += a[r][i];
            const float mean = wave_sum(s) * (1.f / CC); float s2 = 0.f;
#pragma unroll
            for (int i = 0; i < 8; ++i) { a[r][i] -= mean; s2 += a[r][i] * a[r][i]; }
            const float rstd = 1.f / sqrtf(wave_sum(s2) * (1.f / CC) + LN_EPS);
            float y[8];
#pragma unroll
            for (int i = 0; i < 8; ++i) y[i] = siluf_(a[r][i] * rstd * cb[CC + c0 + i] + cb[2 * CC + c0 + i]);
            u32x4 o; o.x = pk2(y[0], y[1]); o.y = pk2(y[2], y[3]); o.z = pk2(y[4], y[5]); o.w = pk2(y[6], y[7]);
            *(u32x4*)(F.AC + (size_t)(m0 + r) * CC + c0) = o;
        }
    }
}

__device__ __forceinline__ void ph_ln2(Frame& F) {
    F.lane = ltid(); F.tid = F.wave * 64 + F.lane;
    const int lane = F.lane;
    constexpr int R = 4;
    for (int m0 = F.gw * R; m0 < T; m0 += F.NGW * R) {
        f32x4 v[R][4]; float mean[R], rstd[R];
#pragma unroll
        for (int r = 0; r < R; ++r) { const f32x4* zr = (const f32x4*)(F.X1 + (size_t)(m0 + r) * D) + lane;
#pragma unroll
            for (int j = 0; j < 4; ++j) v[r][j] = zr[64 * j]; }
#pragma unroll
        for (int r = 0; r < R; ++r) { float s = 0.f;
#pragma unroll
            for (int j = 0; j < 4; ++j) s += (v[r][j].x + v[r][j].y) + (v[r][j].z + v[r][j].w);
            mean[r] = wave_sum(s) * (1.f / D); }
#pragma unroll
        for (int r = 0; r < R; ++r) { float s2 = 0.f;
#pragma unroll
            for (int j = 0; j < 4; ++j) { v[r][j] = v[r][j] - mean[r]; s2 += (v[r][j].x * v[r][j].x + v[r][j].y * v[r][j].y) + (v[r][j].z * v[r][j].z + v[r][j].w * v[r][j].w); }
            rstd[r] = 1.f / sqrtf(wave_sum(s2) * (1.f / D) + LN_EPS); }
#pragma unroll
        for (int r = 0; r < R; ++r) { f32x4* zr = (f32x4*)(F.X1 + (size_t)(m0 + r) * D) + lane; float s = 0.f;
#pragma unroll
            for (int j = 0; j < 4; ++j) { const int col = 4 * lane + 256 * j;
                v[r][j] = v[r][j] * rstd[r] * *(const f32x4*)(F.ln1_g + col) + *(const f32x4*)(F.ln1_b + col);
                zr[64 * j] = v[r][j]; s += (v[r][j].x + v[r][j].y) + (v[r][j].z + v[r][j].w); }
            mean[r] = wave_sum(s) * (1.f / D); }
#pragma unroll
        for (int r = 0; r < R; ++r) { float s2 = 0.f;
#pragma unroll
            for (int j = 0; j < 4; ++j) { v[r][j] = v[r][j] - mean[r]; s2 += (v[r][j].x * v[r][j].x + v[r][j].y * v[r][j].y) + (v[r][j].z * v[r][j].z + v[r][j].w * v[r][j].w); }
            rstd[r] = 1.f / sqrtf(wave_sum(s2) * (1.f / D) + LN_EPS); }
#pragma unroll
        for (int r = 0; r < R; ++r) { const int m = m0 + r, b = m >> 13;
            u32x2* hr = (u32x2*)(F.H2 + (size_t)m * D) + lane; u32x2* lr = (u32x2*)(F.H2LO + (size_t)m * D) + lane;
#pragma unroll
            for (int j = 0; j < 4; ++j) { const int col = 4 * lane + 256 * j;
                const f32x4 sh = *(const f32x4*)(F.ADA + b * 6144 + 3072 + col), sc = *(const f32x4*)(F.ADA + b * 6144 + 4096 + col);
                const f32x4 h = v[r][j] * rstd[r] * (sc + 1.0f) + sh;
                const unsigned h0 = f2bf(h.x), h1 = f2bf(h.y), h2 = f2bf(h.z), h3 = f2bf(h.w);
                u32x2 o; o.x = h0 | (h1 << 16); o.y = h2 | (h3 << 16); hr[64 * j] = o;
                u32x2 l; l.x = pk2(h.x - __uint_as_float(h0 << 16), h.y - __uint_as_float(h1 << 16)); l.y = pk2(h.z - __uint_as_float(h2 << 16), h.w - __uint_as_float(h3 << 16)); lr[64 * j] = l; } }
    }
}

__device__ __forceinline__ void ph_route(Frame& F, int nparts) {
    F.lane = ltid(); F.tid = F.wave * 64 + F.lane;
    const int lane = F.lane;
    for (int t = F.gw; t < T; t += F.NGW) {
        f32x4 lg = *(const f32x4*)(F.RL + (size_t)t * NE + lane * 4);
        for (int p = 1; p < nparts; ++p) lg += *(const f32x4*)(F.RL + (size_t)p * T * NE + (size_t)t * NE + lane * 4);
        const f32x4 bias = *(const f32x4*)(F.router_bias + lane * 4);
        float sc[4], sel[4];
#pragma unroll
        for (int i = 0; i < 4; ++i) { sc[i] = sigmoidf_(lg[i]); sel[i] = sc[i] + bias[i]; }
        float a1 = fmaxf(sel[0], sel[1]), a2 = fminf(sel[0], sel[1]);
        { const float b1 = fmaxf(sel[2], sel[3]), b2 = fminf(sel[2], sel[3]); const float n1 = fmaxf(a1, b1), n2 = fmaxf(fminf(a1, b1), fmaxf(a2, b2)); a1 = n1; a2 = n2; }
#pragma unroll
        for (int o = 1; o < 8; o <<= 1) { const float b1 = __shfl_xor(a1, o), b2 = __shfl_xor(a2, o); const float n1 = fmaxf(a1, b1), n2 = fmaxf(fminf(a1, b1), fmaxf(a2, b2)); a1 = n1; a2 = n2; }
        const float gs = a1 + a2; const int g = lane >> 3;
        int rank = 0;
#pragma unroll
        for (int gg = 0; gg < NG; ++gg) { const float og = __shfl(gs, gg * 8); rank += (og > gs || (og == gs && gg < g)) ? 1 : 0; }
        const bool gsel = rank < 4;
        float mv[4];
#pragma unroll
        for (int i = 0; i < 4; ++i) mv[i] = gsel ? sel[i] : -INFINITY;
        float myw = 0.f; int mye = 0; float wsum = 0.f;
#pragma unroll
        for (int k = 0; k < TOPK; ++k) {
            float bv = mv[0]; int bi = 0;
#pragma unroll
            for (int i = 1; i < 4; ++i) if (mv[i] > bv) { bv = mv[i]; bi = i; }
            int be = lane * 4 + bi; float bs = sc[0];
#pragma unroll
            for (int i = 1; i < 4; ++i) bs = (bi == i) ? sc[i] : bs;
            float v = bv; int e = be; float s = bs;
#pragma unroll
            for (int o = 1; o < 64; o <<= 1) { const float ov = __shfl_xor(v, o); const int oe = __shfl_xor(e, o); const float os = __shfl_xor(s, o);
                if (ov > v || (ov == v && oe < e)) { v = ov; e = oe; s = os; } }
            if ((e >> 2) == lane) {
#pragma unroll
                for (int i = 0; i < 4; ++i) if ((e & 3) == i) mv[i] = -INFINITY; }
            wsum += s;
            if (lane == k) { myw = s; mye = e; }
        }
        if (lane < TOPK) {
            const float w = myw / wsum * ROUTED_SCALE;
            const unsigned p = atomicAdd(F.ctl + CW_CNT + mye, 1u);
            F.LIST[(size_t)mye * LCAP + p] = t * TOPK + lane;
            F.LISTW[(size_t)mye * LCAP + p] = w;
        }
    }
}

__device__ __forceinline__ void build_expert_map(Frame& F, LAS int* pref, LAS int* base, int rows_per_chunk) {
    __syncthreads();
    if (F.tid == 0) { int p = 0, bsum = 0;
        for (int e = 0; e < NE; ++e) { const int n = (int)F.ctl[CW_CNT + e]; pref[e] = p; base[e] = bsum; p += (n + rows_per_chunk - 1) / rows_per_chunk; bsum += n; }
        pref[NE] = p; base[NE] = bsum; }
    __syncthreads();
}
__device__ __forceinline__ int find_expert(const LAS int* pref, int u) { int lo = 0, hi = NE - 1;
    while (lo < hi) { const int mid = (lo + hi + 1) >> 1; if (pref[mid] <= u) lo = mid; else hi = mid - 1; }
    return lo; }

__device__ __forceinline__ void ph_combine(Frame& F) {
    F.lane = ltid(); F.tid = F.wave * 64 + F.lane;
    const int lane = F.lane;
    constexpr int R = 2;
    for (int m0 = F.gw * R; m0 < T; m0 += F.NGW * R) {
        f32x4 y[R][4];
#pragma unroll
        for (int r = 0; r < R; ++r) {
            u32x4 w[NSLOT][2];
#pragma unroll
            for (int k = 0; k < NSLOT; ++k) { const u32x4* yr = (const u32x4*)(F.YAS + ((size_t)(m0 + r) * NSLOT + k) * D) + lane; w[k][0] = yr[0]; w[k][1] = yr[64]; }
#pragma unroll
            for (int j = 0; j < 4; ++j) y[r][j] = (f32x4){0.f, 0.f, 0.f, 0.f};
#pragma unroll
            for (int k = 0; k < NSLOT; ++k)
#pragma unroll
                for (int q = 0; q < 2; ++q) { const u32x4 t = w[k][q];
                    y[r][2 * q].x += __uint_as_float(t.x << 16); y[r][2 * q].y += __uint_as_float(t.x & 0xffff0000u); y[r][2 * q].z += __uint_as_float(t.y << 16); y[r][2 * q].w += __uint_as_float(t.y & 0xffff0000u);
                    y[r][2 * q + 1].x += __uint_as_float(t.z << 16); y[r][2 * q + 1].y += __uint_as_float(t.z & 0xffff0000u); y[r][2 * q + 1].z += __uint_as_float(t.w << 16); y[r][2 * q + 1].w += __uint_as_float(t.w & 0xffff0000u); }
        }
#pragma unroll
        for (int r = 0; r < R; ++r) { const int m = m0 + r, b = m >> 13;
            f32x4 v[4]; float s = 0.f;
#pragma unroll
            for (int j = 0; j < 4; ++j) { const int col = (j >> 1) * 512 + 8 * lane + 4 * (j & 1); const f32x4 g2 = *(const f32x4*)(F.ADA + b * 6144 + 5120 + col);
                v[j] = *(const f32x4*)(F.X1 + (size_t)m * D + col) * ALPHA + (g2 + 1.0f) * y[r][j]; s += (v[j].x + v[j].y) + (v[j].z + v[j].w); }
            const float mean = wave_sum(s) * (1.f / D); float s2 = 0.f;
#pragma unroll
            for (int j = 0; j < 4; ++j) { v[j] = v[j] - mean; s2 += (v[j].x * v[j].x + v[j].y * v[j].y) + (v[j].z * v[j].z + v[j].w * v[j].w); }
            const float rstd = 1.f / sqrtf(wave_sum(s2) * (1.f / D) + LN_EPS);
#pragma unroll
            for (int j = 0; j < 4; ++j) { const int col = (j >> 1) * 512 + 8 * lane + 4 * (j & 1); *(f32x4*)(F.out + (size_t)m * D + col) = v[j] * rstd * *(const f32x4*)(F.ln2_g + col) + *(const f32x4*)(F.ln2_b + col); } }
    }
}

namespace pg8 {
typedef short bf16x8 __attribute__((ext_vector_type(8)));
constexpr int BM = 256, BK = 64, HALF = 128, HTB = HALF * BK * 2, STAGE_BYTES = 8 * HTB, NXCD = 8, WGM = 8;
constexpr int RTAB_OFF = 131072 + 4096;
constexpr int XTAB_OFF = RTAB_OFF + 2048;
__host__ __device__ __forceinline__ int lds_byte(int r, int c) { const int st = (r >> 4) * 2 + (c >> 5), rr = r & 15, cc = c & 31, ob = rr * 64 + cc * 2; return st * 1024 + (ob ^ (((ob >> 9) & 1) << 5)); }
__host__ __device__ __forceinline__ void stage_rc(int b, int& R, int& C) { const int st = b / 1024, sb = b % 1024, swz = sb ^ (((sb >> 9) & 1) << 5); R = (st >> 1) * 16 + swz / 64; C = (st & 1) * 32 + (swz % 64) / 2; }
__host__ __device__ __forceinline__ int perm32(int rho) { const int n = rho >> 4, i = rho & 15; return 8 * (i >> 2) + 4 * n + (i & 3); }

struct Unit { const char* A; const char* B; const char* B2; int pm, pn, e, p0, ne, bs, hf; };

struct TileOrder {
    int nM, nN, nwg, G, c;
    __device__ void init(int nM_, int nN_, int G_, int c_) { nM = nM_; nN = nN_; nwg = nM * nN; G = G_; c = c_; }
    __device__ bool tile(int i, int& pm, int& pn) const {
        const long L = (long)i * G + c; if (L >= nwg) return false;
        int wgid = (int)L; { const int q = nwg / NXCD, r = nwg % NXCD, xcd = wgid % NXCD, off = wgid / NXCD; wgid = (xcd < r ? xcd * (q + 1) : r * (q + 1) + (xcd - r) * q) + off; }
        const int nig = WGM * nN, gid = wgid / nig, fm = gid * WGM, gsz = (nM - fm) < WGM ? (nM - fm) : WGM;
        pm = fm + ((wgid % nig) % gsz); pn = (wgid % nig) / gsz; return true;
    }
};

__device__ __forceinline__ unsigned cvt_pk_bf16(float lo, float hi) { unsigned r; asm volatile("v_cvt_pk_bf16_f32 %0, %1, %2" : "=v"(r) : "v"(lo), "v"(hi)); return r; }
__device__ __forceinline__ float fsigmoid(float x) { return __builtin_amdgcn_rcpf(1.0f + __builtin_amdgcn_exp2f(-LOG2E * x)); }

template <class Epi, class Sched, bool ALIGN_EPI>
__device__ __forceinline__ void gemm_phase(LAS unsigned char* lds, const int K, const int lda, const int ldb, const Sched& S, const Epi& E) {
    const int wid = __builtin_amdgcn_readfirstlane((int)threadIdx.x >> 6), lane = ltid(), tid = wid * 64 + lane, wr = wid >> 2, wc = wid & 3, fr = lane & 15, fq = lane >> 4;
    int nt = K / BK; asm volatile("" : "+s"(nt));
    int RA[2]; unsigned CA[2], voffB[2];
#pragma unroll
    for (int i = 0; i < 2; ++i) { int R, C; stage_rc(tid * 16 + i * 8192, R, C); const int Rb = (R & ~31) + perm32(R & 31);
        RA[i] = R; CA[i] = (unsigned)C * 2u; voffB[i] = (unsigned)(Rb * ldb + C) * 2u; }
    const size_t kstep = (size_t)(BK * 2);
    const size_t hstepB = (size_t)HALF * ldb * 2;
    const unsigned ldsw = (unsigned)wid * 1024u;
    const int aoff = lds_byte(wr * 64 + fr, fq * 8), boff = lds_byte(wc * 32 + fr, fq * 8);
#define PG8_SA(b, h) (((b) * 2 + (h)) * HTB)
#define PG8_SB(b, h) ((4 + (b) * 2 + (h)) * HTB)
#define PG8_STAGE(bufoff, gbase, voff) do { _Pragma("unroll") for (int _i = 0; _i < 2; ++_i) \
        __builtin_amdgcn_global_load_lds((const unsigned*)((const char*)(gbase) + (voff)[_i]), (LAS unsigned*)(lds + (bufoff) + ldsw + _i * 8192), 16, 0, 0); } while (0)
#define PG8_STAGE_NT(bufoff, gbase, voff) do { _Pragma("unroll") for (int _i = 0; _i < 2; ++_i) \
        __builtin_amdgcn_global_load_lds((const unsigned*)((const char*)(gbase) + (voff)[_i]), (LAS unsigned*)(lds + (bufoff) + ldsw + _i * 8192), 16, 0, 2); } while (0)
#define PG8_LDA(dst, b, h) do { _Pragma("unroll") for (int m = 0; m < 4; ++m) _Pragma("unroll") for (int k = 0; k < 2; ++k) dst[m][k] = *(const LAS bf16x8*)(lds + PG8_SA(b, h) + aoff + m * 2048 + k * 1024); } while (0)
#define PG8_LDB(dst, b, h) do { _Pragma("unroll") for (int n = 0; n < 2; ++n) _Pragma("unroll") for (int k = 0; k < 2; ++k) dst[n][k] = *(const LAS bf16x8*)(lds + PG8_SB(b, h) + boff + n * 2048 + k * 1024); } while (0)
#define PG8_MMA(ai, bj, At, Bt) do { __builtin_amdgcn_s_setprio(1); _Pragma("unroll") for (int m = 0; m < 4; ++m) _Pragma("unroll") for (int n = 0; n < 2; ++n) _Pragma("unroll") for (int k = 0; k < 2; ++k) \
        acc[ai][bj][m][n] = __builtin_amdgcn_mfma_f32_16x16x32_bf16(Bt[n][k], At[m][k], acc[ai][bj][m][n], 0, 0, 0); __builtin_amdgcn_s_setprio(0); } while (0)
#define PG8_WAIT_V(n) asm volatile("s_waitcnt vmcnt(" #n ")" ::: "memory")
#define PG8_WAIT_L(n) asm volatile("s_waitcnt lgkmcnt(" #n ")" ::: "memory")
#define PG8_BAR __builtin_amdgcn_s_barrier()
#define PG8_SCHED __builtin_amdgcn_sched_barrier(0)
    Unit cur, nxt; int ui = 0;
    if constexpr (Sched::DYN) { S.fetch(0); S.fetch(1); PG8_WAIT_L(0); PG8_BAR; asm volatile("" ::: "memory"); }
    if (!S.next(0, cur)) return;
    f32x4 acc[2][2][4][2];
#pragma unroll
    for (int a = 0; a < 2; ++a)
#pragma unroll
        for (int b = 0; b < 2; ++b)
#pragma unroll
            for (int m = 0; m < 4; ++m)
#pragma unroll
                for (int n = 0; n < 2; ++n) acc[a][b][m][n] = (f32x4){0.f, 0.f, 0.f, 0.f};
    bf16x8 At[4][2], B0[2][2], B1[2][2];
    const char* cA = cur.A; const char* cB = cur.B;
    LAS unsigned* rtab = (LAS unsigned*)(lds + RTAB_OFF);
    int tb = 0;
#define PG8_STAGE_A(bufoff, gbase, h) do { unsigned _v[2]; _Pragma("unroll") for (int _j = 0; _j < 2; ++_j) \
        _v[_j] = (Sched::GATHER ? rtab[tb * 256 + (h) * HALF + RA[_j]] : S.a_row_off(cur, (h) * HALF + RA[_j])) + CA[_j]; \
        if constexpr (false) PG8_STAGE_NT(bufoff, gbase, _v); else PG8_STAGE(bufoff, gbase, _v); } while (0)
    LAS unsigned* xtab = (LAS unsigned*)(lds + XTAB_OFF); int tbx = 0;
    if constexpr (Sched::GATHER) { if (tid < 256) { rtab[tid] = S.a_row_off(cur, tid); if constexpr (Sched::AUX) { unsigned x0, x1; S.row_aux(cur, tid, x0, x1); xtab[2 * tid] = x0; xtab[2 * tid + 1] = x1; } } PG8_WAIT_L(0); PG8_BAR; }
    [[maybe_unused]] f32x4 breg[8];
    [[maybe_unused]] const int hB = wid >> 2, kcB = (lane & 3) + 4 * (wid & 1), n4B = (lane >> 2) + 16 * ((wid >> 1) & 1);
    [[maybe_unused]] unsigned rowb = 0, bvoff = 0, bdst = 0;
    [[maybe_unused]] const char* cBh = nullptr;
    if constexpr (Sched::BREG) { rowb = S.b_row_bytes(); bvoff = (unsigned)(kcB * 8) * rowb + (unsigned)n4B * 16u;
        const int rho0 = 32 * (n4B >> 3) + 16 * (n4B & 1) + 4 * ((n4B & 7) >> 1);
        bdst = (unsigned)(4 * HTB + hB * HTB + lds_byte(rho0, 8 * kcB)); cBh = hB ? cur.B2 : cur.B; }
#define PG8_BLOAD(gB) do { const char* _g = (gB); _Pragma("unroll") for (int _j = 0; _j < 8; ++_j) \
        asm volatile("global_load_dwordx4 %0, %1, %2" : "=v"(breg[_j]) : "v"(bvoff), "s"(_g + (size_t)_j * rowb) : "memory"); } while (0)
#define PG8_BCVT(b) do { asm volatile("s_waitcnt vmcnt(2)" : "+v"(breg[0]), "+v"(breg[1]), "+v"(breg[2]), "+v"(breg[3]), "+v"(breg[4]), "+v"(breg[5]), "+v"(breg[6]), "+v"(breg[7]) :: "memory"); \
        _Pragma("unroll") for (int _q = 0; _q < 4; ++_q) { u32x4 _w; _w.x = cvt_pk_bf16(breg[0][_q], breg[1][_q]); _w.y = cvt_pk_bf16(breg[2][_q], breg[3][_q]); \
            _w.z = cvt_pk_bf16(breg[4][_q], breg[5][_q]); _w.w = cvt_pk_bf16(breg[6][_q], breg[7][_q]); *(LAS u32x4*)(lds + bdst + (b) * 2 * HTB + 64 * _q) = _w; } } while (0)
    if constexpr (Sched::BREG) {
        PG8_STAGE_A(PG8_SA(0, 0), cA, 0); PG8_BLOAD(cBh); PG8_STAGE_A(PG8_SA(0, 1), cA, 1);
        if (wr == 1) PG8_BAR;
        PG8_BCVT(0); PG8_WAIT_L(0); PG8_BAR;
        PG8_STAGE_A(PG8_SA(1, 0), cA + kstep, 0); PG8_BLOAD(cBh + (size_t)BK * rowb);
        PG8_BAR;
    } else {
    PG8_STAGE(PG8_SB(0, 0), cB, voffB); PG8_STAGE(PG8_SB(0, 1), cB + hstepB, voffB); PG8_STAGE_A(PG8_SA(0, 0), cA, 0); PG8_STAGE_A(PG8_SA(0, 1), cA, 1);
    if (wr == 1) PG8_BAR;
    PG8_WAIT_V(2); PG8_BAR;
    PG8_STAGE(PG8_SB(1, 0), cB + kstep, voffB); PG8_STAGE_A(PG8_SA(1, 0), cA + kstep, 0); PG8_STAGE(PG8_SB(1, 1), cB + hstepB + kstep, voffB);
    PG8_WAIT_V(6); PG8_BAR;
    }
    for (;;) {
        if constexpr (Sched::DYN) S.fetch(ui + 2);
        const bool has_next = S.next(ui + 1, nxt);
        const bool hf = cur.hf != 0;
        const char* nA = has_next ? nxt.A : cA; const char* nB = has_next ? nxt.B : cB;
        if constexpr (Sched::GATHER) { if (has_next && tid < 256) { rtab[((ui + 1) & 1) * 256 + tid] = S.a_row_off(nxt, tid);
            if constexpr (Sched::AUX) { unsigned x0, x1; S.row_aux(nxt, tid, x0, x1); const int nb3 = tbx == 2 ? 0 : tbx + 1; xtab[nb3 * 512 + 2 * tid] = x0; xtab[nb3 * 512 + 2 * tid + 1] = x1; } } }
        for (int t = 0; t < nt; t += 2) {
            const bool last = (t == nt - 2);
            const char* a1 = cA + (size_t)(t + 1) * kstep;
            const char* a2 = last ? nA : cA + (size_t)(t + 2) * kstep; const char* b2 = last ? nB : cB + (size_t)(t + 2) * kstep;
            const char* a3 = a2 + kstep; const char* b3 = b2 + kstep;
            if constexpr (Sched::BREG) {
            const char* nBh = has_next ? (hB ? nxt.B2 : nxt.B) : cBh;
            const char* bp2 = last ? nBh : cBh + (size_t)(t + 2) * BK * rowb; const char* bp3 = bp2 + (size_t)BK * rowb;
            PG8_LDB(B0, 0, 0); PG8_LDB(B1, 0, 1); PG8_SCHED; PG8_LDA(At, 0, 0); PG8_STAGE_A(PG8_SA(1, 1), a1, 1);
            if (last && has_next) tb ^= 1;
            PG8_WAIT_V(12); PG8_WAIT_L(0); PG8_BAR; PG8_MMA(0, 0, At, B0); PG8_MMA(0, 1, At, B1); PG8_BAR; PG8_SCHED;
            if (!hf) PG8_LDA(At, 0, 1); PG8_BCVT(1); PG8_STAGE_A(PG8_SA(0, 0), a2, 0); PG8_BLOAD(bp2);
            PG8_WAIT_L(0); PG8_BAR; if (!hf) { PG8_MMA(1, 0, At, B0); PG8_MMA(1, 1, At, B1); } PG8_BAR; PG8_SCHED;
            PG8_LDB(B0, 1, 0); PG8_LDB(B1, 1, 1); PG8_SCHED; PG8_LDA(At, 1, 0); PG8_STAGE_A(PG8_SA(0, 1), a2, 1);
            PG8_WAIT_V(12); PG8_WAIT_L(0); PG8_BAR; PG8_MMA(0, 0, At, B0); PG8_MMA(0, 1, At, B1); PG8_BAR; PG8_SCHED;
            if (!hf) PG8_LDA(At, 1, 1); PG8_BCVT(0); PG8_STAGE_A(PG8_SA(1, 0), a3, 0); PG8_BLOAD(bp3);
            PG8_WAIT_L(0); PG8_BAR; if (!hf) { PG8_MMA(1, 0, At, B0); PG8_MMA(1, 1, At, B1); } PG8_BAR; PG8_SCHED;
            } else {
            PG8_LDB(B0, 0, 0); PG8_LDB(B1, 0, 1); PG8_SCHED; PG8_LDA(At, 0, 0); PG8_STAGE_A(PG8_SA(1, 1), a1, 1);
            if (last && has_next) tb ^= 1;
            PG8_WAIT_V(8); PG8_WAIT_L(0); PG8_BAR; PG8_MMA(0, 0, At, B0); PG8_MMA(0, 1, At, B1); PG8_BAR; PG8_SCHED;
            if (!hf) PG8_LDA(At, 0, 1); PG8_STAGE(PG8_SB(0, 0), b2, voffB); PG8_STAGE(PG8_SB(0, 1), b2 + hstepB, voffB); PG8_STAGE_A(PG8_SA(0, 0), a2, 0);
            PG8_WAIT_V(8); PG8_WAIT_L(0); PG8_BAR; if (!hf) { PG8_MMA(1, 0, At, B0); PG8_MMA(1, 1, At, B1); } PG8_BAR; PG8_SCHED;
            PG8_LDB(B0, 1, 0); PG8_LDB(B1, 1, 1); PG8_SCHED; PG8_LDA(At, 1, 0); PG8_STAGE_A(PG8_SA(0, 1), a2, 1);
            PG8_WAIT_V(8); PG8_WAIT_L(0); PG8_BAR; PG8_MMA(0, 0, At, B0); PG8_MMA(0, 1, At, B1); PG8_BAR; PG8_SCHED;
            if (!hf) PG8_LDA(At, 1, 1); PG8_STAGE(PG8_SB(1, 0), b3, voffB); PG8_STAGE(PG8_SB(1, 1), b3 + hstepB, voffB); PG8_STAGE_A(PG8_SA(1, 0), a3, 0);
            PG8_WAIT_V(8); PG8_WAIT_L(0); PG8_BAR; if (!hf) { PG8_MMA(1, 0, At, B0); PG8_MMA(1, 1, At, B1); } PG8_BAR; PG8_SCHED;
            }
        }
        if constexpr (ALIGN_EPI) { if (wr == 0) PG8_BAR; }
        E(acc, cur, wr, wc, fr, fq, xtab + tbx * 512);
        if (!has_next) break;
#pragma unroll
        for (int a = 0; a < 2; ++a)
#pragma unroll
            for (int b = 0; b < 2; ++b)
#pragma unroll
                for (int m = 0; m < 4; ++m)
#pragma unroll
                    for (int n = 0; n < 2; ++n) acc[a][b][m][n] = (f32x4){0.f, 0.f, 0.f, 0.f};
        cur = nxt; cA = nA; cB = nB; ++ui; tbx = tbx == 2 ? 0 : tbx + 1;
        if constexpr (Sched::BREG) cBh = hB ? cur.B2 : cur.B;
        if constexpr (ALIGN_EPI) { if (wr == 1) PG8_BAR; }
    }
    PG8_WAIT_V(0);
    if constexpr (!ALIGN_EPI) { if (wr == 0) PG8_BAR; }
    PG8_BAR;
#undef PG8_SA
#undef PG8_SB
#undef PG8_STAGE
#undef PG8_STAGE_NT
#undef PG8_STAGE_A
#undef PG8_BLOAD
#undef PG8_BCVT
#undef PG8_LDA
#undef PG8_LDB
#undef PG8_MMA
#undef PG8_WAIT_V
#undef PG8_WAIT_L
#undef PG8_BAR
#undef PG8_SCHED
}
}

constexpr size_t WS_WIN_T = 4 * MiB, WS_WC_T = 13 * MiB, WS_WF_T = 14 * MiB, WS_WMIX_T = 15 * MiB, WS_WR_HI = 17 * MiB, WS_WR_LO = 17 * MiB + 512 * 1024, WS_WSHGU_T = 18 * MiB, WS_WSHD_T = 19 * MiB;
constexpr size_t WS_WEGU_T = 640 * MiB, WS_WED_T = 896 * MiB;
constexpr int NINW = 4608;

__device__ __forceinline__ void tr_block(const float* src, int ldw, bf16_t* dst, bf16_t* dst2, int ldt, LAS float* scr, int lane) {
#pragma unroll 8
    for (int i = 0; i < 32; ++i) { const int kk = 2 * i + (lane >> 5); scr[kk * 33 + (lane & 31)] = src[(size_t)kk * ldw + (lane & 31)]; }
    asm volatile("s_waitcnt lgkmcnt(0)" ::: "memory");
    const int c = lane & 7;
#pragma unroll
    for (int j = 0; j < 4; ++j) { const int n = (lane >> 3) + 8 * j; const LAS float* s = scr + (8 * c) * 33 + n;
        float v[8];
#pragma unroll
        for (int q = 0; q < 8; ++q) v[q] = s[q * 33];
        u32x4 o; o.x = pk2(v[0], v[1]); o.y = pk2(v[2], v[3]); o.z = pk2(v[4], v[5]); o.w = pk2(v[6], v[7]);
        *(u32x4*)(dst + (size_t)n * ldt + 8 * c) = o;
        if (dst2) { u32x4 l;
            l.x = pk2(v[0] - __uint_as_float(o.x << 16), v[1] - __uint_as_float(o.x & 0xffff0000u)); l.y = pk2(v[2] - __uint_as_float(o.y << 16), v[3] - __uint_as_float(o.y & 0xffff0000u));
            l.z = pk2(v[4] - __uint_as_float(o.z << 16), v[5] - __uint_as_float(o.z & 0xffff0000u)); l.w = pk2(v[6] - __uint_as_float(o.w << 16), v[7] - __uint_as_float(o.w & 0xffff0000u));
            *(u32x4*)(dst2 + (size_t)n * ldt + 8 * c) = l; } }
    asm volatile("s_waitcnt lgkmcnt(0)" ::: "memory");
}
__device__ __forceinline__ int inproj_src_col(int d) { const int pn = d >> 3, c0 = (d & 7) * 32;
    if (pn < 4) return c0 < 128 ? 128 * pn + c0 : 512 + 128 * pn + (c0 - 128);
    if (pn < 6) return O_Q + (pn - 4) * 256 + c0; if (pn < 8) return O_K + (pn - 6) * 256 + c0; if (pn < 10) return O_V + (pn - 8) * 256 + c0;
    if (pn < 14) return O_GA + (pn - 10) * 256 + c0; return O_GB + (pn - 14) * 256 + c0; }
constexpr int CV_I0 = 144 * 16, CV_I1 = 32 * 8, CV_I2 = 32 * 8, CV_I3 = 32 * 16, CV_I4 = 8 * 16, CV_I5 = 16 * 16, CV_I6 = 32 * 4, CV_ALL = CV_I0 + CV_I1 + CV_I2 + CV_I3 + CV_I4 + CV_I5 + CV_I6;
__device__ __forceinline__ void convert_item(Frame& F, int r, LAS float* scr, int lane) {
    unsigned char* ws = F.ws;
    if (r < CV_I0) { const int d = r % 144, kb = r / 144; tr_block(F.w_in + (size_t)kb * 64 * INC + inproj_src_col(d), INC, (bf16_t*)(ws + WS_WIN_T) + (size_t)d * 32 * D + kb * 64, nullptr, D, scr, lane); return; } r -= CV_I0;
    if (r < CV_I1) { const int d = r % 32, kb = r / 32; tr_block(F.w_conv_out + (size_t)kb * 64 * D + d * 32, D, (bf16_t*)(ws + WS_WC_T) + (size_t)d * 32 * CC + kb * 64, nullptr, CC, scr, lane); return; } r -= CV_I1;
    if (r < CV_I2) { const int d = r % 32, kb = r / 32; tr_block(F.w_fox_out + (size_t)kb * 64 * D + d * 32, D, (bf16_t*)(ws + WS_WF_T) + (size_t)d * 32 * FW + kb * 64, nullptr, FW, scr, lane); return; } r -= CV_I2;
    if (r < CV_I3) { const int d = r % 32, kb = r / 32; tr_block(F.w_mix_out + (size_t)kb * 64 * D + d * 32, D, (bf16_t*)(ws + WS_WMIX_T) + (size_t)d * 32 * D + kb * 64, nullptr, D, scr, lane); return; } r -= CV_I3;
    if (r < CV_I4) { const int d = r % 8, kb = r / 8; tr_block(F.w_router + (size_t)kb * 64 * NE + d * 32, NE, (bf16_t*)(ws + WS_WR_HI) + (size_t)d * 32 * D + kb * 64, (bf16_t*)(ws + WS_WR_LO) + (size_t)d * 32 * D + kb * 64, D, scr, lane); return; } r -= CV_I4;
    if (r < CV_I5) { const int d = r % 16, kb = r / 16, ct = d >> 3, c0 = (d & 7) * 32; const float* w = c0 < 128 ? F.w_sh_gate + 128 * ct + c0 : F.w_sh_up + 128 * ct + c0 - 128;
        tr_block(w + (size_t)kb * 64 * SHH, SHH, (bf16_t*)(ws + WS_WSHGU_T) + (size_t)d * 32 * D + kb * 64, nullptr, D, scr, lane); return; } r -= CV_I5;
    { const int d = r % 32, kb = r / 32; tr_block(F.w_sh_down + (size_t)kb * 64 * D + d * 32, D, (bf16_t*)(ws + WS_WSHD_T) + (size_t)d * 32 * SHH + kb * 64, nullptr, SHH, scr, lane); }
}
__device__ __forceinline__ void ph_convert(Frame& F) {
    F.lane = ltid(); F.tid = F.wave * 64 + F.lane;
    LAS float* scr = (LAS float*)(F.lds + F.wave * 16384);
    for (int it = F.gw; it < CV_I0; it += F.NGW) convert_item(F, it, scr, F.lane);
}
__device__ __forceinline__ void ph_convert_filler(Frame& F, unsigned* qhead, volatile LAS unsigned* bc) {
    F.lane = ltid(); F.tid = F.wave * 64 + F.lane;
    LAS float* scr = (LAS float*)(F.lds + F.wave * 16384);
    for (;;) {
        if (F.tid == 0) bc[0] = __hip_atomic_fetch_add(qhead, 1u, __ATOMIC_RELAXED, __HIP_MEMORY_SCOPE_AGENT);
        __syncthreads(); const int it = CV_I0 + (int)bc[0] * NWAVES + F.wave; __syncthreads();
        if (it - F.wave >= CV_ALL) break;
        if (it < CV_ALL) convert_item(F, it, scr, F.lane);
    }
}

struct SchedPlain {
    static constexpr bool GATHER = false, BREG = false, AUX = false, DYN = false;
    __device__ __forceinline__ unsigned b_row_bytes() const { return 0u; }
    pg8::TileOrder o; const char* A; const char* B; unsigned arow, brow;
    __device__ __forceinline__ bool next(int i, pg8::Unit& u) const { int pm, pn; if (!o.tile(i, pm, pn)) return false; u.pm = pm; u.pn = pn; u.e = 0; u.p0 = 0; u.ne = 0; u.bs = 0; u.hf = 0;
        u.A = A + (size_t)pm * 256 * arow; u.B = B + (size_t)pn * 256 * brow; u.B2 = nullptr; return true; }
    __device__ __forceinline__ unsigned a_row_off(const pg8::Unit&, int r) const { return (unsigned)r * arow; }
};
typedef f32x4 AccT[2][2][4][2];
#define EPI_ARGS const AccT& acc, const pg8::Unit& u, int wr, int wc, int fr, int fq, const LAS unsigned* xt
#define EPI_LAUNDER asm volatile("" : "+v"(fr), "+v"(fq))

struct EpiInProj {
    bf16_t *U, *Q, *GA; unsigned* NORM;
    __device__ __forceinline__ void operator()(EPI_ARGS) const {
        EPI_LAUNDER;
        const int row0 = u.pm * 256 + wr * 64 + fr, pn = u.pn, cin = wc * 32 + 8 * fq;
        if (pn < 4) {
#pragma unroll
            for (int ai = 0; ai < 2; ++ai)
#pragma unroll
                for (int m = 0; m < 4; ++m) { const f32x4 a0 = acc[ai][0][m][0], a1 = acc[ai][0][m][1], b0 = acc[ai][1][m][0], b1 = acc[ai][1][m][1]; u32x4 w;
                    w.x = pg8::cvt_pk_bf16(a0[0] * pg8::fsigmoid(b0[0]), a0[1] * pg8::fsigmoid(b0[1])); w.y = pg8::cvt_pk_bf16(a0[2] * pg8::fsigmoid(b0[2]), a0[3] * pg8::fsigmoid(b0[3]));
                    w.z = pg8::cvt_pk_bf16(a1[0] * pg8::fsigmoid(b1[0]), a1[1] * pg8::fsigmoid(b1[1])); w.w = pg8::cvt_pk_bf16(a1[2] * pg8::fsigmoid(b1[2]), a1[3] * pg8::fsigmoid(b1[3]));
                    *(u32x4*)(U + (size_t)(row0 + ai * 128 + m * 16) * CC + 128 * pn + cin) = w; }
        } else {
            const bool sg = pn >= 10; const int ld = sg ? D : FW, cb = sg ? ((pn - 10) & 3) * 256 : ((pn - 4) & 1) * 256;
            bf16_t* dst = sg ? GA + (size_t)((pn - 10) >> 2) * (16u << 20) : Q + (size_t)((pn - 4) >> 1) * (8u << 20);
            const float sc = pn < 6 ? QSCALE : 1.f; float nmx[2] = {0.f, 0.f};
#pragma unroll
            for (int ai = 0; ai < 2; ++ai)
#pragma unroll
                for (int m = 0; m < 4; ++m) { bf16_t* rowp = dst + (size_t)(row0 + ai * 128 + m * 16) * ld + cb + cin;
#pragma unroll
                    for (int bj = 0; bj < 2; ++bj) { f32x4 v0 = acc[ai][bj][m][0], v1 = acc[ai][bj][m][1];
                        if (sg) {
#pragma unroll
                            for (int j = 0; j < 4; ++j) { v0[j] = pg8::fsigmoid(v0[j]); v1[j] = pg8::fsigmoid(v1[j]); } }
                        else { v0 = v0 * sc; v1 = v1 * sc; }
                        if (pn < 8) { float ss = (v0[0] * v0[0] + v0[1] * v0[1]) + (v0[2] * v0[2] + v0[3] * v0[3]) + (v1[0] * v1[0] + v1[1] * v1[1]) + (v1[2] * v1[2] + v1[3] * v1[3]);
                            ss += __shfl_xor(ss, 16); ss += __shfl_xor(ss, 32); nmx[bj] = fmaxf(nmx[bj], ss); }
                        u32x4 w; w.x = pg8::cvt_pk_bf16(v0[0], v0[1]); w.y = pg8::cvt_pk_bf16(v0[2], v0[3]); w.z = pg8::cvt_pk_bf16(v1[0], v1[1]); w.w = pg8::cvt_pk_bf16(v1[2], v1[3]);
                        *(u32x4*)(rowp + bj * 128) = w; } }
            if (pn < 8) {
#pragma unroll
                for (int bj = 0; bj < 2; ++bj) { float v = nmx[bj];
#pragma unroll
                    for (int o = 1; o < 16; o <<= 1) v = fmaxf(v, __shfl_xor(v, o));
                    if ((fr | fq) == 0) { const int bh = ((u.pm * 256) >> 13) * NH + (pn & 1) * 4 + 2 * bj + (wc >> 1);
                        atomicMax(NORM + ((pn >= 6 ? 1 : 0) * 16 + bh) * 2 + (wc & 1), __float_as_uint(v)); } }
            }
        }
    }
};
__device__ __forceinline__ f32x4 bf4lo(u32x4 w) { return (f32x4){__uint_as_float(w.x << 16), __uint_as_float(w.x & 0xffff0000u), __uint_as_float(w.y << 16), __uint_as_float(w.y & 0xffff0000u)}; }
__device__ __forceinline__ f32x4 bf4hi(u32x4 w) { return (f32x4){__uint_as_float(w.z << 16), __uint_as_float(w.z & 0xffff0000u), __uint_as_float(w.w << 16), __uint_as_float(w.w & 0xffff0000u)}; }
__device__ __forceinline__ u32x4 pack8(f32x4 v0, f32x4 v1) { u32x4 w; w.x = pg8::cvt_pk_bf16(v0[0], v0[1]); w.y = pg8::cvt_pk_bf16(v0[2], v0[3]); w.z = pg8::cvt_pk_bf16(v1[0], v1[1]); w.w = pg8::cvt_pk_bf16(v1[2], v1[3]); return w; }

struct SchedMerge {
    static constexpr bool GATHER = false, BREG = false, AUX = false, DYN = false;
    __device__ __forceinline__ unsigned b_row_bytes() const { return 0u; }
    pg8::TileOrder o; const char *AC, *O, *WC, *WF;
    __device__ __forceinline__ bool next(int i, pg8::Unit& u) const { int pm, pn; if (!o.tile(i >> 1, pm, pn)) return false; u.pm = pm; u.pn = pn; u.e = i & 1; u.p0 = 0; u.ne = 0; u.bs = 0; u.hf = 0;
        u.A = ((i & 1) ? O : AC) + (size_t)pm * 256 * 1024; u.B = ((i & 1) ? WF : WC) + (size_t)pn * 256 * 1024; u.B2 = nullptr; return true; }
    __device__ __forceinline__ unsigned a_row_off(const pg8::Unit&, int r) const { return (unsigned)r * 1024u; }
};
struct EpiMerge {
    const bf16_t *GA, *GB; bf16_t *YA, *MG;
    __device__ __forceinline__ void operator()(EPI_ARGS) const {
        EPI_LAUNDER;
        const int row0 = u.pm * 256 + wr * 64 + fr, col0 = u.pn * 256 + wc * 32 + 8 * fq; const bool second = u.e != 0;
        const bf16_t* G = second ? GB : GA; bf16_t* dst = second ? MG : YA;
#pragma unroll
        for (int ai = 0; ai < 2; ++ai)
#pragma unroll
            for (int m = 0; m < 4; ++m) { const size_t off = (size_t)(row0 + ai * 128 + m * 16) * D + col0;
#pragma unroll
                for (int bj = 0; bj < 2; ++bj) { const u32x4 g = *(const u32x4*)(G + off + bj * 128);
                    f32x4 v0 = acc[ai][bj][m][0] * bf4lo(g), v1 = acc[ai][bj][m][1] * bf4hi(g);
                    if (second) { const u32x4 y = *(const u32x4*)(YA + off + bj * 128); v0 += bf4lo(y); v1 += bf4hi(y); }
                    *(u32x4*)(dst + off + bj * 128) = pack8(v0, v1); } }
    }
};
struct EpiMix {
    const float *x, *ADA; float* Z;
    __device__ __forceinline__ void operator()(EPI_ARGS) const {
        EPI_LAUNDER;
        const int row0 = u.pm * 256 + wr * 64 + fr, col0 = u.pn * 256 + wc * 32 + 8 * fq, b = (u.pm * 256) >> 13;
        f32x4 g[2][2];
#pragma unroll
        for (int bj = 0; bj < 2; ++bj)
#pragma unroll
            for (int n = 0; n < 2; ++n) g[bj][n] = *(const f32x4*)(ADA + b * 6144 + 2048 + col0 + bj * 128 + 4 * n) + 1.0f;
#pragma unroll
        for (int ai = 0; ai < 2; ++ai)
#pragma unroll
            for (int m = 0; m < 4; ++m) { const size_t off = (size_t)(row0 + ai * 128 + m * 16) * D + col0;
#pragma unroll
                for (int bj = 0; bj < 2; ++bj)
#pragma unroll
                    for (int n = 0; n < 2; ++n) { const f32x4 xv = *(const f32x4*)(x + off + bj * 128 + 4 * n); *(f32x4*)(Z + off + bj * 128 + 4 * n) = xv * ALPHA + g[bj][n] * acc[ai][bj][m][n]; } }
    }
};
struct SchedRS {
    static constexpr bool GATHER = false, BREG = false, AUX = false, DYN = false;
    __device__ __forceinline__ unsigned b_row_bytes() const { return 0u; }
    int G, c; const char *H2, *H2LO, *WRH, *WRL, *WSH;
    __device__ __forceinline__ bool next(int i, pg8::Unit& u) const { const int L = i * G + c; if (L >= 128 * 5) return false; const int pm = L / 5, j = L % 5; u.pm = pm; u.e = j; u.p0 = 0; u.ne = 0; u.bs = 0; u.B2 = nullptr; u.hf = 1;
        if (j < 3) { u.pn = 0; u.A = (j == 2 ? H2LO : H2) + (size_t)pm * 128 * 2048; u.B = (j == 1 ? WRL : WRH); }
        else { u.pn = j - 3; u.A = H2 + (size_t)pm * 128 * 2048; u.B = WSH + (size_t)(j - 3) * 256 * 2048; }
        return true; }
    __device__ __forceinline__ unsigned a_row_off(const pg8::Unit&, int r) const { return (unsigned)r * 2048u; }
};
struct EpiRS {
    float* RL; bf16_t* SHID;
    __device__ __forceinline__ void operator()(EPI_ARGS) const {
        EPI_LAUNDER;
        const int row0 = u.pm * 128 + wr * 64 + fr, cin = wc * 32 + 8 * fq;
        if (u.e < 3) { float* R = RL + (size_t)u.e * T * NE;
#pragma unroll
            for (int m = 0; m < 4; ++m) { float* rp = R + (size_t)(row0 + m * 16) * NE + cin;
#pragma unroll
                for (int bj = 0; bj < 2; ++bj)
#pragma unroll
                    for (int n = 0; n < 2; ++n) *(f32x4*)(rp + bj * 128 + 4 * n) = acc[0][bj][m][n]; }
        } else {
#pragma unroll
            for (int m = 0; m < 4; ++m) { const f32x4 g0 = acc[0][0][m][0], g1 = acc[0][0][m][1], u0 = acc[0][1][m][0], u1 = acc[0][1][m][1]; f32x4 h0, h1;
#pragma unroll
                for (int j = 0; j < 4; ++j) { h0[j] = g0[j] * pg8::fsigmoid(g0[j]) * u0[j]; h1[j] = g1[j] * pg8::fsigmoid(g1[j]) * u1[j]; }
                *(u32x4*)(SHID + (size_t)(row0 + m * 16) * SHH + 128 * u.pn + cin) = pack8(h0, h1); }
        }
    }
};
constexpr int INPROJ_STATIC_TILES = 12, INPROJ_FILLER_UNITS = (NINW / 256 - INPROJ_STATIC_TILES) * (T / 256);
__device__ __forceinline__ void ph_inproj_fast(Frame& F) {
    F.lane = ltid(); F.tid = F.wave * 64 + F.lane;
    SchedPlain S; S.o.init(T / 256, INPROJ_STATIC_TILES, gridDim.x, blockIdx.x); S.A = (const char*)F.H; S.B = (const char*)(F.ws + WS_WIN_T); S.arow = 2048; S.brow = 2048;
    EpiInProj E{F.U, F.Q, F.GA, F.ctl + CW_NORM};
    static_assert(WS_K - WS_Q == 16 * MiB && WS_V - WS_K == 16 * MiB && WS_GB - WS_GA == 32 * MiB, "EpiInProj destination arithmetic");
    pg8::gemm_phase<EpiInProj, SchedPlain, true>(F.lds, D, D, D, S, E);
}
struct EpiInProjOff { bf16_t *U, *Q, *GA; unsigned* NORM;
    __device__ __forceinline__ void operator()(EPI_ARGS) const { pg8::Unit v = u; v.pn = u.pn + INPROJ_STATIC_TILES; EpiInProj E{U, Q, GA, NORM}; E(acc, v, wr, wc, fr, fq, xt); } };
struct SchedInProjDyn {
    static constexpr bool GATHER = false, BREG = false, AUX = false, DYN = true;
    static constexpr int NT_ = NINW / 256 - INPROJ_STATIC_TILES, PER_X = 8 * NT_;
    __device__ __forceinline__ unsigned b_row_bytes() const { return 0u; }
    unsigned* qhead; volatile LAS unsigned* mb; const char* A; const char* B; int x;
    __device__ __forceinline__ void fetch(int k) const { if (threadIdx.x == 0) mb[k & 3] = __hip_atomic_fetch_add(qhead + 64 * x, 1u, __ATOMIC_RELAXED, __HIP_MEMORY_SCOPE_AGENT); }
    __device__ __forceinline__ bool next(int i, pg8::Unit& u) const { const unsigned idx = (unsigned)__builtin_amdgcn_readfirstlane((int)mb[i & 3]); if (idx >= (unsigned)PER_X) return false;
        const int pm = 8 * x + (int)(idx & 7), pn = (int)(idx >> 3);
        u.pm = pm; u.pn = pn; u.e = 0; u.p0 = 0; u.ne = 0; u.bs = 0; u.hf = 0; u.B2 = nullptr; u.A = A + (size_t)pm * 256 * 2048; u.B = B + (size_t)pn * 256 * 2048; return true; }
    __device__ __forceinline__ unsigned a_row_off(const pg8::Unit&, int r) const { return (unsigned)r * 2048u; }
};
__device__ __forceinline__ void ph_inproj_filler(Frame& F) {
    F.lane = ltid(); F.tid = F.wave * 64 + F.lane;
    SchedInProjDyn S{F.ctl + CW_FQ, (volatile LAS unsigned*)(F.lds + MISC_OFF + 96), (const char*)F.H, (const char*)(F.ws + WS_WIN_T) + (size_t)INPROJ_STATIC_TILES * 256 * 2048, (int)(blockIdx.x & 7)};
    EpiInProjOff E{F.U, F.Q, F.GA, F.ctl + CW_NORM};
    pg8::gemm_phase<EpiInProjOff, SchedInProjDyn, true>(F.lds, D, D, D, S, E);
}
__device__ __forceinline__ void ph_merge_fast(Frame& F) {
    F.lane = ltid(); F.tid = F.wave * 64 + F.lane;
    SchedMerge S; S.o.init(T / 256, D / 256, gridDim.x, blockIdx.x); S.AC = (const char*)F.AC; S.O = (const char*)F.O; S.WC = (const char*)(F.ws + WS_WC_T); S.WF = (const char*)(F.ws + WS_WF_T);
    EpiMerge E{F.GA, F.GB, F.YA, F.MG};
    pg8::gemm_phase<EpiMerge, SchedMerge, true>(F.lds, CC, CC, CC, S, E);
}
__device__ __forceinline__ void ph_mix_fast(Frame& F) {
    F.lane = ltid(); F.tid = F.wave * 64 + F.lane;
    SchedPlain S; S.o.init(T / 256, D / 256, gridDim.x, blockIdx.x); S.A = (const char*)F.MG; S.B = (const char*)(F.ws + WS_WMIX_T); S.arow = 2048; S.brow = 2048;
    EpiMix E{F.x, F.ADA, F.X1};
    pg8::gemm_phase<EpiMix, SchedPlain, true>(F.lds, D, D, D, S, E);
}
__device__ __forceinline__ void ph_router_fast(Frame& F) {
    F.lane = ltid(); F.tid = F.wave * 64 + F.lane;
    SchedRS S{(int)gridDim.x, (int)blockIdx.x, (const char*)F.H2, (const char*)F.H2LO, (const char*)(F.ws + WS_WR_HI), (const char*)(F.ws + WS_WR_LO), (const char*)(F.ws + WS_WSHGU_T)};
    EpiRS E{F.RL, F.SHID};
    pg8::gemm_phase<EpiRS, SchedRS, true>(F.lds, D, D, D, S, E);
}

constexpr int EMAP_OFF = 131072 + 1024;
template <int NCT> __device__ __forceinline__ bool expert_unit(int i, int G, int c, int nunits, const LAS int* pref, int& e, int& ct, int& ch) {
    const int gs = G >> 3, x = c / gs, s = c - x * gs, per = (nunits + 7) >> 3, q = i * gs + s; if (q >= per) return false;
    const int P = x * per + q; if (P >= nunits) return false;
    e = __builtin_amdgcn_readfirstlane(find_expert(pref, P / NCT));
    const int p0 = __builtin_amdgcn_readfirstlane(pref[e]), nch = __builtin_amdgcn_readfirstlane(pref[e + 1]) - p0, r = P - NCT * p0;
    ct = r / nch; ch = r - ct * nch; return true;
}
template <int VARIANT = 0> struct SchedMoe1T {
    static constexpr bool GATHER = true, BREG = true, AUX = false, DYN = false;
    int G, c, nunits; const LAS int* pref; const LAS int* base; const char* H2; const char* WG; const char* WU; const int* LIST;
    __device__ __forceinline__ unsigned b_row_bytes() const { return EH * 4u; }
    __device__ __forceinline__ bool next(int i, pg8::Unit& u) const { int e, ct, ch; if (!expert_unit<2>(i, G, c, nunits, pref, e, ct, ch)) return false;
        u.pm = 0; u.pn = ct; u.e = e; u.p0 = ch * 256; u.bs = __builtin_amdgcn_readfirstlane(base[e]); u.ne = __builtin_amdgcn_readfirstlane(base[e + 1]) - u.bs; u.hf = (u.ne - u.p0) <= 128;
        const int ew = VARIANT == 1 ? (e & 7) : e;
        u.A = H2; u.B = WG + ((size_t)ew * D * EH + 128 * ct) * 4; u.B2 = WU + ((size_t)ew * D * EH + 128 * ct) * 4; return true; }
    __device__ __forceinline__ unsigned a_row_off(const pg8::Unit& u, int r) const { int p = u.p0 + r; p = p < u.ne ? p : u.ne - 1;
        if (VARIANT == 2) return (unsigned)((u.bs + p) & (T - 1)) * 2048u;
        return (unsigned)(LIST[(size_t)u.e * LCAP + p] >> 3) * 2048u; }
};
typedef SchedMoe1T<0> SchedMoe1;
struct EpiMoe1 {
    bf16_t* HID;
    __device__ __forceinline__ void operator()(EPI_ARGS) const {
        EPI_LAUNDER;
        const int r0 = wr * 64 + fr, cin = wc * 32 + 8 * fq;
#pragma unroll
        for (int ai = 0; ai < 2; ++ai)
#pragma unroll
            for (int m = 0; m < 4; ++m) { const int p = u.p0 + r0 + ai * 128 + m * 16;
                const f32x4 g0 = acc[ai][0][m][0], g1 = acc[ai][0][m][1], u0 = acc[ai][1][m][0], u1 = acc[ai][1][m][1]; f32x4 h0, h1;
#pragma unroll
                for (int j = 0; j < 4; ++j) { h0[j] = g0[j] * pg8::fsigmoid(g0[j]) * u0[j]; h1[j] = g1[j] * pg8::fsigmoid(g1[j]) * u1[j]; }
                if (p < u.ne) *(u32x4*)(HID + (size_t)(u.bs + p) * EH + 128 * u.pn + cin) = pack8(h0, h1); }
    }
};
struct SchedMoe2 {
    static constexpr bool GATHER = true, BREG = true, AUX = true, DYN = false;
    int G, c, nunits; const LAS int* pref; const LAS int* base; const char* HID; const char* WD; const int* LIST; const float* LISTW;
    __device__ __forceinline__ void row_aux(const pg8::Unit& u, int r, unsigned& x0, unsigned& x1) const { const int p = u.p0 + r; x0 = ~0u; x1 = 0u;
        if (p < u.ne) { const int as = LIST[(size_t)u.e * LCAP + p]; x0 = (unsigned)((as >> 3) * NSLOT + (as & 7)); x1 = __float_as_uint(LISTW[(size_t)u.e * LCAP + p]); } }
    __device__ __forceinline__ unsigned b_row_bytes() const { return D * 4u; }
    __device__ __forceinline__ bool next(int i, pg8::Unit& u) const { int e, ct, ch; if (!expert_unit<4>(i, G, c, nunits, pref, e, ct, ch)) return false;
        u.pm = 0; u.pn = ct; u.e = e; u.p0 = ch * 256; u.bs = __builtin_amdgcn_readfirstlane(base[e]); u.ne = __builtin_amdgcn_readfirstlane(base[e + 1]) - u.bs; u.hf = (u.ne - u.p0) <= 128;
        u.A = HID + (size_t)(u.bs + u.p0) * 512; u.B = WD + ((size_t)e * EH * D + 256 * ct) * 4; u.B2 = u.B + 512; return true; }
    __device__ __forceinline__ unsigned a_row_off(const pg8::Unit& u, int r) const { const int lim = u.ne - 1 - u.p0; return (unsigned)(r < lim ? r : lim) * 512u; }
};
struct EpiMoe2 {
    bf16_t* YAS;
    __device__ __forceinline__ void operator()(EPI_ARGS) const {
        EPI_LAUNDER;
        const int r0 = wr * 64 + fr, col0 = u.pn * 256 + wc * 32 + 8 * fq;
#pragma unroll
        for (int ai = 0; ai < 2; ++ai)
#pragma unroll
            for (int m = 0; m < 4; ++m) { const int r = r0 + ai * 128 + m * 16; const u32x2 x = *(const LAS u32x2*)(xt + 2 * r);
                if (x.x != ~0u) { const float w = __uint_as_float(x.y); bf16_t* rowp = YAS + (size_t)x.x * D + col0;
#pragma unroll
                    for (int bj = 0; bj < 2; ++bj) *(u32x4*)(rowp + bj * 128) = pack8(acc[ai][bj][m][0] * w, acc[ai][bj][m][1] * w); }
                if (m & 1) asm volatile("" ::: "memory"); }
    }
};
struct EpiShDown {
    bf16_t* YAS;
    __device__ __forceinline__ void operator()(EPI_ARGS) const {
        EPI_LAUNDER;
        const int row0 = u.pm * 256 + wr * 64 + fr, col0 = u.pn * 256 + wc * 32 + 8 * fq;
#pragma unroll
        for (int ai = 0; ai < 2; ++ai)
#pragma unroll
            for (int m = 0; m < 4; ++m) { bf16_t* rowp = YAS + ((size_t)(row0 + ai * 128 + m * 16) * NSLOT + 8) * D + col0;
#pragma unroll
                for (int bj = 0; bj < 2; ++bj) *(u32x4*)(rowp + bj * 128) = pack8(acc[ai][bj][m][0], acc[ai][bj][m][1]); }
    }
};
template <int VARIANT> __device__ __forceinline__ void ph_moe1_experts(Frame& F, bf16_t* hid) {
    F.lane = ltid(); F.tid = F.wave * 64 + F.lane;
    LAS int* pref = (LAS int*)(F.lds + EMAP_OFF); LAS int* base = pref + 260;
    build_expert_map(F, pref, base, 256);
    SchedMoe1T<VARIANT> S{(int)gridDim.x, F.vid, __builtin_amdgcn_readfirstlane(pref[NE]) * 2, pref, base, (const char*)F.H2, (const char*)F.w_exp_gate, (const char*)F.w_exp_up, F.LIST};
    EpiMoe1 E{hid};
    pg8::gemm_phase<EpiMoe1, SchedMoe1T<VARIANT>, true>(F.lds, D, D, D, S, E);
}
__device__ __forceinline__ void ph_shdown(Frame& F) {
    F.lane = ltid(); F.tid = F.wave * 64 + F.lane;
    SchedPlain S; S.o.init(T / 256, D / 256, gridDim.x, blockIdx.x); S.A = (const char*)F.SHID; S.B = (const char*)(F.ws + WS_WSHD_T); S.arow = 512; S.brow = 512;
    EpiShDown E{F.YAS};
    pg8::gemm_phase<EpiShDown, SchedPlain, true>(F.lds, SHH, SHH, SHH, S, E);
}
__device__ __forceinline__ void ph_moe1_fast(Frame& F) { ph_moe1_experts<0>(F, F.HID); ph_shdown(F); }
__device__ __forceinline__ void ph_moe2_fast(Frame& F) {
    F.lane = ltid(); F.tid = F.wave * 64 + F.lane;
    LAS int* pref = (LAS int*)(F.lds + EMAP_OFF); LAS int* base = pref + 260;
    build_expert_map(F, pref, base, 256);
    SchedMoe2 S{(int)gridDim.x, F.vid, __builtin_amdgcn_readfirstlane(pref[NE]) * 4, pref, base, (const char*)F.HID, (const char*)F.w_exp_down, F.LIST, F.LISTW};
    EpiMoe2 E{F.YAS};
    pg8::gemm_phase<EpiMoe2, SchedMoe2, true>(F.lds, EH, EH, EH, S, E);
}

namespace attn_body {
using bf16=__hip_bfloat16;
using bf16x8=__attribute__((ext_vector_type(8)))short;
using s16x4=__attribute__((ext_vector_type(4)))short;
using f32x16=__attribute__((ext_vector_type(16)))float;
using u32x4=__attribute__((ext_vector_type(4)))unsigned;
using f32x4_t=__attribute__((ext_vector_type(4)))float;
constexpr int BATCH=2,NHEAD=8,SEQ=8192,D=64,DM=NHEAD*D;
constexpr int NW=8,QBLK=32,QB=QBLK*NW,KVBLK=64,NQB=SEQ/QB;
constexpr int ATTN_PITCH=DM, ATTN_UNIT_ROWS=QB;
__device__ __forceinline__ int crow(int r,int hi){return (r&3)+8*(r>>2)+4*hi;}
#define SBAR() __builtin_amdgcn_sched_barrier(0)
__device__ __forceinline__ void cmask(f32x16&p0,f32x16&p1,int jb,int qrel,int hi){
  const float NEG=-INFINITY; int kb=64*jb+4*hi;
  #pragma unroll
  for(int r=0;r<16;++r){int kv=kb+(r&3)+8*(r>>2); if(kv>qrel)p0[r]=NEG; if(kv+32>qrel)p1[r]=NEG;}
}

constexpr int NSLOT=3, SLOTB=8192;
constexpr int LDS_K=0, LDS_V=NSLOT*SLOTB, LDS_WS=2*NSLOT*SLOTB, LDS_OST=LDS_WS+NW*64*4, LDS_NB=LDS_OST+NW*4096, LDS_BYTES=LDS_NB+SEQ*4;
constexpr float C2=0.125f*1.4426950408889634f;
__device__ __forceinline__ void glds16(const void*gsrc,unsigned lds_dst){unsigned keep;
  asm volatile("s_mov_b32 %0, m0\n\ts_mov_b32 m0, %2\n\ts_nop 0\n\tglobal_load_lds_dwordx4 %1, off\n\ts_mov_b32 m0, %0":"=&s"(keep):"v"(gsrc),"s"(lds_dst):"memory");}
__device__ __forceinline__ float max3f(float a,float b,float c){float r;asm("v_max3_f32 %0, %1, %2, %3":"=v"(r):"v"(a),"v"(b),"v"(c));return r;}
__device__ __forceinline__ float max2f(float a,float b){float r;asm("v_max_f32_e32 %0, %1, %2":"=v"(r):"v"(a),"v"(b));return r;}
__device__ __forceinline__ float fadd_s(float a,float b){float r;asm("v_add_f32_e32 %0, %1, %2":"=v"(r):"v"(a),"v"(b));return r;}
__device__ __forceinline__ float fsub_s(float a,float b){float r;asm("v_sub_f32_e32 %0, %1, %2":"=v"(r):"v"(a),"v"(b));return r;}
typedef float f32x2_t __attribute__((ext_vector_type(2))); typedef __bf16 bf16x2_t __attribute__((ext_vector_type(2)));
__device__ __forceinline__ unsigned cvtpk_s(float lo,float hi){f32x2_t v={lo,hi};bf16x2_t b=__builtin_convertvector(v,bf16x2_t);return __builtin_bit_cast(unsigned,b);}
#define WAIT_BAR(N) asm volatile("s_waitcnt vmcnt(" #N ") lgkmcnt(0)\n\ts_barrier":::"memory")

__device__ __forceinline__ void qkt(f32x16&p0,f32x16&p1,const char*Kslot,const bf16x8*qr,int r32,int hi){
  const char*kb=Kslot+hi*1024+r32*16;
  #pragma unroll
  for(int d0=0;d0<4;++d0){
    const bf16x8 b0=*reinterpret_cast<const bf16x8*>(kb+d0*2048);
    const bf16x8 b1=*reinterpret_cast<const bf16x8*>(kb+d0*2048+512);
    {p0=__builtin_amdgcn_mfma_f32_32x32x16_bf16(b0,qr[d0],p0,0,0,0);p1=__builtin_amdgcn_mfma_f32_32x32x16_bf16(b1,qr[d0],p1,0,0,0);}}
}
typedef __attribute__((address_space(3))) const char* lds_cptr;
typedef short v4i16_t __attribute__((ext_vector_type(4)));
__device__ __forceinline__ void kload8(bf16x8*kf,lds_cptr kp){
  kf[0]=*(const __attribute__((address_space(3))) bf16x8*)(kp);      kf[1]=*(const __attribute__((address_space(3))) bf16x8*)(kp+512);
  kf[2]=*(const __attribute__((address_space(3))) bf16x8*)(kp+2048); kf[3]=*(const __attribute__((address_space(3))) bf16x8*)(kp+2560);
  kf[4]=*(const __attribute__((address_space(3))) bf16x8*)(kp+4096); kf[5]=*(const __attribute__((address_space(3))) bf16x8*)(kp+4608);
  kf[6]=*(const __attribute__((address_space(3))) bf16x8*)(kp+6144); kf[7]=*(const __attribute__((address_space(3))) bf16x8*)(kp+6656);
}
__device__ __forceinline__ void kload2(bf16x8*kf,lds_cptr kp,int j){ kf[2*j]=*(const __attribute__((address_space(3))) bf16x8*)(kp+j*2048); kf[2*j+1]=*(const __attribute__((address_space(3))) bf16x8*)(kp+j*2048+512); }
__device__ __forceinline__ s16x4 vtr(lds_cptr p){ return __builtin_bit_cast(s16x4,__builtin_amdgcn_ds_read_tr16_b64_v4i16((__attribute__((address_space(3))) v4i16_t*)p)); }
__device__ __forceinline__ float rowmax(const f32x16&p0,const f32x16&p1){
  float a=max3f(p0[0],p0[1],p1[0]),b=max3f(p0[2],p0[3],p1[1]);a=max3f(a,p1[2],p1[3]);
  #pragma unroll
  for(int r=4;r<16;r+=4){a=max3f(a,p0[r],p0[r+1]);b=max3f(b,p0[r+2],p0[r+3]);a=max3f(a,p1[r],p1[r+1]);b=max3f(b,p1[r+2],p1[r+3]);}
  const float m=max2f(a,b);
  auto rr=__builtin_amdgcn_permlane32_swap(__float_as_uint(m),__float_as_uint(m),false,false);
  return max2f(__uint_as_float(rr[0]),__uint_as_float(rr[1]));
}
__device__ __forceinline__ void pv(f32x16*o,int vb,bf16x8 pa0,bf16x8 pa1,bf16x8 pa2,bf16x8 pa3){
  #pragma unroll
  for(int d0=0;d0<2;++d0){s16x4 lo[4],hi[4];
    #pragma unroll
    for(int ks=0;ks<4;++ks){
      asm volatile("ds_read_b64_tr_b16 %0,%1 offset:%c2":"=&v"(lo[ks]):"v"(vb),"i"(d0*4096+ks*1024):"memory");
      asm volatile("ds_read_b64_tr_b16 %0,%1 offset:%c2":"=&v"(hi[ks]):"v"(vb),"i"(d0*4096+ks*1024+512):"memory");}
    asm volatile("s_waitcnt lgkmcnt(0)":::"memory");SBAR();
    #define PK(k) (bf16x8){lo[k][0],lo[k][1],lo[k][2],lo[k][3],hi[k][0],hi[k][1],hi[k][2],hi[k][3]}
    o[d0]=__builtin_amdgcn_mfma_f32_32x32x16_bf16(pa0,PK(0),o[d0],0,0,0);
    o[d0]=__builtin_amdgcn_mfma_f32_32x32x16_bf16(pa1,PK(1),o[d0],0,0,0);
    o[d0]=__builtin_amdgcn_mfma_f32_32x32x16_bf16(pa2,PK(2),o[d0],0,0,0);
    o[d0]=__builtin_amdgcn_mfma_f32_32x32x16_bf16(pa3,PK(3),o[d0],0,0,0);
    #undef PK
  }
}

#ifndef ATTN_STORE16
#define ATTN_STORE16(p,v) (*(u32x4*)(p)=(v))
#endif
template<int THRL> __device__ __forceinline__ void attn_unit(int b,int h,int qb,const bf16*Q,const bf16*__restrict__ K,const bf16*__restrict__ V,bf16*O,char*shm,const float*__restrict__ cum,float skip_thr){
  const int tid=threadIdx.x,lane=tid&63,r32=lane&31,hi=lane>>5; const int wid=__builtin_amdgcn_readfirstlane(tid>>6);
  const long rowbase=(long)b*SEQ; const int q0=qb*QB;
  const bf16*Qw=Q+(rowbase+q0+wid*QBLK)*DM+h*D;
  const bf16*Kh=K+rowbase*DM+h*D,*Vh=V+rowbase*DM+h*D;
  const unsigned lds0=(unsigned)(uintptr_t)shm;
  float*wsf=(float*)(shm+LDS_WS)+wid*64;
  const bf16*ksrc=Kh+(long)lane*DM+wid*8;
  const bf16*vsrc=Vh+(long)(16*(wid&3)+(lane>>2))*DM+(wid>>2)*32+(lane&3)*8;
  const unsigned kdst=lds0+LDS_K+wid*1024, vdst=lds0+LDS_V+wid*1024;
  #define DMA_K(t,slot) glds16(ksrc+(long)(NTF-1-(t))*KVBLK*DM,(unsigned)__builtin_amdgcn_readfirstlane(kdst+(slot)))
  #define DMA_V(t,slot) glds16(vsrc+(long)(NTF-1-(t))*KVBLK*DM,(unsigned)__builtin_amdgcn_readfirstlane(vdst+(slot)))
  const int vb0=(int)(lds0+LDS_V)+((lane>>4)&1)*32+(lane&3)*8+(4*hi+((lane&15)>>2))*64;
  const char*Kbase=shm+LDS_K; bf16x8 kf[8];
  const lds_cptr shm3=(lds_cptr)shm; const lds_cptr kp0=shm3+LDS_K+hi*1024+r32*16; const lds_cptr vp0=shm3+LDS_V+((lane>>4)&1)*32+(lane&3)*8+(4*hi+((lane&15)>>2))*64;
  const int NTF=(q0+QB)/KVBLK;
  const float F0=cum[q0]; int nskip;
  { const int j0=lane,j1=lane+64; bool s0=false,s1=false;
    if(j0<NTF-4) s0=(F0-cum[64*j0+63])*1.4426950408889634f < -skip_thr;
    if(j1<NTF-4) s1=(F0-cum[64*j1+63])*1.4426950408889634f < -skip_thr;
    const unsigned long long m0=__ballot(s0),m1=__ballot(s1);
    nskip=(m0==~0ull)?64+(int)__builtin_ctzll(~m1|(1ull<<63)):(int)__builtin_ctzll(~m0); nskip&=~1; nskip=__builtin_amdgcn_readfirstlane(nskip); }
  const int NT=NTF-nskip, sbase=64*nskip;
  typedef __attribute__((address_space(3))) float* lds_fptr; const lds_fptr nbL=(lds_fptr)(__attribute__((address_space(3))) char*)shm+LDS_NB/4;
  for(int i4=tid*4;i4<q0+QB-sbase;i4+=NW*64*4){ const f32x4_t c4=*reinterpret_cast<const f32x4_t*>(cum+sbase+i4); f32x4_t n4; n4[0]=(F0-c4[0])*1.4426950408889634f; n4[1]=(F0-c4[1])*1.4426950408889634f; n4[2]=(F0-c4[2])*1.4426950408889634f; n4[3]=(F0-c4[3])*1.4426950408889634f; *(__attribute__((address_space(3))) f32x4_t*)(nbL+i4)=n4; }
  asm volatile("s_waitcnt vmcnt(0) lgkmcnt(0)\n\ts_barrier":::"memory");
  DMA_K(0,0);DMA_V(0,0);DMA_K(1,SLOTB);
  bf16x8 qr[4];
  #pragma unroll
  for(int d0=0;d0<4;++d0)qr[d0]=*reinterpret_cast<const bf16x8*>(&Qw[(long)r32*DM+d0*16+hi*8]);
  float l_reg=0.f;f32x16 o[2];o[0]=f32x16{};o[1]=f32x16{};
  const int qrel=wid*QBLK+r32;
  float mhat=nbL[q0-sbase+qrel];
  #define NBRD(X0,X1,i) do{ const lds_fptr nb_=nbL+(64*(NT-1-(i))+4*hi); _Pragma("unroll") for(int g_=0;g_<4;++g_){ const f32x4_t a_=*(const __attribute__((address_space(3))) f32x4_t*)(nb_+8*g_); const f32x4_t b_=*(const __attribute__((address_space(3))) f32x4_t*)(nb_+8*g_+32); \
      X0[4*g_]=a_[0];X0[4*g_+1]=a_[1];X0[4*g_+2]=a_[2];X0[4*g_+3]=a_[3]; X1[4*g_]=b_[0];X1[4*g_+1]=b_[1];X1[4*g_+2]=b_[2];X1[4*g_+3]=b_[3]; } }while(0)
  #define NBSUB(X0,X1) do{ _Pragma("unroll") for(int r=0;r<16;++r){X0[r]-=mhat;X1[r]-=mhat;} }while(0)
  #define CMASK(P0,P1,t) do{int jb_=3-(t); if(jb_>=0)cmask(P0,P1,jb_,qrel,hi);}while(0)
  bool resc=false;
  #define START(P0,P1) do{ const float rm=rowmax(P0,P1); resc=false; \
    { const float dl=max2f(rm,0.f); mhat=fadd_s(mhat,dl); \
      _Pragma("unroll") for(int r=0;r<16;++r){P0[r]=fsub_s(P0[r],dl);P1[r]=fsub_s(P1[r],dl);} } \
    _Pragma("unroll") for(int r=0;r<16;++r)P0[r]=__builtin_amdgcn_exp2f(P0[r]); }while(0)
  #define RESC() do{ if(resc){ asm volatile("s_waitcnt lgkmcnt(0)":::"memory"); \
      _Pragma("unroll") for(int d_=0;d_<2;++d_) _Pragma("unroll") for(int r=0;r<16;++r)o[d_][r]*=wsf[crow(r,hi)]; } }while(0)
  f32x16 pA0,pA1,pB0,pB1;
  int sl_prev=0,sl_cur=0,sl_next=SLOTB;
  #define ROT() do{sl_prev=sl_cur;sl_cur=sl_next;sl_next=(sl_next==(NSLOT-1)*SLOTB)?0:sl_next+SLOTB;}while(0)
  DMA_K(2,2*SLOTB);
  WAIT_BAR(3);
  NBRD(pA0,pA1,0); NBSUB(pA0,pA1);
  qkt(pA0,pA1,Kbase,qr,r32,hi);asm volatile("s_nop 15\n\ts_nop 7":"+v"(pA0),"+v"(pA1));CMASK(pA0,pA1,0);
  START(pA0,pA1);
  _Pragma("unroll") for(int r=0;r<16;++r)pA1[r]=__builtin_amdgcn_exp2f(pA1[r]);
  NBRD(pB0,pB1,1);
  WAIT_BAR(0);
  DMA_K(3,0);DMA_V(1,SLOTB);
  ROT();
  kload8(kf,kp0+sl_cur);
  WAIT_BAR(2);
  s16x4 vlo[8],vhi[8]; u32x4 pw0,pw1,pw2,pw3;
  #define PKW(P,B) cvtpk_s(P[B],P[B+1])
  #define PAF(k) __builtin_bit_cast(bf16x8,pw##k)
  #define VFR(i) (bf16x8){vlo[i][0],vlo[i][1],vlo[i][2],vlo[i][3],vhi[i][0],vhi[i][1],vhi[i][2],vhi[i][3]}
  #define PIN(x) asm volatile("":"+v"(x))
  #define MX3(a,b,c) __builtin_fmaxf(__builtin_fmaxf((a),(b)),(c))
  #define GAPA(MF,A0,A1,A2,A3,W0,W1,PW) do{ MF; sacc+=A0; sacc+=A1; sacc+=A2; sacc+=A3; PIN(sacc); W0; W1; PIN(PW); SBAR(); }while(0)
  #define EX(v) __builtin_amdgcn_exp2f(v)
  #define GAPB(MF,X,B) do{ MF; X[B]=EX(X[B]); X[B+1]=EX(X[B+1]); X[B+2]=EX(X[B+2]); X[B+3]=EX(X[B+3]); PIN(X); SBAR(); }while(0)
  #define VRD(i) do{ vlo[i]=vtr(vp_+(((i)>>2)*4096+((i)&3)*1024)); vhi[i]=vtr(vp_+(((i)>>2)*4096+((i)&3)*1024+512)); }while(0)
  #define KRD(G,j) do{ if(G){ kload2(kf,kp0+sl_next,j); SBAR(); } }while(0)
  #define STEP(C0,C1,P0,P1,t,GK,GV,GL) do{ SBAR(); NBSUB(C0,C1); \
    const lds_cptr vp_=vp0+sl_prev; \
    VRD(0); SBAR(); float sacc=(P0[0]+P0[1]); \
    GAPA(C0=__builtin_amdgcn_mfma_f32_32x32x16_bf16(kf[0],qr[0],C0,0,0,0), P0[2],P0[3],P0[4],P0[5],     pw0[0]=PKW(P0,0), pw0[1]=PKW(P0,2), pw0); \
    VRD(4); SBAR(); GAPA(C1=__builtin_amdgcn_mfma_f32_32x32x16_bf16(kf[1],qr[0],C1,0,0,0), P0[6],P0[7],P0[8],P0[9],     pw0[2]=PKW(P0,4), pw0[3]=PKW(P0,6), pw0); \
    VRD(1); SBAR(); GAPA(C0=__builtin_amdgcn_mfma_f32_32x32x16_bf16(kf[2],qr[1],C0,0,0,0),   P0[10],P0[11],P0[12],P0[13], pw1[0]=PKW(P0,8), pw1[1]=PKW(P0,10), pw1); \
    VRD(5); SBAR(); GAPA(C1=__builtin_amdgcn_mfma_f32_32x32x16_bf16(kf[3],qr[1],C1,0,0,0),   P0[14],P0[15],P1[0],P1[1],   pw1[2]=PKW(P0,12),pw1[3]=PKW(P0,14), pw1); \
    VRD(2); SBAR(); GAPA(C0=__builtin_amdgcn_mfma_f32_32x32x16_bf16(kf[4],qr[2],C0,0,0,0),   P1[2],P1[3],P1[4],P1[5],     pw2[0]=PKW(P1,0), pw2[1]=PKW(P1,2), pw2); \
    VRD(6); SBAR(); GAPA(C1=__builtin_amdgcn_mfma_f32_32x32x16_bf16(kf[5],qr[2],C1,0,0,0),   P1[6],P1[7],P1[8],P1[9],     pw2[2]=PKW(P1,4), pw2[3]=PKW(P1,6), pw2); \
    VRD(3); SBAR(); GAPA(C0=__builtin_amdgcn_mfma_f32_32x32x16_bf16(kf[6],qr[3],C0,0,0,0),   P1[10],P1[11],P1[12],P1[13], pw3[0]=PKW(P1,8), pw3[1]=PKW(P1,10), pw3); \
    VRD(7); SBAR(); GAPA(C1=__builtin_amdgcn_mfma_f32_32x32x16_bf16(kf[7],qr[3],C1,0,0,0),   P1[14],P1[15],0.f,0.f,       pw3[2]=PKW(P1,12),pw3[3]=PKW(P1,14), pw3); \
    l_reg+=sacc; \
    if(GK){DMA_K((t)+3,sl_cur);} if(GV){DMA_V((t)+1,sl_next);} \
    CMASK(C0,C1,t); \
    { float a=MX3(C0[0],C0[1],C1[0]),b=MX3(C0[2],C0[3],C1[1]); a=MX3(a,C1[2],C1[3]); \
      _Pragma("unroll") for(int r=4;r<16;r+=4){a=MX3(a,C0[r],C0[r+1]);b=MX3(b,C0[r+2],C0[r+3]);a=MX3(a,C1[r],C1[r+1]);b=MX3(b,C1[r+2],C1[r+3]);} \
      float rm=__builtin_fmaxf(a,b); { auto rr=__builtin_amdgcn_permlane32_swap(__float_as_uint(rm),__float_as_uint(rm),false,false); rm=__builtin_fmaxf(__uint_as_float(rr[0]),__uint_as_float(rr[1])); } \
      resc=false; \
      if(__builtin_expect(__any(rm>(float)THRL),0)){ const float dl=__builtin_fmaxf(rm,0.f); mhat+=dl; \
        _Pragma("unroll") for(int r=0;r<16;++r){C0[r]-=dl;C1[r]-=dl;} \
        const float f=__builtin_amdgcn_exp2f(-dl); l_reg*=f; if(hi==0)wsf[r32]=f; resc=true; } } \
    SBAR(); \
    if(GL){ NBRD(P0,P1,(t)+1); SBAR(); } \
    GAPB(o[0]=__builtin_amdgcn_mfma_f32_32x32x16_bf16(PAF(0),VFR(0),o[0],0,0,0), C0,0); \
    GAPB(o[1]=__builtin_amdgcn_mfma_f32_32x32x16_bf16(PAF(0),VFR(4),o[1],0,0,0), C0,4); \
    KRD(GL,0); GAPB(o[0]=__builtin_amdgcn_mfma_f32_32x32x16_bf16(PAF(1),VFR(1),o[0],0,0,0), C0,8); \
    KRD(GL,1); GAPB(o[1]=__builtin_amdgcn_mfma_f32_32x32x16_bf16(PAF(1),VFR(5),o[1],0,0,0), C0,12); \
    KRD(GL,2); GAPB(o[0]=__builtin_amdgcn_mfma_f32_32x32x16_bf16(PAF(2),VFR(2),o[0],0,0,0), C1,0); \
    KRD(GL,3); GAPB(o[1]=__builtin_amdgcn_mfma_f32_32x32x16_bf16(PAF(2),VFR(6),o[1],0,0,0), C1,4); \
    GAPB(o[0]=__builtin_amdgcn_mfma_f32_32x32x16_bf16(PAF(3),VFR(3),o[0],0,0,0), C1,8); \
    GAPB(o[1]=__builtin_amdgcn_mfma_f32_32x32x16_bf16(PAF(3),VFR(7),o[1],0,0,0), C1,12); \
    }while(0)
  #define ENDW(tt) do{ if((tt)+3<NT){WAIT_BAR(2);} else if((tt)+2<NT){WAIT_BAR(1);} else {WAIT_BAR(0);} }while(0)
  int t=1;
  for(;t<=3&&t+1<NT;t+=2){
    STEP(pB0,pB1,pA0,pA1,t,(t+3<NT),(t+1<NT),(t+1<NT));       ENDW(t);   RESC(); ROT();
    STEP(pA0,pA1,pB0,pB1,t+1,(t+4<NT),(t+2<NT),(t+2<NT));     ENDW(t+1); RESC(); ROT();
  }
  #undef CMASK
  #define CMASK(P0,P1,t) do{}while(0)
  for(;t+5<NT;t+=2){
    STEP(pB0,pB1,pA0,pA1,t,true,true,true);     WAIT_BAR(2); RESC(); ROT();
    STEP(pA0,pA1,pB0,pB1,t+1,true,true,true);   WAIT_BAR(2); RESC(); ROT();
  }
  for(;t+1<NT;t+=2){
    STEP(pB0,pB1,pA0,pA1,t,(t+3<NT),(t+1<NT),(t+1<NT));       ENDW(t);   RESC(); ROT();
    STEP(pA0,pA1,pB0,pB1,t+1,(t+4<NT),(t+2<NT),(t+2<NT));     ENDW(t+1); RESC(); ROT();
  }
  #undef CMASK
  #define CMASK(P0,P1,t) do{int jb_=3-(t); if(jb_>=0)cmask(P0,P1,jb_,qrel,hi);}while(0)
  STEP(pB0,pB1,pA0,pA1,NT-1,false,false,false); RESC();
  { float sacc=pB0[0]+pB0[1]; _Pragma("unroll") for(int r=2;r<16;++r)sacc+=pB0[r]; _Pragma("unroll") for(int r=0;r<16;++r)sacc+=pB1[r]; l_reg+=sacc;
    pw0=(u32x4){PKW(pB0,0),PKW(pB0,2),PKW(pB0,4),PKW(pB0,6)};pw1=(u32x4){PKW(pB0,8),PKW(pB0,10),PKW(pB0,12),PKW(pB0,14)};pw2=(u32x4){PKW(pB1,0),PKW(pB1,2),PKW(pB1,4),PKW(pB1,6)};pw3=(u32x4){PKW(pB1,8),PKW(pB1,10),PKW(pB1,12),PKW(pB1,14)};
    SBAR(); pv(o,vb0+sl_cur,PAF(0),PAF(1),PAF(2),PAF(3)); }
  #undef PKW
  #undef PAF
  #undef VFR
  #undef PIN
  #undef MX3
  #undef GAPA
  #undef GAPB
  #undef EX
  #undef VRD
  #undef KRD
  #undef STEP
  #undef ENDW
  {auto rr=__builtin_amdgcn_permlane32_swap(__float_as_uint(l_reg),__float_as_uint(l_reg),false,false);l_reg=__uint_as_float(rr[0])+__uint_as_float(rr[1]);}
  if(hi==0)wsf[32+r32]=l_reg;asm volatile("s_waitcnt lgkmcnt(0)":::"memory");
  float rli[16];
  #pragma unroll
  for(int r=0;r<16;++r)rli[r]=__builtin_amdgcn_rcpf(wsf[32+crow(r,hi)]);
  bf16*Ow=O+(rowbase+q0+wid*QBLK)*DM+h*D;
  { bf16*stg=(bf16*)(shm+LDS_OST)+wid*2048;
    #pragma unroll
    for(int r=0;r<16;++r){const int orow=crow(r,hi);
      #pragma unroll
      for(int d0=0;d0<2;++d0)stg[orow*64+d0*32+r32]=__float2bfloat16(o[d0][r]*rli[r]);}
    asm volatile("s_waitcnt lgkmcnt(0)":::"memory");
    #pragma unroll
    for(int i=0;i<4;++i){const int row=i*8+(lane>>3),ch=lane&7; const u32x4 v=*(const u32x4*)(stg+row*64+ch*8); ATTN_STORE16(Ow+(long)row*DM+ch*8,v);} }
  asm volatile("s_waitcnt lgkmcnt(0)\n\ts_barrier":::"memory");
  #undef DMA_K
  #undef DMA_V
  #undef CMASK
  #undef START
  #undef NBRD
  #undef NBSUB
  #undef RESC
  #undef ROT
}
constexpr int ATTN_LDS_BYTES=LDS_BYTES;
struct AttnTensors { const bf16* Q; const bf16* K; const bf16* V; bf16* O; const float* cum; };
struct AttnUnit { int bh; int qb; };
template<int THRL=8> __device__ __forceinline__ void attn_phase(char*lds,const AttnTensors&T,unsigned*qheads,const unsigned*norm,volatile __attribute__((address_space(3))) unsigned*bc){
  const int x=blockIdx.x&7;
  for(;;){
    if(threadIdx.x==0) bc[0]=__hip_atomic_fetch_add(qheads+64*x,1u,__ATOMIC_RELAXED,__HIP_MEMORY_SCOPE_AGENT);
    __syncthreads(); const unsigned idx=bc[0]; __syncthreads();
    if(idx>=64u) break;
    const int b=x>>2, h=(idx&1)?(x&3):7-(x&3), qb=31-(int)(idx>>1), bh=b*NHEAD+h;
    const float qn=(__uint_as_float(norm[(0*16+bh)*2])+__uint_as_float(norm[(0*16+bh)*2+1]))*1.02f, kn=(__uint_as_float(norm[(1*16+bh)*2])+__uint_as_float(norm[(1*16+bh)*2+1]))*1.02f;
    const float thr=2.0f*sqrtf(qn*kn)+160.0f;
    attn_unit<THRL>(b,h,qb,T.Q,T.K,T.V,T.O,lds,T.cum+(long)bh*SEQ,thr);
  }
}
#undef SBAR
#undef WAIT_BAR
}

__device__ __forceinline__ void ph_attn_fast(Frame& F) {
    F.lane = ltid(); F.tid = F.wave * 64 + F.lane;
    static_assert(attn_body::ATTN_LDS_BYTES <= 131072, "attention LDS");
    const attn_body::AttnTensors AT{(const attn_body::bf16*)F.Q, (const attn_body::bf16*)F.K, (const attn_body::bf16*)F.V, (attn_body::bf16*)F.O, F.CUM};
    attn_body::attn_phase<8>((char*)F.lds_generic, AT, F.ctl + CW_AQ, F.ctl + CW_NORM, (volatile LAS unsigned*)(F.lds + MISC_OFF + 64));
}

constexpr int NPHASE = 13;
#ifndef PROBE_PHASE
#define PROBE_PHASE -1
#endif
constexpr int N_LAUNCHES = 1;
__global__ void __launch_bounds__(NTHR, 2) fwd_kernel(Args args) {
    extern __shared__ __attribute__((aligned(16))) unsigned char lds_raw[];
    Frame F;
    F.lds = (LAS unsigned char*)lds_raw; F.lds_generic = lds_raw;
    F.tid = threadIdx.x; F.lane = F.tid & 63; F.wave = __builtin_amdgcn_readfirstlane(F.tid >> 6);
    F.gw = blockIdx.x * NWAVES + F.wave; F.NGW = gridDim.x * NWAVES;
    F.x = args.in[0]; F.c = args.in[1]; F.w_ada = args.in[2]; F.b_ada = args.in[3]; F.w_in = args.in[4]; F.b_forget = args.in[5]; F.conv_w = args.in[6]; F.conv_b = args.in[7];
    F.conv_ln_g = args.in[8]; F.conv_ln_b = args.in[9]; F.w_conv_out = args.in[10]; F.w_fox_out = args.in[11]; F.w_mix_out = args.in[12]; F.ln1_g = args.in[13]; F.ln1_b = args.in[14];
    F.w_router = args.in[15]; F.router_bias = args.in[16]; F.w_exp_gate = args.in[17]; F.w_exp_up = args.in[18]; F.w_exp_down = args.in[19]; F.w_sh_gate = args.in[20]; F.w_sh_up = args.in[21];
    F.w_sh_down = args.in[22]; F.ln2_g = args.in[23]; F.ln2_b = args.in[24];
    F.out = args.out; F.ws = args.ws; unsigned char* ws = args.ws;
    F.ctl = (unsigned*)(ws + WS_CTL);
    F.ADA = (float*)(ws + WS_ADA); F.ADAP = (float*)(ws + WS_ADAP); F.CUM = (float*)(ws + WS_CUM); F.LOGF = (float*)(ws + WS_LOGF); F.X1 = (float*)(ws + WS_X1); F.RL = (float*)(ws + WS_RL);
    F.LISTW = (float*)(ws + WS_LISTW); F.WFC = (float*)(ws + WS_WFC); F.LIST = (int*)(ws + WS_LIST);
    F.H = (bf16_t*)(ws + WS_H); F.U = (bf16_t*)(ws + WS_U); F.Q = (bf16_t*)(ws + WS_Q); F.K = (bf16_t*)(ws + WS_K); F.V = (bf16_t*)(ws + WS_V); F.AC = (bf16_t*)(ws + WS_AC); F.O = (bf16_t*)(ws + WS_O);
    F.GA = (bf16_t*)(ws + WS_GA); F.GB = (bf16_t*)(ws + WS_GB); F.YA = (bf16_t*)(ws + WS_YA); F.MG = (bf16_t*)(ws + WS_MG); F.YAS = (bf16_t*)(ws + WS_YAS); F.H2 = (bf16_t*)(ws + WS_H2);
    F.H2LO = (bf16_t*)(ws + WS_H2LO); F.SHID = (bf16_t*)(ws + WS_SHID); F.HID = (bf16_t*)(ws + WS_HID);
    const int lo = args.ph_lo, hi = args.ph_hi;
    volatile LAS unsigned* MISC = (volatile LAS unsigned*)(F.lds + MISC_OFF);
    for (int u = F.tid; u < 32; u += NTHR) MISC[u] = 0u;
    __syncthreads();
    XcdBarrier bar; bar.bar = F.ctl + CW_BAR; bar.x = 0; bar.st = MISC + 8;
    if (hi - lo > 1) bar = xcd_barrier_post(F.ctl + CW_BAR, MISC + 8);
    F.vid = blockIdx.x;
#define IN(k) (lo <= (k) && (k) < hi)
#define SEAM(k) do { if (IN(k) && IN((k) + 1)) xcd_barrier(bar); } while (0)
    if (IN(0)) { { ph_ada(F); ph_convert(F); } if (PROBE_PHASE == 0) { __syncthreads(); { ph_ada(F); ph_convert(F); } } }
    SEAM(0);
    if (IN(0) && IN(1)) {
        if (F.tid == 0) { unsigned v = MISC[12]; for (unsigned j = 0; j < bar.x; ++j) v += xb_ld(&bar.bar[XB_XCNT(j)]); MISC[13] = v; }
        __syncthreads(); F.vid = __builtin_amdgcn_readfirstlane((int)MISC[13]); if (F.vid < 0 || F.vid >= (int)gridDim.x) F.vid = blockIdx.x; }
    if (IN(1)) { ph_lnmod(F); if (PROBE_PHASE == 1) { __syncthreads(); ph_lnmod(F); } }
    SEAM(1);
    if (IN(2)) { { ph_scan(F); ph_inproj_fast(F); } if (PROBE_PHASE == 2) { __syncthreads(); { ph_scan(F); ph_inproj_fast(F); } } }
    SEAM(2);
    if (IN(3)) { {} if (PROBE_PHASE == 3) { __syncthreads(); {} } }
    if (IN(4)) { ph_conv(F); __syncthreads(); if (PROBE_PHASE == 4) { ph_conv(F); __syncthreads(); } ph_attn_fast(F); __syncthreads(); ph_inproj_filler(F); __syncthreads();
        ph_convert_filler(F, F.ctl + CW_CQ, (volatile LAS unsigned*)(F.lds + MISC_OFF + 64)); }
    SEAM(4);
    if (IN(5)) { ph_merge_fast(F); if (PROBE_PHASE == 5) { __syncthreads(); ph_merge_fast(F); } }
    SEAM(5);
    if (IN(6)) { ph_mix_fast(F); if (PROBE_PHASE == 6) { __syncthreads(); ph_mix_fast(F); } }
    SEAM(6);
    if (IN(7)) { ph_ln2(F); if (PROBE_PHASE == 7) { __syncthreads(); ph_ln2(F); } }
    SEAM(7);
    if (IN(8)) { ph_router_fast(F); if (PROBE_PHASE == 8) { __syncthreads(); ph_router_fast(F); } }
    SEAM(8);
    if (IN(9)) { ph_route(F, 3); if (PROBE_PHASE == 9) { __syncthreads(); ph_route(F, 3); } }
    SEAM(9);
    if (IN(10)) { ph_moe1_fast(F); if (PROBE_PHASE == 10) { __syncthreads(); ph_moe1_fast(F); }
        if (PROBE_PHASE == 100) { __syncthreads(); ph_moe1_experts<0>(F, (bf16_t*)(F.ws + WS_WEGU_T)); } if (PROBE_PHASE == 101) { __syncthreads(); ph_moe1_experts<1>(F, (bf16_t*)(F.ws + WS_WEGU_T)); }
        if (PROBE_PHASE == 102) { __syncthreads(); ph_moe1_experts<2>(F, (bf16_t*)(F.ws + WS_WEGU_T)); } }
    SEAM(10);
    if (IN(11)) { ph_moe2_fast(F); if (PROBE_PHASE == 11) { __syncthreads(); ph_moe2_fast(F); } }
    SEAM(11);
    if (IN(12)) { ph_combine(F); if (PROBE_PHASE == 12) { __syncthreads(); ph_combine(F); } }
#undef IN
#undef SEAM
}

extern "C" void kernel_launch(void* const* d_in, const int* in_sizes, int n_in, void* d_out, int out_size, void* d_ws, size_t ws_size, hipStream_t stream) {
    static int grid = 0;
    if (grid == 0) {
        if (n_in != 25 || out_size != T * D || ws_size < WS_END) { fprintf(stderr, "kernel_launch: unexpected sizes: n_in %d out %d ws %zu (need %zu)\n", n_in, out_size, ws_size, (size_t)WS_END); grid = -1; return; }
        int dev = 0, cus = 0, per_cu = 0;
        (void)hipGetDevice(&dev); (void)hipDeviceGetAttribute(&cus, hipDeviceAttributeMultiprocessorCount, dev);
        (void)hipFuncSetAttribute((const void*)fwd_kernel, hipFuncAttributeMaxDynamicSharedMemorySize, LDS_BYTES);
        (void)hipOccupancyMaxActiveBlocksPerMultiprocessor(&per_cu, (const void*)fwd_kernel, NTHR, LDS_BYTES);
        (void)hipGetLastError();
        if (per_cu < 1) { fprintf(stderr, "kernel_launch: occupancy query says %d blocks/CU\n", per_cu); }
        grid = cus > 0 ? cus : 256;
    }
    if (grid < 0) return;
    (void)hipMemsetAsync((char*)d_ws + WS_CTL, 0, CTL_BYTES, stream);
    Args a{};
    for (int i = 0; i < 25; ++i) a.in[i] = (const float*)d_in[i];
    a.out = (float*)d_out; a.ws = (unsigned char*)d_ws;
    if (N_LAUNCHES == 1) {
        a.ph_lo = 0; a.ph_hi = NPHASE;
        void* kargs[] = {(void*)&a};
        const hipError_t e = hipLaunchCooperativeKernel((const void*)fwd_kernel, dim3(grid), dim3(NTHR), kargs, LDS_BYTES, stream);
        if (e != hipSuccess) fprintf(stderr, "kernel_launch: cooperative launch failed: %s (grid %d)\n", hipGetErrorString(e), grid);
    } else {
        for (int p = 0; p < NPHASE; ++p) { a.ph_lo = p; a.ph_hi = p + 1; hipLaunchKernelGGL(fwd_kernel, dim3(grid), dim3(NTHR), LDS_BYTES, stream, a); }
    }
}
```

```cpp
#include <hip/hip_runtime.h>
#include <cstdio>
#include <cstdint>
#include <hip/hip_bf16.h>

#define LAS __attribute__((address_space(3)))
typedef unsigned short bf16_t;
typedef float f32x4 __attribute__((ext_vector_type(4)));
typedef unsigned u32x4 __attribute__((ext_vector_type(4)));
typedef unsigned u32x2 __attribute__((ext_vector_type(2)));

constexpr int NB = 2, S = 8192, D = 1024, T = NB * S;
constexpr int CC = 512, CW = 31, NH = 8, HD = 64, FW = 512;
constexpr int NE = 256, TOPK = 8, NG = 8, EH = 256, SHH = 256;
constexpr int INC = 4616;
constexpr int O_Q = 1024, O_K = 1536, O_V = 2048, O_F = 2560, O_GA = 2568, O_GB = 3592;
constexpr float LN_EPS = 1e-5f;
constexpr float ALPHA = 1.189207115002721f;
constexpr float LOG2E = 1.4426950408889634f;
constexpr float QSCALE = 0.125f * LOG2E;
constexpr float ROUTED_SCALE = 2.5f;
constexpr int NWAVES = 8, NTHR = 512;
constexpr int LCAP = 16384;
constexpr int NSLOT = 9;
constexpr int LDS_BYTES = 147456, MISC_OFF = 131072 + 320;

constexpr size_t MiB = 1u << 20;
constexpr size_t WS_CTL = 0, CTL_BYTES = 1 * MiB;
constexpr size_t WS_ADA = 1 * MiB;
constexpr size_t WS_ADAP = 1 * MiB + 64 * 1024;
constexpr size_t WS_CUM = 2 * MiB;
constexpr size_t WS_LOGF = 2 * MiB + 512 * 1024;
constexpr size_t WS_WFC = 3 * MiB + 512 * 1024;
constexpr size_t WS_H = 20 * MiB;
constexpr size_t WS_U = 52 * MiB, WS_Q = 68 * MiB, WS_K = 84 * MiB, WS_V = 100 * MiB, WS_AC = 116 * MiB, WS_O = 132 * MiB;
constexpr size_t WS_GA = 148 * MiB, WS_GB = 180 * MiB, WS_YA = 212 * MiB, WS_MG = 244 * MiB;
constexpr size_t WS_YAS = 20 * MiB;
constexpr size_t WS_X1 = 308 * MiB;
constexpr size_t WS_H2 = 372 * MiB, WS_H2LO = 404 * MiB;
constexpr size_t WS_RL = 436 * MiB;
constexpr size_t WS_SHID = 484 * MiB;
constexpr size_t WS_LIST = 492 * MiB, WS_LISTW = 508 * MiB;
constexpr size_t WS_HID = 524 * MiB;
constexpr size_t WS_END = 1024 * MiB;
constexpr int CW_CNT = 16384, CNT_STRIDE = 64;
constexpr int CW_NORM = 2048;
constexpr int CW_AQ = 2304;
constexpr int CW_FQ = 2816, CW_CQ = 3392;

__device__ __forceinline__ float bf2f(bf16_t v) { return __uint_as_float((unsigned)v << 16); }
__device__ __forceinline__ unsigned f2bf(float f) { unsigned u = __float_as_uint(f); return (u + 0x7fffu + ((u >> 16) & 1u)) >> 16; }
__device__ __forceinline__ unsigned pk2(float lo, float hi) { return f2bf(lo) | (f2bf(hi) << 16); }
__device__ __forceinline__ float wave_sum(float v) {
#pragma unroll
    for (int o = 1; o < 64; o <<= 1) v += __shfl_xor(v, o);
    return v;
}
__device__ __forceinline__ float wave_max(float v) {
#pragma unroll
    for (int o = 1; o < 64; o <<= 1) v = fmaxf(v, __shfl_xor(v, o));
    return v;
}
__device__ __forceinline__ int ltid() { int t = (int)__builtin_amdgcn_mbcnt_hi(~0u, __builtin_amdgcn_mbcnt_lo(~0u, 0u)); asm volatile("" : "+v"(t)); return t; }
__device__ __forceinline__ float sigmoidf_(float x) { return 1.0f / (1.0f + expf(-x)); }
__device__ __forceinline__ float siluf_(float x) { return x / (1.0f + expf(-x)); }


constexpr int CW_BAR = 4096;
#define XB_TMO      128
#define XB_XCNT(j)  (256  + 64 * (j))
#define XB_XSUB(j)  (1280 + 64 * (j))
#define XB_XGEN(j)  (2304 + 64 * (j))
#define XB_TOP      3328
#define XB_TOPGEN   3392
#define XCD_BAR_WORDS 3456
#define XB_SPIN_CAP (1u << 20)
__device__ __forceinline__ unsigned xb_ld(unsigned* p)              { return __hip_atomic_load(p, __ATOMIC_RELAXED, __HIP_MEMORY_SCOPE_AGENT); }
__device__ __forceinline__ unsigned xb_add(unsigned* p, unsigned v) { return __hip_atomic_fetch_add(p, v, __ATOMIC_RELAXED, __HIP_MEMORY_SCOPE_AGENT); }
__device__ __forceinline__ unsigned xb_xcc_id() { return (unsigned)__builtin_amdgcn_s_getreg((3 << 11) | 20) & 0xFu; }
#define XB_SPIN(cond, bar) do { unsigned _sp = 0; while (cond) { __builtin_amdgcn_s_sleep(1); \
    if ((++_sp & 255u) == 0u) { if (xb_ld(&(bar)[XB_TMO])) break; if (_sp > XB_SPIN_CAP) { atomicAdd(&(bar)[XB_TMO], 1u); break; } } } } while (0)
struct XcdBarrier { unsigned* bar; unsigned x; volatile LAS unsigned* st; };
__device__ __forceinline__ XcdBarrier xcd_barrier_post(unsigned* bar, volatile LAS unsigned* st) {
    XcdBarrier b; b.bar = bar; b.x = xb_xcc_id(); b.st = st;
    if (threadIdx.x == 0) st[4] = xb_add(&bar[XB_XCNT(b.x)], 1u);
    return b;
}
__device__ __forceinline__ void xcd_barrier_complete(unsigned* bar, unsigned x, unsigned& nloc, unsigned& nx) {
    const unsigned G = gridDim.x * gridDim.y * gridDim.z;
    unsigned sum, cnt, mine, sp = 0u;
    for (;;) {
        sum = 0u; cnt = 0u; mine = 0u;
#pragma unroll
        for (unsigned j = 0; j < 16; ++j) { const unsigned c = xb_ld(&bar[XB_XCNT(j)]); sum += c; cnt += (c > 0u) ? 1u : 0u; mine = (j == x) ? c : mine; }
        if (sum == G) break;
        __builtin_amdgcn_s_sleep(1);
        if ((++sp & 255u) == 0u) { if (xb_ld(&bar[XB_TMO])) break; if (sp > XB_SPIN_CAP) { atomicAdd(&bar[XB_TMO], 1u); break; } }
    }
    nloc = mine > 0u ? mine : 1u; nx = cnt > 0u ? cnt : 1u;
}
__device__ __forceinline__ void xcd_barrier(const XcdBarrier& b) {
    asm volatile("s_waitcnt vmcnt(0)" ::: "memory");
    __syncthreads();
    if (threadIdx.x == 0) {
        unsigned* bar = b.bar;
        __builtin_amdgcn_s_waitcnt(0);
        unsigned nloc = b.st[0], nx = b.st[1];
        if (nloc == 0u) { xcd_barrier_complete(bar, b.x, nloc, nx); b.st[0] = nloc; b.st[1] = nx; }
        const unsigned old = xb_add(&bar[XB_XSUB(b.x)], 1u);
        const unsigned gen = old / nloc;
        if (old + 1u == (gen + 1u) * nloc) {
            __builtin_amdgcn_fence(__ATOMIC_RELEASE, "agent");
            asm volatile("s_waitcnt vmcnt(0)" ::: "memory");
            const unsigned og = xb_add(&bar[XB_TOP], 1u);
            const unsigned tg = og / nx;
            if (og + 1u == (tg + 1u) * nx) xb_add(&bar[XB_TOPGEN], 1u);
            else XB_SPIN(xb_ld(&bar[XB_TOPGEN]) == tg, bar);
            __builtin_amdgcn_fence(__ATOMIC_ACQUIRE, "agent");
            xb_add(&bar[XB_XGEN(b.x)], 1u);
            asm volatile("s_waitcnt vmcnt(0)" ::: "memory");
        } else {
            XB_SPIN(xb_ld(&bar[XB_XGEN(b.x)]) == gen, bar);
            __builtin_amdgcn_fence(__ATOMIC_ACQUIRE, "agent");
            asm volatile("s_waitcnt vmcnt(0)" ::: "memory");
        }
    }
    __syncthreads();
}

struct Args { const float* in[25]; float* out; unsigned char* ws; int ph_lo, ph_hi; };

struct Frame {
    LAS unsigned char* lds; unsigned char* lds_generic;
    int tid, lane, wave, gw, NGW, vid;
    const float *x, *c, *w_ada, *b_ada, *w_in, *b_forget, *conv_w, *conv_b, *conv_ln_g, *conv_ln_b, *w_conv_out, *w_fox_out, *w_mix_out, *ln1_g, *ln1_b,
        *w_router, *router_bias, *w_exp_gate, *w_exp_up, *w_exp_down, *w_sh_gate, *w_sh_up, *w_sh_down, *ln2_g, *ln2_b;
    float* out; unsigned char* ws;
    unsigned* ctl;
    float *ADA, *ADAP, *CUM, *LOGF, *X1, *RL, *LISTW, *WFC;
    bf16_t *H, *U, *Q, *K, *V, *AC, *O, *GA, *GB, *YA, *MG, *YAS, *H2, *H2LO, *SHID, *HID;
    int* LIST;
};

__device__ __forceinline__ void ph_ada(Frame& F) {
    F.lane = ltid(); F.tid = F.wave * 64 + F.lane;
    if (blockIdx.x == gridDim.x - 1) for (int i = F.tid; i < 8192; i += NTHR) { const int k = i >> 3, hh = i & 7; F.WFC[hh * 1024 + k] = F.w_in[(size_t)k * INC + O_F + hh]; }
    if (blockIdx.x >= 24) return;
    LAS float* part = (LAS float*)F.lds;
    const float* c = F.c; const float* w = F.w_ada;
    const int j0 = blockIdx.x * 256 + F.lane * 4, kc = F.wave;
    f32x4 a0 = {0.f, 0.f, 0.f, 0.f}, a1 = {0.f, 0.f, 0.f, 0.f};
#pragma unroll 8
    for (int k = kc * 128; k < kc * 128 + 128; ++k) {
        const f32x4 wv = *(const f32x4*)(w + (size_t)k * 6144 + j0);
        const float c0 = siluf_(c[k]), c1 = siluf_(c[D + k]);
        a0 += wv * c0; a1 += wv * c1;
    }
    *(LAS f32x4*)(part + (kc * 2 + 0) * 256 + F.lane * 4) = a0;
    *(LAS f32x4*)(part + (kc * 2 + 1) * 256 + F.lane * 4) = a1;
    __syncthreads();
    { const int b = F.tid >> 8, j = F.tid & 255; float s = F.b_ada[blockIdx.x * 256 + j];
#pragma unroll
      for (int p = 0; p < 8; ++p) s += part[(p * 2 + b) * 256 + j];
      F.ADA[b * 6144 + blockIdx.x * 256 + j] = s; }
    __syncthreads();
}

__device__ __forceinline__ float wave_sum8(const float (&a)[8], int lane) {
    float b[4], c[2];
#pragma unroll
    for (int i = 0; i < 4; ++i) { const float keep = (lane & 1) ? a[2 * i + 1] : a[2 * i], send = (lane & 1) ? a[2 * i] : a[2 * i + 1]; b[i] = keep + __shfl_xor(send, 1); }
#pragma unroll
    for (int i = 0; i < 2; ++i) { const float keep = (lane & 2) ? b[2 * i + 1] : b[2 * i], send = (lane & 2) ? b[2 * i] : b[2 * i + 1]; c[i] = keep + __shfl_xor(send, 2); }
    float d = ((lane & 4) ? c[1] : c[0]) + __shfl_xor((lane & 4) ? c[0] : c[1], 4);
    d += __shfl_xor(d, 8); d += __shfl_xor(d, 16); d += __shfl_xor(d, 32);
    return d;
}
__device__ __forceinline__ void ph_lnmod(Frame& F) {
    F.lane = ltid(); F.tid = F.wave * 64 + F.lane;
    LAS float* ada1 = (LAS float*)F.lds;
    LAS float* wf = ada1 + 4096;
    for (int i = F.tid; i < 1024; i += NTHR) { const int b = i >> 9, j = (i & 511) * 4; *(LAS f32x4*)(ada1 + b * 2048 + j) = *(const f32x4*)(F.ADA + b * 6144 + j); }
    for (int i = F.tid; i < 2048; i += NTHR) *(LAS f32x4*)(wf + 4 * i) = *(const f32x4*)(F.WFC + 4 * i);
    __syncthreads();
    const int lane = F.lane;
    constexpr int R = 4;
    for (int m0 = F.gw * R; m0 < T; m0 += F.NGW * R) {
        f32x4 v[R][4]; float mean[R], rstd[R];
#pragma unroll
        for (int r = 0; r < R; ++r) { const f32x4* xr = (const f32x4*)(F.x + (size_t)(m0 + r) * D) + lane;
#pragma unroll
            for (int j = 0; j < 4; ++j) v[r][j] = xr[64 * j]; }
#pragma unroll
        for (int r = 0; r < R; ++r) { float s = 0.f;
#pragma unroll
            for (int j = 0; j < 4; ++j) s += (v[r][j].x + v[r][j].y) + (v[r][j].z + v[r][j].w);
            mean[r] = wave_sum(s) * (1.f / D); }
#pragma unroll
        for (int r = 0; r < R; ++r) { float s2 = 0.f;
#pragma unroll
            for (int j = 0; j < 4; ++j) { v[r][j] = v[r][j] - mean[r]; s2 += (v[r][j].x * v[r][j].x + v[r][j].y * v[r][j].y) + (v[r][j].z * v[r][j].z + v[r][j].w * v[r][j].w); }
            rstd[r] = 1.f / sqrtf(wave_sum(s2) * (1.f / D) + LN_EPS); }
#pragma unroll
        for (int r = 0; r < R; ++r) { const int m = m0 + r, b = m >> 13;
            float fl[8];
#pragma unroll
            for (int hh = 0; hh < 8; ++hh) fl[hh] = 0.f;
            u32x2* hrow = (u32x2*)(F.H + (size_t)m * D) + lane;
#pragma unroll
            for (int j = 0; j < 4; ++j) { const int col = 4 * lane + 256 * j;
                const f32x4 sh = *(const LAS f32x4*)(ada1 + b * 2048 + col), sc = *(const LAS f32x4*)(ada1 + b * 2048 + 1024 + col);
                const f32x4 h = v[r][j] * rstd[r] * (sc + 1.0f) + sh;
                u32x2 o; o.x = pk2(h.x, h.y); o.y = pk2(h.z, h.w); hrow[64 * j] = o;
#pragma unroll
                for (int hh = 0; hh < 8; ++hh) { const f32x4 w = *(const LAS f32x4*)(wf + hh * 1024 + col); fl[hh] += (h.x * w.x + h.y * w.y) + (h.z * w.z + h.w * w.w); }
                asm volatile("" ::: "memory"); }
            const float f = wave_sum8(fl, lane);
            if (lane < 8) { const float z = f + F.b_forget[lane]; F.LOGF[(size_t)m * 8 + lane] = fminf(z, 0.f) - log1pf(expf(-fabsf(z))); } }
    }
}

__device__ __forceinline__ void ph_scan(Frame& F) {
    F.lane = ltid(); F.tid = F.wave * 64 + F.lane;
    if (blockIdx.x >= 16) return;
    LAS double* sc = (LAS double*)F.lds;
    const int bh = blockIdx.x, b = bh >> 3, hh = bh & 7, s0 = F.tid * 16;
    double loc[16]; double run = 0.0;
#pragma unroll
    for (int i = 0; i < 16; ++i) { run += (double)F.LOGF[(size_t)(b * S + s0 + i) * 8 + hh]; loc[i] = run; }
    sc[F.tid] = run;
    __syncthreads();
    double off = 0.0;
    for (int i = 0; i < F.tid; ++i) off += sc[i];
#pragma unroll
    for (int i = 0; i < 16; ++i) F.CUM[(size_t)bh * S + s0 + i] = (float)(off + loc[i]);
    __syncthreads();
}

__device__ __forceinline__ void ph_conv(Frame& F) {
    F.lane = ltid(); F.tid = F.wave * 64 + F.lane;
    constexpr int RUN = 8, NIN = RUN + CW - 1, PADJ = RUN - 1, NTAB = CW + 2 * PADJ + 2;
    LAS float* cw = (LAS float*)F.lds;
    LAS float* cb = cw + NTAB * CC;
    for (int i = F.tid; i < NTAB * CC / 4; i += NTHR) { const int jj = (4 * i) / CC, j = jj - PADJ;
        *(LAS f32x4*)(cw + 4 * i) = (j >= 0 && j < CW) ? *(const f32x4*)(F.conv_w + (size_t)j * CC + (4 * i) % CC) : (f32x4){0.f, 0.f, 0.f, 0.f}; }
    for (int i = F.tid; i < CC; i += NTHR) { cb[i] = F.conv_b[i]; cb[CC + i] = F.conv_ln_g[i]; cb[2 * CC + i] = F.conv_ln_b[i]; }
    __syncthreads();
    const int lane = F.lane, c0 = lane * 8;
    for (int run = F.gw; run < T / RUN; run += F.NGW) {
        const int m0 = run * RUN, t0 = m0 & (S - 1);
        float a[RUN][8];
#pragma unroll
        for (int r = 0; r < RUN; ++r)
#pragma unroll
            for (int i = 0; i < 8; ++i) a[r][i] = cb[c0 + i];
#pragma unroll 1
        for (int c = 0; c < (NIN + 7) / 8; ++c) {
            u32x4 uv[8];
#pragma unroll
            for (int k = 0; k < 8; ++k) { const int i = 8 * c + k; uv[k] = (u32x4){0u, 0u, 0u, 0u};
                if (i < NIN && t0 - (CW - 1) + i >= 0) uv[k] = *(const u32x4*)(F.U + (size_t)(m0 - (CW - 1) + i) * CC + c0); }
            float u[8][8];
#pragma unroll
            for (int k = 0; k < 8; ++k) {
                u[k][0] = __uint_as_float(uv[k].x << 16); u[k][1] = __uint_as_float(uv[k].x & 0xffff0000u); u[k][2] = __uint_as_float(uv[k].y << 16); u[k][3] = __uint_as_float(uv[k].y & 0xffff0000u);
                u[k][4] = __uint_as_float(uv[k].z << 16); u[k][5] = __uint_as_float(uv[k].z & 0xffff0000u); u[k][6] = __uint_as_float(uv[k].w << 16); u[k][7] = __uint_as_float(uv[k].w & 0xffff0000u); }
#pragma unroll
            for (int d = -(RUN - 1); d < 8; ++d) {
                const LAS float* wrow = cw + (8 * c + d + PADJ) * CC + c0;
                const f32x4 w0 = *(const LAS f32x4*)(wrow), w1 = *(const LAS f32x4*)(wrow + 4);
#pragma unroll
                for (int r = 0; r < RUN; ++r) { const int k = r + d;
                    if (k >= 0 && k < 8) {
                        a[r][0] += u[k][0] * w0.x; a[r][1] += u[k][1] * w0.y; a[r][2] += u[k][2] * w0.z; a[r][3] += u[k][3] * w0.w;
                        a[r][4] += u[k][4] * w1.x; a[r][5] += u[k][5] * w1.y; a[r][6] += u[k][6] * w1.z; a[r][7] += u[k][7] * w1.w; } }
                asm volatile("" ::: "memory"); }
        }
#pragma unroll
        for (int r = 0; r < RUN; ++r) {
            float s = 0.f;
#pragma unroll
            for (int i = 0; i < 8; ++i) s += a[r][i];
            const float mean = wave_sum(s) * (1.f / CC); float s2 = 0.f;
#pragma unroll
            for (int i = 0; i < 8; ++i) { a[r][i] -= mean; s2 += a[r][i] * a[r][i]; }
            const float rstd = 1.f / sqrtf(wave_sum(s2) * (1.f / CC) + LN_EPS);
            float y[8];
#pragma unroll
            for (int i = 0; i < 8; ++i) y[i] = siluf_(a[r][i] * rstd * cb[CC + c0 + i] + cb[2 * CC + c0 + i]);
            u32x4 o; o.x = pk2(y[0], y[1]); o.y = pk2(y[2], y[3]); o.z = pk2(y[4], y[5]); o.w = pk2(y[6], y[7]);
            *(u32x4*)(F.AC + (size_t)(m0 + r) * CC + c0) = o;
        }
    }
}

__device__ __forceinline__ void ph_ln2(Frame& F, bool dry = false) {
    F.lane = ltid(); F.tid = F.wave * 64 + F.lane;
    float* X1o = dry ? (float*)(F.ws + (size_t)640 * MiB) : F.X1; bf16_t* H2o = dry ? (bf16_t*)(F.ws + (size_t)(640 + 64) * MiB) : F.H2; bf16_t* H2Lo = dry ? (bf16_t*)(F.ws + (size_t)(640 + 96) * MiB) : F.H2LO;
    const int lane = F.lane;
    constexpr int R = 4;
    for (int m0 = F.gw * R; m0 < T; m0 += F.NGW * R) {
        f32x4 v[R][4]; float mean[R], rstd[R];
#pragma unroll
        for (int r = 0; r < R; ++r) { const f32x4* zr = (const f32x4*)(F.X1 + (size_t)(m0 + r) * D) + lane;
#pragma unroll
            for (int j = 0; j < 4; ++j) v[r][j] = zr[64 * j]; }
#pragma unroll
        for (int r = 0; r < R; ++r) { float s = 0.f;
#pragma unroll
            for (int j = 0; j < 4; ++j) s += (v[r][j].x + v[r][j].y) + (v[r][j].z + v[r][j].w);
            mean[r] = wave_sum(s) * (1.f / D); }
#pragma unroll
        for (int r = 0; r < R; ++r) { float s2 = 0.f;
#pragma unroll
            for (int j = 0; j < 4; ++j) { v[r][j] = v[r][j] - mean[r]; s2 += (v[r][j].x * v[r][j].x + v[r][j].y * v[r][j].y) + (v[r][j].z * v[r][j].z + v[r][j].w * v[r][j].w); }
            rstd[r] = 1.f / sqrtf(wave_sum(s2) * (1.f / D) + LN_EPS); }
#pragma unroll
        for (int r = 0; r < R; ++r) { f32x4* zr = (f32x4*)(X1o + (size_t)(m0 + r) * D) + lane; float s = 0.f;
#pragma unroll
            for (int j = 0; j < 4; ++j) { const int col = 4 * lane + 256 * j;
                v[r][j] = v[r][j] * rstd[r] * *(const f32x4*)(F.ln1_g + col) + *(const f32x4*)(F.ln1_b + col);
                zr[64 * j] = v[r][j]; s += (v[r][j].x + v[r][j].y) + (v[r][j].z + v[r][j].w); }
            mean[r] = wave_sum(s) * (1.f / D); }
#pragma unroll
        for (int r = 0; r < R; ++r) { float s2 = 0.f;
#pragma unroll
            for (int j = 0; j < 4; ++j) { v[r][j] = v[r][j] - mean[r]; s2 += (v[r][j].x * v[r][j].x + v[r][j].y * v[r][j].y) + (v[r][j].z * v[r][j].z + v[r][j].w * v[r][j].w); }
            rstd[r] = 1.f / sqrtf(wave_sum(s2) * (1.f / D) + LN_EPS); }
#pragma unroll
        for (int r = 0; r < R; ++r) { const int m = m0 + r, b = m >> 13;
            u32x2* hr = (u32x2*)(H2o + (size_t)m * D) + lane; u32x2* lr = (u32x2*)(H2Lo + (size_t)m * D) + lane;
#pragma unroll
            for (int j = 0; j < 4; ++j) { const int col = 4 * lane + 256 * j;
                const f32x4 sh = *(const f32x4*)(F.ADA + b * 6144 + 3072 + col), sc = *(const f32x4*)(F.ADA + b * 6144 + 4096 + col);
                const f32x4 h = v[r][j] * rstd[r] * (sc + 1.0f) + sh;
                const unsigned h0 = f2bf(h.x), h1 = f2bf(h.y), h2 = f2bf(h.z), h3 = f2bf(h.w);
                u32x2 o; o.x = h0 | (h1 << 16); o.y = h2 | (h3 << 16); hr[64 * j] = o;
                u32x2 l; l.x = pk2(h.x - __uint_as_float(h0 << 16), h.y - __uint_as_float(h1 << 16)); l.y = pk2(h.z - __uint_as_float(h2 << 16), h.w - __uint_as_float(h3 << 16)); lr[64 * j] = l; } }
    }
}

__device__ __forceinline__ void ph_route(Frame& F, int nparts, bool dry = false) {
    F.lane = ltid(); F.tid = F.wave * 64 + F.lane;
    unsigned* cnt = dry ? (unsigned*)(F.ws + (size_t)(640 + 160) * MiB) : F.ctl + CW_CNT; int* LISTo = dry ? (int*)(F.ws + (size_t)(640 + 128) * MiB) : F.LIST; float* LISTWo = dry ? (float*)(F.ws + (size_t)(640 + 144) * MiB) : F.LISTW;
    const int lane = F.lane, g = lane >> 3;
    constexpr int TK = 4;
    const f32x4 bias = *(const f32x4*)(F.router_bias + lane * 4);
    for (int t0 = F.gw * TK; t0 < T; t0 += F.NGW * TK) {
        float sc[TK][4], mv[TK][4], a1[TK], a2[TK], myw[TK], wsum[TK]; int mye[TK];
#pragma unroll
        for (int q = 0; q < TK; ++q) { const int t = t0 + q;
            f32x4 lg = *(const f32x4*)(F.RL + (size_t)t * NE + lane * 4);
            for (int p = 1; p < nparts; ++p) lg += *(const f32x4*)(F.RL + (size_t)p * T * NE + (size_t)t * NE + lane * 4);
#pragma unroll
            for (int i = 0; i < 4; ++i) { sc[q][i] = sigmoidf_(lg[i]); mv[q][i] = sc[q][i] + bias[i]; }
            a1[q] = fmaxf(mv[q][0], mv[q][1]); a2[q] = fminf(mv[q][0], mv[q][1]);
            const float b1 = fmaxf(mv[q][2], mv[q][3]), b2 = fminf(mv[q][2], mv[q][3]); const float n1 = fmaxf(a1[q], b1), n2 = fmaxf(fminf(a1[q], b1), fmaxf(a2[q], b2)); a1[q] = n1; a2[q] = n2; }
#pragma unroll
        for (int o = 1; o < 8; o <<= 1)
#pragma unroll
            for (int q = 0; q < TK; ++q) { const float b1 = __shfl_xor(a1[q], o), b2 = __shfl_xor(a2[q], o); const float n1 = fmaxf(a1[q], b1), n2 = fmaxf(fminf(a1[q], b1), fmaxf(a2[q], b2)); a1[q] = n1; a2[q] = n2; }
        int rank[TK];
#pragma unroll
        for (int q = 0; q < TK; ++q) { a1[q] += a2[q]; rank[q] = 0; }
#pragma unroll
        for (int gg = 0; gg < NG; ++gg)
#pragma unroll
            for (int q = 0; q < TK; ++q) { const float og = __shfl(a1[q], gg * 8); rank[q] += (og > a1[q] || (og == a1[q] && gg < g)) ? 1 : 0; }
#pragma unroll
        for (int q = 0; q < TK; ++q) { if (rank[q] >= 4) {
#pragma unroll
                for (int i = 0; i < 4; ++i) mv[q][i] = -INFINITY; }
            myw[q] = 0.f; mye[q] = 0; wsum[q] = 0.f; }
#pragma unroll
        for (int k = 0; k < TOPK; ++k) {
            float v[TK]; int e[TK];
#pragma unroll
            for (int q = 0; q < TK; ++q) { float bv = mv[q][0]; int bi = 0;
#pragma unroll
                for (int i = 1; i < 4; ++i) if (mv[q][i] > bv) { bv = mv[q][i]; bi = i; }
                v[q] = bv; e[q] = lane * 4 + bi; }
#pragma unroll
            for (int o = 1; o < 64; o <<= 1)
#pragma unroll
                for (int q = 0; q < TK; ++q) { const float ov = __shfl_xor(v[q], o); const int oe = __shfl_xor(e[q], o);
                    if (ov > v[q] || (ov == v[q] && oe < e[q])) { v[q] = ov; e[q] = oe; } }
#pragma unroll
            for (int q = 0; q < TK; ++q) {
                float s = 0.f;
                if ((e[q] >> 2) == lane) {
#pragma unroll
                    for (int i = 0; i < 4; ++i) if ((e[q] & 3) == i) { s = sc[q][i]; mv[q][i] = -INFINITY; } }
                s = __shfl(s, e[q] >> 2);
                wsum[q] += s;
                if (lane == k) { myw[q] = s; mye[q] = e[q]; } }
        }
        if (lane < TOPK) {
#pragma unroll
            for (int q = 0; q < TK; ++q) { const float w = myw[q] / wsum[q] * ROUTED_SCALE;
                const unsigned p = atomicAdd(cnt + mye[q] * CNT_STRIDE, 1u) & (LCAP - 1);
                LISTo[(size_t)mye[q] * LCAP + p] = (t0 + q) * TOPK + lane;
                LISTWo[(size_t)mye[q] * LCAP + p] = w; }
        }
    }
}

__device__ __forceinline__ void build_expert_map(Frame& F, LAS int* pref, LAS int* base, int rows_per_chunk) {
    __syncthreads();
    int nch = 0, n = 0;
    if (F.tid < NE) { n = (int)F.ctl[CW_CNT + F.tid * CNT_STRIDE]; nch = (n + rows_per_chunk - 1) / rows_per_chunk; }
    int sp = nch, sb = n;
#pragma unroll
    for (int o = 1; o < 64; o <<= 1) { const int tp = __shfl_up(sp, o), tb = __shfl_up(sb, o); if (F.lane >= o) { sp += tp; sb += tb; } }
    if (F.tid < NE && F.lane == 63) { pref[NE + 1 + F.wave] = sp; base[NE + 1 + F.wave] = sb; }
    __syncthreads();
    if (F.tid < NE) { int op = 0, ob = 0;
        for (int w = 0; w < F.wave; ++w) { op += pref[NE + 1 + w]; ob += base[NE + 1 + w]; }
        pref[F.tid + 1] = op + sp; base[F.tid + 1] = ob + sb; }
    if (F.tid == 0) { pref[0] = 0; base[0] = 0; }
    __syncthreads();
}
__device__ __forceinline__ int find_expert(const LAS int* pref, int u) { int lo = 0, hi = NE - 1;
    while (lo < hi) { const int mid = (lo + hi + 1) >> 1; if (pref[mid] <= u) lo = mid; else hi = mid - 1; }
    return lo; }

__device__ __forceinline__ void ph_combine(Frame& F) {
    F.lane = ltid(); F.tid = F.wave * 64 + F.lane;
    const int lane = F.lane;
    constexpr int R = 2;
    for (int m0 = F.gw * R; m0 < T; m0 += F.NGW * R) {
        f32x4 y[R][4];
#pragma unroll
        for (int r = 0; r < R; ++r) {
            u32x4 w[NSLOT][2];
#pragma unroll
            for (int k = 0; k < NSLOT; ++k) { const u32x4* yr = (const u32x4*)(F.YAS + ((size_t)(m0 + r) * NSLOT + k) * D) + lane; w[k][0] = yr[0]; w[k][1] = yr[64]; }
#pragma unroll
            for (int j = 0; j < 4; ++j) y[r][j] = (f32x4){0.f, 0.f, 0.f, 0.f};
#pragma unroll
            for (int k = 0; k < NSLOT; ++k)
#pragma unroll
                for (int q = 0; q < 2; ++q) { const u32x4 t = w[k][q];
                    y[r][2 * q].x += __uint_as_float(t.x << 16); y[r][2 * q].y += __uint_as_float(t.x & 0xffff0000u); y[r][2 * q].z += __uint_as_float(t.y << 16); y[r][2 * q].w += __uint_as_float(t.y & 0xffff0000u);
                    y[r][2 * q + 1].x += __uint_as_float(t.z << 16); y[r][2 * q + 1].y += __uint_as_float(t.z & 0xffff0000u); y[r][2 * q + 1].z += __uint_as_float(t.w << 16); y[r][2 * q + 1].w += __uint_as_float(t.w & 0xffff0000u); }
        }
#pragma unroll
        for (int r = 0; r < R; ++r) { const int m = m0 + r, b = m >> 13;
            f32x4 v[4]; float s = 0.f;
#pragma unroll
            for (int j = 0; j < 4; ++j) { const int col = (j >> 1) * 512 + 8 * lane + 4 * (j & 1); const f32x4 g2 = *(const f32x4*)(F.ADA + b * 6144 + 5120 + col);
                v[j] = *(const f32x4*)(F.X1 + (size_t)m * D + col) * ALPHA + (g2 + 1.0f) * y[r][j]; s += (v[j].x + v[j].y) + (v[j].z + v[j].w); }
            const float mean = wave_sum(s) * (1.f / D); float s2 = 0.f;
#pragma unroll
            for (int j = 0; j < 4; ++j) { v[j] = v[j] - mean; s2 += (v[j].x * v[j].x + v[j].y * v[j].y) + (v[j].z * v[j].z + v[j].w * v[j].w); }
            const float rstd = 1.f / sqrtf(wave_sum(s2) * (1.f / D) + LN_EPS);
#pragma unroll
            for (int j = 0; j < 4; ++j) { const int col = (j >> 1) * 512 + 8 * lane + 4 * (j & 1); *(f32x4*)(F.out + (size_t)m * D + col) = v[j] * rstd * *(const f32x4*)(F.ln2_g + col) + *(const f32x4*)(F.ln2_b + col); } }
    }
}

namespace pg8 {
typedef short bf16x8 __attribute__((ext_vector_type(8)));
constexpr int BM = 256, BK = 64, HALF = 128, HTB = HALF * BK * 2, STAGE_BYTES = 8 * HTB, NXCD = 8, WGM = 8;
constexpr int RTAB_OFF = 131072 + 4096;
constexpr int XTAB_OFF = RTAB_OFF + 2048;
__host__ __device__ __forceinline__ int lds_byte(int r, int c) { const int st = (r >> 4) * 2 + (c >> 5), rr = r & 15, cc = c & 31, ob = rr * 64 + cc * 2; return st * 1024 + (ob ^ (((ob >> 9) & 1) << 5)); }
__host__ __device__ __forceinline__ void stage_rc(int b, int& R, int& C) { const int st = b / 1024, sb = b % 1024, swz = sb ^ (((sb >> 9) & 1) << 5); R = (st >> 1) * 16 + swz / 64; C = (st & 1) * 32 + (swz % 64) / 2; }
__host__ __device__ __forceinline__ int perm32(int rho) { const int n = rho >> 4, i = rho & 15; return 8 * (i >> 2) + 4 * n + (i & 3); }

struct Unit { const char* A; const char* B; const char* B2; int pm, pn, e, p0, ne, bs, hf; };

struct TileOrder {
    int nM, nN, nwg, G, c;
    __device__ void init(int nM_, int nN_, int G_, int c_) { nM = nM_; nN = nN_; nwg = nM * nN; G = G_; c = c_; }
    __device__ bool tile(int i, int& pm, int& pn) const {
        const long L = (long)i * G + c; if (L >= nwg) return false;
        int wgid = (int)L; { const int q = nwg / NXCD, r = nwg % NXCD, xcd = wgid % NXCD, off = wgid / NXCD; wgid = (xcd < r ? xcd * (q + 1) : r * (q + 1) + (xcd - r) * q) + off; }
        const int nig = WGM * nN, gid = wgid / nig, fm = gid * WGM, gsz = (nM - fm) < WGM ? (nM - fm) : WGM;
        pm = fm + ((wgid % nig) % gsz); pn = (wgid % nig) / gsz; return true;
    }
};

__device__ __forceinline__ unsigned cvt_pk_bf16(float lo, float hi) { unsigned r; asm volatile("v_cvt_pk_bf16_f32 %0, %1, %2" : "=v"(r) : "v"(lo), "v"(hi)); return r; }
__device__ __forceinline__ float fsigmoid(float x) { return __builtin_amdgcn_rcpf(1.0f + __builtin_amdgcn_exp2f(-LOG2E * x)); }

template <class Epi, class Sched, bool ALIGN_EPI>
__device__ __forceinline__ void gemm_phase(LAS unsigned char* lds, const int K, const int lda, const int ldb, const Sched& S, const Epi& E) {
    const int wid = __builtin_amdgcn_readfirstlane((int)threadIdx.x >> 6), lane = ltid(), tid = wid * 64 + lane, wr = wid >> 2, wc = wid & 3, fr = lane & 15, fq = lane >> 4;
    int nt = K / BK; asm volatile("" : "+s"(nt));
    int RA[2]; unsigned CA[2], voffB[2];
#pragma unroll
    for (int i = 0; i < 2; ++i) { int R, C; stage_rc(tid * 16 + i * 8192, R, C); const int Rb = (R & ~31) + perm32(R & 31);
        RA[i] = R; CA[i] = (unsigned)C * 2u; voffB[i] = (unsigned)(Rb * ldb + C) * 2u; }
    const size_t kstep = (size_t)(BK * 2);
    const size_t hstepB = (size_t)HALF * ldb * 2;
    const unsigned ldsw = (unsigned)wid * 1024u;
    const int aoff = lds_byte(wr * 64 + fr, fq * 8), boff = lds_byte(wc * 32 + fr, fq * 8);
#define PG8_SA(b, h) (((b) * 2 + (h)) * HTB)
#define PG8_SB(b, h) ((4 + (b) * 2 + (h)) * HTB)
#define PG8_STAGE(bufoff, gbase, voff) do { _Pragma("unroll") for (int _i = 0; _i < 2; ++_i) \
        __builtin_amdgcn_global_load_lds((const unsigned*)((const char*)(gbase) + (voff)[_i]), (LAS unsigned*)(lds + (bufoff) + ldsw + _i * 8192), 16, 0, 0); } while (0)
#define PG8_STAGE_NT(bufoff, gbase, voff) do { _Pragma("unroll") for (int _i = 0; _i < 2; ++_i) \
        __builtin_amdgcn_global_load_lds((const unsigned*)((const char*)(gbase) + (voff)[_i]), (LAS unsigned*)(lds + (bufoff) + ldsw + _i * 8192), 16, 0, 2); } while (0)
#define PG8_LDA(dst, b, h) do { _Pragma("unroll") for (int m = 0; m < 4; ++m) _Pragma("unroll") for (int k = 0; k < 2; ++k) dst[m][k] = *(const LAS bf16x8*)(lds + PG8_SA(b, h) + aoff + m * 2048 + k * 1024); } while (0)
#define PG8_LDB(dst, b, h) do { _Pragma("unroll") for (int n = 0; n < 2; ++n) _Pragma("unroll") for (int k = 0; k < 2; ++k) dst[n][k] = *(const LAS bf16x8*)(lds + PG8_SB(b, h) + boff + n * 2048 + k * 1024); } while (0)
#define PG8_MMA(ai, bj, At, Bt) do { __builtin_amdgcn_s_setprio(1); _Pragma("unroll") for (int m = 0; m < 4; ++m) _Pragma("unroll") for (int n = 0; n < 2; ++n) _Pragma("unroll") for (int k = 0; k < 2; ++k) \
        acc[ai][bj][m][n] = __builtin_amdgcn_mfma_f32_16x16x32_bf16(Bt[n][k], At[m][k], acc[ai][bj][m][n], 0, 0, 0); __builtin_amdgcn_s_setprio(0); } while (0)
#define PG8_WAIT_V(n) asm volatile("s_waitcnt vmcnt(" #n ")" ::: "memory")
#define PG8_WAIT_L(n) asm volatile("s_waitcnt lgkmcnt(" #n ")" ::: "memory")
#define PG8_BAR __builtin_amdgcn_s_barrier()
#define PG8_SCHED __builtin_amdgcn_sched_barrier(0)
    Unit cur, nxt; int ui = 0;
    if constexpr (Sched::DYN) { S.fetch(0); S.fetch(1); PG8_WAIT_L(0); PG8_BAR; asm volatile("" ::: "memory"); }
    if (!S.next(0, cur)) return;
    f32x4 acc[2][2][4][2];
#pragma unroll
    for (int a = 0; a < 2; ++a)
#pragma unroll
        for (int b = 0; b < 2; ++b)
#pragma unroll
            for (int m = 0; m < 4; ++m)
#pragma unroll
                for (int n = 0; n < 2; ++n) acc[a][b][m][n] = (f32x4){0.f, 0.f, 0.f, 0.f};
    bf16x8 At[4][2], B0[2][2], B1[2][2];
    const char* cA = cur.A; const char* cB = cur.B;
    LAS unsigned* rtab = (LAS unsigned*)(lds + RTAB_OFF);
    int tb = 0;
#define PG8_STAGE_A(bufoff, gbase, h) do { unsigned _v[2]; _Pragma("unroll") for (int _j = 0; _j < 2; ++_j) \
        _v[_j] = (Sched::GATHER ? rtab[tb * 256 + (h) * HALF + RA[_j]] : S.a_row_off(cur, (h) * HALF + RA[_j])) + CA[_j]; \
        if constexpr (false) PG8_STAGE_NT(bufoff, gbase, _v); else PG8_STAGE(bufoff, gbase, _v); } while (0)
    LAS unsigned* xtab = (LAS unsigned*)(lds + XTAB_OFF); int tbx = 0;
    if constexpr (Sched::GATHER) { if (tid < 256) { rtab[tid] = S.a_row_off(cur, tid); if constexpr (Sched::AUX) { unsigned x0, x1; S.row_aux(cur, tid, x0, x1); xtab[2 * tid] = x0; xtab[2 * tid + 1] = x1; } } PG8_WAIT_L(0); PG8_BAR; }
    [[maybe_unused]] f32x4 breg[8];
    [[maybe_unused]] const int hB = wid >> 2, kcB = (lane & 3) + 4 * (wid & 1), n4B = (lane >> 2) + 16 * ((wid >> 1) & 1);
    [[maybe_unused]] unsigned rowb = 0, bvoff = 0, bdst = 0;
    [[maybe_unused]] const char* cBh = nullptr;
    if constexpr (Sched::BREG) { rowb = S.b_row_bytes(); bvoff = (unsigned)(kcB * 8) * rowb + (unsigned)n4B * 16u;
        const int rho0 = 32 * (n4B >> 3) + 16 * (n4B & 1) + 4 * ((n4B & 7) >> 1);
        bdst = (unsigned)(4 * HTB + hB * HTB + lds_byte(rho0, 8 * kcB)); cBh = hB ? cur.B2 : cur.B; }
#define PG8_BLOAD(gB) do { const char* _g = (gB); _Pragma("unroll") for (int _j = 0; _j < 8; ++_j) \
        asm volatile("global_load_dwordx4 %0, %1, %2" : "=v"(breg[_j]) : "v"(bvoff), "s"(_g + (size_t)_j * rowb) : "memory"); } while (0)
#define PG8_BCVT(b) do { asm volatile("s_waitcnt vmcnt(2)" : "+v"(breg[0]), "+v"(breg[1]), "+v"(breg[2]), "+v"(breg[3]), "+v"(breg[4]), "+v"(breg[5]), "+v"(breg[6]), "+v"(breg[7]) :: "memory"); \
        _Pragma("unroll") for (int _q = 0; _q < 4; ++_q) { u32x4 _w; _w.x = cvt_pk_bf16(breg[0][_q], breg[1][_q]); _w.y = cvt_pk_bf16(breg[2][_q], breg[3][_q]); \
            _w.z = cvt_pk_bf16(breg[4][_q], breg[5][_q]); _w.w = cvt_pk_bf16(breg[6][_q], breg[7][_q]); *(LAS u32x4*)(lds + bdst + (b) * 2 * HTB + 64 * _q) = _w; } } while (0)
    if constexpr (Sched::BREG) {
        PG8_STAGE_A(PG8_SA(0, 0), cA, 0); PG8_BLOAD(cBh); PG8_STAGE_A(PG8_SA(0, 1), cA, 1);
        if (wr == 1) PG8_BAR;
        PG8_BCVT(0); PG8_WAIT_L(0); PG8_BAR;
        PG8_STAGE_A(PG8_SA(1, 0), cA + kstep, 0); PG8_BLOAD(cBh + (size_t)BK * rowb);
        PG8_BAR;
    } else {
    PG8_STAGE(PG8_SB(0, 0), cB, voffB); PG8_STAGE(PG8_SB(0, 1), cB + hstepB, voffB); PG8_STAGE_A(PG8_SA(0, 0), cA, 0); PG8_STAGE_A(PG8_SA(0, 1), cA, 1);
    if (wr == 1) PG8_BAR;
    PG8_WAIT_V(2); PG8_BAR;
    PG8_STAGE(PG8_SB(1, 0), cB + kstep, voffB); PG8_STAGE_A(PG8_SA(1, 0), cA + kstep, 0); PG8_STAGE(PG8_SB(1, 1), cB + hstepB + kstep, voffB);
    PG8_WAIT_V(6); PG8_BAR;
    }
    for (;;) {
        if constexpr (Sched::DYN) S.fetch(ui + 2);
        const bool has_next = S.next(ui + 1, nxt);
        const bool hf = cur.hf != 0;
        const char* nA = has_next ? nxt.A : cA; const char* nB = has_next ? nxt.B : cB;
        if constexpr (Sched::GATHER) { if (has_next && tid < 256) { rtab[((ui + 1) & 1) * 256 + tid] = S.a_row_off(nxt, tid);
            if constexpr (Sched::AUX) { unsigned x0, x1; S.row_aux(nxt, tid, x0, x1); const int nb3 = tbx == 2 ? 0 : tbx + 1; xtab[nb3 * 512 + 2 * tid] = x0; xtab[nb3 * 512 + 2 * tid + 1] = x1; } } }
        for (int t = 0; t < nt; t += 2) {
            const bool last = (t == nt - 2);
            const char* a1 = cA + (size_t)(t + 1) * kstep;
            const char* a2 = last ? nA : cA + (size_t)(t + 2) * kstep; const char* b2 = last ? nB : cB + (size_t)(t + 2) * kstep;
            const char* a3 = a2 + kstep; const char* b3 = b2 + kstep;
            if constexpr (Sched::BREG) {
            const char* nBh = has_next ? (hB ? nxt.B2 : nxt.B) : cBh;
            const char* bp2 = last ? nBh : cBh + (size_t)(t + 2) * BK * rowb; const char* bp3 = bp2 + (size_t)BK * rowb;
            PG8_LDB(B0, 0, 0); PG8_LDB(B1, 0, 1); PG8_SCHED; PG8_LDA(At, 0, 0); PG8_STAGE_A(PG8_SA(1, 1), a1, 1);
            if (last && has_next) tb ^= 1;
            PG8_WAIT_V(12); PG8_WAIT_L(0); PG8_BAR; PG8_MMA(0, 0, At, B0); PG8_MMA(0, 1, At, B1); PG8_BAR; PG8_SCHED;
            if (!hf) PG8_LDA(At, 0, 1); PG8_BCVT(1); PG8_STAGE_A(PG8_SA(0, 0), a2, 0); PG8_BLOAD(bp2);
            PG8_WAIT_L(0); PG8_BAR; if (!hf) { PG8_MMA(1, 0, At, B0); PG8_MMA(1, 1, At, B1); } PG8_BAR; PG8_SCHED;
            PG8_LDB(B0, 1, 0); PG8_LDB(B1, 1, 1); PG8_SCHED; PG8_LDA(At, 1, 0); PG8_STAGE_A(PG8_SA(0, 1), a2, 1);
            PG8_WAIT_V(12); PG8_WAIT_L(0); PG8_BAR; PG8_MMA(0, 0, At, B0); PG8_MMA(0, 1, At, B1); PG8_BAR; PG8_SCHED;
            if (!hf) PG8_LDA(At, 1, 1); PG8_BCVT(0); PG8_STAGE_A(PG8_SA(1, 0), a3, 0); PG8_BLOAD(bp3);
            PG8_WAIT_L(0); PG8_BAR; if (!hf) { PG8_MMA(1, 0, At, B0); PG8_MMA(1, 1, At, B1); } PG8_BAR; PG8_SCHED;
            } else {
            PG8_LDB(B0, 0, 0); PG8_LDB(B1, 0, 1); PG8_SCHED; PG8_LDA(At, 0, 0); PG8_STAGE_A(PG8_SA(1, 1), a1, 1);
            if (last && has_next) tb ^= 1;
            PG8_WAIT_V(8); PG8_WAIT_L(0); PG8_BAR; PG8_MMA(0, 0, At, B0); PG8_MMA(0, 1, At, B1); PG8_BAR; PG8_SCHED;
            if (!hf) PG8_LDA(At, 0, 1); PG8_STAGE(PG8_SB(0, 0), b2, voffB); PG8_STAGE(PG8_SB(0, 1), b2 + hstepB, voffB); PG8_STAGE_A(PG8_SA(0, 0), a2, 0);
            PG8_WAIT_V(8); PG8_WAIT_L(0); PG8_BAR; if (!hf) { PG8_MMA(1, 0, At, B0); PG8_MMA(1, 1, At, B1); } PG8_BAR; PG8_SCHED;
            PG8_LDB(B0, 1, 0); PG8_LDB(B1, 1, 1); PG8_SCHED; PG8_LDA(At, 1, 0); PG8_STAGE_A(PG8_SA(0, 1), a2, 1);
            PG8_WAIT_V(8); PG8_WAIT_L(0); PG8_BAR; PG8_MMA(0, 0, At, B0); PG8_MMA(0, 1, At, B1); PG8_BAR; PG8_SCHED;
            if (!hf) PG8_LDA(At, 1, 1); PG8_STAGE(PG8_SB(1, 0), b3, voffB); PG8_STAGE(PG8_SB(1, 1), b3 + hstepB, voffB); PG8_STAGE_A(PG8_SA(1, 0), a3, 0);
            PG8_WAIT_V(8); PG8_WAIT_L(0); PG8_BAR; if (!hf) { PG8_MMA(1, 0, At, B0); PG8_MMA(1, 1, At, B1); } PG8_BAR; PG8_SCHED;
            }
        }
        if constexpr (ALIGN_EPI) { if (wr == 0) PG8_BAR; }
        E(acc, cur, wr, wc, fr, fq, xtab + tbx * 512);
        if (!has_next) break;
#pragma unroll
        for (int a = 0; a < 2; ++a)
#pragma unroll
            for (int b = 0; b < 2; ++b)
#pragma unroll
                for (int m = 0; m < 4; ++m)
#pragma unroll
                    for (int n = 0; n < 2; ++n) acc[a][b][m][n] = (f32x4){0.f, 0.f, 0.f, 0.f};
        cur = nxt; cA = nA; cB = nB; ++ui; tbx = tbx == 2 ? 0 : tbx + 1;
        if constexpr (Sched::BREG) cBh = hB ? cur.B2 : cur.B;
        if constexpr (ALIGN_EPI) { if (wr == 1) PG8_BAR; }
    }
    PG8_WAIT_V(0);
    if constexpr (!ALIGN_EPI) { if (wr == 0) PG8_BAR; }
    PG8_BAR;
#undef PG8_SA
#undef PG8_SB
#undef PG8_STAGE
#undef PG8_STAGE_NT
#undef PG8_STAGE_A
#undef PG8_BLOAD
#undef PG8_BCVT
#undef PG8_LDA
#undef PG8_LDB
#undef PG8_MMA
#undef PG8_WAIT_V
#undef PG8_WAIT_L
#undef PG8_BAR
#undef PG8_SCHED
}
}

constexpr size_t WS_WIN_T = 4 * MiB, WS_WC_T = 13 * MiB, WS_WF_T = 14 * MiB, WS_WMIX_T = 15 * MiB, WS_WR_HI = 17 * MiB, WS_WR_LO = 17 * MiB + 512 * 1024, WS_WSHGU_T = 18 * MiB, WS_WSHD_T = 19 * MiB;
constexpr size_t WS_WEGU_T = 640 * MiB, WS_WED_T = 896 * MiB;
constexpr int NINW = 4608;

__device__ __forceinline__ void tr_block(const float* src, int ldw, bf16_t* dst, bf16_t* dst2, int ldt, LAS float* scr, int lane) {
#pragma unroll 8
    for (int i = 0; i < 32; ++i) { const int kk = 2 * i + (lane >> 5); scr[kk * 33 + (lane & 31)] = src[(size_t)kk * ldw + (lane & 31)]; }
    asm volatile("s_waitcnt lgkmcnt(0)" ::: "memory");
    const int c = lane & 7;
#pragma unroll
    for (int j = 0; j < 4; ++j) { const int n = (lane >> 3) + 8 * j; const LAS float* s = scr + (8 * c) * 33 + n;
        float v[8];
#pragma unroll
        for (int q = 0; q < 8; ++q) v[q] = s[q * 33];
        u32x4 o; o.x = pk2(v[0], v[1]); o.y = pk2(v[2], v[3]); o.z = pk2(v[4], v[5]); o.w = pk2(v[6], v[7]);
        *(u32x4*)(dst + (size_t)n * ldt + 8 * c) = o;
        if (dst2) { u32x4 l;
            l.x = pk2(v[0] - __uint_as_float(o.x << 16), v[1] - __uint_as_float(o.x & 0xffff0000u)); l.y = pk2(v[2] - __uint_as_float(o.y << 16), v[3] - __uint_as_float(o.y & 0xffff0000u));
            l.z = pk2(v[4] - __uint_as_float(o.z << 16), v[5] - __uint_as_float(o.z & 0xffff0000u)); l.w = pk2(v[6] - __uint_as_float(o.w << 16), v[7] - __uint_as_float(o.w & 0xffff0000u));
            *(u32x4*)(dst2 + (size_t)n * ldt + 8 * c) = l; } }
    asm volatile("s_waitcnt lgkmcnt(0)" ::: "memory");
}
__device__ __forceinline__ int inproj_src_col(int d) { const int pn = d >> 3, c0 = (d & 7) * 32;
    if (pn < 4) return c0 < 128 ? 128 * pn + c0 : 512 + 128 * pn + (c0 - 128);
    if (pn < 6) return O_Q + (pn - 4) * 256 + c0; if (pn < 8) return O_K + (pn - 6) * 256 + c0; if (pn < 10) return O_V + (pn - 8) * 256 + c0;
    if (pn < 14) return O_GA + (pn - 10) * 256 + c0; return O_GB + (pn - 14) * 256 + c0; }
constexpr int CV_I0 = 144 * 16, CV_I1 = 32 * 8, CV_I2 = 32 * 8, CV_I3 = 32 * 16, CV_I4 = 8 * 16, CV_I5 = 16 * 16, CV_I6 = 32 * 4, CV_ALL = CV_I0 + CV_I1 + CV_I2 + CV_I3 + CV_I4 + CV_I5 + CV_I6;
__device__ __forceinline__ void convert_item(Frame& F, int r, LAS float* scr, int lane) {
    unsigned char* ws = F.ws;
    if (r < CV_I0) { const int d = r % 144, kb = r / 144; tr_block(F.w_in + (size_t)kb * 64 * INC + inproj_src_col(d), INC, (bf16_t*)(ws + WS_WIN_T) + (size_t)d * 32 * D + kb * 64, nullptr, D, scr, lane); return; } r -= CV_I0;
    if (r < CV_I1) { const int d = r % 32, kb = r / 32; tr_block(F.w_conv_out + (size_t)kb * 64 * D + d * 32, D, (bf16_t*)(ws + WS_WC_T) + (size_t)d * 32 * CC + kb * 64, nullptr, CC, scr, lane); return; } r -= CV_I1;
    if (r < CV_I2) { const int d = r % 32, kb = r / 32; tr_block(F.w_fox_out + (size_t)kb * 64 * D + d * 32, D, (bf16_t*)(ws + WS_WF_T) + (size_t)d * 32 * FW + kb * 64, nullptr, FW, scr, lane); return; } r -= CV_I2;
    if (r < CV_I3) { const int d = r % 32, kb = r / 32; tr_block(F.w_mix_out + (size_t)kb * 64 * D + d * 32, D, (bf16_t*)(ws + WS_WMIX_T) + (size_t)d * 32 * D + kb * 64, nullptr, D, scr, lane); return; } r -= CV_I3;
    if (r < CV_I4) { const int d = r % 8, kb = r / 8; tr_block(F.w_router + (size_t)kb * 64 * NE + d * 32, NE, (bf16_t*)(ws + WS_WR_HI) + (size_t)d * 32 * D + kb * 64, (bf16_t*)(ws + WS_WR_LO) + (size_t)d * 32 * D + kb * 64, D, scr, lane); return; } r -= CV_I4;
    if (r < CV_I5) { const int d = r % 16, kb = r / 16, ct = d >> 3, c0 = (d & 7) * 32; const float* w = c0 < 128 ? F.w_sh_gate + 128 * ct + c0 : F.w_sh_up + 128 * ct + c0 - 128;
        tr_block(w + (size_t)kb * 64 * SHH, SHH, (bf16_t*)(ws + WS_WSHGU_T) + (size_t)d * 32 * D + kb * 64, nullptr, D, scr, lane); return; } r -= CV_I5;
    { const int d = r % 32, kb = r / 32; tr_block(F.w_sh_down + (size_t)kb * 64 * D + d * 32, D, (bf16_t*)(ws + WS_WSHD_T) + (size_t)d * 32 * SHH + kb * 64, nullptr, SHH, scr, lane); }
}
__device__ __forceinline__ void ph_convert(Frame& F) {
    F.lane = ltid(); F.tid = F.wave * 64 + F.lane;
    LAS float* scr = (LAS float*)(F.lds + F.wave * 16384);
    for (int it = F.gw; it < CV_I0; it += F.NGW) convert_item(F, it, scr, F.lane);
}
__device__ __forceinline__ void ph_convert_filler(Frame& F, unsigned* qhead, volatile LAS unsigned* bc) {
    F.lane = ltid(); F.tid = F.wave * 64 + F.lane;
    LAS float* scr = (LAS float*)(F.lds + F.wave * 16384);
    for (;;) {
        if (F.tid == 0) bc[0] = __hip_atomic_fetch_add(qhead, 1u, __ATOMIC_RELAXED, __HIP_MEMORY_SCOPE_AGENT);
        __syncthreads(); const int it = CV_I0 + (int)bc[0] * NWAVES + F.wave; __syncthreads();
        if (it - F.wave >= CV_ALL) break;
        if (it < CV_ALL) convert_item(F, it, scr, F.lane);
    }
}

struct SchedPlain {
    static constexpr bool GATHER = false, BREG = false, AUX = false, DYN = false;
    __device__ __forceinline__ unsigned b_row_bytes() const { return 0u; }
    pg8::TileOrder o; const char* A; const char* B; unsigned arow, brow;
    __device__ __forceinline__ bool next(int i, pg8::Unit& u) const { int pm, pn; if (!o.tile(i, pm, pn)) return false; u.pm = pm; u.pn = pn; u.e = 0; u.p0 = 0; u.ne = 0; u.bs = 0; u.hf = 0;
        u.A = A + (size_t)pm * 256 * arow; u.B = B + (size_t)pn * 256 * brow; u.B2 = nullptr; return true; }
    __device__ __forceinline__ unsigned a_row_off(const pg8::Unit&, int r) const { return (unsigned)r * arow; }
};
typedef f32x4 AccT[2][2][4][2];
#define EPI_ARGS const AccT& acc, const pg8::Unit& u, int wr, int wc, int fr, int fq, const LAS unsigned* xt
#define EPI_LAUNDER asm volatile("" : "+v"(fr), "+v"(fq))

struct EpiInProj {
    bf16_t *U, *Q, *GA; unsigned* NORM;
    __device__ __forceinline__ void operator()(EPI_ARGS) const {
        EPI_LAUNDER;
        const int row0 = u.pm * 256 + wr * 64 + fr, pn = u.pn, cin = wc * 32 + 8 * fq;
        if (pn < 4) {
#pragma unroll
            for (int ai = 0; ai < 2; ++ai)
#pragma unroll
                for (int m = 0; m < 4; ++m) { const f32x4 a0 = acc[ai][0][m][0], a1 = acc[ai][0][m][1], b0 = acc[ai][1][m][0], b1 = acc[ai][1][m][1]; u32x4 w;
                    w.x = pg8::cvt_pk_bf16(a0[0] * pg8::fsigmoid(b0[0]), a0[1] * pg8::fsigmoid(b0[1])); w.y = pg8::cvt_pk_bf16(a0[2] * pg8::fsigmoid(b0[2]), a0[3] * pg8::fsigmoid(b0[3]));
                    w.z = pg8::cvt_pk_bf16(a1[0] * pg8::fsigmoid(b1[0]), a1[1] * pg8::fsigmoid(b1[1])); w.w = pg8::cvt_pk_bf16(a1[2] * pg8::fsigmoid(b1[2]), a1[3] * pg8::fsigmoid(b1[3]));
                    *(u32x4*)(U + (size_t)(row0 + ai * 128 + m * 16) * CC + 128 * pn + cin) = w; }
        } else {
            const bool sg = pn >= 10; const int ld = sg ? D : FW, cb = sg ? ((pn - 10) & 3) * 256 : ((pn - 4) & 1) * 256;
            bf16_t* dst = sg ? GA + (size_t)((pn - 10) >> 2) * (16u << 20) : Q + (size_t)((pn - 4) >> 1) * (8u << 20);
            const float sc = pn < 6 ? QSCALE : 1.f; float nmx[2] = {0.f, 0.f};
#pragma unroll
            for (int ai = 0; ai < 2; ++ai)
#pragma unroll
                for (int m = 0; m < 4; ++m) { bf16_t* rowp = dst + (size_t)(row0 + ai * 128 + m * 16) * ld + cb + cin;
#pragma unroll
                    for (int bj = 0; bj < 2; ++bj) { f32x4 v0 = acc[ai][bj][m][0], v1 = acc[ai][bj][m][1];
                        if (sg) {
#pragma unroll
                            for (int j = 0; j < 4; ++j) { v0[j] = pg8::fsigmoid(v0[j]); v1[j] = pg8::fsigmoid(v1[j]); } }
                        else { v0 = v0 * sc; v1 = v1 * sc; }
                        if (pn < 8) { float ss = (v0[0] * v0[0] + v0[1] * v0[1]) + (v0[2] * v0[2] + v0[3] * v0[3]) + (v1[0] * v1[0] + v1[1] * v1[1]) + (v1[2] * v1[2] + v1[3] * v1[3]);
                            ss += __shfl_xor(ss, 16); ss += __shfl_xor(ss, 32); nmx[bj] = fmaxf(nmx[bj], ss); }
                        u32x4 w; w.x = pg8::cvt_pk_bf16(v0[0], v0[1]); w.y = pg8::cvt_pk_bf16(v0[2], v0[3]); w.z = pg8::cvt_pk_bf16(v1[0], v1[1]); w.w = pg8::cvt_pk_bf16(v1[2], v1[3]);
                        *(u32x4*)(rowp + bj * 128) = w; } }
            if (pn < 8) {
#pragma unroll
                for (int bj = 0; bj < 2; ++bj) { float v = nmx[bj];
#pragma unroll
                    for (int o = 1; o < 16; o <<= 1) v = fmaxf(v, __shfl_xor(v, o));
                    if ((fr | fq) == 0) { const int bh = ((u.pm * 256) >> 13) * NH + (pn & 1) * 4 + 2 * bj + (wc >> 1);
                        atomicMax(NORM + ((pn >= 6 ? 1 : 0) * 16 + bh) * 2 + (wc & 1), __float_as_uint(v)); } }
            }
        }
    }
};
__device__ __forceinline__ f32x4 bf4lo(u32x4 w) { return (f32x4){__uint_as_float(w.x << 16), __uint_as_float(w.x & 0xffff0000u), __uint_as_float(w.y << 16), __uint_as_float(w.y & 0xffff0000u)}; }
__device__ __forceinline__ f32x4 bf4hi(u32x4 w) { return (f32x4){__uint_as_float(w.z << 16), __uint_as_float(w.z & 0xffff0000u), __uint_as_float(w.w << 16), __uint_as_float(w.w & 0xffff0000u)}; }
__device__ __forceinline__ u32x4 pack8(f32x4 v0, f32x4 v1) { u32x4 w; w.x = pg8::cvt_pk_bf16(v0[0], v0[1]); w.y = pg8::cvt_pk_bf16(v0[2], v0[3]); w.z = pg8::cvt_pk_bf16(v1[0], v1[1]); w.w = pg8::cvt_pk_bf16(v1[2], v1[3]); return w; }

struct SchedMerge {
    static constexpr bool GATHER = false, BREG = false, AUX = false, DYN = false;
    __device__ __forceinline__ unsigned b_row_bytes() const { return 0u; }
    pg8::TileOrder o; const char *AC, *O, *WC, *WF;
    __device__ __forceinline__ bool next(int i, pg8::Unit& u) const { int pm, pn; if (!o.tile(i >> 1, pm, pn)) return false; u.pm = pm; u.pn = pn; u.e = i & 1; u.p0 = 0; u.ne = 0; u.bs = 0; u.hf = 0;
        u.A = ((i & 1) ? O : AC) + (size_t)pm * 256 * 1024; u.B = ((i & 1) ? WF : WC) + (size_t)pn * 256 * 1024; u.B2 = nullptr; return true; }
    __device__ __forceinline__ unsigned a_row_off(const pg8::Unit&, int r) const { return (unsigned)r * 1024u; }
};
struct EpiMerge {
    const bf16_t *GA, *GB; bf16_t *YA, *MG;
    __device__ __forceinline__ void operator()(EPI_ARGS) const {
        EPI_LAUNDER;
        const int row0 = u.pm * 256 + wr * 64 + fr, col0 = u.pn * 256 + wc * 32 + 8 * fq; const bool second = u.e != 0;
        const bf16_t* G = second ? GB : GA; bf16_t* dst = second ? MG : YA;
#pragma unroll
        for (int ai = 0; ai < 2; ++ai)
#pragma unroll
            for (int m = 0; m < 4; ++m) { const size_t off = (size_t)(row0 + ai * 128 + m * 16) * D + col0;
#pragma unroll
                for (int bj = 0; bj < 2; ++bj) { const u32x4 g = *(const u32x4*)(G + off + bj * 128);
                    f32x4 v0 = acc[ai][bj][m][0] * bf4lo(g), v1 = acc[ai][bj][m][1] * bf4hi(g);
                    if (second) { const u32x4 y = *(const u32x4*)(YA + off + bj * 128); v0 += bf4lo(y); v1 += bf4hi(y); }
                    *(u32x4*)(dst + off + bj * 128) = pack8(v0, v1); } }
    }
};
struct EpiMix {
    const float *x, *ADA; float* Z;
    __device__ __forceinline__ void operator()(EPI_ARGS) const {
        EPI_LAUNDER;
        const int row0 = u.pm * 256 + wr * 64 + fr, col0 = u.pn * 256 + wc * 32 + 8 * fq, b = (u.pm * 256) >> 13;
        f32x4 g[2][2];
#pragma unroll
        for (int bj = 0; bj < 2; ++bj)
#pragma unroll
            for (int n = 0; n < 2; ++n) g[bj][n] = *(const f32x4*)(ADA + b * 6144 + 2048 + col0 + bj * 128 + 4 * n) + 1.0f;
#pragma unroll
        for (int ai = 0; ai < 2; ++ai)
#pragma unroll
            for (int m = 0; m < 4; ++m) { const size_t off = (size_t)(row0 + ai * 128 + m * 16) * D + col0;
#pragma unroll
                for (int bj = 0; bj < 2; ++bj)
#pragma unroll
                    for (int n = 0; n < 2; ++n) { const f32x4 xv = *(const f32x4*)(x + off + bj * 128 + 4 * n); *(f32x4*)(Z + off + bj * 128 + 4 * n) = xv * ALPHA + g[bj][n] * acc[ai][bj][m][n]; } }
    }
};
struct SchedRS {
    static constexpr bool GATHER = false, BREG = false, AUX = false, DYN = false;
    __device__ __forceinline__ unsigned b_row_bytes() const { return 0u; }
    int G, c; const char *H2, *H2LO, *WRH, *WRL, *WSH;
    __device__ __forceinline__ bool next(int i, pg8::Unit& u) const { const int L = i * G + c; if (L >= 128 * 5) return false; const int pm = L / 5, j = L % 5; u.pm = pm; u.e = j; u.p0 = 0; u.ne = 0; u.bs = 0; u.B2 = nullptr; u.hf = 1;
        if (j < 3) { u.pn = 0; u.A = (j == 2 ? H2LO : H2) + (size_t)pm * 128 * 2048; u.B = (j == 1 ? WRL : WRH); }
        else { u.pn = j - 3; u.A = H2 + (size_t)pm * 128 * 2048; u.B = WSH + (size_t)(j - 3) * 256 * 2048; }
        return true; }
    __device__ __forceinline__ unsigned a_row_off(const pg8::Unit&, int r) const { return (unsigned)r * 2048u; }
};
struct EpiRS {
    float* RL; bf16_t* SHID;
    __device__ __forceinline__ void operator()(EPI_ARGS) const {
        EPI_LAUNDER;
        const int row0 = u.pm * 128 + wr * 64 + fr, cin = wc * 32 + 8 * fq;
        if (u.e < 3) { float* R = RL + (size_t)u.e * T * NE;
#pragma unroll
            for (int m = 0; m < 4; ++m) { float* rp = R + (size_t)(row0 + m * 16) * NE + cin;
#pragma unroll
                for (int bj = 0; bj < 2; ++bj)
#pragma unroll
                    for (int n = 0; n < 2; ++n) *(f32x4*)(rp + bj * 128 + 4 * n) = acc[0][bj][m][n]; }
        } else {
#pragma unroll
            for (int m = 0; m < 4; ++m) { const f32x4 g0 = acc[0][0][m][0], g1 = acc[0][0][m][1], u0 = acc[0][1][m][0], u1 = acc[0][1][m][1]; f32x4 h0, h1;
#pragma unroll
                for (int j = 0; j < 4; ++j) { h0[j] = g0[j] * pg8::fsigmoid(g0[j]) * u0[j]; h1[j] = g1[j] * pg8::fsigmoid(g1[j]) * u1[j]; }
                *(u32x4*)(SHID + (size_t)(row0 + m * 16) * SHH + 128 * u.pn + cin) = pack8(h0, h1); }
        }
    }
};
constexpr int INPROJ_STATIC_TILES = 12, INPROJ_FILLER_UNITS = (NINW / 256 - INPROJ_STATIC_TILES) * (T / 256);
__device__ __forceinline__ void ph_inproj_fast(Frame& F) {
    F.lane = ltid(); F.tid = F.wave * 64 + F.lane;
    SchedPlain S; S.o.init(T / 256, INPROJ_STATIC_TILES, gridDim.x, blockIdx.x); S.A = (const char*)F.H; S.B = (const char*)(F.ws + WS_WIN_T); S.arow = 2048; S.brow = 2048;
    EpiInProj E{F.U, F.Q, F.GA, F.ctl + CW_NORM};
    static_assert(WS_K - WS_Q == 16 * MiB && WS_V - WS_K == 16 * MiB && WS_GB - WS_GA == 32 * MiB, "EpiInProj destination arithmetic");
    pg8::gemm_phase<EpiInProj, SchedPlain, true>(F.lds, D, D, D, S, E);
}
struct EpiInProjOff { bf16_t *U, *Q, *GA; unsigned* NORM;
    __device__ __forceinline__ void operator()(EPI_ARGS) const { pg8::Unit v = u; v.pn = u.pn + INPROJ_STATIC_TILES; EpiInProj E{U, Q, GA, NORM}; E(acc, v, wr, wc, fr, fq, xt); } };
struct SchedInProjDyn {
    static constexpr bool GATHER = false, BREG = false, AUX = false, DYN = true;
    static constexpr int NT_ = NINW / 256 - INPROJ_STATIC_TILES, PER_X = 8 * NT_;
    __device__ __forceinline__ unsigned b_row_bytes() const { return 0u; }
    unsigned* qhead; volatile LAS unsigned* mb; const char* A; const char* B; int x;
    __device__ __forceinline__ void fetch(int k) const { if (threadIdx.x == 0) mb[k & 3] = __hip_atomic_fetch_add(qhead + 64 * x, 1u, __ATOMIC_RELAXED, __HIP_MEMORY_SCOPE_AGENT); }
    __device__ __forceinline__ bool next(int i, pg8::Unit& u) const { const unsigned idx = (unsigned)__builtin_amdgcn_readfirstlane((int)mb[i & 3]); if (idx >= (unsigned)PER_X) return false;
        const int pm = 8 * x + (int)(idx & 7), pn = (int)(idx >> 3);
        u.pm = pm; u.pn = pn; u.e = 0; u.p0 = 0; u.ne = 0; u.bs = 0; u.hf = 0; u.B2 = nullptr; u.A = A + (size_t)pm * 256 * 2048; u.B = B + (size_t)pn * 256 * 2048; return true; }
    __device__ __forceinline__ unsigned a_row_off(const pg8::Unit&, int r) const { return (unsigned)r * 2048u; }
};
__device__ __forceinline__ void ph_inproj_filler(Frame& F) {
    F.lane = ltid(); F.tid = F.wave * 64 + F.lane;
    SchedInProjDyn S{F.ctl + CW_FQ, (volatile LAS unsigned*)(F.lds + MISC_OFF + 96), (const char*)F.H, (const char*)(F.ws + WS_WIN_T) + (size_t)INPROJ_STATIC_TILES * 256 * 2048, (int)(blockIdx.x & 7)};
    EpiInProjOff E{F.U, F.Q, F.GA, F.ctl + CW_NORM};
    pg8::gemm_phase<EpiInProjOff, SchedInProjDyn, true>(F.lds, D, D, D, S, E);
}
__device__ __forceinline__ void ph_merge_fast(Frame& F) {
    F.lane = ltid(); F.tid = F.wave * 64 + F.lane;
    SchedMerge S; S.o.init(T / 256, D / 256, gridDim.x, blockIdx.x); S.AC = (const char*)F.AC; S.O = (const char*)F.O; S.WC = (const char*)(F.ws + WS_WC_T); S.WF = (const char*)(F.ws + WS_WF_T);
    EpiMerge E{F.GA, F.GB, F.YA, F.MG};
    pg8::gemm_phase<EpiMerge, SchedMerge, true>(F.lds, CC, CC, CC, S, E);
}
__device__ __forceinline__ void ph_mix_fast(Frame& F) {
    F.lane = ltid(); F.tid = F.wave * 64 + F.lane;
    SchedPlain S; S.o.init(T / 256, D / 256, gridDim.x, blockIdx.x); S.A = (const char*)F.MG; S.B = (const char*)(F.ws + WS_WMIX_T); S.arow = 2048; S.brow = 2048;
    EpiMix E{F.x, F.ADA, F.X1};
    pg8::gemm_phase<EpiMix, SchedPlain, true>(F.lds, D, D, D, S, E);
}
__device__ __forceinline__ void ph_router_fast(Frame& F) {
    F.lane = ltid(); F.tid = F.wave * 64 + F.lane;
    SchedRS S{(int)gridDim.x, (int)blockIdx.x, (const char*)F.H2, (const char*)F.H2LO, (const char*)(F.ws + WS_WR_HI), (const char*)(F.ws + WS_WR_LO), (const char*)(F.ws + WS_WSHGU_T)};
    EpiRS E{F.RL, F.SHID};
    pg8::gemm_phase<EpiRS, SchedRS, true>(F.lds, D, D, D, S, E);
}

constexpr int EMAP_OFF = 131072 + 1024;
template <int NCT> __device__ __forceinline__ bool expert_unit(int i, int G, int c, int nunits, const LAS int* pref, int& e, int& ct, int& ch) {
    const int gs = G >> 3, x = c / gs, s = c - x * gs, per = (nunits + 7) >> 3, q = i * gs + s; if (q >= per) return false;
    const int P = x * per + q; if (P >= nunits) return false;
    e = __builtin_amdgcn_readfirstlane(find_expert(pref, P / NCT));
    const int p0 = __builtin_amdgcn_readfirstlane(pref[e]), nch = __builtin_amdgcn_readfirstlane(pref[e + 1]) - p0, r = P - NCT * p0;
    ct = r / nch; ch = r - ct * nch; return true;
}
template <int VARIANT = 0> struct SchedMoe1T {
    static constexpr bool GATHER = true, BREG = true, AUX = false, DYN = false;
    int G, c, nunits; const LAS int* pref; const LAS int* base; const char* H2; const char* WG; const char* WU; const int* LIST;
    __device__ __forceinline__ unsigned b_row_bytes() const { return EH * 4u; }
    __device__ __forceinline__ bool next(int i, pg8::Unit& u) const { int e, ct, ch; if (!expert_unit<2>(i, G, c, nunits, pref, e, ct, ch)) return false;
        u.pm = 0; u.pn = ct; u.e = e; u.p0 = ch * 256; u.bs = __builtin_amdgcn_readfirstlane(base[e]); u.ne = __builtin_amdgcn_readfirstlane(base[e + 1]) - u.bs; u.hf = (u.ne - u.p0) <= 128;
        const int ew = VARIANT == 1 ? (e & 7) : e;
        u.A = H2; u.B = WG + ((size_t)ew * D * EH + 128 * ct) * 4; u.B2 = WU + ((size_t)ew * D * EH + 128 * ct) * 4; return true; }
    __device__ __forceinline__ unsigned a_row_off(const pg8::Unit& u, int r) const { int p = u.p0 + r; p = p < u.ne ? p : u.ne - 1;
        if (VARIANT == 2) return (unsigned)((u.bs + p) & (T - 1)) * 2048u;
        return (unsigned)(LIST[(size_t)u.e * LCAP + p] >> 3) * 2048u; }
};
typedef SchedMoe1T<0> SchedMoe1;
struct EpiMoe1 {
    bf16_t* HID;
    __device__ __forceinline__ void operator()(EPI_ARGS) const {
        EPI_LAUNDER;
        const int r0 = wr * 64 + fr, cin = wc * 32 + 8 * fq;
#pragma unroll
        for (int ai = 0; ai < 2; ++ai)
#pragma unroll
            for (int m = 0; m < 4; ++m) { const int p = u.p0 + r0 + ai * 128 + m * 16;
                const f32x4 g0 = acc[ai][0][m][0], g1 = acc[ai][0][m][1], u0 = acc[ai][1][m][0], u1 = acc[ai][1][m][1]; f32x4 h0, h1;
#pragma unroll
                for (int j = 0; j < 4; ++j) { h0[j] = g0[j] * pg8::fsigmoid(g0[j]) * u0[j]; h1[j] = g1[j] * pg8::fsigmoid(g1[j]) * u1[j]; }
                if (p < u.ne) *(u32x4*)(HID + (size_t)(u.bs + p) * EH + 128 * u.pn + cin) = pack8(h0, h1); }
    }
};
struct SchedMoe2 {
    static constexpr bool GATHER = true, BREG = true, AUX = true, DYN = false;
    int G, c, nunits; const LAS int* pref; const LAS int* base; const char* HID; const char* WD; const int* LIST; const float* LISTW;
    __device__ __forceinline__ void row_aux(const pg8::Unit& u, int r, unsigned& x0, unsigned& x1) const { const int p = u.p0 + r; x0 = ~0u; x1 = 0u;
        if (p < u.ne) { const int as = LIST[(size_t)u.e * LCAP + p]; x0 = (unsigned)((as >> 3) * NSLOT + (as & 7)); x1 = __float_as_uint(LISTW[(size_t)u.e * LCAP + p]); } }
    __device__ __forceinline__ unsigned b_row_bytes() const { return D * 4u; }
    __device__ __forceinline__ bool next(int i, pg8::Unit& u) const { int e, ct, ch; if (!expert_unit<4>(i, G, c, nunits, pref, e, ct, ch)) return false;
        u.pm = 0; u.pn = ct; u.e = e; u.p0 = ch * 256; u.bs = __builtin_amdgcn_readfirstlane(base[e]); u.ne = __builtin_amdgcn_readfirstlane(base[e + 1]) - u.bs; u.hf = (u.ne - u.p0) <= 128;
        u.A = HID + (size_t)(u.bs + u.p0) * 512; u.B = WD + ((size_t)e * EH * D + 256 * ct) * 4; u.B2 = u.B + 512; return true; }
    __device__ __forceinline__ unsigned a_row_off(const pg8::Unit& u, int r) const { const int lim = u.ne - 1 - u.p0; return (unsigned)(r < lim ? r : lim) * 512u; }
};
struct EpiMoe2 {
    bf16_t* YAS;
    __device__ __forceinline__ void operator()(EPI_ARGS) const {
        EPI_LAUNDER;
        const int r0 = wr * 64 + fr, col0 = u.pn * 256 + wc * 32 + 8 * fq;
#pragma unroll
        for (int ai = 0; ai < 2; ++ai)
#pragma unroll
            for (int m = 0; m < 4; ++m) { const int r = r0 + ai * 128 + m * 16; const u32x2 x = *(const LAS u32x2*)(xt + 2 * r);
                if (x.x != ~0u) { const float w = __uint_as_float(x.y); bf16_t* rowp = YAS + (size_t)x.x * D + col0;
#pragma unroll
                    for (int bj = 0; bj < 2; ++bj) *(u32x4*)(rowp + bj * 128) = pack8(acc[ai][bj][m][0] * w, acc[ai][bj][m][1] * w); }
                if (m & 1) asm volatile("" ::: "memory"); }
    }
};
struct EpiShDown {
    bf16_t* YAS;
    __device__ __forceinline__ void operator()(EPI_ARGS) const {
        EPI_LAUNDER;
        const int row0 = u.pm * 256 + wr * 64 + fr, col0 = u.pn * 256 + wc * 32 + 8 * fq;
#pragma unroll
        for (int ai = 0; ai < 2; ++ai)
#pragma unroll
            for (int m = 0; m < 4; ++m) { bf16_t* rowp = YAS + ((size_t)(row0 + ai * 128 + m * 16) * NSLOT + 8) * D + col0;
#pragma unroll
                for (int bj = 0; bj < 2; ++bj) *(u32x4*)(rowp + bj * 128) = pack8(acc[ai][bj][m][0], acc[ai][bj][m][1]); }
    }
};
template <int VARIANT> __device__ __forceinline__ void ph_moe1_experts(Frame& F, bf16_t* hid) {
    F.lane = ltid(); F.tid = F.wave * 64 + F.lane;
    LAS int* pref = (LAS int*)(F.lds + EMAP_OFF); LAS int* base = pref + 260;
    build_expert_map(F, pref, base, 256);
    SchedMoe1T<VARIANT> S{(int)gridDim.x, F.vid, __builtin_amdgcn_readfirstlane(pref[NE]) * 2, pref, base, (const char*)F.H2, (const char*)F.w_exp_gate, (const char*)F.w_exp_up, F.LIST};
    EpiMoe1 E{hid};
    pg8::gemm_phase<EpiMoe1, SchedMoe1T<VARIANT>, true>(F.lds, D, D, D, S, E);
}
__device__ __forceinline__ void ph_shdown(Frame& F) {
    F.lane = ltid(); F.tid = F.wave * 64 + F.lane;
    SchedPlain S; S.o.init(T / 256, D / 256, gridDim.x, blockIdx.x); S.A = (const char*)F.SHID; S.B = (const char*)(F.ws + WS_WSHD_T); S.arow = 512; S.brow = 512;
    EpiShDown E{F.YAS};
    pg8::gemm_phase<EpiShDown, SchedPlain, true>(F.lds, SHH, SHH, SHH, S, E);
}
__device__ __forceinline__ void ph_moe1_fast(Frame& F) { ph_moe1_experts<0>(F, F.HID); ph_shdown(F); }
__device__ __forceinline__ void ph_moe2_fast(Frame& F) {
    F.lane = ltid(); F.tid = F.wave * 64 + F.lane;
    LAS int* pref = (LAS int*)(F.lds + EMAP_OFF); LAS int* base = pref + 260;
    build_expert_map(F, pref, base, 256);
    SchedMoe2 S{(int)gridDim.x, F.vid, __builtin_amdgcn_readfirstlane(pref[NE]) * 4, pref, base, (const char*)F.HID, (const char*)F.w_exp_down, F.LIST, F.LISTW};
    EpiMoe2 E{F.YAS};
    pg8::gemm_phase<EpiMoe2, SchedMoe2, true>(F.lds, EH, EH, EH, S, E);
}

namespace attn_body {
using bf16=__hip_bfloat16;
using bf16x8=__attribute__((ext_vector_type(8)))short;
using s16x4=__attribute__((ext_vector_type(4)))short;
using f32x16=__attribute__((ext_vector_type(16)))float;
using u32x4=__attribute__((ext_vector_type(4)))unsigned;
using f32x4_t=__attribute__((ext_vector_type(4)))float;
constexpr int BATCH=2,NHEAD=8,SEQ=8192,D=64,DM=NHEAD*D;
constexpr int NW=8,QBLK=32,QB=QBLK*NW,KVBLK=64,NQB=SEQ/QB;
constexpr int ATTN_PITCH=DM, ATTN_UNIT_ROWS=QB;
__device__ __forceinline__ int crow(int r,int hi){return (r&3)+8*(r>>2)+4*hi;}
#define SBAR() __builtin_amdgcn_sched_barrier(0)
__device__ __forceinline__ void cmask(f32x16&p0,f32x16&p1,int jb,int qrel,int hi){
  const float NEG=-INFINITY; int kb=64*jb+4*hi;
  #pragma unroll
  for(int r=0;r<16;++r){int kv=kb+(r&3)+8*(r>>2); if(kv>qrel)p0[r]=NEG; if(kv+32>qrel)p1[r]=NEG;}
}

constexpr int NSLOT=3, SLOTB=8192;
constexpr int LDS_K=0, LDS_V=NSLOT*SLOTB, LDS_WS=2*NSLOT*SLOTB, LDS_OST=LDS_WS+NW*64*4, LDS_NB=LDS_OST+NW*4096, LDS_BYTES=LDS_NB+SEQ*4;
constexpr float C2=0.125f*1.4426950408889634f;
__device__ __forceinline__ void glds16(const void*gsrc,unsigned lds_dst){unsigned keep;
  asm volatile("s_mov_b32 %0, m0\n\ts_mov_b32 m0, %2\n\ts_nop 0\n\tglobal_load_lds_dwordx4 %1, off\n\ts_mov_b32 m0, %0":"=&s"(keep):"v"(gsrc),"s"(lds_dst):"memory");}
__device__ __forceinline__ float max3f(float a,float b,float c){float r;asm("v_max3_f32 %0, %1, %2, %3":"=v"(r):"v"(a),"v"(b),"v"(c));return r;}
__device__ __forceinline__ float max2f(float a,float b){float r;asm("v_max_f32_e32 %0, %1, %2":"=v"(r):"v"(a),"v"(b));return r;}
__device__ __forceinline__ float fadd_s(float a,float b){float r;asm("v_add_f32_e32 %0, %1, %2":"=v"(r):"v"(a),"v"(b));return r;}
__device__ __forceinline__ float fsub_s(float a,float b){float r;asm("v_sub_f32_e32 %0, %1, %2":"=v"(r):"v"(a),"v"(b));return r;}
typedef float f32x2_t __attribute__((ext_vector_type(2))); typedef __bf16 bf16x2_t __attribute__((ext_vector_type(2)));
__device__ __forceinline__ unsigned cvtpk_s(float lo,float hi){f32x2_t v={lo,hi};bf16x2_t b=__builtin_convertvector(v,bf16x2_t);return __builtin_bit_cast(unsigned,b);}
#define WAIT_BAR(N) asm volatile("s_waitcnt vmcnt(" #N ") lgkmcnt(0)\n\ts_barrier":::"memory")

__device__ __forceinline__ void qkt(f32x16&p0,f32x16&p1,const char*Kslot,const bf16x8*qr,int r32,int hi){
  const char*kb=Kslot+hi*1024+r32*16;
  #pragma unroll
  for(int d0=0;d0<4;++d0){
    const bf16x8 b0=*reinterpret_cast<const bf16x8*>(kb+d0*2048);
    const bf16x8 b1=*reinterpret_cast<const bf16x8*>(kb+d0*2048+512);
    {p0=__builtin_amdgcn_mfma_f32_32x32x16_bf16(b0,qr[d0],p0,0,0,0);p1=__builtin_amdgcn_mfma_f32_32x32x16_bf16(b1,qr[d0],p1,0,0,0);}}
}
typedef __attribute__((address_space(3))) const char* lds_cptr;
typedef short v4i16_t __attribute__((ext_vector_type(4)));
__device__ __forceinline__ void kload8(bf16x8*kf,lds_cptr kp){
  kf[0]=*(const __attribute__((address_space(3))) bf16x8*)(kp);      kf[1]=*(const __attribute__((address_space(3))) bf16x8*)(kp+512);
  kf[2]=*(const __attribute__((address_space(3))) bf16x8*)(kp+2048); kf[3]=*(const __attribute__((address_space(3))) bf16x8*)(kp+2560);
  kf[4]=*(const __attribute__((address_space(3))) bf16x8*)(kp+4096); kf[5]=*(const __attribute__((address_space(3))) bf16x8*)(kp+4608);
  kf[6]=*(const __attribute__((address_space(3))) bf16x8*)(kp+6144); kf[7]=*(const __attribute__((address_space(3))) bf16x8*)(kp+6656);
}
__device__ __forceinline__ void kload2(bf16x8*kf,lds_cptr kp,int j){ kf[2*j]=*(const __attribute__((address_space(3))) bf16x8*)(kp+j*2048); kf[2*j+1]=*(const __attribute__((address_space(3))) bf16x8*)(kp+j*2048+512); }
__device__ __forceinline__ s16x4 vtr(lds_cptr p){ return __builtin_bit_cast(s16x4,__builtin_amdgcn_ds_read_tr16_b64_v4i16((__attribute__((address_space(3))) v4i16_t*)p)); }
__device__ __forceinline__ float rowmax(const f32x16&p0,const f32x16&p1){
  float a=max3f(p0[0],p0[1],p1[0]),b=max3f(p0[2],p0[3],p1[1]);a=max3f(a,p1[2],p1[3]);
  #pragma unroll
  for(int r=4;r<16;r+=4){a=max3f(a,p0[r],p0[r+1]);b=max3f(b,p0[r+2],p0[r+3]);a=max3f(a,p1[r],p1[r+1]);b=max3f(b,p1[r+2],p1[r+3]);}
  const float m=max2f(a,b);
  auto rr=__builtin_amdgcn_permlane32_swap(__float_as_uint(m),__float_as_uint(m),false,false);
  return max2f(__uint_as_float(rr[0]),__uint_as_float(rr[1]));
}
__device__ __forceinline__ void pv(f32x16*o,int vb,bf16x8 pa0,bf16x8 pa1,bf16x8 pa2,bf16x8 pa3){
  #pragma unroll
  for(int d0=0;d0<2;++d0){s16x4 lo[4],hi[4];
    #pragma unroll
    for(int ks=0;ks<4;++ks){
      asm volatile("ds_read_b64_tr_b16 %0,%1 offset:%c2":"=&v"(lo[ks]):"v"(vb),"i"(d0*4096+ks*1024):"memory");
      asm volatile("ds_read_b64_tr_b16 %0,%1 offset:%c2":"=&v"(hi[ks]):"v"(vb),"i"(d0*4096+ks*1024+512):"memory");}
    asm volatile("s_waitcnt lgkmcnt(0)":::"memory");SBAR();
    #define PK(k) (bf16x8){lo[k][0],lo[k][1],lo[k][2],lo[k][3],hi[k][0],hi[k][1],hi[k][2],hi[k][3]}
    o[d0]=__builtin_amdgcn_mfma_f32_32x32x16_bf16(pa0,PK(0),o[d0],0,0,0);
    o[d0]=__builtin_amdgcn_mfma_f32_32x32x16_bf16(pa1,PK(1),o[d0],0,0,0);
    o[d0]=__builtin_amdgcn_mfma_f32_32x32x16_bf16(pa2,PK(2),o[d0],0,0,0);
    o[d0]=__builtin_amdgcn_mfma_f32_32x32x16_bf16(pa3,PK(3),o[d0],0,0,0);
    #undef PK
  }
}

#ifndef ATTN_STORE16
#define ATTN_STORE16(p,v) (*(u32x4*)(p)=(v))
#endif
template<int THRL> __device__ __forceinline__ void attn_unit(int b,int h,int qb,const bf16*Q,const bf16*__restrict__ K,const bf16*__restrict__ V,bf16*O,char*shm,const float*__restrict__ cum,float skip_thr){
  const int tid=threadIdx.x,lane=tid&63,r32=lane&31,hi=lane>>5; const int wid=__builtin_amdgcn_readfirstlane(tid>>6);
  const long rowbase=(long)b*SEQ; const int q0=qb*QB;
  const bf16*Qw=Q+(rowbase+q0+wid*QBLK)*DM+h*D;
  const bf16*Kh=K+rowbase*DM+h*D,*Vh=V+rowbase*DM+h*D;
  const unsigned lds0=(unsigned)(uintptr_t)shm;
  float*wsf=(float*)(shm+LDS_WS)+wid*64;
  const bf16*ksrc=Kh+(long)lane*DM+wid*8;
  const bf16*vsrc=Vh+(long)(16*(wid&3)+(lane>>2))*DM+(wid>>2)*32+(lane&3)*8;
  const unsigned kdst=lds0+LDS_K+wid*1024, vdst=lds0+LDS_V+wid*1024;
  #define DMA_K(t,slot) glds16(ksrc+(long)(NTF-1-(t))*KVBLK*DM,(unsigned)__builtin_amdgcn_readfirstlane(kdst+(slot)))
  #define DMA_V(t,slot) glds16(vsrc+(long)(NTF-1-(t))*KVBLK*DM,(unsigned)__builtin_amdgcn_readfirstlane(vdst+(slot)))
  const int vb0=(int)(lds0+LDS_V)+((lane>>4)&1)*32+(lane&3)*8+(4*hi+((lane&15)>>2))*64;
  const char*Kbase=shm+LDS_K; bf16x8 kf[8];
  const lds_cptr shm3=(lds_cptr)shm; const lds_cptr kp0=shm3+LDS_K+hi*1024+r32*16; const lds_cptr vp0=shm3+LDS_V+((lane>>4)&1)*32+(lane&3)*8+(4*hi+((lane&15)>>2))*64;
  const int NTF=(q0+QB)/KVBLK;
  const float F0=cum[q0]; int nskip;
  { const int j0=lane,j1=lane+64; bool s0=false,s1=false;
    if(j0<NTF-4) s0=(F0-cum[64*j0+63])*1.4426950408889634f < -skip_thr;
    if(j1<NTF-4) s1=(F0-cum[64*j1+63])*1.4426950408889634f < -skip_thr;
    const unsigned long long m0=__ballot(s0),m1=__ballot(s1);
    nskip=(m0==~0ull)?64+(int)__builtin_ctzll(~m1|(1ull<<63)):(int)__builtin_ctzll(~m0); nskip&=~1; nskip=__builtin_amdgcn_readfirstlane(nskip); }
  const int NT=NTF-nskip, sbase=64*nskip;
  typedef __attribute__((address_space(3))) float* lds_fptr; const lds_fptr nbL=(lds_fptr)(__attribute__((address_space(3))) char*)shm+LDS_NB/4;
  for(int i4=tid*4;i4<q0+QB-sbase;i4+=NW*64*4){ const f32x4_t c4=*reinterpret_cast<const f32x4_t*>(cum+sbase+i4); f32x4_t n4; n4[0]=(F0-c4[0])*1.4426950408889634f; n4[1]=(F0-c4[1])*1.4426950408889634f; n4[2]=(F0-c4[2])*1.4426950408889634f; n4[3]=(F0-c4[3])*1.4426950408889634f; *(__attribute__((address_space(3))) f32x4_t*)(nbL+i4)=n4; }
  asm volatile("s_waitcnt vmcnt(0) lgkmcnt(0)\n\ts_barrier":::"memory");
  DMA_K(0,0);DMA_V(0,0);DMA_K(1,SLOTB);
  bf16x8 qr[4];
  #pragma unroll
  for(int d0=0;d0<4;++d0)qr[d0]=*reinterpret_cast<const bf16x8*>(&Qw[(long)r32*DM+d0*16+hi*8]);
  float l_reg=0.f;f32x16 o[2];o[0]=f32x16{};o[1]=f32x16{};
  const int qrel=wid*QBLK+r32;
  float mhat=nbL[q0-sbase+qrel];
  #define NBRD(X0,X1,i) do{ const lds_fptr nb_=nbL+(64*(NT-1-(i))+4*hi); _Pragma("unroll") for(int g_=0;g_<4;++g_){ const f32x4_t a_=*(const __attribute__((address_space(3))) f32x4_t*)(nb_+8*g_); const f32x4_t b_=*(const __attribute__((address_space(3))) f32x4_t*)(nb_+8*g_+32); \
      X0[4*g_]=a_[0];X0[4*g_+1]=a_[1];X0[4*g_+2]=a_[2];X0[4*g_+3]=a_[3]; X1[4*g_]=b_[0];X1[4*g_+1]=b_[1];X1[4*g_+2]=b_[2];X1[4*g_+3]=b_[3]; } }while(0)
  #define NBSUB(X0,X1) do{ _Pragma("unroll") for(int r=0;r<16;++r){X0[r]-=mhat;X1[r]-=mhat;} }while(0)
  #define CMASK(P0,P1,t) do{int jb_=3-(t); if(jb_>=0)cmask(P0,P1,jb_,qrel,hi);}while(0)
  bool resc=false;
  #define START(P0,P1) do{ const float rm=rowmax(P0,P1); resc=false; \
    { const float dl=max2f(rm,0.f); mhat=fadd_s(mhat,dl); \
      _Pragma("unroll") for(int r=0;r<16;++r){P0[r]=fsub_s(P0[r],dl);P1[r]=fsub_s(P1[r],dl);} } \
    _Pragma("unroll") for(int r=0;r<16;++r)P0[r]=__builtin_amdgcn_exp2f(P0[r]); }while(0)
  #define RESC() do{ if(resc){ asm volatile("s_waitcnt lgkmcnt(0)":::"memory"); \
      _Pragma("unroll") for(int d_=0;d_<2;++d_) _Pragma("unroll") for(int r=0;r<16;++r)o[d_][r]*=wsf[crow(r,hi)]; } }while(0)
  f32x16 pA0,pA1,pB0,pB1;
  int sl_prev=0,sl_cur=0,sl_next=SLOTB;
  #define ROT() do{sl_prev=sl_cur;sl_cur=sl_next;sl_next=(sl_next==(NSLOT-1)*SLOTB)?0:sl_next+SLOTB;}while(0)
  DMA_K(2,2*SLOTB);
  WAIT_BAR(3);
  NBRD(pA0,pA1,0); NBSUB(pA0,pA1);
  qkt(pA0,pA1,Kbase,qr,r32,hi);asm volatile("s_nop 15\n\ts_nop 7":"+v"(pA0),"+v"(pA1));CMASK(pA0,pA1,0);
  START(pA0,pA1);
  _Pragma("unroll") for(int r=0;r<16;++r)pA1[r]=__builtin_amdgcn_exp2f(pA1[r]);
  NBRD(pB0,pB1,1);
  WAIT_BAR(0);
  DMA_K(3,0);DMA_V(1,SLOTB);
  ROT();
  kload8(kf,kp0+sl_cur);
  WAIT_BAR(2);
  s16x4 vlo[8],vhi[8]; u32x4 pw0,pw1,pw2,pw3;
  #define PKW(P,B) cvtpk_s(P[B],P[B+1])
  #define PAF(k) __builtin_bit_cast(bf16x8,pw##k)
  #define VFR(i) (bf16x8){vlo[i][0],vlo[i][1],vlo[i][2],vlo[i][3],vhi[i][0],vhi[i][1],vhi[i][2],vhi[i][3]}
  #define PIN(x) asm volatile("":"+v"(x))
  #define MX3(a,b,c) __builtin_fmaxf(__builtin_fmaxf((a),(b)),(c))
  #define GAPA(MF,A0,A1,A2,A3,W0,W1,PW) do{ MF; sacc+=A0; sacc+=A1; sacc+=A2; sacc+=A3; PIN(sacc); W0; W1; PIN(PW); SBAR(); }while(0)
  #define EX(v) __builtin_amdgcn_exp2f(v)
  #define GAPB(MF,X,B) do{ MF; X[B]=EX(X[B]); X[B+1]=EX(X[B+1]); X[B+2]=EX(X[B+2]); X[B+3]=EX(X[B+3]); PIN(X); SBAR(); }while(0)
  #define VRD(i) do{ vlo[i]=vtr(vp_+(((i)>>2)*4096+((i)&3)*1024)); vhi[i]=vtr(vp_+(((i)>>2)*4096+((i)&3)*1024+512)); }while(0)
  #define KRD(G,j) do{ if(G){ kload2(kf,kp0+sl_next,j); SBAR(); } }while(0)
  #define STEP(C0,C1,P0,P1,t,GK,GV,GL) do{ SBAR(); NBSUB(C0,C1); \
    const lds_cptr vp_=vp0+sl_prev; \
    VRD(0); SBAR(); float sacc=(P0[0]+P0[1]); \
    GAPA(C0=__builtin_amdgcn_mfma_f32_32x32x16_bf16(kf[0],qr[0],C0,0,0,0), P0[2],P0[3],P0[4],P0[5],     pw0[0]=PKW(P0,0), pw0[1]=PKW(P0,2), pw0); \
    VRD(4); SBAR(); GAPA(C1=__builtin_amdgcn_mfma_f32_32x32x16_bf16(kf[1],qr[0],C1,0,0,0), P0[6],P0[7],P0[8],P0[9],     pw0[2]=PKW(P0,4), pw0[3]=PKW(P0,6), pw0); \
    VRD(1); SBAR(); GAPA(C0=__builtin_amdgcn_mfma_f32_32x32x16_bf16(kf[2],qr[1],C0,0,0,0),   P0[10],P0[11],P0[12],P0[13], pw1[0]=PKW(P0,8), pw1[1]=PKW(P0,10), pw1); \
    VRD(5); SBAR(); GAPA(C1=__builtin_amdgcn_mfma_f32_32x32x16_bf16(kf[3],qr[1],C1,0,0,0),   P0[14],P0[15],P1[0],P1[1],   pw1[2]=PKW(P0,12),pw1[3]=PKW(P0,14), pw1); \
    VRD(2); SBAR(); GAPA(C0=__builtin_amdgcn_mfma_f32_32x32x16_bf16(kf[4],qr[2],C0,0,0,0),   P1[2],P1[3],P1[4],P1[5],     pw2[0]=PKW(P1,0), pw2[1]=PKW(P1,2), pw2); \
    VRD(6); SBAR(); GAPA(C1=__builtin_amdgcn_mfma_f32_32x32x16_bf16(kf[5],qr[2],C1,0,0,0),   P1[6],P1[7],P1[8],P1[9],     pw2[2]=PKW(P1,4), pw2[3]=PKW(P1,6), pw2); \
    VRD(3); SBAR(); GAPA(C0=__builtin_amdgcn_mfma_f32_32x32x16_bf16(kf[6],qr[3],C0,0,0,0),   P1[10],P1[11],P1[12],P1[13], pw3[0]=PKW(P1,8), pw3[1]=PKW(P1,10), pw3); \
    VRD(7); SBAR(); GAPA(C1=__builtin_amdgcn_mfma_f32_32x32x16_bf16(kf[7],qr[3],C1,0,0,0),   P1[14],P1[15],0.f,0.f,       pw3[2]=PKW(P1,12),pw3[3]=PKW(P1,14), pw3); \
    l_reg+=sacc; \
    if(GK){DMA_K((t)+3,sl_cur);} if(GV){DMA_V((t)+1,sl_next);} \
    CMASK(C0,C1,t); \
    { float a=MX3(C0[0],C0[1],C1[0]),b=MX3(C0[2],C0[3],C1[1]); a=MX3(a,C1[2],C1[3]); \
      _Pragma("unroll") for(int r=4;r<16;r+=4){a=MX3(a,C0[r],C0[r+1]);b=MX3(b,C0[r+2],C0[r+3]);a=MX3(a,C1[r],C1[r+1]);b=MX3(b,C1[r+2],C1[r+3]);} \
      float rm=__builtin_fmaxf(a,b); { auto rr=__builtin_amdgcn_permlane32_swap(__float_as_uint(rm),__float_as_uint(rm),false,false); rm=__builtin_fmaxf(__uint_as_float(rr[0]),__uint_as_float(rr[1])); } \
      resc=false; \
      if(__builtin_expect(__any(rm>(float)THRL),0)){ const float dl=__builtin_fmaxf(rm,0.f); mhat+=dl; \
        _Pragma("unroll") for(int r=0;r<16;++r){C0[r]-=dl;C1[r]-=dl;} \
        const float f=__builtin_amdgcn_exp2f(-dl); l_reg*=f; if(hi==0)wsf[r32]=f; resc=true; } } \
    SBAR(); \
    if(GL){ NBRD(P0,P1,(t)+1); SBAR(); } \
    GAPB(o[0]=__builtin_amdgcn_mfma_f32_32x32x16_bf16(PAF(0),VFR(0),o[0],0,0,0), C0,0); \
    GAPB(o[1]=__builtin_amdgcn_mfma_f32_32x32x16_bf16(PAF(0),VFR(4),o[1],0,0,0), C0,4); \
    KRD(GL,0); GAPB(o[0]=__builtin_amdgcn_mfma_f32_32x32x16_bf16(PAF(1),VFR(1),o[0],0,0,0), C0,8); \
    KRD(GL,1); GAPB(o[1]=__builtin_amdgcn_mfma_f32_32x32x16_bf16(PAF(1),VFR(5),o[1],0,0,0), C0,12); \
    KRD(GL,2); GAPB(o[0]=__builtin_amdgcn_mfma_f32_32x32x16_bf16(PAF(2),VFR(2),o[0],0,0,0), C1,0); \
    KRD(GL,3); GAPB(o[1]=__builtin_amdgcn_mfma_f32_32x32x16_bf16(PAF(2),VFR(6),o[1],0,0,0), C1,4); \
    GAPB(o[0]=__builtin_amdgcn_mfma_f32_32x32x16_bf16(PAF(3),VFR(3),o[0],0,0,0), C1,8); \
    GAPB(o[1]=__builtin_amdgcn_mfma_f32_32x32x16_bf16(PAF(3),VFR(7),o[1],0,0,0), C1,12); \
    }while(0)
  #define ENDW(tt) do{ if((tt)+3<NT){WAIT_BAR(2);} else if((tt)+2<NT){WAIT_BAR(1);} else {WAIT_BAR(0);} }while(0)
  int t=1;
  for(;t<=3&&t+1<NT;t+=2){
    STEP(pB0,pB1,pA0,pA1,t,(t+3<NT),(t+1<NT),(t+1<NT));       ENDW(t);   RESC(); ROT();
    STEP(pA0,pA1,pB0,pB1,t+1,(t+4<NT),(t+2<NT),(t+2<NT));     ENDW(t+1); RESC(); ROT();
  }
  #undef CMASK
  #define CMASK(P0,P1,t) do{}while(0)
  for(;t+5<NT;t+=2){
    STEP(pB0,pB1,pA0,pA1,t,true,true,true);     WAIT_BAR(2); RESC(); ROT();
    STEP(pA0,pA1,pB0,pB1,t+1,true,true,true);   WAIT_BAR(2); RESC(); ROT();
  }
  for(;t+1<NT;t+=2){
    STEP(pB0,pB1,pA0,pA1,t,(t+3<NT),(t+1<NT),(t+1<NT));       ENDW(t);   RESC(); ROT();
    STEP(pA0,pA1,pB0,pB1,t+1,(t+4<NT),(t+2<NT),(t+2<NT));     ENDW(t+1); RESC(); ROT();
  }
  #undef CMASK
  #define CMASK(P0,P1,t) do{int jb_=3-(t); if(jb_>=0)cmask(P0,P1,jb_,qrel,hi);}while(0)
  STEP(pB0,pB1,pA0,pA1,NT-1,false,false,false); RESC();
  { float sacc=pB0[0]+pB0[1]; _Pragma("unroll") for(int r=2;r<16;++r)sacc+=pB0[r]; _Pragma("unroll") for(int r=0;r<16;++r)sacc+=pB1[r]; l_reg+=sacc;
    pw0=(u32x4){PKW(pB0,0),PKW(pB0,2),PKW(pB0,4),PKW(pB0,6)};pw1=(u32x4){PKW(pB0,8),PKW(pB0,10),PKW(pB0,12),PKW(pB0,14)};pw2=(u32x4){PKW(pB1,0),PKW(pB1,2),PKW(pB1,4),PKW(pB1,6)};pw3=(u32x4){PKW(pB1,8),PKW(pB1,10),PKW(pB1,12),PKW(pB1,14)};
    SBAR(); pv(o,vb0+sl_cur,PAF(0),PAF(1),PAF(2),PAF(3)); }
  #undef PKW
  #undef PAF
  #undef VFR
  #undef PIN
  #undef MX3
  #undef GAPA
  #undef GAPB
  #undef EX
  #undef VRD
  #undef KRD
  #undef STEP
  #undef ENDW
  {auto rr=__builtin_amdgcn_permlane32_swap(__float_as_uint(l_reg),__float_as_uint(l_reg),false,false);l_reg=__uint_as_float(rr[0])+__uint_as_float(rr[1]);}
  if(hi==0)wsf[32+r32]=l_reg;asm volatile("s_waitcnt lgkmcnt(0)":::"memory");
  float rli[16];
  #pragma unroll
  for(int r=0;r<16;++r)rli[r]=__builtin_amdgcn_rcpf(wsf[32+crow(r,hi)]);
  bf16*Ow=O+(rowbase+q0+wid*QBLK)*DM+h*D;
  { bf16*stg=(bf16*)(shm+LDS_OST)+wid*2048;
    #pragma unroll
    for(int r=0;r<16;++r){const int orow=crow(r,hi);
      #pragma unroll
      for(int d0=0;d0<2;++d0)stg[orow*64+d0*32+r32]=__float2bfloat16(o[d0][r]*rli[r]);}
    asm volatile("s_waitcnt lgkmcnt(0)":::"memory");
    #pragma unroll
    for(int i=0;i<4;++i){const int row=i*8+(lane>>3),ch=lane&7; const u32x4 v=*(const u32x4*)(stg+row*64+ch*8); ATTN_STORE16(Ow+(long)row*DM+ch*8,v);} }
  asm volatile("s_waitcnt lgkmcnt(0)\n\ts_barrier":::"memory");
  #undef DMA_K
  #undef DMA_V
  #undef CMASK
  #undef START
  #undef NBRD
  #undef NBSUB
  #undef RESC
  #undef ROT
}
constexpr int ATTN_LDS_BYTES=LDS_BYTES;
struct AttnTensors { const bf16* Q; const bf16* K; const bf16* V; bf16* O; const float* cum; };
struct AttnUnit { int bh; int qb; };
template<int THRL=8> __device__ __forceinline__ void attn_phase(char*lds,const AttnTensors&T,unsigned*qheads,const unsigned*norm,volatile __attribute__((address_space(3))) unsigned*bc){
  const int x=blockIdx.x&7;
  for(;;){
    if(threadIdx.x==0) bc[0]=__hip_atomic_fetch_add(qheads+64*x,1u,__ATOMIC_RELAXED,__HIP_MEMORY_SCOPE_AGENT);
    __syncthreads(); const unsigned idx=bc[0]; __syncthreads();
    if(idx>=64u) break;
    const int b=x>>2, h=(idx&1)?(x&3):7-(x&3), qb=31-(int)(idx>>1), bh=b*NHEAD+h;
    const float qn=(__uint_as_float(norm[(0*16+bh)*2])+__uint_as_float(norm[(0*16+bh)*2+1]))*1.02f, kn=(__uint_as_float(norm[(1*16+bh)*2])+__uint_as_float(norm[(1*16+bh)*2+1]))*1.02f;
    const float thr=2.0f*sqrtf(qn*kn)+160.0f;
    attn_unit<THRL>(b,h,qb,T.Q,T.K,T.V,T.O,lds,T.cum+(long)bh*SEQ,thr);
  }
}
#undef SBAR
#undef WAIT_BAR
}

__device__ __forceinline__ void ph_attn_fast(Frame& F) {
    F.lane = ltid(); F.tid = F.wave * 64 + F.lane;
    static_assert(attn_body::ATTN_LDS_BYTES <= 131072, "attention LDS");
    const attn_body::AttnTensors AT{(const attn_body::bf16*)F.Q, (const attn_body::bf16*)F.K, (const attn_body::bf16*)F.V, (attn_body::bf16*)F.O, F.CUM};
    attn_body::attn_phase<8>((char*)F.lds_generic, AT, F.ctl + CW_AQ, F.ctl + CW_NORM, (volatile LAS unsigned*)(F.lds + MISC_OFF + 64));
}

constexpr int NPHASE = 13;
#ifndef PROBE_PHASE
#define PROBE_PHASE -1
#endif
constexpr int N_LAUNCHES = 1;
__global__ void __launch_bounds__(NTHR, 2) fwd_kernel(Args args) {
    extern __shared__ __attribute__((aligned(16))) unsigned char lds_raw[];
    Frame F;
    F.lds = (LAS unsigned char*)lds_raw; F.lds_generic = lds_raw;
    F.tid = threadIdx.x; F.lane = F.tid & 63; F.wave = __builtin_amdgcn_readfirstlane(F.tid >> 6);
    F.gw = blockIdx.x * NWAVES + F.wave; F.NGW = gridDim.x * NWAVES;
    F.x = args.in[0]; F.c = args.in[1]; F.w_ada = args.in[2]; F.b_ada = args.in[3]; F.w_in = args.in[4]; F.b_forget = args.in[5]; F.conv_w = args.in[6]; F.conv_b = args.in[7];
    F.conv_ln_g = args.in[8]; F.conv_ln_b = args.in[9]; F.w_conv_out = args.in[10]; F.w_fox_out = args.in[11]; F.w_mix_out = args.in[12]; F.ln1_g = args.in[13]; F.ln1_b = args.in[14];
    F.w_router = args.in[15]; F.router_bias = args.in[16]; F.w_exp_gate = args.in[17]; F.w_exp_up = args.in[18]; F.w_exp_down = args.in[19]; F.w_sh_gate = args.in[20]; F.w_sh_up = args.in[21];
    F.w_sh_down = args.in[22]; F.ln2_g = args.in[23]; F.ln2_b = args.in[24];
    F.out = args.out; F.ws = args.ws; unsigned char* ws = args.ws;
    F.ctl = (unsigned*)(ws + WS_CTL);
    F.ADA = (float*)(ws + WS_ADA); F.ADAP = (float*)(ws + WS_ADAP); F.CUM = (float*)(ws + WS_CUM); F.LOGF = (float*)(ws + WS_LOGF); F.X1 = (float*)(ws + WS_X1); F.RL = (float*)(ws + WS_RL);
    F.LISTW = (float*)(ws + WS_LISTW); F.WFC = (float*)(ws + WS_WFC); F.LIST = (int*)(ws + WS_LIST);
    F.H = (bf16_t*)(ws + WS_H); F.U = (bf16_t*)(ws + WS_U); F.Q = (bf16_t*)(ws + WS_Q); F.K = (bf16_t*)(ws + WS_K); F.V = (bf16_t*)(ws + WS_V); F.AC = (bf16_t*)(ws + WS_AC); F.O = (bf16_t*)(ws + WS_O);
    F.GA = (bf16_t*)(ws + WS_GA); F.GB = (bf16_t*)(ws + WS_GB); F.YA = (bf16_t*)(ws + WS_YA); F.MG = (bf16_t*)(ws + WS_MG); F.YAS = (bf16_t*)(ws + WS_YAS); F.H2 = (bf16_t*)(ws + WS_H2);
    F.H2LO = (bf16_t*)(ws + WS_H2LO); F.SHID = (bf16_t*)(ws + WS_SHID); F.HID = (bf16_t*)(ws + WS_HID);
    const int lo = args.ph_lo, hi = args.ph_hi;
    volatile LAS unsigned* MISC = (volatile LAS unsigned*)(F.lds + MISC_OFF);
    for (int u = F.tid; u < 32; u += NTHR) MISC[u] = 0u;
    __syncthreads();
    XcdBarrier bar; bar.bar = F.ctl + CW_BAR; bar.x = 0; bar.st = MISC + 8;
    if (hi - lo > 1) bar = xcd_barrier_post(F.ctl + CW_BAR, MISC + 8);
    F.vid = blockIdx.x;
#define IN(k) (lo <= (k) && (k) < hi)
#define SEAM(k) do { if (IN(k) && IN((k) + 1)) xcd_barrier(bar); } while (0)
    if (IN(0)) { { ph_ada(F); ph_convert(F); } if (PROBE_PHASE == 0) { __syncthreads(); { ph_ada(F); ph_convert(F); } } }
    SEAM(0);
    if (IN(0) && IN(1)) {
        if (F.tid == 0) { unsigned v = MISC[12]; for (unsigned j = 0; j < bar.x; ++j) v += xb_ld(&bar.bar[XB_XCNT(j)]); MISC[13] = v; }
        __syncthreads(); F.vid = __builtin_amdgcn_readfirstlane((int)MISC[13]); if (F.vid < 0 || F.vid >= (int)gridDim.x) F.vid = blockIdx.x; }
    if (IN(1)) { ph_lnmod(F); if (PROBE_PHASE == 1) { __syncthreads(); ph_lnmod(F); } }
    SEAM(1);
    if (IN(2)) { { ph_scan(F); ph_inproj_fast(F); } if (PROBE_PHASE == 2) { __syncthreads(); { ph_scan(F); ph_inproj_fast(F); } } }
    SEAM(2);
    if (IN(3)) { {} if (PROBE_PHASE == 3) { __syncthreads(); {} } }
    if (IN(4)) { ph_conv(F); __syncthreads(); if (PROBE_PHASE == 4) { ph_conv(F); __syncthreads(); } for (int rep = 0; rep < (PROBE_PHASE == 40 ? 2 : 1); ++rep) { ph_attn_fast(F); __syncthreads(); if (PROBE_PHASE == 40 && rep == 0) { xcd_barrier(bar); if (blockIdx.x < 8 && F.tid == 0) __hip_atomic_store(F.ctl + CW_AQ + 64 * blockIdx.x, 0u, __ATOMIC_RELAXED, __HIP_MEMORY_SCOPE_AGENT); xcd_barrier(bar); } } ph_inproj_filler(F); __syncthreads();
        ph_convert_filler(F, F.ctl + CW_CQ, (volatile LAS unsigned*)(F.lds + MISC_OFF + 64)); }
    SEAM(4);
    if (IN(5)) { ph_merge_fast(F); if (PROBE_PHASE == 5) { __syncthreads(); ph_merge_fast(F); } }
    SEAM(5);
    if (IN(6)) { ph_mix_fast(F); if (PROBE_PHASE == 6) { __syncthreads(); ph_mix_fast(F); } }
    SEAM(6);
    if (IN(7)) { ph_ln2(F); if (PROBE_PHASE == 7) { __syncthreads(); ph_ln2(F, true); } }
    SEAM(7);
    if (IN(8)) { ph_router_fast(F); if (PROBE_PHASE == 8) { __syncthreads(); ph_router_fast(F); } }
    SEAM(8);
    if (IN(9)) { ph_route(F, 3); if (PROBE_PHASE == 9) { __syncthreads(); ph_route(F, 3, true); } }
    SEAM(9);
    if (IN(10)) { ph_moe1_fast(F); if (PROBE_PHASE == 10) { __syncthreads(); ph_moe1_fast(F); }
        if (PROBE_PHASE == 100) { __syncthreads(); ph_moe1_experts<0>(F, (bf16_t*)(F.ws + WS_WEGU_T)); } if (PROBE_PHASE == 101) { __syncthreads(); ph_moe1_experts<1>(F, (bf16_t*)(F.ws + WS_WEGU_T)); }
        if (PROBE_PHASE == 102) { __syncthreads(); ph_moe1_experts<2>(F, (bf16_t*)(F.ws + WS_WEGU_T)); } }
    SEAM(10);
    if (IN(11)) { ph_moe2_fast(F); if (PROBE_PHASE == 11) { __syncthreads(); ph_moe2_fast(F); } }
    SEAM(11);
    if (IN(12)) { ph_combine(F); if (PROBE_PHASE == 12) { __syncthreads(); ph_combine(F); } }
#undef IN
#undef SEAM
}

extern "C" void kernel_launch(void* const* d_in, const int* in_sizes, int n_in, void* d_out, int out_size, void* d_ws, size_t ws_size, hipStream_t stream) {
    static int grid = 0;
    if (grid == 0) {
        if (n_in != 25 || out_size != T * D || ws_size < WS_END) { fprintf(stderr, "kernel_launch: unexpected sizes: n_in %d out %d ws %zu (need %zu)\n", n_in, out_size, ws_size, (size_t)WS_END); grid = -1; return; }
        int dev = 0, cus = 0, per_cu = 0;
        (void)hipGetDevice(&dev); (void)hipDeviceGetAttribute(&cus, hipDeviceAttributeMultiprocessorCount, dev);
        (void)hipFuncSetAttribute((const void*)fwd_kernel, hipFuncAttributeMaxDynamicSharedMemorySize, LDS_BYTES);
        (void)hipOccupancyMaxActiveBlocksPerMultiprocessor(&per_cu, (const void*)fwd_kernel, NTHR, LDS_BYTES);
        (void)hipGetLastError();
        if (per_cu < 1) { fprintf(stderr, "kernel_launch: occupancy query says %d blocks/CU\n", per_cu); }
        grid = cus > 0 ? cus : 256;
    }
    if (grid < 0) return;
    (void)hipMemsetAsync((char*)d_ws + WS_CTL, 0, CTL_BYTES, stream);
    Args a{};
    for (int i = 0; i < 25; ++i) a.in[i] = (const float*)d_in[i];
    a.out = (float*)d_out; a.ws = (unsigned char*)d_ws;
    if (N_LAUNCHES == 1) {
        a.ph_lo = 0; a.ph_hi = NPHASE;
        void* kargs[] = {(void*)&a};
        const hipError_t e = hipLaunchCooperativeKernel((const void*)fwd_kernel, dim3(grid), dim3(NTHR), kargs, LDS_BYTES, stream);
        if (e != hipSuccess) fprintf(stderr, "kernel_launch: cooperative launch failed: %s (grid %d)\n", hipGetErrorString(e), grid);
    } else {
        for (int p = 0; p < NPHASE; ++p) { a.ph_lo = p; a.ph_hi = p + 1; hipLaunchKernelGGL(fwd_kernel, dim3(grid), dim3(NTHR), LDS_BYTES, stream, a); }
    }
}
```

```cpp
#include <hip/hip_runtime.h>
#include <cstdio>
#include <cstdint>
#include <hip/hip_bf16.h>

#define LAS __attribute__((address_space(3)))
typedef unsigned short bf16_t;
typedef float f32x4 __attribute__((ext_vector_type(4)));
typedef unsigned u32x4 __attribute__((ext_vector_type(4)));
typedef unsigned u32x2 __attribute__((ext_vector_type(2)));

constexpr int NB = 2, S = 8192, D = 1024, T = NB * S;
constexpr int CC = 512, CW = 31, NH = 8, HD = 64, FW = 512;
constexpr int NE = 256, TOPK = 8, NG = 8, EH = 256, SHH = 256;
constexpr int INC = 4616;
constexpr int O_Q = 1024, O_K = 1536, O_V = 2048, O_F = 2560, O_GA = 2568, O_GB = 3592;
constexpr float LN_EPS = 1e-5f;
constexpr float ALPHA = 1.189207115002721f;
constexpr float LOG2E = 1.4426950408889634f;
constexpr float QSCALE = 0.125f * LOG2E;
constexpr float ROUTED_SCALE = 2.5f;
constexpr int NWAVES = 8, NTHR = 512;
constexpr int LCAP = 16384;
constexpr int NSLOT = 9;
constexpr int LDS_BYTES = 147456, MISC_OFF = 131072 + 320;

constexpr size_t MiB = 1u << 20;
constexpr size_t WS_CTL = 0, CTL_BYTES = 1 * MiB;
constexpr size_t WS_ADA = 1 * MiB;
constexpr size_t WS_ADAP = 1 * MiB + 64 * 1024;
constexpr size_t WS_CUM = 2 * MiB;
constexpr size_t WS_LOGF = 2 * MiB + 512 * 1024;
constexpr size_t WS_STATS = 3 * MiB;
constexpr size_t WS_WFC = 3 * MiB + 512 * 1024;
constexpr size_t WS_H = 20 * MiB;
constexpr size_t WS_U = 52 * MiB, WS_Q = 68 * MiB, WS_K = 84 * MiB, WS_V = 100 * MiB, WS_AC = 116 * MiB, WS_O = 132 * MiB;
constexpr size_t WS_GA = 148 * MiB, WS_GB = 180 * MiB, WS_YA = 212 * MiB, WS_MG = 244 * MiB;
constexpr size_t WS_YAS = 20 * MiB;
constexpr size_t WS_X1 = 308 * MiB;
constexpr size_t WS_H2 = 372 * MiB, WS_H2LO = 404 * MiB;
constexpr size_t WS_RL = 436 * MiB;
constexpr size_t WS_SHID = 484 * MiB;
constexpr size_t WS_LIST = 492 * MiB, WS_LISTW = 508 * MiB;
constexpr size_t WS_HID = 524 * MiB;
constexpr size_t WS_END = 1024 * MiB;
constexpr int CW_CNT = 16384, CNT_STRIDE = 64;
constexpr int CW_NORM = 2048;
constexpr int CW_AQ = 2304;
constexpr int CW_FQ = 2816, CW_CQ = 3392, CW_VQ = 3456;

__device__ __forceinline__ float bf2f(bf16_t v) { return __uint_as_float((unsigned)v << 16); }
__device__ __forceinline__ unsigned f2bf(float f) { unsigned u = __float_as_uint(f); return (u + 0x7fffu + ((u >> 16) & 1u)) >> 16; }
__device__ __forceinline__ unsigned pk2(float lo, float hi) { return f2bf(lo) | (f2bf(hi) << 16); }
typedef _Float16 f16x2_t __attribute__((ext_vector_type(2)));
typedef float f32x2_t __attribute__((ext_vector_type(2)));
__device__ __forceinline__ unsigned pkh2(float lo, float hi) { const f16x2_t h = __builtin_convertvector((f32x2_t){lo, hi}, f16x2_t); return __builtin_bit_cast(unsigned, h); }
__device__ __forceinline__ float wave_sum(float v) {
#pragma unroll
    for (int o = 1; o < 64; o <<= 1) v += __shfl_xor(v, o);
    return v;
}
__device__ __forceinline__ float wave_max(float v) {
#pragma unroll
    for (int o = 1; o < 64; o <<= 1) v = fmaxf(v, __shfl_xor(v, o));
    return v;
}
__device__ __forceinline__ int ltid() { int t = (int)__builtin_amdgcn_mbcnt_hi(~0u, __builtin_amdgcn_mbcnt_lo(~0u, 0u)); asm volatile("" : "+v"(t)); return t; }
__device__ __forceinline__ float sigmoidf_(float x) { return 1.0f / (1.0f + expf(-x)); }
__device__ __forceinline__ float siluf_(float x) { return x / (1.0f + expf(-x)); }


constexpr int CW_BAR = 4096;
#define XB_TMO      128
#define XB_XCNT(j)  (256  + 64 * (j))
#define XB_XSUB(j)  (1280 + 64 * (j))
#define XB_XGEN(j)  (2304 + 64 * (j))
#define XB_TOP      3328
#define XB_TOPGEN   3392
#define XCD_BAR_WORDS 3456
#define XB_SPIN_CAP (1u << 20)
__device__ __forceinline__ unsigned xb_ld(unsigned* p)              { return __hip_atomic_load(p, __ATOMIC_RELAXED, __HIP_MEMORY_SCOPE_AGENT); }
__device__ __forceinline__ unsigned xb_add(unsigned* p, unsigned v) { return __hip_atomic_fetch_add(p, v, __ATOMIC_RELAXED, __HIP_MEMORY_SCOPE_AGENT); }
__device__ __forceinline__ unsigned xb_xcc_id() { return (unsigned)__builtin_amdgcn_s_getreg((3 << 11) | 20) & 0xFu; }
#define XB_SPIN(cond, bar) do { unsigned _sp = 0; while (cond) { __builtin_amdgcn_s_sleep(1); \
    if ((++_sp & 255u) == 0u) { if (xb_ld(&(bar)[XB_TMO])) break; if (_sp > XB_SPIN_CAP) { atomicAdd(&(bar)[XB_TMO], 1u); break; } } } } while (0)
struct XcdBarrier { unsigned* bar; unsigned x; volatile LAS unsigned* st; };
__device__ __forceinline__ XcdBarrier xcd_barrier_post(unsigned* bar, volatile LAS unsigned* st) {
    XcdBarrier b; b.bar = bar; b.x = xb_xcc_id(); b.st = st;
    if (threadIdx.x == 0) st[4] = xb_add(&bar[XB_XCNT(b.x)], 1u);
    return b;
}
__device__ __forceinline__ void xcd_barrier_complete(unsigned* bar, unsigned x, unsigned& nloc, unsigned& nx) {
    const unsigned G = gridDim.x * gridDim.y * gridDim.z;
    unsigned sum, cnt, mine, sp = 0u;
    for (;;) {
        sum = 0u; cnt = 0u; mine = 0u;
#pragma unroll
        for (unsigned j = 0; j < 16; ++j) { const unsigned c = xb_ld(&bar[XB_XCNT(j)]); sum += c; cnt += (c > 0u) ? 1u : 0u; mine = (j == x) ? c : mine; }
        if (sum == G) break;
        __builtin_amdgcn_s_sleep(1);
        if ((++sp & 255u) == 0u) { if (xb_ld(&bar[XB_TMO])) break; if (sp > XB_SPIN_CAP) { atomicAdd(&bar[XB_TMO], 1u); break; } }
    }
    nloc = mine > 0u ? mine : 1u; nx = cnt > 0u ? cnt : 1u;
}
__device__ __forceinline__ void xcd_barrier(const XcdBarrier& b) {
    asm volatile("s_waitcnt vmcnt(0)" ::: "memory");
    __syncthreads();
    if (threadIdx.x == 0) {
        unsigned* bar = b.bar;
        __builtin_amdgcn_s_waitcnt(0);
        unsigned nloc = b.st[0], nx = b.st[1];
        if (nloc == 0u) { xcd_barrier_complete(bar, b.x, nloc, nx); b.st[0] = nloc; b.st[1] = nx; }
        const unsigned old = xb_add(&bar[XB_XSUB(b.x)], 1u);
        const unsigned gen = old / nloc;
        if (old + 1u == (gen + 1u) * nloc) {
            __builtin_amdgcn_fence(__ATOMIC_RELEASE, "agent");
            asm volatile("s_waitcnt vmcnt(0)" ::: "memory");
            const unsigned og = xb_add(&bar[XB_TOP], 1u);
            const unsigned tg = og / nx;
            if (og + 1u == (tg + 1u) * nx) xb_add(&bar[XB_TOPGEN], 1u);
            else XB_SPIN(xb_ld(&bar[XB_TOPGEN]) == tg, bar);
            __builtin_amdgcn_fence(__ATOMIC_ACQUIRE, "agent");
            xb_add(&bar[XB_XGEN(b.x)], 1u);
            asm volatile("s_waitcnt vmcnt(0)" ::: "memory");
        } else {
            XB_SPIN(xb_ld(&bar[XB_XGEN(b.x)]) == gen, bar);
            __builtin_amdgcn_fence(__ATOMIC_ACQUIRE, "agent");
            asm volatile("s_waitcnt vmcnt(0)" ::: "memory");
        }
    }
    __syncthreads();
}

struct Args { const float* in[25]; float* out; unsigned char* ws; int ph_lo, ph_hi; };

struct Frame {
    LAS unsigned char* lds; unsigned char* lds_generic;
    int tid, lane, wave, gw, NGW, vid;
    const float *x, *c, *w_ada, *b_ada, *w_in, *b_forget, *conv_w, *conv_b, *conv_ln_g, *conv_ln_b, *w_conv_out, *w_fox_out, *w_mix_out, *ln1_g, *ln1_b,
        *w_router, *router_bias, *w_exp_gate, *w_exp_up, *w_exp_down, *w_sh_gate, *w_sh_up, *w_sh_down, *ln2_g, *ln2_b;
    float* out; unsigned char* ws;
    unsigned* ctl;
    float *ADA, *ADAP, *CUM, *LOGF, *X1, *RL, *LISTW, *WFC, *STATS;
    bf16_t *H, *U, *Q, *K, *V, *AC, *O, *GA, *GB, *YA, *MG, *YAS, *H2, *H2LO, *SHID, *HID;
    int* LIST;
};

__device__ __forceinline__ void ph_ada(Frame& F) {
    F.lane = ltid(); F.tid = F.wave * 64 + F.lane;
    if (blockIdx.x == gridDim.x - 1) for (int i = F.tid; i < 8192; i += NTHR) { const int k = i >> 3, hh = i & 7; F.WFC[hh * 1024 + k] = F.w_in[(size_t)k * INC + O_F + hh]; }
    if (blockIdx.x >= 24) return;
    LAS float* part = (LAS float*)F.lds;
    const float* c = F.c; const float* w = F.w_ada;
    const int j0 = blockIdx.x * 256 + F.lane * 4, kc = F.wave;
    f32x4 a0 = {0.f, 0.f, 0.f, 0.f}, a1 = {0.f, 0.f, 0.f, 0.f};
#pragma unroll 8
    for (int k = kc * 128; k < kc * 128 + 128; ++k) {
        const f32x4 wv = *(const f32x4*)(w + (size_t)k * 6144 + j0);
        const float c0 = siluf_(c[k]), c1 = siluf_(c[D + k]);
        a0 += wv * c0; a1 += wv * c1;
    }
    *(LAS f32x4*)(part + (kc * 2 + 0) * 256 + F.lane * 4) = a0;
    *(LAS f32x4*)(part + (kc * 2 + 1) * 256 + F.lane * 4) = a1;
    __syncthreads();
    { const int b = F.tid >> 8, j = F.tid & 255; float s = F.b_ada[blockIdx.x * 256 + j];
#pragma unroll
      for (int p = 0; p < 8; ++p) s += part[(p * 2 + b) * 256 + j];
      F.ADA[b * 6144 + blockIdx.x * 256 + j] = s; }
    __syncthreads();
}

__device__ __forceinline__ float wave_sum8(const float (&a)[8], int lane) {
    float b[4], c[2];
#pragma unroll
    for (int i = 0; i < 4; ++i) { const float keep = (lane & 1) ? a[2 * i + 1] : a[2 * i], send = (lane & 1) ? a[2 * i] : a[2 * i + 1]; b[i] = keep + __shfl_xor(send, 1); }
#pragma unroll
    for (int i = 0; i < 2; ++i) { const float keep = (lane & 2) ? b[2 * i + 1] : b[2 * i], send = (lane & 2) ? b[2 * i] : b[2 * i + 1]; c[i] = keep + __shfl_xor(send, 2); }
    float d = ((lane & 4) ? c[1] : c[0]) + __shfl_xor((lane & 4) ? c[0] : c[1], 4);
    d += __shfl_xor(d, 8); d += __shfl_xor(d, 16); d += __shfl_xor(d, 32);
    return d;
}
__device__ __forceinline__ void ph_lnmod(Frame& F) {
    F.lane = ltid(); F.tid = F.wave * 64 + F.lane;
    LAS float* ada1 = (LAS float*)F.lds;
    LAS float* wf = ada1 + 4096;
    for (int i = F.tid; i < 1024; i += NTHR) { const int b = i >> 9, j = (i & 511) * 4; *(LAS f32x4*)(ada1 + b * 2048 + j) = *(const f32x4*)(F.ADA + b * 6144 + j); }
    for (int i = F.tid; i < 2048; i += NTHR) *(LAS f32x4*)(wf + 4 * i) = *(const f32x4*)(F.WFC + 4 * i);
    __syncthreads();
    const int lane = F.lane;
    constexpr int R = 4;
    for (int m0 = F.gw * R; m0 < T; m0 += F.NGW * R) {
        f32x4 v[R][4]; float mean[R], rstd[R];
#pragma unroll
        for (int r = 0; r < R; ++r) { const f32x4* xr = (const f32x4*)(F.x + (size_t)(m0 + r) * D) + lane;
#pragma unroll
            for (int j = 0; j < 4; ++j) v[r][j] = xr[64 * j]; }
#pragma unroll
        for (int r = 0; r < R; ++r) { float s = 0.f;
#pragma unroll
            for (int j = 0; j < 4; ++j) s += (v[r][j].x + v[r][j].y) + (v[r][j].z + v[r][j].w);
            mean[r] = wave_sum(s) * (1.f / D); }
#pragma unroll
        for (int r = 0; r < R; ++r) { float s2 = 0.f;
#pragma unroll
            for (int j = 0; j < 4; ++j) { v[r][j] = v[r][j] - mean[r]; s2 += (v[r][j].x * v[r][j].x + v[r][j].y * v[r][j].y) + (v[r][j].z * v[r][j].z + v[r][j].w * v[r][j].w); }
            rstd[r] = 1.f / sqrtf(wave_sum(s2) * (1.f / D) + LN_EPS); }
#pragma unroll
        for (int r = 0; r < R; ++r) { const int m = m0 + r, b = m >> 13;
            float fl[8];
#pragma unroll
            for (int hh = 0; hh < 8; ++hh) fl[hh] = 0.f;
            u32x2* hrow = (u32x2*)(F.H + (size_t)m * D) + lane;
#pragma unroll
            for (int j = 0; j < 4; ++j) { const int col = 4 * lane + 256 * j;
                const f32x4 sh = *(const LAS f32x4*)(ada1 + b * 2048 + col), sc = *(const LAS f32x4*)(ada1 + b * 2048 + 1024 + col);
                const f32x4 h = v[r][j] * rstd[r] * (sc + 1.0f) + sh;
                u32x2 o; o.x = pk2(h.x, h.y); o.y = pk2(h.z, h.w); hrow[64 * j] = o;
#pragma unroll
                for (int hh = 0; hh < 8; ++hh) { const f32x4 w = *(const LAS f32x4*)(wf + hh * 1024 + col); fl[hh] += (h.x * w.x + h.y * w.y) + (h.z * w.z + h.w * w.w); }
                asm volatile("" ::: "memory"); }
            const float f = wave_sum8(fl, lane);
            if (lane < 8) { const float z = f + F.b_forget[lane]; F.LOGF[(size_t)m * 8 + lane] = fminf(z, 0.f) - log1pf(expf(-fabsf(z))); } }
    }
}

__device__ __forceinline__ void ph_scan(Frame& F) {
    F.lane = ltid(); F.tid = F.wave * 64 + F.lane;
    if (blockIdx.x >= 16) return;
    LAS double* sc = (LAS double*)F.lds;
    const int bh = blockIdx.x, b = bh >> 3, hh = bh & 7, s0 = F.tid * 16;
    double loc[16]; double run = 0.0;
#pragma unroll
    for (int i = 0; i < 16; ++i) { run += (double)F.LOGF[(size_t)(b * S + s0 + i) * 8 + hh]; loc[i] = run; }
    sc[F.tid] = run;
    __syncthreads();
    double off = 0.0;
    for (int i = 0; i < F.tid; ++i) off += sc[i];
#pragma unroll
    for (int i = 0; i < 16; ++i) F.CUM[(size_t)bh * S + s0 + i] = (float)(off + loc[i]);
    __syncthreads();
}

__device__ __forceinline__ void ph_conv(Frame& F, unsigned* qhead, volatile LAS unsigned* bc) {
    F.lane = ltid(); F.tid = F.wave * 64 + F.lane;
    constexpr int RUN = 8, NIN = RUN + CW - 1, PADJ = RUN - 1, NTAB = CW + 2 * PADJ + 2;
    LAS float* cw = (LAS float*)F.lds;
    LAS float* cb = cw + NTAB * CC;
    for (int i = F.tid; i < NTAB * CC / 4; i += NTHR) { const int jj = (4 * i) / CC, j = jj - PADJ;
        *(LAS f32x4*)(cw + 4 * i) = (j >= 0 && j < CW) ? *(const f32x4*)(F.conv_w + (size_t)j * CC + (4 * i) % CC) : (f32x4){0.f, 0.f, 0.f, 0.f}; }
    for (int i = F.tid; i < CC; i += NTHR) { cb[i] = F.conv_b[i]; cb[CC + i] = F.conv_ln_g[i]; cb[2 * CC + i] = F.conv_ln_b[i]; }
    __syncthreads();
    const int lane = F.lane, c0 = lane * 8;
    for (;;) {
        if (F.tid == 0) bc[0] = __hip_atomic_fetch_add(qhead, 1u, __ATOMIC_RELAXED, __HIP_MEMORY_SCOPE_AGENT);
        __syncthreads(); const int run = (int)bc[0] * NWAVES + F.wave; __syncthreads();
        if (run - F.wave >= T / RUN) break;
        const int m0 = run * RUN, t0 = m0 & (S - 1);
        float a[RUN][8];
#pragma unroll
        for (int r = 0; r < RUN; ++r)
#pragma unroll
            for (int i = 0; i < 8; ++i) a[r][i] = cb[c0 + i];
#pragma unroll 1
        for (int c = 0; c < (NIN + 7) / 8; ++c) {
            u32x4 uv[8];
#pragma unroll
            for (int k = 0; k < 8; ++k) { const int i = 8 * c + k; uv[k] = (u32x4){0u, 0u, 0u, 0u};
                if (i < NIN && t0 - (CW - 1) + i >= 0) uv[k] = *(const u32x4*)(F.U + (size_t)(m0 - (CW - 1) + i) * CC + c0); }
            float u[8][8];
#pragma unroll
            for (int k = 0; k < 8; ++k) {
                u[k][0] = __uint_as_float(uv[k].x << 16); u[k][1] = __uint_as_float(uv[k].x & 0xffff0000u); u[k][2] = __uint_as_float(uv[k].y << 16); u[k][3] = __uint_as_float(uv[k].y & 0xffff0000u);
                u[k][4] = __uint_as_float(uv[k].z << 16); u[k][5] = __uint_as_float(uv[k].z & 0xffff0000u); u[k][6] = __uint_as_float(uv[k].w << 16); u[k][7] = __uint_as_float(uv[k].w & 0xffff0000u); }
#pragma unroll
            for (int d = -(RUN - 1); d < 8; ++d) {
                const LAS float* wrow = cw + (8 * c + d + PADJ) * CC + c0;
                const f32x4 w0 = *(const LAS f32x4*)(wrow), w1 = *(const LAS f32x4*)(wrow + 4);
#pragma unroll
                for (int r = 0; r < RUN; ++r) { const int k = r + d;
                    if (k >= 0 && k < 8) {
                        a[r][0] += u[k][0] * w0.x; a[r][1] += u[k][1] * w0.y; a[r][2] += u[k][2] * w0.z; a[r][3] += u[k][3] * w0.w;
                        a[r][4] += u[k][4] * w1.x; a[r][5] += u[k][5] * w1.y; a[r][6] += u[k][6] * w1.z; a[r][7] += u[k][7] * w1.w; } }
                asm volatile("" ::: "memory"); }
        }
#pragma unroll
        for (int r = 0; r < RUN; ++r) {
            float s = 0.f;
#pragma unroll
            for (int i = 0; i < 8; ++i) s += a[r][i];
            const float mean = wave_sum(s) * (1.f / CC); float s2 = 0.f;
#pragma unroll
            for (int i = 0; i < 8; ++i) { a[r][i] -= mean; s2 += a[r][i] * a[r][i]; }
            const float rstd = 1.f / sqrtf(wave_sum(s2) * (1.f / CC) + LN_EPS);
            float y[8];
#pragma unroll
            for (int i = 0; i < 8; ++i) y[i] = siluf_(a[r][i] * rstd * cb[CC + c0 + i] + cb[2 * CC + c0 + i]);
            u32x4 o; o.x = pk2(y[0], y[1]); o.y = pk2(y[2], y[3]); o.z = pk2(y[4], y[5]); o.w = pk2(y[6], y[7]);
            *(u32x4*)(F.AC + (size_t)(m0 + r) * CC + c0) = o;
        }
    }
}

__device__ __forceinline__ int col8(int lane, int j) { return (j >> 1) * 512 + 8 * lane + 4 * (j & 1); }
__device__ __forceinline__ void ph_ln2(Frame& F, bool dry = false) {
    F.lane = ltid(); F.tid = F.wave * 64 + F.lane;
    bf16_t* H2o = dry ? (bf16_t*)(F.ws + (size_t)(640 + 64) * MiB) : F.H2; bf16_t* H2Lo = dry ? (bf16_t*)(F.ws + (size_t)(640 + 96) * MiB) : F.H2LO; float* ST = dry ? (float*)(F.ws + (size_t)640 * MiB) : F.STATS;
    const int lane = F.lane;
    constexpr int R = 4;
    for (int m0 = F.gw * R; m0 < T; m0 += F.NGW * R) {
        f32x4 v[R][4]; float mean[R], rstd[R];
#pragma unroll
        for (int r = 0; r < R; ++r)
#pragma unroll
            for (int j = 0; j < 4; ++j) v[r][j] = *(const f32x4*)(F.X1 + (size_t)(m0 + r) * D + col8(lane, j));
#pragma unroll
        for (int r = 0; r < R; ++r) { float s = 0.f;
#pragma unroll
            for (int j = 0; j < 4; ++j) s += (v[r][j].x + v[r][j].y) + (v[r][j].z + v[r][j].w);
            mean[r] = wave_sum(s) * (1.f / D); }
#pragma unroll
        for (int r = 0; r < R; ++r) { float s2 = 0.f;
#pragma unroll
            for (int j = 0; j < 4; ++j) { v[r][j] = v[r][j] - mean[r]; s2 += (v[r][j].x * v[r][j].x + v[r][j].y * v[r][j].y) + (v[r][j].z * v[r][j].z + v[r][j].w * v[r][j].w); }
            rstd[r] = 1.f / sqrtf(wave_sum(s2) * (1.f / D) + LN_EPS);
            if (lane == 0) { ST[2 * (m0 + r)] = mean[r]; ST[2 * (m0 + r) + 1] = rstd[r]; } }
#pragma unroll
        for (int r = 0; r < R; ++r) { float s = 0.f;
#pragma unroll
            for (int j = 0; j < 4; ++j) { const int col = col8(lane, j);
                v[r][j] = v[r][j] * rstd[r] * *(const f32x4*)(F.ln1_g + col) + *(const f32x4*)(F.ln1_b + col);
                s += (v[r][j].x + v[r][j].y) + (v[r][j].z + v[r][j].w); }
            mean[r] = wave_sum(s) * (1.f / D); }
#pragma unroll
        for (int r = 0; r < R; ++r) { float s2 = 0.f;
#pragma unroll
            for (int j = 0; j < 4; ++j) { v[r][j] = v[r][j] - mean[r]; s2 += (v[r][j].x * v[r][j].x + v[r][j].y * v[r][j].y) + (v[r][j].z * v[r][j].z + v[r][j].w * v[r][j].w); }
            rstd[r] = 1.f / sqrtf(wave_sum(s2) * (1.f / D) + LN_EPS); }
#pragma unroll
        for (int r = 0; r < R; ++r) { const int m = m0 + r, b = m >> 13;
#pragma unroll
            for (int q = 0; q < 2; ++q) { unsigned hb[8]; float hv[8];
#pragma unroll
                for (int jj = 0; jj < 2; ++jj) { const int j = 2 * q + jj, col = col8(lane, j);
                    const f32x4 sh = *(const f32x4*)(F.ADA + b * 6144 + 3072 + col), sc = *(const f32x4*)(F.ADA + b * 6144 + 4096 + col);
                    const f32x4 h = v[r][j] * rstd[r] * (sc + 1.0f) + sh;
                    hv[4 * jj] = h.x; hv[4 * jj + 1] = h.y; hv[4 * jj + 2] = h.z; hv[4 * jj + 3] = h.w; }
#pragma unroll
                for (int i = 0; i < 8; ++i) hb[i] = f2bf(hv[i]);
                u32x4 o, l; o.x = hb[0] | (hb[1] << 16); o.y = hb[2] | (hb[3] << 16); o.z = hb[4] | (hb[5] << 16); o.w = hb[6] | (hb[7] << 16);
                l.x = pkh2(hv[0], hv[1]); l.y = pkh2(hv[2], hv[3]); l.z = pkh2(hv[4], hv[5]); l.w = pkh2(hv[6], hv[7]);
                *(u32x4*)(H2o + (size_t)m * D + q * 512 + 8 * lane) = o; *(u32x4*)(H2Lo + (size_t)m * D + q * 512 + 8 * lane) = l; } }
    }
}

__device__ __forceinline__ void ph_route(Frame& F, int nparts, bool dry = false) {
    F.lane = ltid(); F.tid = F.wave * 64 + F.lane;
    unsigned* cnt = dry ? (unsigned*)(F.ws + (size_t)(640 + 160) * MiB) : F.ctl + CW_CNT; int* LISTo = dry ? (int*)(F.ws + (size_t)(640 + 128) * MiB) : F.LIST; float* LISTWo = dry ? (float*)(F.ws + (size_t)(640 + 144) * MiB) : F.LISTW;
    const int lane = F.lane, g = lane >> 3;
    constexpr int TK = 4;
    const f32x4 bias = *(const f32x4*)(F.router_bias + lane * 4);
    for (int t0 = F.gw * TK; t0 < T; t0 += F.NGW * TK) {
        float sc[TK][4], mv[TK][4], a1[TK], a2[TK], myw[TK], wsum[TK]; int mye[TK];
#pragma unroll
        for (int q = 0; q < TK; ++q) { const int t = t0 + q;
            f32x4 lg = *(const f32x4*)(F.RL + (size_t)t * NE + lane * 4);
            for (int p = 1; p < nparts; ++p) lg += *(const f32x4*)(F.RL + (size_t)p * T * NE + (size_t)t * NE + lane * 4);
#pragma unroll
            for (int i = 0; i < 4; ++i) { sc[q][i] = sigmoidf_(lg[i]); mv[q][i] = sc[q][i] + bias[i]; }
            a1[q] = fmaxf(mv[q][0], mv[q][1]); a2[q] = fminf(mv[q][0], mv[q][1]);
            const float b1 = fmaxf(mv[q][2], mv[q][3]), b2 = fminf(mv[q][2], mv[q][3]); const float n1 = fmaxf(a1[q], b1), n2 = fmaxf(fminf(a1[q], b1), fmaxf(a2[q], b2)); a1[q] = n1; a2[q] = n2; }
#pragma unroll
        for (int o = 1; o < 8; o <<= 1)
#pragma unroll
            for (int q = 0; q < TK; ++q) { const float b1 = __shfl_xor(a1[q], o), b2 = __shfl_xor(a2[q], o); const float n1 = fmaxf(a1[q], b1), n2 = fmaxf(fminf(a1[q], b1), fmaxf(a2[q], b2)); a1[q] = n1; a2[q] = n2; }
        int rank[TK];
#pragma unroll
        for (int q = 0; q < TK; ++q) { a1[q] += a2[q]; rank[q] = 0; }
#pragma unroll
        for (int gg = 0; gg < NG; ++gg)
#pragma unroll
            for (int q = 0; q < TK; ++q) { const float og = __shfl(a1[q], gg * 8); rank[q] += (og > a1[q] || (og == a1[q] && gg < g)) ? 1 : 0; }
#pragma unroll
        for (int q = 0; q < TK; ++q) { if (rank[q] >= 4) {
#pragma unroll
                for (int i = 0; i < 4; ++i) mv[q][i] = -INFINITY; }
            myw[q] = 0.f; mye[q] = 0; wsum[q] = 0.f; }
#pragma unroll
        for (int k = 0; k < TOPK; ++k) {
            float v[TK]; int e[TK];
#pragma unroll
            for (int q = 0; q < TK; ++q) { float bv = mv[q][0]; int bi = 0;
#pragma unroll
                for (int i = 1; i < 4; ++i) if (mv[q][i] > bv) { bv = mv[q][i]; bi = i; }
                v[q] = bv; e[q] = lane * 4 + bi; }
#pragma unroll
            for (int o = 1; o < 64; o <<= 1)
#pragma unroll
                for (int q = 0; q < TK; ++q) { const float ov = __shfl_xor(v[q], o); const int oe = __shfl_xor(e[q], o);
                    if (ov > v[q] || (ov == v[q] && oe < e[q])) { v[q] = ov; e[q] = oe; } }
#pragma unroll
            for (int q = 0; q < TK; ++q) {
                float s = 0.f;
                if ((e[q] >> 2) == lane) {
#pragma unroll
                    for (int i = 0; i < 4; ++i) if ((e[q] & 3) == i) { s = sc[q][i]; mv[q][i] = -INFINITY; } }
                s = __shfl(s, e[q] >> 2);
                wsum[q] += s;
                if (lane == k) { myw[q] = s; mye[q] = e[q]; } }
        }
        if (lane < TOPK) {
#pragma unroll
            for (int q = 0; q < TK; ++q) { const float w = myw[q] / wsum[q] * ROUTED_SCALE;
                const unsigned p = atomicAdd(cnt + mye[q] * CNT_STRIDE, 1u) & (LCAP - 1);
                LISTo[(size_t)mye[q] * LCAP + p] = (t0 + q) * TOPK + lane;
                LISTWo[(size_t)mye[q] * LCAP + p] = w; }
        }
    }
}

__device__ __forceinline__ void build_expert_map(Frame& F, LAS int* pref, LAS int* base, int rows_per_chunk) {
    __syncthreads();
    int nch = 0, n = 0;
    if (F.tid < NE) { n = (int)F.ctl[CW_CNT + F.tid * CNT_STRIDE]; nch = (n + rows_per_chunk - 1) / rows_per_chunk; }
    int sp = nch, sb = n;
#pragma unroll
    for (int o = 1; o < 64; o <<= 1) { const int tp = __shfl_up(sp, o), tb = __shfl_up(sb, o); if (F.lane >= o) { sp += tp; sb += tb; } }
    if (F.tid < NE && F.lane == 63) { pref[NE + 1 + F.wave] = sp; base[NE + 1 + F.wave] = sb; }
    __syncthreads();
    if (F.tid < NE) { int op = 0, ob = 0;
        for (int w = 0; w < F.wave; ++w) { op += pref[NE + 1 + w]; ob += base[NE + 1 + w]; }
        pref[F.tid + 1] = op + sp; base[F.tid + 1] = ob + sb; }
    if (F.tid == 0) { pref[0] = 0; base[0] = 0; }
    __syncthreads();
}
__device__ __forceinline__ int find_expert(const LAS int* pref, int u) { int lo = 0, hi = NE - 1;
    while (lo < hi) { const int mid = (lo + hi + 1) >> 1; if (pref[mid] <= u) lo = mid; else hi = mid - 1; }
    return lo; }

__device__ __forceinline__ void ph_combine(Frame& F) {
    F.lane = ltid(); F.tid = F.wave * 64 + F.lane;
    const int lane = F.lane;
    constexpr int R = 2;
    for (int m0 = F.gw * R; m0 < T; m0 += F.NGW * R) {
        f32x4 y[R][4];
#pragma unroll
        for (int r = 0; r < R; ++r) {
            u32x4 w[NSLOT][2];
#pragma unroll
            for (int k = 0; k < NSLOT; ++k) { const u32x4* yr = (const u32x4*)(F.YAS + ((size_t)(m0 + r) * NSLOT + k) * D) + lane; w[k][0] = __builtin_nontemporal_load(yr); w[k][1] = __builtin_nontemporal_load(yr + 64); }
#pragma unroll
            for (int j = 0; j < 4; ++j) y[r][j] = (f32x4){0.f, 0.f, 0.f, 0.f};
#pragma unroll
            for (int k = 0; k < NSLOT; ++k)
#pragma unroll
                for (int q = 0; q < 2; ++q) { const u32x4 t = w[k][q];
                    y[r][2 * q].x += __uint_as_float(t.x << 16); y[r][2 * q].y += __uint_as_float(t.x & 0xffff0000u); y[r][2 * q].z += __uint_as_float(t.y << 16); y[r][2 * q].w += __uint_as_float(t.y & 0xffff0000u);
                    y[r][2 * q + 1].x += __uint_as_float(t.z << 16); y[r][2 * q + 1].y += __uint_as_float(t.z & 0xffff0000u); y[r][2 * q + 1].z += __uint_as_float(t.w << 16); y[r][2 * q + 1].w += __uint_as_float(t.w & 0xffff0000u); }
        }
#pragma unroll
        for (int r = 0; r < R; ++r) { const int m = m0 + r, b = m >> 13; const float zmean = F.STATS[2 * m], zrstd = F.STATS[2 * m + 1];
            f32x4 v[4]; float s = 0.f;
#pragma unroll
            for (int j = 0; j < 4; ++j) { const int col = (j >> 1) * 512 + 8 * lane + 4 * (j & 1); const f32x4 g2 = *(const f32x4*)(F.ADA + b * 6144 + 5120 + col);
                const f32x4 x1 = (*(const f32x4*)(F.X1 + (size_t)m * D + col) - zmean) * zrstd * *(const f32x4*)(F.ln1_g + col) + *(const f32x4*)(F.ln1_b + col);
                v[j] = x1 * ALPHA + (g2 + 1.0f) * y[r][j]; s += (v[j].x + v[j].y) + (v[j].z + v[j].w); }
            const float mean = wave_sum(s) * (1.f / D); float s2 = 0.f;
#pragma unroll
            for (int j = 0; j < 4; ++j) { v[j] = v[j] - mean; s2 += (v[j].x * v[j].x + v[j].y * v[j].y) + (v[j].z * v[j].z + v[j].w * v[j].w); }
            const float rstd = 1.f / sqrtf(wave_sum(s2) * (1.f / D) + LN_EPS);
#pragma unroll
            for (int j = 0; j < 4; ++j) { const int col = (j >> 1) * 512 + 8 * lane + 4 * (j & 1); *(f32x4*)(F.out + (size_t)m * D + col) = v[j] * rstd * *(const f32x4*)(F.ln2_g + col) + *(const f32x4*)(F.ln2_b + col); } }
    }
}

namespace pg8 {
typedef short bf16x8 __attribute__((ext_vector_type(8)));
typedef _Float16 f16x8 __attribute__((ext_vector_type(8)));
constexpr int BM = 256, BK = 64, HALF = 128, HTB = HALF * BK * 2, STAGE_BYTES = 8 * HTB, NXCD = 8, WGM = 8;
constexpr int RTAB_OFF = 131072 + 4096;
constexpr int XTAB_OFF = RTAB_OFF + 2048;
__host__ __device__ __forceinline__ int lds_byte(int r, int c) { const int st = (r >> 4) * 2 + (c >> 5), rr = r & 15, cc = c & 31, ob = rr * 64 + cc * 2; return st * 1024 + (ob ^ (((ob >> 9) & 1) << 5)); }
__host__ __device__ __forceinline__ void stage_rc(int b, int& R, int& C) { const int st = b / 1024, sb = b % 1024, swz = sb ^ (((sb >> 9) & 1) << 5); R = (st >> 1) * 16 + swz / 64; C = (st & 1) * 32 + (swz % 64) / 2; }
__host__ __device__ __forceinline__ int perm32(int rho) { const int n = rho >> 4, i = rho & 15; return 8 * (i >> 2) + 4 * n + (i & 3); }

struct Unit { const char* A; const char* B; const char* B2; int pm, pn, e, p0, ne, bs, hf; };

struct TileOrder {
    int nM, nN, nwg, G, c;
    __device__ void init(int nM_, int nN_, int G_, int c_) { nM = nM_; nN = nN_; nwg = nM * nN; G = G_; c = c_; }
    __device__ bool tile(int i, int& pm, int& pn) const {
        const long L = (long)i * G + c; if (L >= nwg) return false;
        int wgid = (int)L; { const int q = nwg / NXCD, r = nwg % NXCD, xcd = wgid % NXCD, off = wgid / NXCD; wgid = (xcd < r ? xcd * (q + 1) : r * (q + 1) + (xcd - r) * q) + off; }
        const int nig = WGM * nN, gid = wgid / nig, fm = gid * WGM, gsz = (nM - fm) < WGM ? (nM - fm) : WGM;
        pm = fm + ((wgid % nig) % gsz); pn = (wgid % nig) / gsz; return true;
    }
};

__device__ __forceinline__ unsigned cvt_pk_bf16(float lo, float hi) { unsigned r; asm volatile("v_cvt_pk_bf16_f32 %0, %1, %2" : "=v"(r) : "v"(lo), "v"(hi)); return r; }
__device__ __forceinline__ float fsigmoid(float x) { return __builtin_amdgcn_rcpf(1.0f + __builtin_amdgcn_exp2f(-LOG2E * x)); }

template <class Epi, class Sched, bool ALIGN_EPI>
__device__ __forceinline__ void gemm_phase(LAS unsigned char* lds, const int K, const int lda, const int ldb, const Sched& S, const Epi& E) {
    const int wid = __builtin_amdgcn_readfirstlane((int)threadIdx.x >> 6), lane = ltid(), tid = wid * 64 + lane, wr = wid >> 2, wc = wid & 3, fr = lane & 15, fq = lane >> 4;
    int nt = K / BK; asm volatile("" : "+s"(nt));
    int RA[2]; unsigned CA[2], voffB[2];
#pragma unroll
    for (int i = 0; i < 2; ++i) { int R, C; stage_rc(tid * 16 + i * 8192, R, C); const int Rb = (R & ~31) + perm32(R & 31);
        RA[i] = R; CA[i] = (unsigned)C * 2u; voffB[i] = (unsigned)(Rb * ldb + C) * 2u; }
    const size_t kstep = (size_t)(BK * 2);
    const size_t hstepB = (size_t)HALF * ldb * 2;
    const unsigned ldsw = (unsigned)wid * 1024u;
    const int aoff = lds_byte(wr * 64 + fr, fq * 8), boff = lds_byte(wc * 32 + fr, fq * 8);
#define PG8_SA(b, h) (((b) * 2 + (h)) * HTB)
#define PG8_SB(b, h) ((4 + (b) * 2 + (h)) * HTB)
#define PG8_STAGE(bufoff, gbase, voff) do { _Pragma("unroll") for (int _i = 0; _i < 2; ++_i) \
        __builtin_amdgcn_global_load_lds((const unsigned*)((const char*)(gbase) + (voff)[_i]), (LAS unsigned*)(lds + (bufoff) + ldsw + _i * 8192), 16, 0, 0); } while (0)
#define PG8_STAGE_NT(bufoff, gbase, voff) do { _Pragma("unroll") for (int _i = 0; _i < 2; ++_i) \
        __builtin_amdgcn_global_load_lds((const unsigned*)((const char*)(gbase) + (voff)[_i]), (LAS unsigned*)(lds + (bufoff) + ldsw + _i * 8192), 16, 0, 2); } while (0)
#define PG8_LDA(dst, b, h) do { _Pragma("unroll") for (int m = 0; m < 4; ++m) _Pragma("unroll") for (int k = 0; k < 2; ++k) dst[m][k] = *(const LAS bf16x8*)(lds + PG8_SA(b, h) + aoff + m * 2048 + k * 1024); } while (0)
#define PG8_LDB(dst, b, h) do { _Pragma("unroll") for (int n = 0; n < 2; ++n) _Pragma("unroll") for (int k = 0; k < 2; ++k) dst[n][k] = *(const LAS bf16x8*)(lds + PG8_SB(b, h) + boff + n * 2048 + k * 1024); } while (0)
#define PG8_MMA(ai, bj, At, Bt) do { __builtin_amdgcn_s_setprio(1); _Pragma("unroll") for (int m = 0; m < 4; ++m) _Pragma("unroll") for (int n = 0; n < 2; ++n) _Pragma("unroll") for (int k = 0; k < 2; ++k) \
        acc[ai][bj][m][n] = Sched::F16 ? __builtin_amdgcn_mfma_f32_16x16x32_f16(__builtin_bit_cast(f16x8, Bt[n][k]), __builtin_bit_cast(f16x8, At[m][k]), acc[ai][bj][m][n], 0, 0, 0) \
                                       : __builtin_amdgcn_mfma_f32_16x16x32_bf16(Bt[n][k], At[m][k], acc[ai][bj][m][n], 0, 0, 0); __builtin_amdgcn_s_setprio(0); } while (0)
#define PG8_WAIT_V(n) asm volatile("s_waitcnt vmcnt(" #n ")" ::: "memory")
#define PG8_WAIT_L(n) asm volatile("s_waitcnt lgkmcnt(" #n ")" ::: "memory")
#define PG8_BAR __builtin_amdgcn_s_barrier()
#define PG8_SCHED __builtin_amdgcn_sched_barrier(0)
    Unit cur, nxt; int ui = 0;
    if constexpr (Sched::DYN) { S.fetch(0); S.fetch(1); PG8_WAIT_L(0); PG8_BAR; asm volatile("" ::: "memory"); }
    if (!S.next(0, cur)) return;
    f32x4 acc[2][2][4][2];
#pragma unroll
    for (int a = 0; a < 2; ++a)
#pragma unroll
        for (int b = 0; b < 2; ++b)
#pragma unroll
            for (int m = 0; m < 4; ++m)
#pragma unroll
                for (int n = 0; n < 2; ++n) acc[a][b][m][n] = (f32x4){0.f, 0.f, 0.f, 0.f};
    bf16x8 At[4][2], B0[2][2], B1[2][2];
    const char* cA = cur.A; const char* cB = cur.B;
    LAS unsigned* rtab = (LAS unsigned*)(lds + RTAB_OFF);
    int tb = 0;
#define PG8_STAGE_A(bufoff, gbase, h) do { unsigned _v[2]; _Pragma("unroll") for (int _j = 0; _j < 2; ++_j) \
        _v[_j] = (Sched::GATHER ? rtab[tb * 256 + (h) * HALF + RA[_j]] : S.a_row_off(cur, (h) * HALF + RA[_j])) + CA[_j]; \
        if constexpr (false) PG8_STAGE_NT(bufoff, gbase, _v); else PG8_STAGE(bufoff, gbase, _v); } while (0)
    LAS unsigned* xtab = (LAS unsigned*)(lds + XTAB_OFF); int tbx = 0;
    if constexpr (Sched::GATHER) { if (tid < 256) { rtab[tid] = S.a_row_off(cur, tid); if constexpr (Sched::AUX) { unsigned x0, x1; S.row_aux(cur, tid, x0, x1); xtab[2 * tid] = x0; xtab[2 * tid + 1] = x1; } } PG8_WAIT_L(0); PG8_BAR; }
    [[maybe_unused]] f32x4 breg[8];
    [[maybe_unused]] const int hB = wid >> 2, kcB = (lane & 3) + 4 * (wid & 1), n4B = (lane >> 2) + 16 * ((wid >> 1) & 1);
    [[maybe_unused]] unsigned rowb = 0, bvoff = 0, bdst = 0;
    [[maybe_unused]] const char* cBh = nullptr;
    if constexpr (Sched::BREG) { rowb = S.b_row_bytes(); bvoff = (unsigned)(kcB * 8) * rowb + (unsigned)n4B * 16u;
        const int rho0 = 32 * (n4B >> 3) + 16 * (n4B & 1) + 4 * ((n4B & 7) >> 1);
        bdst = (unsigned)(4 * HTB + hB * HTB + lds_byte(rho0, 8 * kcB)); cBh = hB ? cur.B2 : cur.B; }
#define PG8_BLOAD(gB) do { const char* _g = (gB); if (Sched::VAR != 4) _Pragma("unroll") for (int _j = 0; _j < 8; ++_j) \
        asm volatile("global_load_dwordx4 %0, %1, %2" : "=v"(breg[_j]) : "v"(bvoff), "s"(_g + (size_t)_j * rowb) : "memory"); } while (0)
#define PG8_BCVT(b) do { if (Sched::VAR == 4) asm volatile("" : "+v"(breg[0]), "+v"(breg[1]), "+v"(breg[2]), "+v"(breg[3]), "+v"(breg[4]), "+v"(breg[5]), "+v"(breg[6]), "+v"(breg[7])); else asm volatile("s_waitcnt vmcnt(2)" : "+v"(breg[0]), "+v"(breg[1]), "+v"(breg[2]), "+v"(breg[3]), "+v"(breg[4]), "+v"(breg[5]), "+v"(breg[6]), "+v"(breg[7]) :: "memory"); \
        _Pragma("unroll") for (int _q = 0; _q < 4; ++_q) { u32x4 _w; _w.x = cvt_pk_bf16(breg[0][_q], breg[1][_q]); _w.y = cvt_pk_bf16(breg[2][_q], breg[3][_q]); \
            _w.z = cvt_pk_bf16(breg[4][_q], breg[5][_q]); _w.w = cvt_pk_bf16(breg[6][_q], breg[7][_q]); if (Sched::VAR != 3) *(LAS u32x4*)(lds + bdst + (b) * 2 * HTB + 64 * _q) = _w; else asm volatile("" :: "v"(_w)); } } while (0)
    if constexpr (Sched::BREG) {
        PG8_STAGE_A(PG8_SA(0, 0), cA, 0); PG8_BLOAD(cBh); PG8_STAGE_A(PG8_SA(0, 1), cA, 1);
        if (wr == 1) PG8_BAR;
        PG8_BCVT(0); PG8_WAIT_L(0); PG8_BAR;
        PG8_STAGE_A(PG8_SA(1, 0), cA + kstep, 0); PG8_BLOAD(cBh + (size_t)BK * rowb);
        PG8_BAR;
    } else {
    PG8_STAGE(PG8_SB(0, 0), cB, voffB); PG8_STAGE(PG8_SB(0, 1), cB + hstepB, voffB); PG8_STAGE_A(PG8_SA(0, 0), cA, 0); PG8_STAGE_A(PG8_SA(0, 1), cA, 1);
    if (wr == 1) PG8_BAR;
    PG8_WAIT_V(2); PG8_BAR;
    PG8_STAGE(PG8_SB(1, 0), cB + kstep, voffB); PG8_STAGE_A(PG8_SA(1, 0), cA + kstep, 0); PG8_STAGE(PG8_SB(1, 1), cB + hstepB + kstep, voffB);
    PG8_WAIT_V(6); PG8_BAR;
    }
    for (;;) {
        if constexpr (Sched::DYN) S.fetch(ui + 2);
        const bool has_next = S.next(ui + 1, nxt);
        const bool hf = cur.hf != 0;
        const char* nA = has_next ? nxt.A : cA; const char* nB = has_next ? nxt.B : cB;
        if constexpr (Sched::GATHER) { if (has_next && tid < 256) { rtab[((ui + 1) & 1) * 256 + tid] = S.a_row_off(nxt, tid);
            if constexpr (Sched::AUX) { unsigned x0, x1; S.row_aux(nxt, tid, x0, x1); const int nb3 = tbx == 2 ? 0 : tbx + 1; xtab[nb3 * 512 + 2 * tid] = x0; xtab[nb3 * 512 + 2 * tid + 1] = x1; } } }
        for (int t = 0; t < nt; t += 2) {
            const bool last = (t == nt - 2);
            const char* a1 = cA + (size_t)(t + 1) * kstep;
            const char* a2 = last ? nA : cA + (size_t)(t + 2) * kstep; const char* b2 = last ? nB : cB + (size_t)(t + 2) * kstep;
            const char* a3 = a2 + kstep; const char* b3 = b2 + kstep;
            if constexpr (Sched::BREG) {
            const char* nBh = has_next ? (hB ? nxt.B2 : nxt.B) : cBh;
            const char* bp2 = last ? nBh : cBh + (size_t)(t + 2) * BK * rowb; const char* bp3 = bp2 + (size_t)BK * rowb;
            PG8_LDB(B0, 0, 0); PG8_LDB(B1, 0, 1); PG8_SCHED; PG8_LDA(At, 0, 0); PG8_STAGE_A(PG8_SA(1, 1), a1, 1);
            if (last && has_next) tb ^= 1;
            PG8_WAIT_V(12); PG8_WAIT_L(0); PG8_BAR; PG8_MMA(0, 0, At, B0); PG8_MMA(0, 1, At, B1); PG8_BAR; PG8_SCHED;
            if (!hf) PG8_LDA(At, 0, 1); PG8_BCVT(1); PG8_STAGE_A(PG8_SA(0, 0), a2, 0); PG8_BLOAD(bp2);
            PG8_WAIT_L(0); PG8_BAR; if (!hf) { PG8_MMA(1, 0, At, B0); PG8_MMA(1, 1, At, B1); } PG8_BAR; PG8_SCHED;
            PG8_LDB(B0, 1, 0); PG8_LDB(B1, 1, 1); PG8_SCHED; PG8_LDA(At, 1, 0); PG8_STAGE_A(PG8_SA(0, 1), a2, 1);
            PG8_WAIT_V(12); PG8_WAIT_L(0); PG8_BAR; PG8_MMA(0, 0, At, B0); PG8_MMA(0, 1, At, B1); PG8_BAR; PG8_SCHED;
            if (!hf) PG8_LDA(At, 1, 1); PG8_BCVT(0); PG8_STAGE_A(PG8_SA(1, 0), a3, 0); PG8_BLOAD(bp3);
            PG8_WAIT_L(0); PG8_BAR; if (!hf) { PG8_MMA(1, 0, At, B0); PG8_MMA(1, 1, At, B1); } PG8_BAR; PG8_SCHED;
            } else {
            PG8_LDB(B0, 0, 0); PG8_LDB(B1, 0, 1); PG8_SCHED; PG8_LDA(At, 0, 0); PG8_STAGE_A(PG8_SA(1, 1), a1, 1);
            if (last && has_next) tb ^= 1;
            PG8_WAIT_V(8); PG8_WAIT_L(0); PG8_BAR; PG8_MMA(0, 0, At, B0); PG8_MMA(0, 1, At, B1); PG8_BAR; PG8_SCHED;
            if (!hf) PG8_LDA(At, 0, 1); PG8_STAGE(PG8_SB(0, 0), b2, voffB); PG8_STAGE(PG8_SB(0, 1), b2 + hstepB, voffB); PG8_STAGE_A(PG8_SA(0, 0), a2, 0);
            PG8_WAIT_V(8); PG8_WAIT_L(0); PG8_BAR; if (!hf) { PG8_MMA(1, 0, At, B0); PG8_MMA(1, 1, At, B1); } PG8_BAR; PG8_SCHED;
            PG8_LDB(B0, 1, 0); PG8_LDB(B1, 1, 1); PG8_SCHED; PG8_LDA(At, 1, 0); PG8_STAGE_A(PG8_SA(0, 1), a2, 1);
            PG8_WAIT_V(8); PG8_WAIT_L(0); PG8_BAR; PG8_MMA(0, 0, At, B0); PG8_MMA(0, 1, At, B1); PG8_BAR; PG8_SCHED;
            if (!hf) PG8_LDA(At, 1, 1); PG8_STAGE(PG8_SB(1, 0), b3, voffB); PG8_STAGE(PG8_SB(1, 1), b3 + hstepB, voffB); PG8_STAGE_A(PG8_SA(1, 0), a3, 0);
            PG8_WAIT_V(8); PG8_WAIT_L(0); PG8_BAR; if (!hf) { PG8_MMA(1, 0, At, B0); PG8_MMA(1, 1, At, B1); } PG8_BAR; PG8_SCHED;
            }
        }
        if constexpr (ALIGN_EPI) { if (wr == 0) PG8_BAR; }
        E(acc, cur, wr, wc, fr, fq, xtab + tbx * 512);
        if (!has_next) break;
#pragma unroll
        for (int a = 0; a < 2; ++a)
#pragma unroll
            for (int b = 0; b < 2; ++b)
#pragma unroll
                for (int m = 0; m < 4; ++m)
#pragma unroll
                    for (int n = 0; n < 2; ++n) acc[a][b][m][n] = (f32x4){0.f, 0.f, 0.f, 0.f};
        cur = nxt; cA = nA; cB = nB; ++ui; tbx = tbx == 2 ? 0 : tbx + 1;
        if constexpr (Sched::BREG) cBh = hB ? cur.B2 : cur.B;
        if constexpr (ALIGN_EPI) { if (wr == 1) PG8_BAR; }
    }
    PG8_WAIT_V(0);
    if constexpr (!ALIGN_EPI) { if (wr == 0) PG8_BAR; }
    PG8_BAR;
#undef PG8_SA
#undef PG8_SB
#undef PG8_STAGE
#undef PG8_STAGE_NT
#undef PG8_STAGE_A
#undef PG8_BLOAD
#undef PG8_BCVT
#undef PG8_LDA
#undef PG8_LDB
#undef PG8_MMA
#undef PG8_WAIT_V
#undef PG8_WAIT_L
#undef PG8_BAR
#undef PG8_SCHED
}
}

constexpr size_t WS_WIN_T = 4 * MiB, WS_WC_T = 13 * MiB, WS_WF_T = 14 * MiB, WS_WMIX_T = 15 * MiB, WS_WR_HI = 17 * MiB, WS_WR_LO = 17 * MiB + 512 * 1024, WS_WSHGU_T = 18 * MiB, WS_WSHD_T = 19 * MiB;
constexpr size_t WS_WEGU_T = 640 * MiB, WS_WED_T = 896 * MiB;
constexpr int NINW = 4608;

__device__ __forceinline__ void tr_block(const float* src, int ldw, bf16_t* dst, bf16_t* dst2, int ldt, LAS float* scr, int lane) {
#pragma unroll 8
    for (int i = 0; i < 32; ++i) { const int kk = 2 * i + (lane >> 5); scr[kk * 33 + (lane & 31)] = src[(size_t)kk * ldw + (lane & 31)]; }
    asm volatile("s_waitcnt lgkmcnt(0)" ::: "memory");
    const int c = lane & 7;
#pragma unroll
    for (int j = 0; j < 4; ++j) { const int n = (lane >> 3) + 8 * j; const LAS float* s = scr + (8 * c) * 33 + n;
        float v[8];
#pragma unroll
        for (int q = 0; q < 8; ++q) v[q] = s[q * 33];
        u32x4 o; o.x = pk2(v[0], v[1]); o.y = pk2(v[2], v[3]); o.z = pk2(v[4], v[5]); o.w = pk2(v[6], v[7]);
        if (dst2 == dst) { o.x = pkh2(v[0], v[1]); o.y = pkh2(v[2], v[3]); o.z = pkh2(v[4], v[5]); o.w = pkh2(v[6], v[7]); }
        *(u32x4*)(dst + (size_t)n * ldt + 8 * c) = o;
        if (dst2 && dst2 != dst) { u32x4 l;
            l.x = pk2(v[0] - __uint_as_float(o.x << 16), v[1] - __uint_as_float(o.x & 0xffff0000u)); l.y = pk2(v[2] - __uint_as_float(o.y << 16), v[3] - __uint_as_float(o.y & 0xffff0000u));
            l.z = pk2(v[4] - __uint_as_float(o.z << 16), v[5] - __uint_as_float(o.z & 0xffff0000u)); l.w = pk2(v[6] - __uint_as_float(o.w << 16), v[7] - __uint_as_float(o.w & 0xffff0000u));
            *(u32x4*)(dst2 + (size_t)n * ldt + 8 * c) = l; } }
    asm volatile("s_waitcnt lgkmcnt(0)" ::: "memory");
}
__device__ __forceinline__ int inproj_src_col(int d) { const int pn = d >> 3, c0 = (d & 7) * 32;
    if (pn < 4) return c0 < 128 ? 128 * pn + c0 : 512 + 128 * pn + (c0 - 128);
    if (pn < 6) return O_Q + (pn - 4) * 256 + c0; if (pn < 8) return O_K + (pn - 6) * 256 + c0; if (pn < 10) return O_V + (pn - 8) * 256 + c0;
    if (pn < 14) return O_GA + (pn - 10) * 256 + c0; return O_GB + (pn - 14) * 256 + c0; }
constexpr int CV_I0 = 144 * 16, CV_I1 = 32 * 8, CV_I2 = 32 * 8, CV_I3 = 32 * 16, CV_I4 = 8 * 16, CV_I5 = 16 * 16, CV_I6 = 32 * 4, CV_ALL = CV_I0 + CV_I1 + CV_I2 + CV_I3 + CV_I4 + CV_I5 + CV_I6;
__device__ __forceinline__ void convert_item(Frame& F, int r, LAS float* scr, int lane) {
    unsigned char* ws = F.ws;
    if (r < CV_I0) { const int d = r % 144, kb = r / 144; tr_block(F.w_in + (size_t)kb * 64 * INC + inproj_src_col(d), INC, (bf16_t*)(ws + WS_WIN_T) + (size_t)d * 32 * D + kb * 64, nullptr, D, scr, lane); return; } r -= CV_I0;
    if (r < CV_I1) { const int d = r % 32, kb = r / 32; tr_block(F.w_conv_out + (size_t)kb * 64 * D + d * 32, D, (bf16_t*)(ws + WS_WC_T) + (size_t)d * 32 * CC + kb * 64, nullptr, CC, scr, lane); return; } r -= CV_I1;
    if (r < CV_I2) { const int d = r % 32, kb = r / 32; tr_block(F.w_fox_out + (size_t)kb * 64 * D + d * 32, D, (bf16_t*)(ws + WS_WF_T) + (size_t)d * 32 * FW + kb * 64, nullptr, FW, scr, lane); return; } r -= CV_I2;
    if (r < CV_I3) { const int d = r % 32, kb = r / 32; tr_block(F.w_mix_out + (size_t)kb * 64 * D + d * 32, D, (bf16_t*)(ws + WS_WMIX_T) + (size_t)d * 32 * D + kb * 64, nullptr, D, scr, lane); return; } r -= CV_I3;
    if (r < CV_I4) { const int d = r % 8, kb = r / 8; tr_block(F.w_router + (size_t)kb * 64 * NE + d * 32, NE, (bf16_t*)(ws + WS_WR_HI) + (size_t)d * 32 * D + kb * 64, (bf16_t*)(ws + WS_WR_HI) + (size_t)d * 32 * D + kb * 64, D, scr, lane); return; } r -= CV_I4;
    if (r < CV_I5) { const int d = r % 16, kb = r / 16, ct = d >> 3, c0 = (d & 7) * 32; const float* w = c0 < 128 ? F.w_sh_gate + 128 * ct + c0 : F.w_sh_up + 128 * ct + c0 - 128;
        tr_block(w + (size_t)kb * 64 * SHH, SHH, (bf16_t*)(ws + WS_WSHGU_T) + (size_t)d * 32 * D + kb * 64, nullptr, D, scr, lane); return; } r -= CV_I5;
    { const int d = r % 32, kb = r / 32; tr_block(F.w_sh_down + (size_t)kb * 64 * D + d * 32, D, (bf16_t*)(ws + WS_WSHD_T) + (size_t)d * 32 * SHH + kb * 64, nullptr, SHH, scr, lane); }
}
__device__ __forceinline__ void ph_convert(Frame& F) {
    F.lane = ltid(); F.tid = F.wave * 64 + F.lane;
    LAS float* scr = (LAS float*)(F.lds + F.wave * 16384);
    for (int it = F.gw; it < CV_I0; it += F.NGW) convert_item(F, it, scr, F.lane);
}
__device__ __forceinline__ void ph_convert_filler(Frame& F, unsigned* qhead, volatile LAS unsigned* bc) {
    F.lane = ltid(); F.tid = F.wave * 64 + F.lane;
    LAS float* scr = (LAS float*)(F.lds + F.wave * 16384);
    for (;;) {
        if (F.tid == 0) bc[0] = __hip_atomic_fetch_add(qhead, 1u, __ATOMIC_RELAXED, __HIP_MEMORY_SCOPE_AGENT);
        __syncthreads(); const int it = CV_I0 + (int)bc[0] * NWAVES + F.wave; __syncthreads();
        if (it - F.wave >= CV_ALL) break;
        if (it < CV_ALL) convert_item(F, it, scr, F.lane);
    }
}

struct SchedPlain {
    static constexpr bool GATHER = false, BREG = false, AUX = false, DYN = false, F16 = false; static constexpr int VAR = 0;
    __device__ __forceinline__ unsigned b_row_bytes() const { return 0u; }
    pg8::TileOrder o; const char* A; const char* B; unsigned arow, brow;
    __device__ __forceinline__ bool next(int i, pg8::Unit& u) const { int pm, pn; if (!o.tile(i, pm, pn)) return false; u.pm = pm; u.pn = pn; u.e = 0; u.p0 = 0; u.ne = 0; u.bs = 0; u.hf = 0;
        u.A = A + (size_t)pm * 256 * arow; u.B = B + (size_t)pn * 256 * brow; u.B2 = nullptr; return true; }
    __device__ __forceinline__ unsigned a_row_off(const pg8::Unit&, int r) const { return (unsigned)r * arow; }
};
typedef f32x4 AccT[2][2][4][2];
#define EPI_ARGS const AccT& acc, const pg8::Unit& u, int wr, int wc, int fr, int fq, const LAS unsigned* xt
#define EPI_LAUNDER asm volatile("" : "+v"(fr), "+v"(fq))

struct EpiInProj {
    bf16_t *U, *Q, *GA; unsigned* NORM;
    __device__ __forceinline__ void operator()(EPI_ARGS) const {
        EPI_LAUNDER;
        const int row0 = u.pm * 256 + wr * 64 + fr, pn = u.pn, cin = wc * 32 + 8 * fq;
        if (pn < 4) {
#pragma unroll
            for (int ai = 0; ai < 2; ++ai)
#pragma unroll
                for (int m = 0; m < 4; ++m) { const f32x4 a0 = acc[ai][0][m][0], a1 = acc[ai][0][m][1], b0 = acc[ai][1][m][0], b1 = acc[ai][1][m][1]; u32x4 w;
                    w.x = pg8::cvt_pk_bf16(a0[0] * pg8::fsigmoid(b0[0]), a0[1] * pg8::fsigmoid(b0[1])); w.y = pg8::cvt_pk_bf16(a0[2] * pg8::fsigmoid(b0[2]), a0[3] * pg8::fsigmoid(b0[3]));
                    w.z = pg8::cvt_pk_bf16(a1[0] * pg8::fsigmoid(b1[0]), a1[1] * pg8::fsigmoid(b1[1])); w.w = pg8::cvt_pk_bf16(a1[2] * pg8::fsigmoid(b1[2]), a1[3] * pg8::fsigmoid(b1[3]));
                    *(u32x4*)(U + (size_t)(row0 + ai * 128 + m * 16) * CC + 128 * pn + cin) = w; }
        } else {
            const bool sg = pn >= 10; const int ld = sg ? D : FW, cb = sg ? ((pn - 10) & 3) * 256 : ((pn - 4) & 1) * 256;
            bf16_t* dst = sg ? GA + (size_t)((pn - 10) >> 2) * (16u << 20) : Q + (size_t)((pn - 4) >> 1) * (8u << 20);
            const float sc = pn < 6 ? QSCALE : 1.f; float nmx[2] = {0.f, 0.f};
#pragma unroll
            for (int ai = 0; ai < 2; ++ai)
#pragma unroll
                for (int m = 0; m < 4; ++m) { bf16_t* rowp = dst + (size_t)(row0 + ai * 128 + m * 16) * ld + cb + cin;
#pragma unroll
                    for (int bj = 0; bj < 2; ++bj) { f32x4 v0 = acc[ai][bj][m][0], v1 = acc[ai][bj][m][1];
                        if (sg) {
#pragma unroll
                            for (int j = 0; j < 4; ++j) { v0[j] = pg8::fsigmoid(v0[j]); v1[j] = pg8::fsigmoid(v1[j]); } }
                        else { v0 = v0 * sc; v1 = v1 * sc; }
                        if (pn < 8) { float ss = (v0[0] * v0[0] + v0[1] * v0[1]) + (v0[2] * v0[2] + v0[3] * v0[3]) + (v1[0] * v1[0] + v1[1] * v1[1]) + (v1[2] * v1[2] + v1[3] * v1[3]);
                            ss += __shfl_xor(ss, 16); ss += __shfl_xor(ss, 32); nmx[bj] = fmaxf(nmx[bj], ss); }
                        u32x4 w; w.x = pg8::cvt_pk_bf16(v0[0], v0[1]); w.y = pg8::cvt_pk_bf16(v0[2], v0[3]); w.z = pg8::cvt_pk_bf16(v1[0], v1[1]); w.w = pg8::cvt_pk_bf16(v1[2], v1[3]);
                        *(u32x4*)(rowp + bj * 128) = w; } }
            if (pn < 8) {
#pragma unroll
                for (int bj = 0; bj < 2; ++bj) { float v = nmx[bj];
#pragma unroll
                    for (int o = 1; o < 16; o <<= 1) v = fmaxf(v, __shfl_xor(v, o));
                    if ((fr | fq) == 0) { const int bh = ((u.pm * 256) >> 13) * NH + (pn & 1) * 4 + 2 * bj + (wc >> 1);
                        atomicMax(NORM + ((pn >= 6 ? 1 : 0) * 16 + bh) * 2 + (wc & 1), __float_as_uint(v)); } }
            }
        }
    }
};
__device__ __forceinline__ f32x4 bf4lo(u32x4 w) { return (f32x4){__uint_as_float(w.x << 16), __uint_as_float(w.x & 0xffff0000u), __uint_as_float(w.y << 16), __uint_as_float(w.y & 0xffff0000u)}; }
__device__ __forceinline__ f32x4 bf4hi(u32x4 w) { return (f32x4){__uint_as_float(w.z << 16), __uint_as_float(w.z & 0xffff0000u), __uint_as_float(w.w << 16), __uint_as_float(w.w & 0xffff0000u)}; }
__device__ __forceinline__ u32x4 pack8(f32x4 v0, f32x4 v1) { u32x4 w; w.x = pg8::cvt_pk_bf16(v0[0], v0[1]); w.y = pg8::cvt_pk_bf16(v0[2], v0[3]); w.z = pg8::cvt_pk_bf16(v1[0], v1[1]); w.w = pg8::cvt_pk_bf16(v1[2], v1[3]); return w; }

struct SchedMerge {
    static constexpr bool GATHER = false, BREG = false, AUX = false, DYN = false, F16 = false; static constexpr int VAR = 0;
    __device__ __forceinline__ unsigned b_row_bytes() const { return 0u; }
    pg8::TileOrder o; const char *AC, *O, *WC, *WF;
    __device__ __forceinline__ bool next(int i, pg8::Unit& u) const { int pm, pn; if (!o.tile(i >> 1, pm, pn)) return false; u.pm = pm; u.pn = pn; u.e = i & 1; u.p0 = 0; u.ne = 0; u.bs = 0; u.hf = 0;
        u.A = ((i & 1) ? O : AC) + (size_t)pm * 256 * 1024; u.B = ((i & 1) ? WF : WC) + (size_t)pn * 256 * 1024; u.B2 = nullptr; return true; }
    __device__ __forceinline__ unsigned a_row_off(const pg8::Unit&, int r) const { return (unsigned)r * 1024u; }
};
struct EpiMerge {
    const bf16_t *GA, *GB; bf16_t *YA, *MG;
    __device__ __forceinline__ void operator()(EPI_ARGS) const {
        EPI_LAUNDER;
        const int row0 = u.pm * 256 + wr * 64 + fr, col0 = u.pn * 256 + wc * 32 + 8 * fq; const bool second = u.e != 0;
        const bf16_t* G = second ? GB : GA; bf16_t* dst = second ? MG : YA;
#pragma unroll
        for (int ai = 0; ai < 2; ++ai)
#pragma unroll
            for (int m = 0; m < 4; ++m) { const size_t off = (size_t)(row0 + ai * 128 + m * 16) * D + col0;
#pragma unroll
                for (int bj = 0; bj < 2; ++bj) { const u32x4 g = *(const u32x4*)(G + off + bj * 128);
                    f32x4 v0 = acc[ai][bj][m][0] * bf4lo(g), v1 = acc[ai][bj][m][1] * bf4hi(g);
                    if (second) { const u32x4 y = *(const u32x4*)(YA + off + bj * 128); v0 += bf4lo(y); v1 += bf4hi(y); }
                    *(u32x4*)(dst + off + bj * 128) = pack8(v0, v1); } }
    }
};
struct EpiMix {
    const float *x, *ADA; float* Z;
    __device__ __forceinline__ void operator()(EPI_ARGS) const {
        EPI_LAUNDER;
        const int row0 = u.pm * 256 + wr * 64 + fr, col0 = u.pn * 256 + wc * 32 + 8 * fq, b = (u.pm * 256) >> 13;
        f32x4 g[2][2];
#pragma unroll
        for (int bj = 0; bj < 2; ++bj)
#pragma unroll
            for (int n = 0; n < 2; ++n) g[bj][n] = *(const f32x4*)(ADA + b * 6144 + 2048 + col0 + bj * 128 + 4 * n) + 1.0f;
#pragma unroll
        for (int ai = 0; ai < 2; ++ai)
#pragma unroll
            for (int m = 0; m < 4; ++m) { const size_t off = (size_t)(row0 + ai * 128 + m * 16) * D + col0;
#pragma unroll
                for (int bj = 0; bj < 2; ++bj)
#pragma unroll
                    for (int n = 0; n < 2; ++n) { const f32x4 xv = *(const f32x4*)(x + off + bj * 128 + 4 * n); *(f32x4*)(Z + off + bj * 128 + 4 * n) = xv * ALPHA + g[bj][n] * acc[ai][bj][m][n]; } }
    }
};
struct SchedOne {
    static constexpr bool GATHER = false, BREG = false, AUX = false, DYN = false; static constexpr int VAR = 0;
    __device__ __forceinline__ unsigned b_row_bytes() const { return 0u; }
    int c0, n, npn; const char *A, *B;
    __device__ __forceinline__ bool next(int i, pg8::Unit& u) const { const int L = (int)blockIdx.x - c0; if (i != 0 || L < 0 || L >= n) return false; const int pm = L / npn, pn = L % npn;
        u.pm = pm; u.pn = pn; u.e = 0; u.p0 = 0; u.ne = 0; u.bs = 0; u.hf = 0; u.B2 = nullptr; u.A = A + (size_t)pm * 256 * 2048; u.B = B + (size_t)pn * 256 * 2048; return true; }
    __device__ __forceinline__ unsigned a_row_off(const pg8::Unit&, int r) const { return (unsigned)r * 2048u; }
};
struct SchedRouter : SchedOne { static constexpr bool F16 = true; };
struct SchedShared : SchedOne { static constexpr bool F16 = false; };
struct EpiRouter {
    float* RL;
    __device__ __forceinline__ void operator()(EPI_ARGS) const {
        EPI_LAUNDER;
        const int row0 = u.pm * 256 + wr * 64 + fr, cin = wc * 32 + 8 * fq;
#pragma unroll
        for (int ai = 0; ai < 2; ++ai)
#pragma unroll
            for (int m = 0; m < 4; ++m) { float* rp = RL + (size_t)(row0 + ai * 128 + m * 16) * NE + cin;
#pragma unroll
                for (int bj = 0; bj < 2; ++bj)
#pragma unroll
                    for (int n = 0; n < 2; ++n) *(f32x4*)(rp + bj * 128 + 4 * n) = acc[ai][bj][m][n]; }
    }
};
struct EpiShared {
    bf16_t* SHID;
    __device__ __forceinline__ void operator()(EPI_ARGS) const {
        EPI_LAUNDER;
        const int row0 = u.pm * 256 + wr * 64 + fr, cin = wc * 32 + 8 * fq;
#pragma unroll
        for (int ai = 0; ai < 2; ++ai)
#pragma unroll
            for (int m = 0; m < 4; ++m) { const f32x4 g0 = acc[ai][0][m][0], g1 = acc[ai][0][m][1], u0 = acc[ai][1][m][0], u1 = acc[ai][1][m][1]; f32x4 h0, h1;
#pragma unroll
                for (int j = 0; j < 4; ++j) { h0[j] = g0[j] * pg8::fsigmoid(g0[j]) * u0[j]; h1[j] = g1[j] * pg8::fsigmoid(g1[j]) * u1[j]; }
                *(u32x4*)(SHID + (size_t)(row0 + ai * 128 + m * 16) * SHH + 128 * u.pn + cin) = pack8(h0, h1); }
    }
};
constexpr int INPROJ_STATIC_TILES = 12, INPROJ_FILLER_UNITS = (NINW / 256 - INPROJ_STATIC_TILES) * (T / 256);
__device__ __forceinline__ void ph_inproj_fast(Frame& F) {
    F.lane = ltid(); F.tid = F.wave * 64 + F.lane;
    SchedPlain S; S.o.init(T / 256, INPROJ_STATIC_TILES, gridDim.x, blockIdx.x); S.A = (const char*)F.H; S.B = (const char*)(F.ws + WS_WIN_T); S.arow = 2048; S.brow = 2048;
    EpiInProj E{F.U, F.Q, F.GA, F.ctl + CW_NORM};
    static_assert(WS_K - WS_Q == 16 * MiB && WS_V - WS_K == 16 * MiB && WS_GB - WS_GA == 32 * MiB, "EpiInProj destination arithmetic");
    pg8::gemm_phase<EpiInProj, SchedPlain, true>(F.lds, D, D, D, S, E);
}
struct EpiInProjOff { bf16_t *U, *Q, *GA; unsigned* NORM;
    __device__ __forceinline__ void operator()(EPI_ARGS) const { pg8::Unit v = u; v.pn = u.pn + INPROJ_STATIC_TILES; EpiInProj E{U, Q, GA, NORM}; E(acc, v, wr, wc, fr, fq, xt); } };
struct SchedInProjDyn {
    static constexpr bool GATHER = false, BREG = false, AUX = false, DYN = true, F16 = false; static constexpr int VAR = 0;
    static constexpr int NT_ = NINW / 256 - INPROJ_STATIC_TILES, PER_X = 8 * NT_;
    __device__ __forceinline__ unsigned b_row_bytes() const { return 0u; }
    unsigned* qhead; volatile LAS unsigned* mb; const char* A; const char* B; int x;
    __device__ __forceinline__ void fetch(int k) const { if (threadIdx.x == 0) mb[k & 3] = __hip_atomic_fetch_add(qhead + 64 * x, 1u, __ATOMIC_RELAXED, __HIP_MEMORY_SCOPE_AGENT); }
    __device__ __forceinline__ bool next(int i, pg8::Unit& u) const { const unsigned idx = (unsigned)__builtin_amdgcn_readfirstlane((int)mb[i & 3]); if (idx >= (unsigned)PER_X) return false;
        const int pm = 8 * x + (int)(idx & 7), pn = (int)(idx >> 3);
        u.pm = pm; u.pn = pn; u.e = 0; u.p0 = 0; u.ne = 0; u.bs = 0; u.hf = 0; u.B2 = nullptr; u.A = A + (size_t)pm * 256 * 2048; u.B = B + (size_t)pn * 256 * 2048; return true; }
    __device__ __forceinline__ unsigned a_row_off(const pg8::Unit&, int r) const { return (unsigned)r * 2048u; }
};
__device__ __forceinline__ void ph_inproj_filler(Frame& F) {
    F.lane = ltid(); F.tid = F.wave * 64 + F.lane;
    SchedInProjDyn S{F.ctl + CW_FQ, (volatile LAS unsigned*)(F.lds + MISC_OFF + 96), (const char*)F.H, (const char*)(F.ws + WS_WIN_T) + (size_t)INPROJ_STATIC_TILES * 256 * 2048, (int)(blockIdx.x & 7)};
    EpiInProjOff E{F.U, F.Q, F.GA, F.ctl + CW_NORM};
    pg8::gemm_phase<EpiInProjOff, SchedInProjDyn, true>(F.lds, D, D, D, S, E);
}
__device__ __forceinline__ void ph_merge_fast(Frame& F) {
    F.lane = ltid(); F.tid = F.wave * 64 + F.lane;
    SchedMerge S; S.o.init(T / 256, D / 256, gridDim.x, blockIdx.x); S.AC = (const char*)F.AC; S.O = (const char*)F.O; S.WC = (const char*)(F.ws + WS_WC_T); S.WF = (const char*)(F.ws + WS_WF_T);
    EpiMerge E{F.GA, F.GB, F.YA, F.MG};
    pg8::gemm_phase<EpiMerge, SchedMerge, true>(F.lds, CC, CC, CC, S, E);
}
__device__ __forceinline__ void ph_mix_fast(Frame& F) {
    F.lane = ltid(); F.tid = F.wave * 64 + F.lane;
    SchedPlain S; S.o.init(T / 256, D / 256, gridDim.x, blockIdx.x); S.A = (const char*)F.MG; S.B = (const char*)(F.ws + WS_WMIX_T); S.arow = 2048; S.brow = 2048;
    EpiMix E{F.x, F.ADA, F.X1};
    pg8::gemm_phase<EpiMix, SchedPlain, true>(F.lds, D, D, D, S, E);
}
__device__ __forceinline__ void ph_router_fast(Frame& F) {
    F.lane = ltid(); F.tid = F.wave * 64 + F.lane;
    { SchedRouter S; S.c0 = 0; S.n = T / 256; S.npn = 1; S.A = (const char*)F.H2LO  ; S.B = (const char*)(F.ws + WS_WR_HI);
      EpiRouter E{F.RL};
      pg8::gemm_phase<EpiRouter, SchedRouter, true>(F.lds, D, D, D, S, E); }
    { SchedShared S; S.c0 = T / 256; S.n = 2 * (T / 256); S.npn = 2; S.A = (const char*)F.H2; S.B = (const char*)(F.ws + WS_WSHGU_T);
      EpiShared E{F.SHID};
      pg8::gemm_phase<EpiShared, SchedShared, true>(F.lds, D, D, D, S, E); }
}

constexpr int EMAP_OFF = 131072 + 1024;
template <int NCT> __device__ __forceinline__ bool expert_unit(int i, int G, int c, int nunits, const LAS int* pref, int& e, int& ct, int& ch) {
    const int gs = G >> 3, x = c / gs, s = c - x * gs, per = (nunits + 7) >> 3, q = i * gs + s; if (q >= per) return false;
    const int P = x * per + q; if (P >= nunits) return false;
    e = __builtin_amdgcn_readfirstlane(find_expert(pref, P / NCT));
    const int p0 = __builtin_amdgcn_readfirstlane(pref[e]), nch = __builtin_amdgcn_readfirstlane(pref[e + 1]) - p0, r = P - NCT * p0;
    ct = r / nch; ch = r - ct * nch; return true;
}
template <int VARIANT = 0> struct SchedMoe1T {
    static constexpr bool GATHER = true, BREG = true, AUX = false, DYN = false, F16 = false; static constexpr int VAR = VARIANT;
    int G, c, nunits; const LAS int* pref; const LAS int* base; const char* H2; const char* WG; const char* WU; const int* LIST;
    __device__ __forceinline__ unsigned b_row_bytes() const { return EH * 4u; }
    __device__ __forceinline__ bool next(int i, pg8::Unit& u) const { int e, ct, ch; if (!expert_unit<2>(i, G, c, nunits, pref, e, ct, ch)) return false;
        u.pm = 0; u.pn = ct; u.e = e; u.p0 = ch * 256; u.bs = __builtin_amdgcn_readfirstlane(base[e]); u.ne = __builtin_amdgcn_readfirstlane(base[e + 1]) - u.bs; u.hf = (u.ne - u.p0) <= 128;
        const int ew = VARIANT == 1 ? (e & 7) : e;
        u.A = H2; u.B = WG + ((size_t)ew * D * EH + 128 * ct) * 4; u.B2 = WU + ((size_t)ew * D * EH + 128 * ct) * 4; return true; }
    __device__ __forceinline__ unsigned a_row_off(const pg8::Unit& u, int r) const { int p = u.p0 + r; p = p < u.ne ? p : u.ne - 1;
        if (VARIANT == 2) return (unsigned)((u.bs + p) & (T - 1)) * 2048u;
        return (unsigned)(LIST[(size_t)u.e * LCAP + p] >> 3) * 2048u; }
};
typedef SchedMoe1T<0> SchedMoe1;
struct EpiMoe1 {
    bf16_t* HID;
    __device__ __forceinline__ void operator()(EPI_ARGS) const {
        EPI_LAUNDER;
        const int r0 = wr * 64 + fr, cin = wc * 32 + 8 * fq;
#pragma unroll
        for (int ai = 0; ai < 2; ++ai)
#pragma unroll
            for (int m = 0; m < 4; ++m) { const int p = u.p0 + r0 + ai * 128 + m * 16;
                const f32x4 g0 = acc[ai][0][m][0], g1 = acc[ai][0][m][1], u0 = acc[ai][1][m][0], u1 = acc[ai][1][m][1]; f32x4 h0, h1;
#pragma unroll
                for (int j = 0; j < 4; ++j) { h0[j] = g0[j] * pg8::fsigmoid(g0[j]) * u0[j]; h1[j] = g1[j] * pg8::fsigmoid(g1[j]) * u1[j]; }
                if (p < u.ne) *(u32x4*)(HID + (size_t)(u.bs + p) * EH + 128 * u.pn + cin) = pack8(h0, h1); }
    }
};
struct SchedMoe2 {
    static constexpr bool GATHER = true, BREG = true, AUX = true, DYN = false, F16 = false; static constexpr int VAR = 0;
    int G, c, nunits; const LAS int* pref; const LAS int* base; const char* HID; const char* WD; const int* LIST; const float* LISTW;
    __device__ __forceinline__ void row_aux(const pg8::Unit& u, int r, unsigned& x0, unsigned& x1) const { const int p = u.p0 + r; x0 = ~0u; x1 = 0u;
        if (p < u.ne) { const int as = LIST[(size_t)u.e * LCAP + p]; x0 = (unsigned)((as >> 3) * NSLOT + (as & 7)); x1 = __float_as_uint(LISTW[(size_t)u.e * LCAP + p]); } }
    __device__ __forceinline__ unsigned b_row_bytes() const { return D * 4u; }
    __device__ __forceinline__ bool next(int i, pg8::Unit& u) const { int e, ct, ch; if (!expert_unit<4>(i, G, c, nunits, pref, e, ct, ch)) return false;
        u.pm = 0; u.pn = ct; u.e = e; u.p0 = ch * 256; u.bs = __builtin_amdgcn_readfirstlane(base[e]); u.ne = __builtin_amdgcn_readfirstlane(base[e + 1]) - u.bs; u.hf = (u.ne - u.p0) <= 128;
        u.A = HID + (size_t)(u.bs + u.p0) * 512; u.B = WD + ((size_t)e * EH * D + 256 * ct) * 4; u.B2 = u.B + 512; return true; }
    __device__ __forceinline__ unsigned a_row_off(const pg8::Unit& u, int r) const { const int lim = u.ne - 1 - u.p0; return (unsigned)(r < lim ? r : lim) * 512u; }
};
struct EpiMoe2 {
    bf16_t* YAS;
    __device__ __forceinline__ void operator()(EPI_ARGS) const {
        EPI_LAUNDER;
        const int r0 = wr * 64 + fr, col0 = u.pn * 256 + wc * 32 + 8 * fq;
#pragma unroll
        for (int ai = 0; ai < 2; ++ai)
#pragma unroll
            for (int m = 0; m < 4; ++m) { const int r = r0 + ai * 128 + m * 16; const u32x2 x = *(const LAS u32x2*)(xt + 2 * r);
                if (x.x != ~0u) { const float w = __uint_as_float(x.y); bf16_t* rowp = YAS + (size_t)x.x * D + col0;
#pragma unroll
                    for (int bj = 0; bj < 2; ++bj) *(u32x4*)(rowp + bj * 128) = pack8(acc[ai][bj][m][0] * w, acc[ai][bj][m][1] * w); }
                if (m & 1) asm volatile("" ::: "memory"); }
    }
};
struct EpiShDown {
    bf16_t* YAS;
    __device__ __forceinline__ void operator()(EPI_ARGS) const {
        EPI_LAUNDER;
        const int row0 = u.pm * 256 + wr * 64 + fr, col0 = u.pn * 256 + wc * 32 + 8 * fq;
#pragma unroll
        for (int ai = 0; ai < 2; ++ai)
#pragma unroll
            for (int m = 0; m < 4; ++m) { bf16_t* rowp = YAS + ((size_t)(row0 + ai * 128 + m * 16) * NSLOT + 8) * D + col0;
#pragma unroll
                for (int bj = 0; bj < 2; ++bj) *(u32x4*)(rowp + bj * 128) = pack8(acc[ai][bj][m][0], acc[ai][bj][m][1]); }
    }
};
template <int VARIANT> __device__ __forceinline__ void ph_moe1_experts(Frame& F, bf16_t* hid) {
    F.lane = ltid(); F.tid = F.wave * 64 + F.lane;
    LAS int* pref = (LAS int*)(F.lds + EMAP_OFF); LAS int* base = pref + 260;
    build_expert_map(F, pref, base, 256);
    SchedMoe1T<VARIANT> S{(int)gridDim.x, F.vid, __builtin_amdgcn_readfirstlane(pref[NE]) * 2, pref, base, (const char*)F.H2, (const char*)F.w_exp_gate, (const char*)F.w_exp_up, F.LIST};
    EpiMoe1 E{hid};
    pg8::gemm_phase<EpiMoe1, SchedMoe1T<VARIANT>, true>(F.lds, D, D, D, S, E);
}
__device__ __forceinline__ void ph_shdown(Frame& F) {
    F.lane = ltid(); F.tid = F.wave * 64 + F.lane;
    SchedPlain S; S.o.init(T / 256, D / 256, gridDim.x, blockIdx.x); S.A = (const char*)F.SHID; S.B = (const char*)(F.ws + WS_WSHD_T); S.arow = 512; S.brow = 512;
    EpiShDown E{F.YAS};
    pg8::gemm_phase<EpiShDown, SchedPlain, true>(F.lds, SHH, SHH, SHH, S, E);
}
__device__ __forceinline__ void ph_moe1_fast(Frame& F) { ph_moe1_experts<0>(F, F.HID); ph_shdown(F); }
__device__ __forceinline__ void ph_moe2_fast(Frame& F) {
    F.lane = ltid(); F.tid = F.wave * 64 + F.lane;
    LAS int* pref = (LAS int*)(F.lds + EMAP_OFF); LAS int* base = pref + 260;
    build_expert_map(F, pref, base, 256);
    SchedMoe2 S{(int)gridDim.x, F.vid, __builtin_amdgcn_readfirstlane(pref[NE]) * 4, pref, base, (const char*)F.HID, (const char*)F.w_exp_down, F.LIST, F.LISTW};
    EpiMoe2 E{F.YAS};
    pg8::gemm_phase<EpiMoe2, SchedMoe2, true>(F.lds, EH, EH, EH, S, E);
}

namespace attn_body {
using bf16=__hip_bfloat16;
using bf16x8=__attribute__((ext_vector_type(8)))short;
using s16x4=__attribute__((ext_vector_type(4)))short;
using f32x16=__attribute__((ext_vector_type(16)))float;
using u32x4=__attribute__((ext_vector_type(4)))unsigned;
using f32x4_t=__attribute__((ext_vector_type(4)))float;
constexpr int BATCH=2,NHEAD=8,SEQ=8192,D=64,DM=NHEAD*D;
constexpr int NW=8,QBLK=32,QB=QBLK*NW,KVBLK=64,NQB=SEQ/QB;
constexpr int ATTN_PITCH=DM, ATTN_UNIT_ROWS=QB;
__device__ __forceinline__ int crow(int r,int hi){return (r&3)+8*(r>>2)+4*hi;}
#define SBAR() __builtin_amdgcn_sched_barrier(0)
__device__ __forceinline__ void cmask(f32x16&p0,f32x16&p1,int jb,int qrel,int hi){
  const float NEG=-INFINITY; int kb=64*jb+4*hi;
  #pragma unroll
  for(int r=0;r<16;++r){int kv=kb+(r&3)+8*(r>>2); if(kv>qrel)p0[r]=NEG; if(kv+32>qrel)p1[r]=NEG;}
}

constexpr int NSLOT=3, SLOTB=8192;
constexpr int LDS_K=0, LDS_V=NSLOT*SLOTB, LDS_WS=2*NSLOT*SLOTB, LDS_OST=LDS_WS+NW*64*4, LDS_NB=LDS_OST+NW*4096, LDS_BYTES=LDS_NB+SEQ*4;
constexpr float C2=0.125f*1.4426950408889634f;
__device__ __forceinline__ void glds16(const void*gsrc,unsigned lds_dst){unsigned keep;
  asm volatile("s_mov_b32 %0, m0\n\ts_mov_b32 m0, %2\n\ts_nop 0\n\tglobal_load_lds_dwordx4 %1, off\n\ts_mov_b32 m0, %0":"=&s"(keep):"v"(gsrc),"s"(lds_dst):"memory");}
__device__ __forceinline__ float max3f(float a,float b,float c){float r;asm("v_max3_f32 %0, %1, %2, %3":"=v"(r):"v"(a),"v"(b),"v"(c));return r;}
__device__ __forceinline__ float max2f(float a,float b){float r;asm("v_max_f32_e32 %0, %1, %2":"=v"(r):"v"(a),"v"(b));return r;}
__device__ __forceinline__ float fadd_s(float a,float b){float r;asm("v_add_f32_e32 %0, %1, %2":"=v"(r):"v"(a),"v"(b));return r;}
__device__ __forceinline__ float fsub_s(float a,float b){float r;asm("v_sub_f32_e32 %0, %1, %2":"=v"(r):"v"(a),"v"(b));return r;}
typedef float f32x2_t __attribute__((ext_vector_type(2))); typedef __bf16 bf16x2_t __attribute__((ext_vector_type(2)));
__device__ __forceinline__ unsigned cvtpk_s(float lo,float hi){f32x2_t v={lo,hi};bf16x2_t b=__builtin_convertvector(v,bf16x2_t);return __builtin_bit_cast(unsigned,b);}
#define WAIT_BAR(N) asm volatile("s_waitcnt vmcnt(" #N ") lgkmcnt(0)\n\ts_barrier":::"memory")

__device__ __forceinline__ void qkt(f32x16&p0,f32x16&p1,const char*Kslot,const bf16x8*qr,int r32,int hi){
  const char*kb=Kslot+hi*1024+r32*16;
  #pragma unroll
  for(int d0=0;d0<4;++d0){
    const bf16x8 b0=*reinterpret_cast<const bf16x8*>(kb+d0*2048);
    const bf16x8 b1=*reinterpret_cast<const bf16x8*>(kb+d0*2048+512);
    {p0=__builtin_amdgcn_mfma_f32_32x32x16_bf16(b0,qr[d0],p0,0,0,0);p1=__builtin_amdgcn_mfma_f32_32x32x16_bf16(b1,qr[d0],p1,0,0,0);}}
}
typedef __attribute__((address_space(3))) const char* lds_cptr;
typedef short v4i16_t __attribute__((ext_vector_type(4)));
__device__ __forceinline__ void kload8(bf16x8*kf,lds_cptr kp){
  kf[0]=*(const __attribute__((address_space(3))) bf16x8*)(kp);      kf[1]=*(const __attribute__((address_space(3))) bf16x8*)(kp+512);
  kf[2]=*(const __attribute__((address_space(3))) bf16x8*)(kp+2048); kf[3]=*(const __attribute__((address_space(3))) bf16x8*)(kp+2560);
  kf[4]=*(const __attribute__((address_space(3))) bf16x8*)(kp+4096); kf[5]=*(const __attribute__((address_space(3))) bf16x8*)(kp+4608);
  kf[6]=*(const __attribute__((address_space(3))) bf16x8*)(kp+6144); kf[7]=*(const __attribute__((address_space(3))) bf16x8*)(kp+6656);
}
__device__ __forceinline__ void kload2(bf16x8*kf,lds_cptr kp,int j){ kf[2*j]=*(const __attribute__((address_space(3))) bf16x8*)(kp+j*2048); kf[2*j+1]=*(const __attribute__((address_space(3))) bf16x8*)(kp+j*2048+512); }
__device__ __forceinline__ s16x4 vtr(lds_cptr p){ return __builtin_bit_cast(s16x4,__builtin_amdgcn_ds_read_tr16_b64_v4i16((__attribute__((address_space(3))) v4i16_t*)p)); }
__device__ __forceinline__ float rowmax(const f32x16&p0,const f32x16&p1){
  float a=max3f(p0[0],p0[1],p1[0]),b=max3f(p0[2],p0[3],p1[1]);a=max3f(a,p1[2],p1[3]);
  #pragma unroll
  for(int r=4;r<16;r+=4){a=max3f(a,p0[r],p0[r+1]);b=max3f(b,p0[r+2],p0[r+3]);a=max3f(a,p1[r],p1[r+1]);b=max3f(b,p1[r+2],p1[r+3]);}
  const float m=max2f(a,b);
  auto rr=__builtin_amdgcn_permlane32_swap(__float_as_uint(m),__float_as_uint(m),false,false);
  return max2f(__uint_as_float(rr[0]),__uint_as_float(rr[1]));
}
__device__ __forceinline__ void pv(f32x16*o,int vb,bf16x8 pa0,bf16x8 pa1,bf16x8 pa2,bf16x8 pa3){
  #pragma unroll
  for(int d0=0;d0<2;++d0){s16x4 lo[4],hi[4];
    #pragma unroll
    for(int ks=0;ks<4;++ks){
      asm volatile("ds_read_b64_tr_b16 %0,%1 offset:%c2":"=&v"(lo[ks]):"v"(vb),"i"(d0*4096+ks*1024):"memory");
      asm volatile("ds_read_b64_tr_b16 %0,%1 offset:%c2":"=&v"(hi[ks]):"v"(vb),"i"(d0*4096+ks*1024+512):"memory");}
    asm volatile("s_waitcnt lgkmcnt(0)":::"memory");SBAR();
    #define PK(k) (bf16x8){lo[k][0],lo[k][1],lo[k][2],lo[k][3],hi[k][0],hi[k][1],hi[k][2],hi[k][3]}
    o[d0]=__builtin_amdgcn_mfma_f32_32x32x16_bf16(pa0,PK(0),o[d0],0,0,0);
    o[d0]=__builtin_amdgcn_mfma_f32_32x32x16_bf16(pa1,PK(1),o[d0],0,0,0);
    o[d0]=__builtin_amdgcn_mfma_f32_32x32x16_bf16(pa2,PK(2),o[d0],0,0,0);
    o[d0]=__builtin_amdgcn_mfma_f32_32x32x16_bf16(pa3,PK(3),o[d0],0,0,0);
    #undef PK
  }
}

#ifndef ATTN_STORE16
#define ATTN_STORE16(p,v) (*(u32x4*)(p)=(v))
#endif
template<int THRL> __device__ __forceinline__ void attn_unit(int b,int h,int qb,const bf16*Q,const bf16*__restrict__ K,const bf16*__restrict__ V,bf16*O,char*shm,const float*__restrict__ cum,float skip_thr){
  const int tid=threadIdx.x,lane=tid&63,r32=lane&31,hi=lane>>5; const int wid=__builtin_amdgcn_readfirstlane(tid>>6);
  const long rowbase=(long)b*SEQ; const int q0=qb*QB;
  const bf16*Qw=Q+(rowbase+q0+wid*QBLK)*DM+h*D;
  const bf16*Kh=K+rowbase*DM+h*D,*Vh=V+rowbase*DM+h*D;
  const unsigned lds0=(unsigned)(uintptr_t)shm;
  float*wsf=(float*)(shm+LDS_WS)+wid*64;
  const bf16*ksrc=Kh+(long)lane*DM+wid*8;
  const bf16*vsrc=Vh+(long)(16*(wid&3)+(lane>>2))*DM+(wid>>2)*32+(lane&3)*8;
  const unsigned kdst=lds0+LDS_K+wid*1024, vdst=lds0+LDS_V+wid*1024;
  #define DMA_K(t,slot) glds16(ksrc+(long)(NTF-1-(t))*KVBLK*DM,(unsigned)__builtin_amdgcn_readfirstlane(kdst+(slot)))
  #define DMA_V(t,slot) glds16(vsrc+(long)(NTF-1-(t))*KVBLK*DM,(unsigned)__builtin_amdgcn_readfirstlane(vdst+(slot)))
  const int vb0=(int)(lds0+LDS_V)+((lane>>4)&1)*32+(lane&3)*8+(4*hi+((lane&15)>>2))*64;
  const char*Kbase=shm+LDS_K; bf16x8 kf[8];
  const lds_cptr shm3=(lds_cptr)shm; const lds_cptr kp0=shm3+LDS_K+hi*1024+r32*16; const lds_cptr vp0=shm3+LDS_V+((lane>>4)&1)*32+(lane&3)*8+(4*hi+((lane&15)>>2))*64;
  const int NTF=(q0+QB)/KVBLK;
  const float F0=cum[q0]; int nskip;
  { const int j0=lane,j1=lane+64; bool s0=false,s1=false;
    if(j0<NTF-4) s0=(F0-cum[64*j0+63])*1.4426950408889634f < -skip_thr;
    if(j1<NTF-4) s1=(F0-cum[64*j1+63])*1.4426950408889634f < -skip_thr;
    const unsigned long long m0=__ballot(s0),m1=__ballot(s1);
    nskip=(m0==~0ull)?64+(int)__builtin_ctzll(~m1|(1ull<<63)):(int)__builtin_ctzll(~m0); nskip&=~1; nskip=__builtin_amdgcn_readfirstlane(nskip); }
  const int NT=NTF-nskip, sbase=64*nskip;
  typedef __attribute__((address_space(3))) float* lds_fptr; const lds_fptr nbL=(lds_fptr)(__attribute__((address_space(3))) char*)shm+LDS_NB/4;
  for(int i4=tid*4;i4<q0+QB-sbase;i4+=NW*64*4){ const f32x4_t c4=*reinterpret_cast<const f32x4_t*>(cum+sbase+i4); f32x4_t n4; n4[0]=(F0-c4[0])*1.4426950408889634f; n4[1]=(F0-c4[1])*1.4426950408889634f; n4[2]=(F0-c4[2])*1.4426950408889634f; n4[3]=(F0-c4[3])*1.4426950408889634f; *(__attribute__((address_space(3))) f32x4_t*)(nbL+i4)=n4; }
  asm volatile("s_waitcnt vmcnt(0) lgkmcnt(0)\n\ts_barrier":::"memory");
  DMA_K(0,0);DMA_V(0,0);DMA_K(1,SLOTB);
  bf16x8 qr[4];
  #pragma unroll
  for(int d0=0;d0<4;++d0)qr[d0]=*reinterpret_cast<const bf16x8*>(&Qw[(long)r32*DM+d0*16+hi*8]);
  float l_reg=0.f;f32x16 o[2];o[0]=f32x16{};o[1]=f32x16{};
  const int qrel=wid*QBLK+r32;
  float mhat=nbL[q0-sbase+qrel];
  #define NBRD(X0,X1,i) do{ const lds_fptr nb_=nbL+(64*(NT-1-(i))+4*hi); _Pragma("unroll") for(int g_=0;g_<4;++g_){ const f32x4_t a_=*(const __attribute__((address_space(3))) f32x4_t*)(nb_+8*g_); const f32x4_t b_=*(const __attribute__((address_space(3))) f32x4_t*)(nb_+8*g_+32); \
      X0[4*g_]=a_[0];X0[4*g_+1]=a_[1];X0[4*g_+2]=a_[2];X0[4*g_+3]=a_[3]; X1[4*g_]=b_[0];X1[4*g_+1]=b_[1];X1[4*g_+2]=b_[2];X1[4*g_+3]=b_[3]; } }while(0)
  #define NBSUB(X0,X1) do{ _Pragma("unroll") for(int r=0;r<16;++r){X0[r]-=mhat;X1[r]-=mhat;} }while(0)
  #define CMASK(P0,P1,t) do{int jb_=3-(t); if(jb_>=0)cmask(P0,P1,jb_,qrel,hi);}while(0)
  bool resc=false;
  #define START(P0,P1) do{ const float rm=rowmax(P0,P1); resc=false; \
    { const float dl=max2f(rm,0.f); mhat=fadd_s(mhat,dl); \
      _Pragma("unroll") for(int r=0;r<16;++r){P0[r]=fsub_s(P0[r],dl);P1[r]=fsub_s(P1[r],dl);} } \
    _Pragma("unroll") for(int r=0;r<16;++r)P0[r]=__builtin_amdgcn_exp2f(P0[r]); }while(0)
  #define RESC() do{ if(resc){ asm volatile("s_waitcnt lgkmcnt(0)":::"memory"); \
      _Pragma("unroll") for(int d_=0;d_<2;++d_) _Pragma("unroll") for(int r=0;r<16;++r)o[d_][r]*=wsf[crow(r,hi)]; } }while(0)
  f32x16 pA0,pA1,pB0,pB1;
  int sl_prev=0,sl_cur=0,sl_next=SLOTB;
  #define ROT() do{sl_prev=sl_cur;sl_cur=sl_next;sl_next=(sl_next==(NSLOT-1)*SLOTB)?0:sl_next+SLOTB;}while(0)
  DMA_K(2,2*SLOTB);
  WAIT_BAR(3);
  NBRD(pA0,pA1,0); NBSUB(pA0,pA1);
  qkt(pA0,pA1,Kbase,qr,r32,hi);asm volatile("s_nop 15\n\ts_nop 7":"+v"(pA0),"+v"(pA1));CMASK(pA0,pA1,0);
  START(pA0,pA1);
  _Pragma("unroll") for(int r=0;r<16;++r)pA1[r]=__builtin_amdgcn_exp2f(pA1[r]);
  NBRD(pB0,pB1,1);
  WAIT_BAR(0);
  DMA_K(3,0);DMA_V(1,SLOTB);
  ROT();
  kload8(kf,kp0+sl_cur);
  WAIT_BAR(2);
  s16x4 vlo[8],vhi[8]; u32x4 pw0,pw1,pw2,pw3;
  #define PKW(P,B) cvtpk_s(P[B],P[B+1])
  #define PAF(k) __builtin_bit_cast(bf16x8,pw##k)
  #define VFR(i) (bf16x8){vlo[i][0],vlo[i][1],vlo[i][2],vlo[i][3],vhi[i][0],vhi[i][1],vhi[i][2],vhi[i][3]}
  #define PIN(x) asm volatile("":"+v"(x))
  #define MX3(a,b,c) __builtin_fmaxf(__builtin_fmaxf((a),(b)),(c))
  #define GAPA(MF,A0,A1,A2,A3,W0,W1,PW) do{ MF; sacc+=A0; sacc+=A1; sacc+=A2; sacc+=A3; PIN(sacc); W0; W1; PIN(PW); SBAR(); }while(0)
  #define EX(v) __builtin_amdgcn_exp2f(v)
  #define GAPB(MF,X,B) do{ MF; X[B]=EX(X[B]); X[B+1]=EX(X[B+1]); X[B+2]=EX(X[B+2]); X[B+3]=EX(X[B+3]); PIN(X); SBAR(); }while(0)
  #define VRD(i) do{ vlo[i]=vtr(vp_+(((i)>>2)*4096+((i)&3)*1024)); vhi[i]=vtr(vp_+(((i)>>2)*4096+((i)&3)*1024+512)); }while(0)
  #define KRD(G,j) do{ if(G){ kload2(kf,kp0+sl_next,j); SBAR(); } }while(0)
  #define STEP(C0,C1,P0,P1,t,GK,GV,GL) do{ SBAR(); NBSUB(C0,C1); \
    const lds_cptr vp_=vp0+sl_prev; \
    VRD(0); SBAR(); float sacc=(P0[0]+P0[1]); \
    GAPA(C0=__builtin_amdgcn_mfma_f32_32x32x16_bf16(kf[0],qr[0],C0,0,0,0), P0[2],P0[3],P0[4],P0[5],     pw0[0]=PKW(P0,0), pw0[1]=PKW(P0,2), pw0); \
    VRD(4); SBAR(); GAPA(C1=__builtin_amdgcn_mfma_f32_32x32x16_bf16(kf[1],qr[0],C1,0,0,0), P0[6],P0[7],P0[8],P0[9],     pw0[2]=PKW(P0,4), pw0[3]=PKW(P0,6), pw0); \
    VRD(1); SBAR(); GAPA(C0=__builtin_amdgcn_mfma_f32_32x32x16_bf16(kf[2],qr[1],C0,0,0,0),   P0[10],P0[11],P0[12],P0[13], pw1[0]=PKW(P0,8), pw1[1]=PKW(P0,10), pw1); \
    VRD(5); SBAR(); GAPA(C1=__builtin_amdgcn_mfma_f32_32x32x16_bf16(kf[3],qr[1],C1,0,0,0),   P0[14],P0[15],P1[0],P1[1],   pw1[2]=PKW(P0,12),pw1[3]=PKW(P0,14), pw1); \
    VRD(2); SBAR(); GAPA(C0=__builtin_amdgcn_mfma_f32_32x32x16_bf16(kf[4],qr[2],C0,0,0,0),   P1[2],P1[3],P1[4],P1[5],     pw2[0]=PKW(P1,0), pw2[1]=PKW(P1,2), pw2); \
    VRD(6); SBAR(); GAPA(C1=__builtin_amdgcn_mfma_f32_32x32x16_bf16(kf[5],qr[2],C1,0,0,0),   P1[6],P1[7],P1[8],P1[9],     pw2[2]=PKW(P1,4), pw2[3]=PKW(P1,6), pw2); \
    VRD(3); SBAR(); GAPA(C0=__builtin_amdgcn_mfma_f32_32x32x16_bf16(kf[6],qr[3],C0,0,0,0),   P1[10],P1[11],P1[12],P1[13], pw3[0]=PKW(P1,8), pw3[1]=PKW(P1,10), pw3); \
    VRD(7); SBAR(); GAPA(C1=__builtin_amdgcn_mfma_f32_32x32x16_bf16(kf[7],qr[3],C1,0,0,0),   P1[14],P1[15],0.f,0.f,       pw3[2]=PKW(P1,12),pw3[3]=PKW(P1,14), pw3); \
    l_reg+=sacc; \
    if(GK){DMA_K((t)+3,sl_cur);} if(GV){DMA_V((t)+1,sl_next);} \
    CMASK(C0,C1,t); \
    { float a=MX3(C0[0],C0[1],C1[0]),b=MX3(C0[2],C0[3],C1[1]); a=MX3(a,C1[2],C1[3]); \
      _Pragma("unroll") for(int r=4;r<16;r+=4){a=MX3(a,C0[r],C0[r+1]);b=MX3(b,C0[r+2],C0[r+3]);a=MX3(a,C1[r],C1[r+1]);b=MX3(b,C1[r+2],C1[r+3]);} \
      float rm=__builtin_fmaxf(a,b); { auto rr=__builtin_amdgcn_permlane32_swap(__float_as_uint(rm),__float_as_uint(rm),false,false); rm=__builtin_fmaxf(__uint_as_float(rr[0]),__uint_as_float(rr[1])); } \
      resc=false; \
      if(__builtin_expect(__any(rm>(float)THRL),0)){ const float dl=__builtin_fmaxf(rm,0.f); mhat+=dl; \
        _Pragma("unroll") for(int r=0;r<16;++r){C0[r]-=dl;C1[r]-=dl;} \
        const float f=__builtin_amdgcn_exp2f(-dl); l_reg*=f; if(hi==0)wsf[r32]=f; resc=true; } } \
    SBAR(); \
    if(GL){ NBRD(P0,P1,(t)+1); SBAR(); } \
    GAPB(o[0]=__builtin_amdgcn_mfma_f32_32x32x16_bf16(PAF(0),VFR(0),o[0],0,0,0), C0,0); \
    GAPB(o[1]=__builtin_amdgcn_mfma_f32_32x32x16_bf16(PAF(0),VFR(4),o[1],0,0,0), C0,4); \
    KRD(GL,0); GAPB(o[0]=__builtin_amdgcn_mfma_f32_32x32x16_bf16(PAF(1),VFR(1),o[0],0,0,0), C0,8); \
    KRD(GL,1); GAPB(o[1]=__builtin_amdgcn_mfma_f32_32x32x16_bf16(PAF(1),VFR(5),o[1],0,0,0), C0,12); \
    KRD(GL,2); GAPB(o[0]=__builtin_amdgcn_mfma_f32_32x32x16_bf16(PAF(2),VFR(2),o[0],0,0,0), C1,0); \
    KRD(GL,3); GAPB(o[1]=__builtin_amdgcn_mfma_f32_32x32x16_bf16(PAF(2),VFR(6),o[1],0,0,0), C1,4); \
    GAPB(o[0]=__builtin_amdgcn_mfma_f32_32x32x16_bf16(PAF(3),VFR(3),o[0],0,0,0), C1,8); \
    GAPB(o[1]=__builtin_amdgcn_mfma_f32_32x32x16_bf16(PAF(3),VFR(7),o[1],0,0,0), C1,12); \
    }while(0)
  #define ENDW(tt) do{ if((tt)+3<NT){WAIT_BAR(2);} else if((tt)+2<NT){WAIT_BAR(1);} else {WAIT_BAR(0);} }while(0)
  int t=1;
  for(;t<=3&&t+1<NT;t+=2){
    STEP(pB0,pB1,pA0,pA1,t,(t+3<NT),(t+1<NT),(t+1<NT));       ENDW(t);   RESC(); ROT();
    STEP(pA0,pA1,pB0,pB1,t+1,(t+4<NT),(t+2<NT),(t+2<NT));     ENDW(t+1); RESC(); ROT();
  }
  #undef CMASK
  #define CMASK(P0,P1,t) do{}while(0)
  for(;t+5<NT;t+=2){
    STEP(pB0,pB1,pA0,pA1,t,true,true,true);     WAIT_BAR(2); RESC(); ROT();
    STEP(pA0,pA1,pB0,pB1,t+1,true,true,true);   WAIT_BAR(2); RESC(); ROT();
  }
  for(;t+1<NT;t+=2){
    STEP(pB0,pB1,pA0,pA1,t,(t+3<NT),(t+1<NT),(t+1<NT));       ENDW(t);   RESC(); ROT();
    STEP(pA0,pA1,pB0,pB1,t+1,(t+4<NT),(t+2<NT),(t+2<NT));     ENDW(t+1); RESC(); ROT();
  }
  #undef CMASK
  #define CMASK(P0,P1,t) do{int jb_=3-(t); if(jb_>=0)cmask(P0,P1,jb_,qrel,hi);}while(0)
  STEP(pB0,pB1,pA0,pA1,NT-1,false,false,false); RESC();
  { float sacc=pB0[0]+pB0[1]; _Pragma("unroll") for(int r=2;r<16;++r)sacc+=pB0[r]; _Pragma("unroll") for(int r=0;r<16;++r)sacc+=pB1[r]; l_reg+=sacc;
    pw0=(u32x4){PKW(pB0,0),PKW(pB0,2),PKW(pB0,4),PKW(pB0,6)};pw1=(u32x4){PKW(pB0,8),PKW(pB0,10),PKW(pB0,12),PKW(pB0,14)};pw2=(u32x4){PKW(pB1,0),PKW(pB1,2),PKW(pB1,4),PKW(pB1,6)};pw3=(u32x4){PKW(pB1,8),PKW(pB1,10),PKW(pB1,12),PKW(pB1,14)};
    SBAR(); pv(o,vb0+sl_cur,PAF(0),PAF(1),PAF(2),PAF(3)); }
  #undef PKW
  #undef PAF
  #undef VFR
  #undef PIN
  #undef MX3
  #undef GAPA
  #undef GAPB
  #undef EX
  #undef VRD
  #undef KRD
  #undef STEP
  #undef ENDW
  {auto rr=__builtin_amdgcn_permlane32_swap(__float_as_uint(l_reg),__float_as_uint(l_reg),false,false);l_reg=__uint_as_float(rr[0])+__uint_as_float(rr[1]);}
  if(hi==0)wsf[32+r32]=l_reg;asm volatile("s_waitcnt lgkmcnt(0)":::"memory");
  float rli[16];
  #pragma unroll
  for(int r=0;r<16;++r)rli[r]=__builtin_amdgcn_rcpf(wsf[32+crow(r,hi)]);
  bf16*Ow=O+(rowbase+q0+wid*QBLK)*DM+h*D;
  { bf16*stg=(bf16*)(shm+LDS_OST)+wid*2048;
    #pragma unroll
    for(int r=0;r<16;++r){const int orow=crow(r,hi);
      #pragma unroll
      for(int d0=0;d0<2;++d0)stg[orow*64+d0*32+r32]=__float2bfloat16(o[d0][r]*rli[r]);}
    asm volatile("s_waitcnt lgkmcnt(0)":::"memory");
    #pragma unroll
    for(int i=0;i<4;++i){const int row=i*8+(lane>>3),ch=lane&7; const u32x4 v=*(const u32x4*)(stg+row*64+ch*8); ATTN_STORE16(Ow+(long)row*DM+ch*8,v);} }
  asm volatile("s_waitcnt lgkmcnt(0)\n\ts_barrier":::"memory");
  #undef DMA_K
  #undef DMA_V
  #undef CMASK
  #undef START
  #undef NBRD
  #undef NBSUB
  #undef RESC
  #undef ROT
}
constexpr int ATTN_LDS_BYTES=LDS_BYTES;
struct AttnTensors { const bf16* Q; const bf16* K; const bf16* V; bf16* O; const float* cum; };
struct AttnUnit { int bh; int qb; };
template<int THRL=8> __device__ __forceinline__ void attn_phase(char*lds,const AttnTensors&T,unsigned*qheads,const unsigned*norm,volatile __attribute__((address_space(3))) unsigned*bc){
  const int x=blockIdx.x&7;
  for(;;){
    if(threadIdx.x==0) bc[0]=__hip_atomic_fetch_add(qheads+64*x,1u,__ATOMIC_RELAXED,__HIP_MEMORY_SCOPE_AGENT);
    __syncthreads(); const unsigned idx=bc[0]; __syncthreads();
    if(idx>=64u) break;
    const int b=x>>2, h=(idx&1)?(x&3):7-(x&3), qb=31-(int)(idx>>1), bh=b*NHEAD+h;
    const float qn=(__uint_as_float(norm[(0*16+bh)*2])+__uint_as_float(norm[(0*16+bh)*2+1]))*1.02f, kn=(__uint_as_float(norm[(1*16+bh)*2])+__uint_as_float(norm[(1*16+bh)*2+1]))*1.02f;
    const float thr=2.0f*sqrtf(qn*kn)+160.0f;
    attn_unit<THRL>(b,h,qb,T.Q,T.K,T.V,T.O,lds,T.cum+(long)bh*SEQ,thr);
  }
}
#undef SBAR
#undef WAIT_BAR
}

__device__ __forceinline__ void ph_attn_fast(Frame& F) {
    F.lane = ltid(); F.tid = F.wave * 64 + F.lane;
    static_assert(attn_body::ATTN_LDS_BYTES <= 131072, "attention LDS");
    const attn_body::AttnTensors AT{(const attn_body::bf16*)F.Q, (const attn_body::bf16*)F.K, (const attn_body::bf16*)F.V, (attn_body::bf16*)F.O, F.CUM};
    attn_body::attn_phase<8>((char*)F.lds_generic, AT, F.ctl + CW_AQ, F.ctl + CW_NORM, (volatile LAS unsigned*)(F.lds + MISC_OFF + 64));
}

constexpr int NPHASE = 13;
#ifndef PROBE_PHASE
#define PROBE_PHASE -1
#endif
constexpr int N_LAUNCHES = 1;
__global__ void __launch_bounds__(NTHR, 2) fwd_kernel(Args args) {
    extern __shared__ __attribute__((aligned(16))) unsigned char lds_raw[];
    Frame F;
    F.lds = (LAS unsigned char*)lds_raw; F.lds_generic = lds_raw;
    F.tid = threadIdx.x; F.lane = F.tid & 63; F.wave = __builtin_amdgcn_readfirstlane(F.tid >> 6);
    F.gw = blockIdx.x * NWAVES + F.wave; F.NGW = gridDim.x * NWAVES;
    F.x = args.in[0]; F.c = args.in[1]; F.w_ada = args.in[2]; F.b_ada = args.in[3]; F.w_in = args.in[4]; F.b_forget = args.in[5]; F.conv_w = args.in[6]; F.conv_b = args.in[7];
    F.conv_ln_g = args.in[8]; F.conv_ln_b = args.in[9]; F.w_conv_out = args.in[10]; F.w_fox_out = args.in[11]; F.w_mix_out = args.in[12]; F.ln1_g = args.in[13]; F.ln1_b = args.in[14];
    F.w_router = args.in[15]; F.router_bias = args.in[16]; F.w_exp_gate = args.in[17]; F.w_exp_up = args.in[18]; F.w_exp_down = args.in[19]; F.w_sh_gate = args.in[20]; F.w_sh_up = args.in[21];
    F.w_sh_down = args.in[22]; F.ln2_g = args.in[23]; F.ln2_b = args.in[24];
    F.out = args.out; F.ws = args.ws; unsigned char* ws = args.ws;
    F.ctl = (unsigned*)(ws + WS_CTL);
    F.ADA = (float*)(ws + WS_ADA); F.ADAP = (float*)(ws + WS_ADAP); F.CUM = (float*)(ws + WS_CUM); F.LOGF = (float*)(ws + WS_LOGF); F.X1 = (float*)(ws + WS_X1); F.RL = (float*)(ws + WS_RL);
    F.LISTW = (float*)(ws + WS_LISTW); F.WFC = (float*)(ws + WS_WFC); F.STATS = (float*)(ws + WS_STATS); F.LIST = (int*)(ws + WS_LIST);
    F.H = (bf16_t*)(ws + WS_H); F.U = (bf16_t*)(ws + WS_U); F.Q = (bf16_t*)(ws + WS_Q); F.K = (bf16_t*)(ws + WS_K); F.V = (bf16_t*)(ws + WS_V); F.AC = (bf16_t*)(ws + WS_AC); F.O = (bf16_t*)(ws + WS_O);
    F.GA = (bf16_t*)(ws + WS_GA); F.GB = (bf16_t*)(ws + WS_GB); F.YA = (bf16_t*)(ws + WS_YA); F.MG = (bf16_t*)(ws + WS_MG); F.YAS = (bf16_t*)(ws + WS_YAS); F.H2 = (bf16_t*)(ws + WS_H2);
    F.H2LO = (bf16_t*)(ws + WS_H2LO); F.SHID = (bf16_t*)(ws + WS_SHID); F.HID = (bf16_t*)(ws + WS_HID);
    const int lo = args.ph_lo, hi = args.ph_hi;
    volatile LAS unsigned* MISC = (volatile LAS unsigned*)(F.lds + MISC_OFF);
    for (int u = F.tid; u < 32; u += NTHR) MISC[u] = 0u;
    __syncthreads();
    XcdBarrier bar; bar.bar = F.ctl + CW_BAR; bar.x = 0; bar.st = MISC + 8;
    if (hi - lo > 1) bar = xcd_barrier_post(F.ctl + CW_BAR, MISC + 8);
    F.vid = blockIdx.x;
#define IN(k) (lo <= (k) && (k) < hi)
#define SEAM(k) do { if (IN(k) && IN((k) + 1)) xcd_barrier(bar); } while (0)
    if (IN(0)) { { ph_ada(F); ph_convert(F); } if (PROBE_PHASE == 0) { __syncthreads(); { ph_ada(F); ph_convert(F); } } }
    SEAM(0);
    if (IN(0) && IN(1)) {
        if (F.tid == 0) { unsigned v = MISC[12]; for (unsigned j = 0; j < bar.x; ++j) v += xb_ld(&bar.bar[XB_XCNT(j)]); MISC[13] = v; }
        __syncthreads(); F.vid = __builtin_amdgcn_readfirstlane((int)MISC[13]); if (F.vid < 0 || F.vid >= (int)gridDim.x) F.vid = blockIdx.x; }
    if (IN(1)) { ph_lnmod(F); if (PROBE_PHASE == 1) { __syncthreads(); ph_lnmod(F); } }
    SEAM(1);
    if (IN(2)) { { ph_scan(F); ph_inproj_fast(F); } if (PROBE_PHASE == 2) { __syncthreads(); { ph_scan(F); ph_inproj_fast(F); } } }
    SEAM(2);
    if (IN(3)) { {} if (PROBE_PHASE == 3) { __syncthreads(); {} } }
    if (IN(4)) { for (int rep = 0; rep < (PROBE_PHASE == 40 ? 2 : 1); ++rep) { ph_attn_fast(F); __syncthreads(); if (PROBE_PHASE == 40 && rep == 0) { xcd_barrier(bar); if (blockIdx.x < 8 && F.tid == 0) __hip_atomic_store(F.ctl + CW_AQ + 64 * blockIdx.x, 0u, __ATOMIC_RELAXED, __HIP_MEMORY_SCOPE_AGENT); xcd_barrier(bar); } } ph_inproj_filler(F); __syncthreads();
        ph_conv(F, F.ctl + CW_VQ, (volatile LAS unsigned*)(F.lds + MISC_OFF + 64)); __syncthreads();
        ph_convert_filler(F, F.ctl + CW_CQ, (volatile LAS unsigned*)(F.lds + MISC_OFF + 64)); }
    SEAM(4);
    if (IN(5)) { ph_merge_fast(F); if (PROBE_PHASE == 5) { __syncthreads(); ph_merge_fast(F); } }
    SEAM(5);
    if (IN(6)) { ph_mix_fast(F); if (PROBE_PHASE == 6) { __syncthreads(); ph_mix_fast(F); } }
    SEAM(6);
    if (IN(7)) { ph_ln2(F); if (PROBE_PHASE == 7) { __syncthreads(); ph_ln2(F, true); } }
    SEAM(7);
    if (IN(8)) { ph_router_fast(F); if (PROBE_PHASE == 8) { __syncthreads(); ph_router_fast(F); } }
    SEAM(8);
    if (IN(9)) { ph_route(F, 1); if (PROBE_PHASE == 9) { __syncthreads(); ph_route(F, 1, true); } }
    SEAM(9);
    if (IN(10)) { ph_moe1_fast(F); if (PROBE_PHASE == 10) { __syncthreads(); ph_moe1_fast(F); }
        if (PROBE_PHASE == 100) { __syncthreads(); ph_moe1_experts<0>(F, (bf16_t*)(F.ws + WS_WEGU_T)); } if (PROBE_PHASE == 101) { __syncthreads(); ph_moe1_experts<1>(F, (bf16_t*)(F.ws + WS_WEGU_T)); }
        if (PROBE_PHASE == 102) { __syncthreads(); ph_moe1_experts<2>(F, (bf16_t*)(F.ws + WS_WEGU_T)); }
        if (PROBE_PHASE == 103) { __syncthreads(); ph_moe1_experts<3>(F, (bf16_t*)(F.ws + WS_WEGU_T)); } if (PROBE_PHASE == 104) { __syncthreads(); ph_moe1_experts<4>(F, (bf16_t*)(F.ws + WS_WEGU_T)); } }
    SEAM(10);
    if (IN(11)) { ph_moe2_fast(F); if (PROBE_PHASE == 11) { __syncthreads(); ph_moe2_fast(F); } }
    SEAM(11);
    if (IN(12)) { ph_combine(F); if (PROBE_PHASE == 12) { __syncthreads(); ph_combine(F); } }
#undef IN
#undef SEAM
}

extern "C" void kernel_launch(void* const* d_in, const int* in_sizes, int n_in, void* d_out, int out_size, void* d_ws, size_t ws_size, hipStream_t stream) {
    static int grid = 0;
    if (grid == 0) {
        if (n_in != 25 || out_size != T * D || ws_size < WS_END) { fprintf(stderr, "kernel_launch: unexpected sizes: n_in %d out %d ws %zu (need %zu)\n", n_in, out_size, ws_size, (size_t)WS_END); grid = -1; return; }
        int dev = 0, cus = 0, per_cu = 0;
        (void)hipGetDevice(&dev); (void)hipDeviceGetAttribute(&cus, hipDeviceAttributeMultiprocessorCount, dev);
        (void)hipFuncSetAttribute((const void*)fwd_kernel, hipFuncAttributeMaxDynamicSharedMemorySize, LDS_BYTES);
        (void)hipOccupancyMaxActiveBlocksPerMultiprocessor(&per_cu, (const void*)fwd_kernel, NTHR, LDS_BYTES);
        (void)hipGetLastError();
        if (per_cu < 1) { fprintf(stderr, "kernel_launch: occupancy query says %d blocks/CU\n", per_cu); }
        grid = cus > 0 ? cus : 256;
    }
    if (grid < 0) return;
    (void)hipMemsetAsync((char*)d_ws + WS_CTL, 0, CTL_BYTES, stream);
    Args a{};
    for (int i = 0; i < 25; ++i) a.in[i] = (const float*)d_in[i];
    a.out = (float*)d_out; a.ws = (unsigned char*)d_ws;
    if (N_LAUNCHES == 1) {
        a.ph_lo = 0; a.ph_hi = NPHASE;
        void* kargs[] = {(void*)&a};
        const hipError_t e = hipLaunchCooperativeKernel((const void*)fwd_kernel, dim3(grid), dim3(NTHR), kargs, LDS_BYTES, stream);
        if (e != hipSuccess) fprintf(stderr, "kernel_launch: cooperative launch failed: %s (grid %d)\n", hipGetErrorString(e), grid);
    } else {
        for (int p = 0; p < NPHASE; ++p) { a.ph_lo = p; a.ph_hi = p + 1; hipLaunchKernelGGL(fwd_kernel, dim3(grid), dim3(NTHR), LDS_BYTES, stream, a); }
    }
}
```
